# Optimizing an MI355X kernel written in HIP

```python
import jax, jax.numpy as jnp
from jax import lax
import numpy as np

D_MODEL = 1024
BATCH = 8
SEQ = 4096
DEPTH = 4

GRID_W = 64
CTX_LEN = 256
HEAD_DIM = 64
A_HEADS = 6
A_W = A_HEADS * HEAD_DIM
W_LORA = 64
A_LORA = 64
G_LORA = 128
A_COLS = 3 * A_W + W_LORA + A_LORA + G_LORA
B_GROUPS = 4
B_W = B_GROUPS * HEAD_DIM
CHUNK = 128
B_COLS = 2 * B_W
C_HEADS = 6
C_KV_HEADS = 2
C_GROUP = C_HEADS // C_KV_HEADS
C_W = C_HEADS * HEAD_DIM
C_KV_W = C_KV_HEADS * HEAD_DIM
C_COLS = C_W + 2 * C_KV_W
Q_BLOCK = 128
ROPE_THETA = 10000.0
ROPE_PAIRS = HEAD_DIM // 4
MIX_W = A_W + B_W + C_W
IN_COLS = A_COLS + B_COLS + C_COLS
D_FF = -(-8 * D_MODEL // (3 * 256)) * 256
NORM_EPS = 1e-6
GN_EPS = 64e-5

kernel_name = "hybrid_rwkv7_gmlp_gqa_prefix_dit"


def rmsnorm(x, g):
    xf = x.astype(jnp.float32)
    y = xf * lax.rsqrt(jnp.mean(xf * xf, axis=-1, keepdims=True) + NORM_EPS)
    return (y * g.astype(jnp.float32)).astype(x.dtype)


def modulate(h, shift, scale):
    return h * (1 + scale) + shift


def swiglu(h, w1, w2):
    gate, up = jnp.split(h @ w1, 2, axis=-1)
    return (jax.nn.silu(gate) * up) @ w2


def short_conv3(z, w):
    zp = jnp.pad(z, ((0, 0), (1, 1), (0, 0)))
    return zp[:, :-2] * w[0] + zp[:, 1:-1] * w[1] + zp[:, 2:] * w[2]


def rope1d(x, ang):
    half = x.shape[-1] // 2
    cos = jnp.cos(ang).astype(x.dtype)
    sin = jnp.sin(ang).astype(x.dtype)
    x1, x2 = x[..., :half], x[..., half:]
    return jnp.concatenate([x1 * cos - x2 * sin, x2 * cos + x1 * sin], axis=-1)


def rope2d(x, ang_row, ang_col):
    half = HEAD_DIM // 2
    return jnp.concatenate([rope1d(x[..., :half], ang_row[None, :, None, :]),
                            rope1d(x[..., half:], ang_col[None, :, None, :])], axis=-1)


def heads(t):
    return t.reshape(t.shape[:-1] + (t.shape[-1] // HEAD_DIM, HEAD_DIM))


def rwkv_prepare(zA, conv, w0, w_up, a0, a_up, g_up, k_k, k_a):
    zA = short_conv3(zA, conv)
    r, k, v, wd, ad, gd = jnp.split(
        zA, [A_W, 2 * A_W, 3 * A_W, 3 * A_W + W_LORA, 3 * A_W + W_LORA + A_LORA], axis=-1)
    w_pre = (w0[:, None, None, :] + jnp.einsum('btr,drc->dbtc', jnp.tanh(wd), w_up)).astype(jnp.float32)
    decay = jnp.exp(-jnp.exp(-jax.nn.softplus(-w_pre) - 0.5))
    a = jax.nn.sigmoid(a0[:, None, None, :] + jnp.einsum('btr,drc->dbtc', ad, a_up))
    g = jax.nn.sigmoid(gd) @ g_up
    kk = heads(k * k_k).astype(jnp.float32)
    kk = kk / jnp.maximum(jnp.sqrt(jnp.sum(kk * kk, axis=-1, keepdims=True)), 1e-12)
    k_dir = k[None] * (1 + (a - 1) * k_a)
    return heads(r), heads(decay), heads(k_dir), heads(v), kk, heads(a), g


def _two_dirs(fwd, bwd):
    return jnp.moveaxis(jnp.stack([fwd, jnp.flip(bwd, axis=1)]).astype(jnp.float32), 2, 0)


def rwkv_scan(r, decay, k_dir, v, kk, a, state0):
    def step(S, inp):
        r_t, w_t, k_t, v_t, kk_t, a_t = inp
        sa = jnp.einsum('dbhij,dbhj->dbhi', S, -kk_t)
        S = S * w_t[..., None, :] + sa[..., :, None] * (kk_t * a_t)[..., None, :] + v_t[..., :, None] * k_t[..., None, :]
        return S, jnp.einsum('dbhij,dbhj->dbhi', S, r_t)
    xs = (_two_dirs(r, r), _two_dirs(decay[0], decay[1]), _two_dirs(k_dir[0], k_dir[1]),
          _two_dirs(v, v), _two_dirs(kk, kk), _two_dirs(a[0], a[1]))
    S, y = lax.scan(step, state0, xs)
    y = jnp.moveaxis(y, 0, 2)
    return y[0] + jnp.flip(y[1], axis=1), S


def rwkv_output(y_sum, r, k_dir, v, g, r_k, ln_g, ln_b, dtype):
    mu = jnp.mean(y_sum, axis=-1, keepdims=True)
    var = jnp.mean(jnp.square(y_sum - mu), axis=-1, keepdims=True)
    yn = ((y_sum - mu) * lax.rsqrt(var + GN_EPS)).reshape(y_sum.shape[:2] + (A_W,))
    yn = yn * ln_g.astype(jnp.float32) + ln_b.astype(jnp.float32)
    bonus = jnp.sum((r[None] * k_dir * r_k).astype(jnp.float32), axis=(0, -1))[..., None] * v.astype(jnp.float32)
    out = (yn + bonus.reshape(yn.shape)) * g.astype(jnp.float32)
    return out.astype(dtype)


def spatial_gate(zB, norm_g, sg_w, sg_b):
    zB = jax.nn.gelu(zB)
    u, v = jnp.split(zB, 2, axis=-1)
    n_b, t = v.shape[:2]
    v = rmsnorm(v.reshape(n_b, t, B_GROUPS, HEAD_DIM), norm_g.reshape(B_GROUPS, HEAD_DIM))
    v = v.reshape(n_b, t // CHUNK, CHUNK, B_GROUPS, HEAD_DIM)
    mixed = jnp.einsum('gpq,bnqgc->bnpgc', sg_w, v) + sg_b.T[:, :, None]
    return u * mixed.reshape(n_b, t, B_W)


def _split_qkv(zC):
    q, k, v = jnp.split(zC, [C_W, C_W + C_KV_W], axis=-1)
    return heads(q), heads(k), heads(v)


def _attend(q, keys, vals):
    s = jnp.einsum('bqhgd,bkhd->bhgqk', q, keys).astype(jnp.float32) * (HEAD_DIM ** -0.5)
    p = jax.nn.softmax(s, axis=-1).astype(vals.dtype)
    return jnp.einsum('bhgqk,bkhd->bqhgd', p, vals)


def gqa_attention(zC, zCc, q_g, k_g, ang_row, ang_col, need_ctx_out):
    q, k, v = _split_qkv(zC)
    qc, kc, vc = _split_qkv(zCc)
    q = rope2d(rmsnorm(q, q_g), ang_row, ang_col)
    k = rope2d(rmsnorm(k, k_g), ang_row, ang_col)
    kc = rmsnorm(kc, k_g)
    k_all = jnp.concatenate([k, kc], axis=1)
    v_all = jnp.concatenate([v, vc], axis=1)
    n_b, t = q.shape[:2]
    qb = q.reshape(n_b, t // Q_BLOCK, Q_BLOCK, C_KV_HEADS, C_GROUP, HEAD_DIM).swapaxes(0, 1)
    o = lax.map(lambda qblk: _attend(qblk, k_all, v_all), qb)
    o = o.swapaxes(0, 1).reshape(n_b, t, C_W)
    oc = None
    if need_ctx_out:
        qc = rmsnorm(qc, q_g).reshape(qc.shape[:2] + (C_KV_HEADS, C_GROUP, HEAD_DIM))
        oc = _attend(qc, kc, vc).reshape(qc.shape[:2] + (C_W,))
    return o, oc


def hybrid_layer(x, xc, c_act, cc_act, ang_row, ang_col, need_ctx_out,
                 n1, n2, ada_w, ada_b, w_in, conv, w0, w_up, a0, a_up, g_up, k_k, k_a, r_k,
                 ln_g, ln_b, sg_norm, sg_w, sg_b, q_g, k_g, w_out, w1, w2):
    sh1, sc1, g1, sh2, sc2, g2 = jnp.split((c_act @ ada_w + ada_b)[:, None, :], 6, axis=-1)
    shc1, scc1, gc1, shc2, scc2, gc2 = jnp.split(cc_act @ ada_w + ada_b, 6, axis=-1)
    z = modulate(rmsnorm(x, n1), sh1, sc1) @ w_in
    zc = modulate(rmsnorm(xc, n1), shc1, scc1) @ w_in
    zA, zB, zC = jnp.split(z, [A_COLS, A_COLS + B_COLS], axis=-1)
    zAc, zBc, zCc = jnp.split(zc, [A_COLS, A_COLS + B_COLS], axis=-1)

    pa = (conv, w0, w_up, a0, a_up, g_up, k_k, k_a)
    rc, dc, kdc, vcc, kkc, ac, gcA = rwkv_prepare(zAc, *pa)
    state0 = jnp.zeros((2, x.shape[0], A_HEADS, HEAD_DIM, HEAD_DIM), jnp.float32)
    yc, state_ctx = rwkv_scan(rc, dc, kdc, vcc, kkc, ac, state0)
    r, d, kd, v, kk, a, gA = rwkv_prepare(zA, *pa)
    y, _ = rwkv_scan(r, d, kd, v, kk, a, state_ctx)
    oA = rwkv_output(y, r, kd, v, gA, r_k, ln_g, ln_b, x.dtype)
    oB = spatial_gate(zB, sg_norm, sg_w, sg_b)
    oC, oCc = gqa_attention(zC, zCc, q_g, k_g, ang_row, ang_col, need_ctx_out)

    x = x + g1 * (jnp.concatenate([oA, oB, oC], axis=-1) @ w_out)
    x = x + g2 * swiglu(modulate(rmsnorm(x, n2), sh2, sc2), w1, w2)
    if need_ctx_out:
        oAc = rwkv_output(yc, rc, kdc, vcc, gcA, r_k, ln_g, ln_b, xc.dtype)
        oBc = spatial_gate(zBc, sg_norm, sg_w, sg_b)
        xc = xc + gc1 * (jnp.concatenate([oAc, oBc, oCc], axis=-1) @ w_out)
        xc = xc + gc2 * swiglu(modulate(rmsnorm(xc, n2), shc2, scc2), w1, w2)
    return x, xc


def setup_inputs(seed: int = 0) -> dict:
    key = jax.random.key(seed)
    ks = jax.random.split(key, 32)
    f32 = jnp.float32

    def nrm(k, shape, scale):
        return jax.random.normal(k, shape, f32) * scale

    conv_base = jnp.array([0.25, 0.8, 0.25], f32)[None, :, None]
    return {
        "x": nrm(ks[0], (BATCH, SEQ, D_MODEL), 1.0),
        "c": nrm(ks[1], (BATCH, D_MODEL), 1.0),
        "ctx": nrm(ks[2], (BATCH, CTX_LEN, D_MODEL), 1.0),
        "c_ctx": nrm(ks[3], (D_MODEL,), 1.0),
        "norm1_g": 1.0 + nrm(ks[4], (DEPTH, D_MODEL), 0.05),
        "norm2_g": 1.0 + nrm(ks[5], (DEPTH, D_MODEL), 0.05),
        "ada_w": nrm(ks[6], (DEPTH, D_MODEL, 6 * D_MODEL), 0.5 * D_MODEL ** -0.5),
        "ada_b": nrm(ks[7], (DEPTH, 6 * D_MODEL), 0.02),
        "w_in": nrm(ks[8], (DEPTH, D_MODEL, IN_COLS), D_MODEL ** -0.5),
        "rwkv_conv": conv_base + nrm(ks[9], (DEPTH, 3, A_COLS), 0.05),
        "rwkv_w0": jax.random.uniform(ks[10], (DEPTH, 2, A_W), f32, -5.0, 0.5),
        "rwkv_w_up": nrm(ks[11], (DEPTH, 2, W_LORA, A_W), 0.5 * W_LORA ** -0.5),
        "rwkv_a0": nrm(ks[12], (DEPTH, 2, A_W), 0.5),
        "rwkv_a_up": nrm(ks[13], (DEPTH, 2, A_LORA, A_W), 0.5 * A_LORA ** -0.5),
        "rwkv_g_up": nrm(ks[14], (DEPTH, G_LORA, A_W), G_LORA ** -0.5),
        "rwkv_k_k": 0.85 + nrm(ks[15], (DEPTH, A_W), 0.05),
        "rwkv_k_a": 1.0 + nrm(ks[16], (DEPTH, A_W), 0.05),
        "rwkv_r_k": nrm(ks[17], (DEPTH, A_HEADS, HEAD_DIM), 0.1),
        "rwkv_ln_g": 1.0 + nrm(ks[18], (DEPTH, A_W), 0.05),
        "rwkv_ln_b": nrm(ks[19], (DEPTH, A_W), 0.02),
        "sg_norm_g": 1.0 + nrm(ks[20], (DEPTH, B_W), 0.05),
        "sg_w": nrm(ks[21], (DEPTH, B_GROUPS, CHUNK, CHUNK), CHUNK ** -0.5),
        "sg_b": 1.0 + nrm(ks[22], (DEPTH, B_GROUPS, CHUNK), 0.05),
        "q_norm_g": 1.0 + nrm(ks[23], (DEPTH, HEAD_DIM), 0.05),
        "k_norm_g": 1.0 + nrm(ks[24], (DEPTH, HEAD_DIM), 0.05),
        "w_out": nrm(ks[25], (DEPTH, MIX_W, D_MODEL), MIX_W ** -0.5),
        "ffn_w1": nrm(ks[26], (DEPTH, D_MODEL, 2 * D_FF), D_MODEL ** -0.5),
        "ffn_w2": nrm(ks[27], (DEPTH, D_FF, D_MODEL), D_FF ** -0.5),
        "final_norm_g": 1.0 + nrm(ks[28], (D_MODEL,), 0.05),
    }


def reference(x, c, ctx, c_ctx, norm1_g, norm2_g, ada_w, ada_b, w_in, rwkv_conv, rwkv_w0, rwkv_w_up,
              rwkv_a0, rwkv_a_up, rwkv_g_up, rwkv_k_k, rwkv_k_a, rwkv_r_k, rwkv_ln_g, rwkv_ln_b,
              sg_norm_g, sg_w, sg_b, q_norm_g, k_norm_g, w_out, ffn_w1, ffn_w2, final_norm_g):
    n_tok = x.shape[1]
    ROWS = n_tok // GRID_W
    row = jnp.repeat(jnp.arange(ROWS, dtype=jnp.float32), GRID_W)
    col = jnp.tile(jnp.arange(GRID_W, dtype=jnp.float32), ROWS)
    inv_freq = ROPE_THETA ** (-jnp.arange(ROPE_PAIRS, dtype=jnp.float32) / ROPE_PAIRS)
    ang_row = row[:, None] * inv_freq[None, :]
    ang_col = col[:, None] * inv_freq[None, :]
    c_act = jax.nn.silu(c)
    cc_act = jax.nn.silu(c_ctx)
    xc = ctx
    for l in range(DEPTH):
        x, xc = hybrid_layer(
            x, xc, c_act, cc_act, ang_row, ang_col, l < DEPTH - 1,
            norm1_g[l], norm2_g[l], ada_w[l], ada_b[l], w_in[l], rwkv_conv[l], rwkv_w0[l], rwkv_w_up[l],
            rwkv_a0[l], rwkv_a_up[l], rwkv_g_up[l], rwkv_k_k[l], rwkv_k_a[l], rwkv_r_k[l], rwkv_ln_g[l],
            rwkv_ln_b[l], sg_norm_g[l], sg_w[l], sg_b[l], q_norm_g[l], k_norm_g[l], w_out[l], ffn_w1[l],
            ffn_w2[l])
    return rmsnorm(x, final_norm_g)
```

```cpp
#include <hip/hip_runtime.h>
#include <hip/hip_bf16.h>
#include <hip/hip_cooperative_groups.h>
#include <cstdio>
namespace cg = cooperative_groups;

typedef __attribute__((ext_vector_type(8))) short bf16x8;
typedef __attribute__((ext_vector_type(4))) float f32x4;
typedef unsigned short u16;

#define DEV __device__ __forceinline__
DEV int tid_l() { int t = threadIdx.x; asm volatile("" : "+v"(t)); return t; }
DEV int bid_l() { int b = blockIdx.x; asm volatile("" : "+s"(b)); return b; }

constexpr int DM = 1024, NBATCH = 8, SEQ = 4096, DEPTH = 4, CTXL = 256;
constexpr int MC = NBATCH * CTXL;
constexpr int ML = NBATCH * SEQ;
constexpr int MT = MC + ML;
constexpr int INC = 2560, DFF = 2816;
constexpr int NMT = MT / 128;

struct P {
  const float *x, *c, *ctx, *c_ctx, *n1g, *n2g, *ada_w, *ada_b, *w_in, *conv, *w0, *w_up, *a0, *a_up, *g_up,
      *k_k, *k_a, *r_k, *ln_g, *ln_b, *sgn, *sg_w, *sg_b, *q_g, *k_g, *w_out, *w1, *w2, *fng;
  float* out;
  u16 *wIn, *wOut, *w1t, *w2t, *wUpT, *aUpT, *gUpT, *sgW;
  float *mods, *rope;
  int* cnt;
  float* xc;
  u16 *act, *z, *h, *vTl, *vTc;
  float *y, *bonus;
};

DEV u16 f2bf(float f) {
  unsigned u = __float_as_uint(f);
  u += 0x7fffu + ((u >> 16) & 1u);
  return (u16)(u >> 16);
}
DEV float bf2f(u16 h) { return __uint_as_float(((unsigned)h) << 16); }
DEV unsigned pk2(float a, float b) { return (unsigned)f2bf(a) | ((unsigned)f2bf(b) << 16); }
DEV float sigmoidf_(float x) { return __builtin_amdgcn_rcpf(1.f + __expf(-x)); }
DEV float siluf_(float x) { return x * __builtin_amdgcn_rcpf(1.f + __expf(-x)); }
DEV float geluf_(float x) {
  float u = 0.7978845608028654f * (x + 0.044715f * x * x * x);
  return 0.5f * x * (1.f + tanhf(u));
}
DEV int swz(int r, int ch) { return r * 128 + ((ch ^ ((r >> 1) & 7)) << 4); }

template <int CTRL>
DEV float dppf(float v) {
  return __int_as_float(__builtin_amdgcn_update_dpp(0, __float_as_int(v), CTRL, 0xF, 0xF, false));
}
DEV float red16_sum(float v) {
  v += dppf<0xB1>(v);
  v += dppf<0x4E>(v);
  v += dppf<0x141>(v);
  v += dppf<0x140>(v);
  return v;
}
DEV float red16_max(float v) {
  v = fmaxf(v, dppf<0xB1>(v));
  v = fmaxf(v, dppf<0x4E>(v));
  v = fmaxf(v, dppf<0x141>(v));
  v = fmaxf(v, dppf<0x140>(v));
  return v;
}
DEV float wave_sum(float v) {
#pragma unroll
  for (int o = 32; o >= 1; o >>= 1) v += __shfl_xor(v, o);
  return v;
}
DEV f32x4 mfma16(bf16x8 a, bf16x8 b, f32x4 c) { return __builtin_amdgcn_mfma_f32_16x16x32_bf16(a, b, c, 0, 0, 0); }

DEV void tr_tile(const float* __restrict__ src, u16* __restrict__ dst, int K, int N, int kt, int nt, bool il, float* lds) {
  const int tid = tid_l();
  const int k0 = kt * 64, n0 = nt * 64;
  {
    const int c = tid & 63, r0 = tid >> 6;
#pragma unroll 4
    for (int i = 0; i < 16; ++i) {
      int r = r0 + i * 4;
      lds[r * 65 + c] = src[(size_t)(k0 + r) * N + n0 + c];
    }
  }
  __syncthreads();
  {
    const int k = tid & 63, nn0 = tid >> 6;
#pragma unroll 4
    for (int i = 0; i < 16; ++i) {
      int n = nn0 + i * 4;
      int gn = n0 + n;
      int np = gn;
      if (il) {
        int j = gn < DFF ? gn : gn - DFF;
        np = (j >> 4) * 32 + (j & 15) + (gn < DFF ? 0 : 16);
      }
      dst[(size_t)np * K + k0 + k] = f2bf(lds[k * 65 + n]);
    }
  }
  __syncthreads();
}

DEV void phase0(const P& p, char* smem) {
  float* lds = (float*)smem;
  const int tid = tid_l();
  constexpr int C0 = 2560, C1 = C0 + 1024, C2 = C1 + 5632, C3 = C2 + 2816, C4 = C3 + 48, C5 = C4 + 48, C6 = C5 + 48,
                C7 = C6 + 64, C8 = C7 + 384, C9 = C8 + 1;
  for (int it = bid_l(); it < C9; it += gridDim.x) {
    if (it < C6) {
      const float* src; u16* dst; int K, N, kt, nt; bool il = false;
      if (it < C0) {
        int l = it / 640, r = it % 640;
        src = p.w_in + (size_t)l * 1024 * 2560; dst = p.wIn + (size_t)l * 2560 * 1024; K = 1024; N = 2560; kt = r / 40; nt = r % 40;
      } else if (it < C1) {
        int i2 = it - C0, l = i2 / 256, r = i2 % 256;
        src = p.w_out + (size_t)l * 1024 * 1024; dst = p.wOut + (size_t)l * 1024 * 1024; K = 1024; N = 1024; kt = r / 16; nt = r % 16;
      } else if (it < C2) {
        int i2 = it - C1, l = i2 / 1408, r = i2 % 1408;
        src = p.w1 + (size_t)l * 1024 * 5632; dst = p.w1t + (size_t)l * 5632 * 1024; K = 1024; N = 5632; kt = r / 88; nt = r % 88; il = true;
      } else if (it < C3) {
        int i2 = it - C2, l = i2 / 704, r = i2 % 704;
        src = p.w2 + (size_t)l * 2816 * 1024; dst = p.w2t + (size_t)l * 1024 * 2816; K = 2816; N = 1024; kt = r / 16; nt = r % 16;
      } else if (it < C4) {
        int i2 = it - C3, bb = i2 / 6;
        src = p.w_up + (size_t)bb * 64 * 384; dst = p.wUpT + (size_t)bb * 384 * 64; K = 64; N = 384; kt = 0; nt = i2 % 6;
      } else if (it < C5) {
        int i2 = it - C4, bb = i2 / 6;
        src = p.a_up + (size_t)bb * 64 * 384; dst = p.aUpT + (size_t)bb * 384 * 64; K = 64; N = 384; kt = 0; nt = i2 % 6;
      } else {
        int i2 = it - C5, l = i2 / 12, r = i2 % 12;
        src = p.g_up + (size_t)l * 128 * 384; dst = p.gUpT + (size_t)l * 384 * 128; K = 128; N = 384; kt = r / 6; nt = r % 6;
      }
      tr_tile(src, dst, K, N, kt, nt, il, lds);
    } else if (it < C7) {
      int i2 = it - C6;
      for (int i = 0; i < 16; ++i) {
        int e = i2 * 4096 + i * 256 + tid;
        p.sgW[e] = f2bf(p.sg_w[e]);
      }
    } else if (it < C8) {
      int i2 = it - C7, l = i2 / 96, cb = i2 % 96;
      for (int e = tid; e < 9 * 1024; e += 256) {
        int s = e >> 10, k = e & 1023;
        float v = s < 8 ? p.c[s * 1024 + k] : p.c_ctx[k];
        lds[e] = siluf_(v);
      }
      __syncthreads();
      const int col = tid & 63, kq = tid >> 6;
      const int n = cb * 64 + col;
      float acc[9];
#pragma unroll
      for (int s = 0; s < 9; ++s) acc[s] = 0.f;
      const float* wp = p.ada_w + (size_t)l * 1024 * 6144 + n;
#pragma unroll 4
      for (int k = kq * 256; k < kq * 256 + 256; ++k) {
        float w = wp[(size_t)k * 6144];
#pragma unroll
        for (int s = 0; s < 9; ++s) acc[s] += lds[s * 1024 + k] * w;
      }
      __syncthreads();
      float* red = lds + 9216;
#pragma unroll
      for (int s = 0; s < 9; ++s) red[(kq * 9 + s) * 64 + col] = acc[s];
      __syncthreads();
      for (int e = tid; e < 9 * 64; e += 256) {
        int s = e >> 6, cc = e & 63;
        float v = red[(0 * 9 + s) * 64 + cc] + red[(1 * 9 + s) * 64 + cc] + red[(2 * 9 + s) * 64 + cc] + red[(3 * 9 + s) * 64 + cc];
        int nn = cb * 64 + cc;
        p.mods[((size_t)l * 9 + s) * 6144 + nn] = v + p.ada_b[l * 6144 + nn];
      }
      __syncthreads();
    } else {
      for (int e = tid; e < 1024; e += 256) {
        int pos = e >> 4, i = e & 15;
        float inv = powf(10000.f, -(float)i / 16.f);
        float ang = (float)pos * inv;
        p.rope[e * 2] = cosf(ang);
        p.rope[e * 2 + 1] = sinf(ang);
      }
      if (tid < 64) p.cnt[tid] = 0;
    }
  }
}

DEV void norm_phase(const P& p, int l, const float* __restrict__ g, int shoff, int scoff, int row_lo, bool from_input) {
  const int tid = tid_l();
  const int lane = tid & 63;
  const int gw = bid_l() * 4 + (tid >> 6), nw = gridDim.x * 4;
  for (int r = row_lo + gw; r < MT; r += nw) {
    const float* src;
    if (from_input) src = r < MC ? p.ctx + (size_t)r * DM : p.x + (size_t)(r - MC) * DM;
    else src = r < MC ? p.xc + (size_t)r * DM : p.out + (size_t)(r - MC) * DM;
    const int s = r < MC ? 8 : (r - MC) >> 12;
    const float* md = p.mods + ((size_t)l * 9 + s) * 6144;
    float4 v[4];
    float ss = 0.f;
#pragma unroll
    for (int i = 0; i < 4; ++i) {
      v[i] = *(const float4*)(src + i * 256 + lane * 4);
      ss += v[i].x * v[i].x + v[i].y * v[i].y + v[i].z * v[i].z + v[i].w * v[i].w;
    }
    ss = wave_sum(ss);
    const float rstd = rsqrtf(ss * (1.f / DM) + 1e-6f);
#pragma unroll
    for (int i = 0; i < 4; ++i) {
      const int c = i * 256 + lane * 4;
      float4 gg = *(const float4*)(g + c);
      float4 sh = *(const float4*)(md + shoff + c);
      float4 sc = *(const float4*)(md + scoff + c);
      float o0 = v[i].x * rstd * gg.x * (1.f + sc.x) + sh.x;
      float o1 = v[i].y * rstd * gg.y * (1.f + sc.y) + sh.y;
      float o2 = v[i].z * rstd * gg.z * (1.f + sc.z) + sh.z;
      float o3 = v[i].w * rstd * gg.w * (1.f + sc.w) + sh.w;
      uint2 o;
      o.x = pk2(o0, o1);
      o.y = pk2(o2, o3);
      *(uint2*)(p.act + (size_t)r * DM + c) = o;
    }
  }
}

DEV void final_norm(const P& p) {
  const int tid = tid_l();
  const int lane = tid & 63;
  const int gw = bid_l() * 4 + (tid >> 6), nw = gridDim.x * 4;
  for (int r = gw; r < ML; r += nw) {
    float* src = p.out + (size_t)r * DM;
    float4 v[4];
    float ss = 0.f;
#pragma unroll
    for (int i = 0; i < 4; ++i) {
      v[i] = *(const float4*)(src + i * 256 + lane * 4);
      ss += v[i].x * v[i].x + v[i].y * v[i].y + v[i].z * v[i].z + v[i].w * v[i].w;
    }
    ss = wave_sum(ss);
    const float rstd = rsqrtf(ss * (1.f / DM) + 1e-6f);
#pragma unroll
    for (int i = 0; i < 4; ++i) {
      const int c = i * 256 + lane * 4;
      float4 gg = *(const float4*)(p.fng + c);
      float4 o;
      o.x = v[i].x * rstd * gg.x;
      o.y = v[i].y * rstd * gg.y;
      o.z = v[i].z * rstd * gg.z;
      o.w = v[i].w * rstd * gg.w;
      *(float4*)(src + c) = o;
    }
  }
}

enum { EPI_Z = 0, EPI_RES = 1, EPI_SWIGLU = 2 };

template <int EPI>
DEV void gemm_phase(const P& p, int l, const u16* __restrict__ A, int lda, const u16* __restrict__ Bt, int K, int NT,
                           int mt_lo, int goff, char* smem) {
  const int tid = tid_l(), lane = tid & 63, wid = tid >> 6, wr = wid >> 1, wc = wid & 1, l15 = lane & 15, quad = lane >> 4;
  const int nmt = NMT - mt_lo;
  const int ntiles = nmt * NT;
  const int nk = K / 64;
  for (int t = bid_l(); t < ntiles; t += gridDim.x) {
    const int g = t / (16 * NT), rem = t % (16 * NT);
    const int nt = rem >> 4, mt = mt_lo + g * 16 + (rem & 15);
    const int m0 = mt * 128, n0 = nt * 128;
    f32x4 acc[4][4];
#pragma unroll
    for (int i = 0; i < 4; ++i)
#pragma unroll
      for (int j = 0; j < 4; ++j) acc[i][j] = f32x4{0.f, 0.f, 0.f, 0.f};
    const u16* Ag = A + (size_t)(m0 + (tid >> 3)) * lda + (tid & 7) * 8;
    const u16* Bg = Bt + (size_t)(n0 + (tid >> 3)) * K + (tid & 7) * 8;
    uint4 ra[4], rb[4];
#pragma unroll
    for (int q = 0; q < 4; ++q) {
      ra[q] = *(const uint4*)(Ag + (size_t)q * 32 * lda);
      rb[q] = *(const uint4*)(Bg + (size_t)q * 32 * K);
    }
#pragma unroll
    for (int q = 0; q < 4; ++q) {
      *(uint4*)(smem + swz((tid >> 3) + q * 32, tid & 7)) = ra[q];
      *(uint4*)(smem + 16384 + swz((tid >> 3) + q * 32, tid & 7)) = rb[q];
    }
    __syncthreads();
    for (int kt = 0; kt < nk; ++kt) {
      const int buf = kt & 1;
      if (kt + 1 < nk) {
        const int k0 = (kt + 1) * 64;
#pragma unroll
        for (int q = 0; q < 4; ++q) {
          ra[q] = *(const uint4*)(Ag + (size_t)q * 32 * lda + k0);
          rb[q] = *(const uint4*)(Bg + (size_t)q * 32 * K + k0);
        }
      }
      const char* As = smem + buf * 32768;
      const char* Bs = As + 16384;
#pragma unroll
      for (int kh = 0; kh < 2; ++kh) {
        bf16x8 a[4], b[4];
#pragma unroll
        for (int mi = 0; mi < 4; ++mi) a[mi] = *(const bf16x8*)(As + swz(wr * 64 + mi * 16 + l15, kh * 4 + quad));
#pragma unroll
        for (int ni = 0; ni < 4; ++ni) b[ni] = *(const bf16x8*)(Bs + swz(wc * 64 + ni * 16 + l15, kh * 4 + quad));
#pragma unroll
        for (int mi = 0; mi < 4; ++mi)
#pragma unroll
          for (int ni = 0; ni < 4; ++ni) acc[mi][ni] = mfma16(a[mi], b[ni], acc[mi][ni]);
      }
      if (kt + 1 < nk) {
        char* Aw = smem + (buf ^ 1) * 32768;
#pragma unroll
        for (int q = 0; q < 4; ++q) {
          *(uint4*)(Aw + swz((tid >> 3) + q * 32, tid & 7)) = ra[q];
          *(uint4*)(Aw + 16384 + swz((tid >> 3) + q * 32, tid & 7)) = rb[q];
        }
      }
      __syncthreads();
    }
    const int cw0 = n0 + wc * 64;
    if constexpr (EPI == EPI_Z) {
      if (cw0 < 1920) {
#pragma unroll
        for (int mi = 0; mi < 4; ++mi)
#pragma unroll
          for (int j = 0; j < 4; ++j) {
            const int r = m0 + wr * 64 + mi * 16 + quad * 4 + j;
#pragma unroll
            for (int ni = 0; ni < 4; ++ni) p.z[(size_t)r * INC + cw0 + ni * 16 + l15] = f2bf(acc[mi][ni][j]);
            __builtin_amdgcn_sched_barrier(0);
          }
      } else {
        const int hh = (cw0 - 1920) >> 6;
        if (hh < 8) {
          const float* gp = (hh < 6 ? p.q_g : p.k_g) + l * 64;
          float gv[4];
#pragma unroll
          for (int ni = 0; ni < 4; ++ni) gv[ni] = gp[ni * 16 + l15];
          const float qs = hh < 6 ? 0.125f : 1.f;
#pragma unroll
          for (int mi = 0; mi < 4; ++mi)
#pragma unroll
            for (int j = 0; j < 4; ++j) {
              const int r = m0 + wr * 64 + mi * 16 + quad * 4 + j;
              float ss = 0.f;
#pragma unroll
              for (int ni = 0; ni < 4; ++ni) ss += acc[mi][ni][j] * acc[mi][ni][j];
              ss = red16_sum(ss);
              const float rstd = rsqrtf(ss * (1.f / 64.f) + 1e-6f);
              float yv[4];
#pragma unroll
              for (int ni = 0; ni < 4; ++ni) yv[ni] = acc[mi][ni][j] * rstd * gv[ni];
              if (r >= MC) {
                const int tt = (r - MC) & 4095;
                const int prow = tt >> 6, pcol = tt & 63;
                const float2 cr = *(const float2*)(p.rope + (prow * 16 + l15) * 2);
                const float2 cc = *(const float2*)(p.rope + (pcol * 16 + l15) * 2);
                float a0 = yv[0] * cr.x - yv[1] * cr.y, a1 = yv[1] * cr.x + yv[0] * cr.y;
                float a2 = yv[2] * cc.x - yv[3] * cc.y, a3 = yv[3] * cc.x + yv[2] * cc.y;
                yv[0] = a0; yv[1] = a1; yv[2] = a2; yv[3] = a3;
              }
#pragma unroll
              for (int ni = 0; ni < 4; ++ni) p.z[(size_t)r * INC + cw0 + ni * 16 + l15] = f2bf(yv[ni] * qs);
              __builtin_amdgcn_sched_barrier(0);
            }
        } else {
          const int kvh = hh - 8;
#pragma unroll
          for (int mi = 0; mi < 4; ++mi) {
            const int r0 = m0 + wr * 64 + mi * 16 + quad * 4;
#pragma unroll
            for (int ni = 0; ni < 4; ++ni) {
              const int d = ni * 16 + l15;
              uint2 o;
              o.x = pk2(acc[mi][ni][0], acc[mi][ni][1]);
              o.y = pk2(acc[mi][ni][2], acc[mi][ni][3]);
              if (r0 < MC) {
                const int b = r0 >> 8, tt = r0 & 255;
                *(uint2*)(p.vTc + ((size_t)((b * 2 + kvh) * 64 + d)) * CTXL + tt) = o;
              } else {
                const int rr = r0 - MC;
                const int b = rr >> 12, tt = rr & 4095;
                *(uint2*)(p.vTl + ((size_t)((b * 2 + kvh) * 64 + d)) * SEQ + tt) = o;
              }
            }
          }
        }
      }
    } else if constexpr (EPI == EPI_RES) {
      const int s = m0 < MC ? 8 : (m0 - MC) >> 12;
      const float* gate = p.mods + ((size_t)l * 9 + s) * 6144 + goff;
      float gv[4];
#pragma unroll
      for (int ni = 0; ni < 4; ++ni) gv[ni] = gate[cw0 + ni * 16 + l15];
#pragma unroll
      for (int mi = 0; mi < 4; ++mi)
#pragma unroll
        for (int j = 0; j < 4; ++j) {
          const int r = m0 + wr * 64 + mi * 16 + quad * 4 + j;
          const float* src;
          if (l == 0 && goff == 2048) src = r < MC ? p.ctx + (size_t)r * DM : p.x + (size_t)(r - MC) * DM;
          else src = r < MC ? p.xc + (size_t)r * DM : p.out + (size_t)(r - MC) * DM;
          float* dst = r < MC ? p.xc + (size_t)r * DM : p.out + (size_t)(r - MC) * DM;
#pragma unroll
          for (int ni = 0; ni < 4; ++ni) {
            const int c = cw0 + ni * 16 + l15;
            dst[c] = src[c] + gv[ni] * acc[mi][ni][j];
          }
          __builtin_amdgcn_sched_barrier(0);
        }
    } else {
      const int hc0 = (n0 >> 1) + wc * 32;
#pragma unroll
      for (int mi = 0; mi < 4; ++mi)
#pragma unroll
        for (int j = 0; j < 4; ++j) {
          const int r = m0 + wr * 64 + mi * 16 + quad * 4 + j;
#pragma unroll
          for (int pp = 0; pp < 2; ++pp) {
            float gt = acc[mi][2 * pp][j], up = acc[mi][2 * pp + 1][j];
            p.h[(size_t)r * DFF + hc0 + pp * 16 + l15] = f2bf(siluf_(gt) * up);
          }
          __builtin_amdgcn_sched_barrier(0);
        }
    }
  }
}

template <int LPR>
DEV float red_lpr(float v) {
  v += dppf<0xB1>(v);
  v += dppf<0x4E>(v);
  if (LPR >= 8) v += dppf<0x141>(v);
  if (LPR >= 16) v += dppf<0x140>(v);
  return v;
}

constexpr int SCAN_LPR = 16;
constexpr int SCAN_NPART = SCAN_LPR / 4;
constexpr int SCAN_ITEMS = 96 * SCAN_NPART;

template <int LPR>
DEV void scan_item(const P& p, int l, int item, char* smem) {
  constexpr int JL = 64 / LPR;
  constexpr int RPB = 256 / LPR;
  constexpr int NPART = LPR / 4;
  const int tid = tid_l(), lane = tid & 63, wid = tid >> 6, l15 = lane & 15, quad = lane >> 4;
  const int scan = item / NPART, part = item % NPART;
  const int d = scan / 48, b = (scan % 48) / 6, h = scan % 6;
  const int rloc = tid / LPR, jq = tid % LPR;
  const int irow = part * RPB + rloc;
  const int j0 = jq * JL;

  float* sR = (float*)smem;
  float* sK = sR + 1024;
  float* sV = sK + 1024;
  float* sW = sV + 1024;
  float* sA = sW + 1024;
  float* sNKK = sA + 1024;
  float* sKA = sNKK + 1024;
  float* sKD = sKA + 1024;
  u16* sRaw = (u16*)(smem + 32768);
  u16* sWD = (u16*)(smem + 32768 + 11520);
  u16* sAD = sWD + 16 * 72;
  float* sCW = (float*)(smem + 32768 + 11520 + 4608);
  float* sY = sCW + 960;

  for (int e = tid; e < 960; e += 256) {
    int tap = e / 320, col = e % 320;
    int seg = col >> 6, c = col & 63;
    int gcol = seg < 3 ? seg * 384 + h * 64 + c : 1152 + (seg - 3) * 64 + c;
    sCW[e] = p.conv[((size_t)l * 3 + tap) * 1408 + gcol];
  }
  bf16x8 bW[2], bA[2];
  {
    const u16* wb = p.wUpT + ((size_t)(l * 2 + d) * 384 + h * 64 + wid * 16 + l15) * 64 + quad * 8;
    const u16* ab = p.aUpT + ((size_t)(l * 2 + d) * 384 + h * 64 + wid * 16 + l15) * 64 + quad * 8;
    bW[0] = *(const bf16x8*)(wb);
    bW[1] = *(const bf16x8*)(wb + 32);
    bA[0] = *(const bf16x8*)(ab);
    bA[1] = *(const bf16x8*)(ab + 32);
  }
  const float w0v = p.w0[(size_t)(l * 2 + d) * 384 + h * 64 + wid * 16 + l15];
  const float a0v = p.a0[(size_t)(l * 2 + d) * 384 + h * 64 + wid * 16 + l15];
  const int dts = tid >> 4, dj = (tid & 15) * 4;
  float kkc[4], kac[4], rkc[4];
#pragma unroll
  for (int i = 0; i < 4; ++i) {
    kkc[i] = p.k_k[l * 384 + h * 64 + dj + i];
    kac[i] = p.k_a[l * 384 + h * 64 + dj + i];
    rkc[i] = p.r_k[l * 384 + h * 64 + dj + i];
  }
  float S[JL];
#pragma unroll
  for (int j = 0; j < JL; ++j) S[j] = 0.f;
  __syncthreads();

  for (int c = 0; c < 272; ++c) {
    const int s0 = c * 16;
    int len, pos0, rowbase;
    if (s0 < 256) { len = 256; pos0 = s0; rowbase = b * 256; }
    else { len = 4096; pos0 = s0 - 256; rowbase = MC + b * 4096; }
    const int tlo = d ? (len - 16 - pos0) : pos0;
    for (int idx = tid; idx < 720; idx += 256) {
      int rr = idx / 40, rem = idx % 40;
      int seg = rem >> 3, ch = rem & 7;
      int tt = tlo - 1 + rr;
      int gcol = (seg < 3 ? seg * 384 + h * 64 : 1152 + (seg - 3) * 64) + ch * 8;
      uint4 v = make_uint4(0, 0, 0, 0);
      if (tt >= 0 && tt < len) v = *(const uint4*)(p.z + (size_t)(rowbase + tt) * INC + gcol);
      *(uint4*)(sRaw + rr * 320 + seg * 64 + ch * 8) = v;
    }
    __syncthreads();
    for (int idx = tid; idx < 5120; idx += 256) {
      int ts = idx / 320, col = idx % 320;
      float v = bf2f(sRaw[ts * 320 + col]) * sCW[col] + bf2f(sRaw[(ts + 1) * 320 + col]) * sCW[320 + col] +
                bf2f(sRaw[(ts + 2) * 320 + col]) * sCW[640 + col];
      int seg = col >> 6, cc = col & 63;
      if (seg == 0) sR[ts * 64 + cc] = v;
      else if (seg == 1) sK[ts * 64 + cc] = v;
      else if (seg == 2) sV[ts * 64 + cc] = v;
      else if (seg == 3) sWD[ts * 72 + cc] = f2bf(tanhf(v));
      else sAD[ts * 72 + cc] = f2bf(v);
    }
    __syncthreads();
    {
      bf16x8 aw0 = *(const bf16x8*)(sWD + l15 * 72 + quad * 8);
      bf16x8 aw1 = *(const bf16x8*)(sWD + l15 * 72 + 32 + quad * 8);
      bf16x8 aa0 = *(const bf16x8*)(sAD + l15 * 72 + quad * 8);
      bf16x8 aa1 = *(const bf16x8*)(sAD + l15 * 72 + 32 + quad * 8);
      f32x4 accW = f32x4{0.f, 0.f, 0.f, 0.f}, accA = f32x4{0.f, 0.f, 0.f, 0.f};
      accW = mfma16(aw0, bW[0], accW);
      accW = mfma16(aw1, bW[1], accW);
      accA = mfma16(aa0, bA[0], accA);
      accA = mfma16(aa1, bA[1], accA);
#pragma unroll
      for (int j = 0; j < 4; ++j) {
        int ts = quad * 4 + j, n = wid * 16 + l15;
        float sg = sigmoidf_(w0v + accW[j]);
        sW[ts * 64 + n] = __expf(-0.6065306597126334f * sg);
        sA[ts * 64 + n] = sigmoidf_(a0v + accA[j]);
      }
    }
    __syncthreads();
    {
      float kv[4], av[4], rv[4], kk[4], kd[4];
      float ss = 0.f, bon = 0.f;
#pragma unroll
      for (int i = 0; i < 4; ++i) {
        kv[i] = sK[dts * 64 + dj + i];
        av[i] = sA[dts * 64 + dj + i];
        rv[i] = sR[dts * 64 + dj + i];
        kk[i] = kv[i] * kkc[i];
        ss += kk[i] * kk[i];
        kd[i] = kv[i] * (1.f + (av[i] - 1.f) * kac[i]);
        bon += rv[i] * kd[i] * rkc[i];
      }
      ss = red16_sum(ss);
      bon = red16_sum(bon);
      const float inv = 1.f / fmaxf(sqrtf(ss), 1e-12f);
#pragma unroll
      for (int i = 0; i < 4; ++i) {
        float kn = kk[i] * inv;
        sNKK[dts * 64 + dj + i] = -kn;
        sKA[dts * 64 + dj + i] = kn * av[i];
        sKD[dts * 64 + dj + i] = kd[i];
      }
      if ((tid & 15) == 0 && part == 0) p.bonus[(size_t)(rowbase + tlo + dts) * 16 + d * 6 + h] = bon;
    }
    __syncthreads();
#pragma unroll 2
    for (int si = 0; si < 16; ++si) {
      const int ts = d ? 15 - si : si;
      float w[JL], nk[JL], ka[JL], kd[JL], rr[JL];
#pragma unroll
      for (int j = 0; j < JL; j += 4) {
        *(float4*)(w + j) = *(const float4*)(sW + ts * 64 + j0 + j);
        *(float4*)(nk + j) = *(const float4*)(sNKK + ts * 64 + j0 + j);
        *(float4*)(ka + j) = *(const float4*)(sKA + ts * 64 + j0 + j);
        *(float4*)(kd + j) = *(const float4*)(sKD + ts * 64 + j0 + j);
        *(float4*)(rr + j) = *(const float4*)(sR + ts * 64 + j0 + j);
      }
      const float vi = sV[ts * 64 + irow];
      float sa = 0.f;
#pragma unroll
      for (int j = 0; j < JL; ++j) sa += S[j] * nk[j];
      sa = red_lpr<LPR>(sa);
      float yv = 0.f;
#pragma unroll
      for (int j = 0; j < JL; ++j) {
        S[j] = S[j] * w[j] + sa * ka[j] + vi * kd[j];
        yv += S[j] * rr[j];
      }
      yv = red_lpr<LPR>(yv);
      if (jq == 0) sY[ts * RPB + rloc] = yv;
    }
    __syncthreads();
    for (int idx = tid; idx < 16 * RPB; idx += 256) {
      int ts = idx / RPB, rl = idx % RPB;
      p.y[((size_t)d * MT + rowbase + tlo + ts) * 384 + h * 64 + part * RPB + rl] = sY[idx];
    }
  }
  __syncthreads();
}

DEV void attn_item(const P& p, int item, char* smem) {
  const int tid = tid_l(), lane = tid & 63, wid = tid >> 6, l15 = lane & 15, quad = lane >> 4;
  bool lat = item < 1536;
  int b, hq, qb;
  if (lat) { b = item / 192; int rem = item % 192; hq = rem / 32; qb = rem % 32; }
  else { int i2 = item - 1536; b = i2 / 12; int rem = i2 % 12; hq = rem / 2; qb = rem % 2; }
  const int kvh = hq / 3;
  const int qrow0 = lat ? MC + b * 4096 + qb * 128 : b * 256 + qb * 128;
  const int nkt = lat ? 68 : 4;
  const float LOG2E = 1.4426950408889634f;

  bf16x8 qf[2][2];
#pragma unroll
  for (int mi = 0; mi < 2; ++mi)
#pragma unroll
    for (int ks = 0; ks < 2; ++ks)
      qf[mi][ks] = *(const bf16x8*)(p.z + (size_t)(qrow0 + wid * 32 + mi * 16 + l15) * INC + 1920 + hq * 64 + ks * 32 + quad * 8);

  f32x4 O[2][4];
  float mrow[2][4], lpart[2][4];
#pragma unroll
  for (int mi = 0; mi < 2; ++mi) {
#pragma unroll
    for (int nd = 0; nd < 4; ++nd) O[mi][nd] = f32x4{0.f, 0.f, 0.f, 0.f};
#pragma unroll
    for (int j = 0; j < 4; ++j) { mrow[mi][j] = -1e30f; lpart[mi][j] = 0.f; }
  }
  char* Ps = smem + 32768 + wid * 4096;
  const int lrow = tid >> 3, lch = tid & 7;
  uint4 rk0, rk1, rv0, rv1;
#define ATT_GLOAD(KT)                                                                         \
  {                                                                                           \
    const int kt_ = (KT);                                                                     \
    const u16* kp;                                                                            \
    const u16* vp;                                                                            \
    int vstride;                                                                              \
    if (lat && kt_ < 64) {                                                                    \
      kp = p.z + (size_t)(MC + b * 4096 + kt_ * 64) * INC + 2304 + kvh * 64;                  \
      vp = p.vTl + (size_t)((b * 2 + kvh) * 64) * SEQ + kt_ * 64;                             \
      vstride = SEQ;                                                                          \
    } else {                                                                                  \
      const int kc = lat ? kt_ - 64 : kt_;                                                    \
      kp = p.z + (size_t)(b * 256 + kc * 64) * INC + 2304 + kvh * 64;                         \
      vp = p.vTc + (size_t)((b * 2 + kvh) * 64) * CTXL + kc * 64;                             \
      vstride = CTXL;                                                                         \
    }                                                                                         \
    rk0 = *(const uint4*)(kp + (size_t)(lrow)*INC + lch * 8);                                 \
    rk1 = *(const uint4*)(kp + (size_t)(lrow + 32) * INC + lch * 8);                          \
    rv0 = *(const uint4*)(vp + (size_t)(lrow)*vstride + lch * 8);                             \
    rv1 = *(const uint4*)(vp + (size_t)(lrow + 32) * vstride + lch * 8);                      \
  }
#define ATT_LSTORE(BUF)                                     \
  {                                                         \
    char* Kb_ = smem + (BUF)*16384;                         \
    *(uint4*)(Kb_ + swz(lrow, lch)) = rk0;                  \
    *(uint4*)(Kb_ + swz(lrow + 32, lch)) = rk1;             \
    *(uint4*)(Kb_ + 8192 + swz(lrow, lch)) = rv0;           \
    *(uint4*)(Kb_ + 8192 + swz(lrow + 32, lch)) = rv1;      \
  }
  ATT_GLOAD(0);
  ATT_LSTORE(0);
  __syncthreads();
  for (int kt = 0; kt < nkt; ++kt) {
    const int buf = kt & 1;
    if (kt + 1 < nkt) ATT_GLOAD(kt + 1);
    const char* Kb = smem + buf * 16384;
    const char* Vb = Kb + 8192;
    f32x4 Sx[2][4];
#pragma unroll
    for (int mi = 0; mi < 2; ++mi)
#pragma unroll
      for (int ni = 0; ni < 4; ++ni) Sx[mi][ni] = f32x4{0.f, 0.f, 0.f, 0.f};
#pragma unroll
    for (int ks = 0; ks < 2; ++ks) {
      bf16x8 kf[4];
#pragma unroll
      for (int ni = 0; ni < 4; ++ni) kf[ni] = *(const bf16x8*)(Kb + swz(ni * 16 + l15, ks * 4 + quad));
#pragma unroll
      for (int mi = 0; mi < 2; ++mi)
#pragma unroll
        for (int ni = 0; ni < 4; ++ni) Sx[mi][ni] = mfma16(qf[mi][ks], kf[ni], Sx[mi][ni]);
    }
#pragma unroll
    for (int mi = 0; mi < 2; ++mi)
#pragma unroll
      for (int j = 0; j < 4; ++j) {
        float mx = fmaxf(fmaxf(Sx[mi][0][j], Sx[mi][1][j]), fmaxf(Sx[mi][2][j], Sx[mi][3][j]));
        mx = red16_max(mx);
        const float mnew = fmaxf(mrow[mi][j], mx);
        const float alpha = __builtin_amdgcn_exp2f((mrow[mi][j] - mnew) * LOG2E);
        mrow[mi][j] = mnew;
        const float mb = mnew * LOG2E;
        float ps = 0.f;
        const int prow = mi * 16 + quad * 4 + j;
#pragma unroll
        for (int ni = 0; ni < 4; ++ni) {
          float pv = __builtin_amdgcn_exp2f(Sx[mi][ni][j] * LOG2E - mb);
          ps += pv;
          *(u16*)(Ps + swz(prow, ni * 2 + (l15 >> 3)) + (l15 & 7) * 2) = f2bf(pv);
        }
        lpart[mi][j] = lpart[mi][j] * alpha + ps;
#pragma unroll
        for (int nd = 0; nd < 4; ++nd) O[mi][nd][j] *= alpha;
      }
    __builtin_amdgcn_fence(__ATOMIC_RELEASE, "wavefront");
    __builtin_amdgcn_wave_barrier();
    __builtin_amdgcn_fence(__ATOMIC_ACQUIRE, "wavefront");
#pragma unroll
    for (int ks = 0; ks < 2; ++ks) {
      bf16x8 pf[2], vf[4];
#pragma unroll
      for (int mi = 0; mi < 2; ++mi) pf[mi] = *(const bf16x8*)(Ps + swz(mi * 16 + l15, ks * 4 + quad));
#pragma unroll
      for (int nd = 0; nd < 4; ++nd) vf[nd] = *(const bf16x8*)(Vb + swz(nd * 16 + l15, ks * 4 + quad));
#pragma unroll
      for (int mi = 0; mi < 2; ++mi)
#pragma unroll
        for (int nd = 0; nd < 4; ++nd) O[mi][nd] = mfma16(pf[mi], vf[nd], O[mi][nd]);
    }
    if (kt + 1 < nkt) ATT_LSTORE(buf ^ 1);
    __syncthreads();
  }
#pragma unroll
  for (int mi = 0; mi < 2; ++mi)
#pragma unroll
    for (int j = 0; j < 4; ++j) {
      const float lsum = red16_sum(lpart[mi][j]);
      const float inv = 1.f / lsum;
      const int r = qrow0 + wid * 32 + mi * 16 + quad * 4 + j;
#pragma unroll
      for (int nd = 0; nd < 4; ++nd) p.act[(size_t)r * DM + 640 + hq * 64 + nd * 16 + l15] = f2bf(O[mi][nd][j] * inv);
    }
}

DEV void sgate_item(const P& p, int l, int ck, int g, char* smem) {
  const int tid = tid_l(), lane = tid & 63, wid = tid >> 6, l15 = lane & 15, quad = lane >> 4;
  const int m0 = ck * 128;
  u16* sVT = (u16*)smem;
  {
    const int q = tid >> 1, half = tid & 1;
    const u16* src = p.z + (size_t)(m0 + q) * INC + 1408 + 256 + g * 64 + half * 32;
    float v[32];
    float ss = 0.f;
#pragma unroll
    for (int cidx = 0; cidx < 4; ++cidx) {
      uint4 u = *(const uint4*)(src + cidx * 8);
      unsigned uu[4] = {u.x, u.y, u.z, u.w};
#pragma unroll
      for (int e = 0; e < 4; ++e) {
        float f0 = geluf_(bf2f((u16)(uu[e] & 0xffff)));
        float f1 = geluf_(bf2f((u16)(uu[e] >> 16)));
        v[cidx * 8 + e * 2] = f0;
        v[cidx * 8 + e * 2 + 1] = f1;
        ss += f0 * f0 + f1 * f1;
      }
    }
    ss += __shfl_xor(ss, 1);
    const float rstd = rsqrtf(ss * (1.f / 64.f) + 1e-6f);
    const float* gn = p.sgn + l * 256 + g * 64 + half * 32;
#pragma unroll
    for (int e = 0; e < 32; ++e) sVT[(half * 32 + e) * 136 + q] = f2bf(v[e] * rstd * gn[e]);
  }
  __syncthreads();
  f32x4 acc[2][4];
#pragma unroll
  for (int mi = 0; mi < 2; ++mi)
#pragma unroll
    for (int ni = 0; ni < 4; ++ni) acc[mi][ni] = f32x4{0.f, 0.f, 0.f, 0.f};
  const u16* Wg = p.sgW + (size_t)(l * 4 + g) * 128 * 128;
#pragma unroll
  for (int ks = 0; ks < 4; ++ks) {
    bf16x8 a[2], bb[4];
#pragma unroll
    for (int mi = 0; mi < 2; ++mi) a[mi] = *(const bf16x8*)(Wg + (size_t)(wid * 32 + mi * 16 + l15) * 128 + ks * 32 + quad * 8);
#pragma unroll
    for (int ni = 0; ni < 4; ++ni) bb[ni] = *(const bf16x8*)(sVT + (ni * 16 + l15) * 136 + ks * 32 + quad * 8);
#pragma unroll
    for (int mi = 0; mi < 2; ++mi)
#pragma unroll
      for (int ni = 0; ni < 4; ++ni) acc[mi][ni] = mfma16(a[mi], bb[ni], acc[mi][ni]);
  }
#pragma unroll
  for (int mi = 0; mi < 2; ++mi)
#pragma unroll
    for (int j = 0; j < 4; ++j) {
      const int pr = wid * 32 + mi * 16 + quad * 4 + j;
      const float bias = p.sg_b[(size_t)(l * 4 + g) * 128 + pr];
#pragma unroll
      for (int ni = 0; ni < 4; ++ni) {
        const int c = ni * 16 + l15;
        float u = geluf_(bf2f(p.z[(size_t)(m0 + pr) * INC + 1408 + g * 64 + c]));
        p.act[(size_t)(m0 + pr) * DM + 384 + g * 64 + c] = f2bf(u * (acc[mi][ni][j] + bias));
      }
    }
  __syncthreads();
}

DEV void mix_phase(const P& p, int l, char* smem) {
  __shared__ int s_item;
  const bool last = (l == DEPTH - 1);
  const int n_attn = last ? 1536 : 1632;
  const int ck_lo = last ? 16 : 0;
  const int n_sg = (NMT - ck_lo) * 4;
  const int total = SCAN_ITEMS + n_attn + n_sg;
  for (;;) {
    if (tid_l() == 0) s_item = atomicAdd(p.cnt + l, 1);
    __syncthreads();
    const int it = s_item;
    __syncthreads();
    if (it >= total) break;
    if (it < SCAN_ITEMS) scan_item<SCAN_LPR>(p, l, it, smem);
    else if (it < SCAN_ITEMS + n_attn) attn_item(p, it - SCAN_ITEMS, smem);
    else {
      int i2 = it - SCAN_ITEMS - n_attn;
      sgate_item(p, l, ck_lo + (i2 >> 2), i2 & 3, smem);
    }
  }
}

DEV void apost_phase(const P& p, int l, int mt_lo, char* smem) {
  const int tid = tid_l(), lane = tid & 63, wid = tid >> 6, l15 = lane & 15, quad = lane >> 4;
  u16* sG = (u16*)smem;
  const float* cw = p.conv + (size_t)l * 3 * 1408;
  for (int mt = mt_lo + bid_l(); mt < NMT; mt += gridDim.x) {
    const int m0 = mt * 128;
    int len, seqbase;
    if (m0 < MC) { len = 256; seqbase = (m0 >> 8) << 8; }
    else { len = 4096; seqbase = MC + (((m0 - MC) >> 12) << 12); }
    {
      const int rr = tid >> 1, half = tid & 1;
      const int r = m0 + rr, tt = r - seqbase;
      const bool hp = tt > 0, hn = tt < len - 1;
#pragma unroll 2
      for (int cidx = 0; cidx < 8; ++cidx) {
        const int gc = 1280 + half * 64 + cidx * 8;
        uint4 u1 = *(const uint4*)(p.z + (size_t)r * INC + gc);
        uint4 u0 = make_uint4(0, 0, 0, 0), u2 = make_uint4(0, 0, 0, 0);
        if (hp) u0 = *(const uint4*)(p.z + (size_t)(r - 1) * INC + gc);
        if (hn) u2 = *(const uint4*)(p.z + (size_t)(r + 1) * INC + gc);
        unsigned a0[4] = {u0.x, u0.y, u0.z, u0.w}, a1[4] = {u1.x, u1.y, u1.z, u1.w}, a2[4] = {u2.x, u2.y, u2.z, u2.w};
        unsigned o[4];
#pragma unroll
        for (int e = 0; e < 4; ++e) {
          const int c0 = gc + e * 2;
          float lo = bf2f((u16)(a0[e] & 0xffff)) * cw[c0] + bf2f((u16)(a1[e] & 0xffff)) * cw[1408 + c0] +
                     bf2f((u16)(a2[e] & 0xffff)) * cw[2816 + c0];
          float hi = bf2f((u16)(a0[e] >> 16)) * cw[c0 + 1] + bf2f((u16)(a1[e] >> 16)) * cw[1408 + c0 + 1] +
                     bf2f((u16)(a2[e] >> 16)) * cw[2816 + c0 + 1];
          o[e] = pk2(sigmoidf_(lo), sigmoidf_(hi));
        }
        *(uint4*)(sG + rr * 136 + half * 64 + cidx * 8) = make_uint4(o[0], o[1], o[2], o[3]);
      }
    }
    __syncthreads();
#pragma unroll 1
    for (int hh = 0; hh < 6; ++hh) {
      f32x4 acc[2][4];
#pragma unroll
      for (int mi = 0; mi < 2; ++mi)
#pragma unroll
        for (int ni = 0; ni < 4; ++ni) acc[mi][ni] = f32x4{0.f, 0.f, 0.f, 0.f};
#pragma unroll
      for (int ks = 0; ks < 4; ++ks) {
        bf16x8 a[2], bb[4];
#pragma unroll
        for (int mi = 0; mi < 2; ++mi) a[mi] = *(const bf16x8*)(sG + (wid * 32 + mi * 16 + l15) * 136 + ks * 32 + quad * 8);
#pragma unroll
        for (int ni = 0; ni < 4; ++ni)
          bb[ni] = *(const bf16x8*)(p.gUpT + ((size_t)l * 384 + hh * 64 + ni * 16 + l15) * 128 + ks * 32 + quad * 8);
#pragma unroll
        for (int mi = 0; mi < 2; ++mi)
#pragma unroll
          for (int ni = 0; ni < 4; ++ni) acc[mi][ni] = mfma16(a[mi], bb[ni], acc[mi][ni]);
      }
      float lg[4], lb[4], cv0[4], cv1[4], cv2[4];
#pragma unroll
      for (int ni = 0; ni < 4; ++ni) {
        const int c = hh * 64 + ni * 16 + l15;
        lg[ni] = p.ln_g[l * 384 + c];
        lb[ni] = p.ln_b[l * 384 + c];
        cv0[ni] = cw[768 + c];
        cv1[ni] = cw[1408 + 768 + c];
        cv2[ni] = cw[2816 + 768 + c];
      }
#pragma unroll
      for (int mi = 0; mi < 2; ++mi)
#pragma unroll
        for (int j = 0; j < 4; ++j) {
          const int r = m0 + wid * 32 + mi * 16 + quad * 4 + j;
          const int tt = r - seqbase;
          const bool hp = tt > 0, hn = tt < len - 1;
          float ys[4];
          float sm = 0.f;
#pragma unroll
          for (int ni = 0; ni < 4; ++ni) {
            const int c = hh * 64 + ni * 16 + l15;
            ys[ni] = p.y[(size_t)r * 384 + c] + p.y[((size_t)MT + r) * 384 + c];
            sm += ys[ni];
          }
          sm = red16_sum(sm);
          const float mean = sm * (1.f / 64.f);
          float vs = 0.f;
#pragma unroll
          for (int ni = 0; ni < 4; ++ni) { ys[ni] -= mean; vs += ys[ni] * ys[ni]; }
          vs = red16_sum(vs);
          const float rstd = rsqrtf(vs * (1.f / 64.f) + 64e-5f);
          const float bon = p.bonus[(size_t)r * 16 + hh] + p.bonus[(size_t)r * 16 + 6 + hh];
#pragma unroll
          for (int ni = 0; ni < 4; ++ni) {
            const int c = hh * 64 + ni * 16 + l15;
            float v = bf2f(p.z[(size_t)r * INC + 768 + c]) * cv1[ni];
            if (hp) v += bf2f(p.z[(size_t)(r - 1) * INC + 768 + c]) * cv0[ni];
            if (hn) v += bf2f(p.z[(size_t)(r + 1) * INC + 768 + c]) * cv2[ni];
            float o = (ys[ni] * rstd * lg[ni] + lb[ni] + bon * v) * acc[mi][ni][j];
            p.act[(size_t)r * DM + c] = f2bf(o);
          }
          __builtin_amdgcn_sched_barrier(0);
        }
    }
    __syncthreads();
  }
}

__global__ void __launch_bounds__(256, 2) fwd_megakernel(P p, int ph_lo, int ph_hi) {
  __shared__ __attribute__((aligned(16))) char smem[65536 - 64];
  cg::grid_group grid = cg::this_grid();
  for (int ph = ph_lo; ph < ph_hi; ++ph) {
    if (ph > ph_lo) grid.sync();
    if (ph == 0) { phase0(p, smem); continue; }
    if (ph == 1 + 8 * DEPTH) { final_norm(p); continue; }
    const int l = (ph - 1) >> 3, sub = (ph - 1) & 7;
    const bool last = (l == DEPTH - 1);
    const int mt_lo = last ? 16 : 0;
    if (sub == 0 || sub == 5) {
      const bool n2 = sub == 5;
      norm_phase(p, l, (n2 ? p.n2g : p.n1g) + l * DM, n2 ? 3072 : 0, n2 ? 4096 : 1024, n2 ? mt_lo * 128 : 0, !n2 && l == 0);
    } else if (sub == 1) {
      gemm_phase<EPI_Z>(p, l, p.act, DM, p.wIn + (size_t)l * 2560 * 1024, 1024, 20, 0, 0, smem);
    } else if (sub == 2) {
      mix_phase(p, l, smem);
    } else if (sub == 3) {
      apost_phase(p, l, mt_lo, smem);
    } else if (sub == 4 || sub == 7) {
      const bool g4 = sub == 7;
      gemm_phase<EPI_RES>(p, l, g4 ? p.h : p.act, g4 ? DFF : DM,
                          g4 ? p.w2t + (size_t)l * 1024 * 2816 : p.wOut + (size_t)l * 1024 * 1024, g4 ? 2816 : 1024, 8, mt_lo,
                          g4 ? 5120 : 2048, smem);
    } else {
      gemm_phase<EPI_SWIGLU>(p, l, p.act, DM, p.w1t + (size_t)l * 5632 * 1024, 1024, 44, mt_lo, 0, smem);
    }
  }
}

extern "C" void kernel_launch(void* const* d_in, const int* in_sizes, int n_in, void* d_out, int out_size, void* d_ws,
                              size_t ws_size, hipStream_t stream) {
  static int grid_blocks = 0;
  if (!grid_blocks) {
    int dev = 0, cus = 0, per_cu = 0;
    hipGetDevice(&dev);
    hipDeviceGetAttribute(&cus, hipDeviceAttributeMultiprocessorCount, dev);
    hipOccupancyMaxActiveBlocksPerMultiprocessor(&per_cu, fwd_megakernel, 256, 0);
    if (per_cu > 2) per_cu = 2;
    if (per_cu < 1) per_cu = 1;
    grid_blocks = cus * per_cu;
  }
  P p{};
  const float* const* in = (const float* const*)d_in;
  p.x = in[0]; p.c = in[1]; p.ctx = in[2]; p.c_ctx = in[3]; p.n1g = in[4]; p.n2g = in[5]; p.ada_w = in[6]; p.ada_b = in[7];
  p.w_in = in[8]; p.conv = in[9]; p.w0 = in[10]; p.w_up = in[11]; p.a0 = in[12]; p.a_up = in[13]; p.g_up = in[14];
  p.k_k = in[15]; p.k_a = in[16]; p.r_k = in[17]; p.ln_g = in[18]; p.ln_b = in[19]; p.sgn = in[20]; p.sg_w = in[21];
  p.sg_b = in[22]; p.q_g = in[23]; p.k_g = in[24]; p.w_out = in[25]; p.w1 = in[26]; p.w2 = in[27]; p.fng = in[28];
  p.out = (float*)d_out;
  char* ws = (char*)d_ws;
  size_t off = 0;
  auto take = [&](size_t bytes) { char* r = ws + off; off += (bytes + 255) & ~(size_t)255; return r; };
  p.wIn = (u16*)take((size_t)4 * 2560 * 1024 * 2);
  p.wOut = (u16*)take((size_t)4 * 1024 * 1024 * 2);
  p.w1t = (u16*)take((size_t)4 * 5632 * 1024 * 2);
  p.w2t = (u16*)take((size_t)4 * 1024 * 2816 * 2);
  p.wUpT = (u16*)take((size_t)8 * 384 * 64 * 2);
  p.aUpT = (u16*)take((size_t)8 * 384 * 64 * 2);
  p.gUpT = (u16*)take((size_t)4 * 384 * 128 * 2);
  p.sgW = (u16*)take((size_t)16 * 128 * 128 * 2);
  p.mods = (float*)take((size_t)4 * 9 * 6144 * 4);
  p.rope = (float*)take(2048 * 4);
  p.cnt = (int*)take(256);
  p.xc = (float*)take((size_t)MC * DM * 4);
  p.act = (u16*)take((size_t)MT * DM * 2);
  p.z = (u16*)take((size_t)MT * DFF * 2);
  p.h = p.z;
  p.vTl = (u16*)take((size_t)16 * 64 * SEQ * 2);
  p.vTc = (u16*)take((size_t)16 * 64 * CTXL * 2);
  p.y = (float*)take((size_t)2 * MT * 384 * 4);
  p.bonus = (float*)take((size_t)MT * 16 * 4);
  if (off > ws_size) { fprintf(stderr, "workspace too small: need %zu have %zu\n", off, ws_size); return; }
  int ph_lo = 0, ph_hi = 2 + 8 * DEPTH;
  void* args[] = {&p, &ph_lo, &ph_hi};
  hipError_t e = hipLaunchCooperativeKernel((void*)fwd_megakernel, dim3(grid_blocks), dim3(256), args, 0, stream);
  if (e != hipSuccess) fprintf(stderr, "cooperative launch failed: %s (grid %d)\n", hipGetErrorString(e), grid_blocks);
}
```

```cpp
#include <hip/hip_runtime.h>
#include <hip/hip_bf16.h>
#include <hip/hip_cooperative_groups.h>
#include <cstdio>
namespace cg = cooperative_groups;

typedef __attribute__((ext_vector_type(8))) short bf16x8;
typedef __attribute__((ext_vector_type(4))) float f32x4;
typedef unsigned short u16;
typedef __attribute__((ext_vector_type(2))) float float2v;

#define DEV __device__ __forceinline__
DEV int tid_l() { int t = threadIdx.x; asm volatile("" : "+v"(t)); return t; }
DEV int bid_l() { int b = blockIdx.x; asm volatile("" : "+s"(b)); return b; }

constexpr int DM = 1024, NBATCH = 8, SEQ = 4096, DEPTH = 4, CTXL = 256;
constexpr int MC = NBATCH * CTXL;
constexpr int ML = NBATCH * SEQ;
constexpr int MT = MC + ML;
constexpr int INC = 2560, DFF = 2816;
constexpr int NMT = MT / 128;
#ifndef PROBE_MASK
#define PROBE_MASK 0
#endif
#define SCAN_REP 1
#define ATT_REP 1
#define SG_REP 1

struct P {
  const float *x, *c, *ctx, *c_ctx, *n1g, *n2g, *ada_w, *ada_b, *w_in, *conv, *w0, *w_up, *a0, *a_up, *g_up,
      *k_k, *k_a, *r_k, *ln_g, *ln_b, *sgn, *sg_w, *sg_b, *q_g, *k_g, *w_out, *w1, *w2, *fng;
  float* out;
  u16 *wIn, *wOut, *w1t, *w2t, *wUpT, *aUpT, *gUpT, *sgW;
  float *mods, *rope;
  int* cnt;
  float* xc;
  u16 *act, *z, *h, *vTl, *vTc;
  float *y, *bonus, *invn;
};

DEV u16 f2bf(float f) {
  unsigned u = __float_as_uint(f);
  u += 0x7fffu + ((u >> 16) & 1u);
  return (u16)(u >> 16);
}
DEV float bf2f(u16 h) { return __uint_as_float(((unsigned)h) << 16); }
DEV unsigned pk2(float a, float b) { return (unsigned)f2bf(a) | ((unsigned)f2bf(b) << 16); }
DEV float sigmoidf_(float x) { return __builtin_amdgcn_rcpf(1.f + __expf(-x)); }
DEV float siluf_(float x) { return x * __builtin_amdgcn_rcpf(1.f + __expf(-x)); }
DEV float geluf_(float x) {
  float u = 0.7978845608028654f * (x + 0.044715f * x * x * x);
  return 0.5f * x * (1.f + tanhf(u));
}
DEV int swz(int r, int ch) { return r * 128 + ((ch ^ ((r >> 1) & 7)) << 4); }

template <int CTRL>
DEV float dppf(float v) {
  return __int_as_float(__builtin_amdgcn_update_dpp(0, __float_as_int(v), CTRL, 0xF, 0xF, false));
}
DEV float red16_sum(float v) {
  v += dppf<0xB1>(v);
  v += dppf<0x4E>(v);
  v += dppf<0x141>(v);
  v += dppf<0x140>(v);
  return v;
}
DEV float red16_max(float v) {
  v = fmaxf(v, dppf<0xB1>(v));
  v = fmaxf(v, dppf<0x4E>(v));
  v = fmaxf(v, dppf<0x141>(v));
  v = fmaxf(v, dppf<0x140>(v));
  return v;
}
DEV float wave_sum(float v) {
#pragma unroll
  for (int o = 32; o >= 1; o >>= 1) v += __shfl_xor(v, o);
  return v;
}
DEV f32x4 mfma16(bf16x8 a, bf16x8 b, f32x4 c) { return __builtin_amdgcn_mfma_f32_16x16x32_bf16(a, b, c, 0, 0, 0); }

DEV void tr_tile(const float* __restrict__ src, u16* __restrict__ dst, int K, int N, int kt, int nt, bool il, float* lds) {
  const int tid = tid_l();
  const int k0 = kt * 64, n0 = nt * 64;
  {
    const int c = tid & 63, r0 = tid >> 6;
#pragma unroll 4
    for (int i = 0; i < 16; ++i) {
      int r = r0 + i * 4;
      lds[r * 65 + c] = src[(size_t)(k0 + r) * N + n0 + c];
    }
  }
  __syncthreads();
  {
    const int k = tid & 63, nn0 = tid >> 6;
#pragma unroll 4
    for (int i = 0; i < 16; ++i) {
      int n = nn0 + i * 4;
      int gn = n0 + n;
      int np = gn;
      if (il) {
        int j = gn < DFF ? gn : gn - DFF;
        np = (j >> 4) * 32 + (j & 15) + (gn < DFF ? 0 : 16);
      }
      dst[(size_t)np * K + k0 + k] = f2bf(lds[k * 65 + n]);
    }
  }
  __syncthreads();
}

DEV void phase0(const P& p, char* smem) {
  float* lds = (float*)smem;
  const int tid = tid_l();
  constexpr int C0 = 2560, C1 = C0 + 1024, C2 = C1 + 5632, C3 = C2 + 2816, C4 = C3 + 48, C5 = C4 + 48, C6 = C5 + 48,
                C7 = C6 + 64, C8 = C7 + 384, C9 = C8 + 1;
  for (int it = bid_l(); it < C9; it += gridDim.x) {
    if (it < C6) {
      const float* src; u16* dst; int K, N, kt, nt; bool il = false;
      if (it < C0) {
        int l = it / 640, r = it % 640;
        src = p.w_in + (size_t)l * 1024 * 2560; dst = p.wIn + (size_t)l * 2560 * 1024; K = 1024; N = 2560; kt = r / 40; nt = r % 40;
      } else if (it < C1) {
        int i2 = it - C0, l = i2 / 256, r = i2 % 256;
        src = p.w_out + (size_t)l * 1024 * 1024; dst = p.wOut + (size_t)l * 1024 * 1024; K = 1024; N = 1024; kt = r / 16; nt = r % 16;
      } else if (it < C2) {
        int i2 = it - C1, l = i2 / 1408, r = i2 % 1408;
        src = p.w1 + (size_t)l * 1024 * 5632; dst = p.w1t + (size_t)l * 5632 * 1024; K = 1024; N = 5632; kt = r / 88; nt = r % 88; il = true;
      } else if (it < C3) {
        int i2 = it - C2, l = i2 / 704, r = i2 % 704;
        src = p.w2 + (size_t)l * 2816 * 1024; dst = p.w2t + (size_t)l * 1024 * 2816; K = 2816; N = 1024; kt = r / 16; nt = r % 16;
      } else if (it < C4) {
        int i2 = it - C3, bb = i2 / 6;
        src = p.w_up + (size_t)bb * 64 * 384; dst = p.wUpT + (size_t)bb * 384 * 64; K = 64; N = 384; kt = 0; nt = i2 % 6;
      } else if (it < C5) {
        int i2 = it - C4, bb = i2 / 6;
        src = p.a_up + (size_t)bb * 64 * 384; dst = p.aUpT + (size_t)bb * 384 * 64; K = 64; N = 384; kt = 0; nt = i2 % 6;
      } else {
        int i2 = it - C5, l = i2 / 12, r = i2 % 12;
        src = p.g_up + (size_t)l * 128 * 384; dst = p.gUpT + (size_t)l * 384 * 128; K = 128; N = 384; kt = r / 6; nt = r % 6;
      }
      tr_tile(src, dst, K, N, kt, nt, il, lds);
    } else if (it < C7) {
      int i2 = it - C6;
      for (int i = 0; i < 16; ++i) {
        int e = i2 * 4096 + i * 256 + tid;
        p.sgW[e] = f2bf(p.sg_w[e]);
      }
    } else if (it < C8) {
      int i2 = it - C7, l = i2 / 96, cb = i2 % 96;
      for (int e = tid; e < 9 * 1024; e += 256) {
        int s = e >> 10, k = e & 1023;
        float v = s < 8 ? p.c[s * 1024 + k] : p.c_ctx[k];
        lds[e] = siluf_(v);
      }
      __syncthreads();
      const int col = tid & 63, kq = tid >> 6;
      const int n = cb * 64 + col;
      float acc[9];
#pragma unroll
      for (int s = 0; s < 9; ++s) acc[s] = 0.f;
      const float* wp = p.ada_w + (size_t)l * 1024 * 6144 + n;
#pragma unroll 4
      for (int k = kq * 256; k < kq * 256 + 256; ++k) {
        float w = wp[(size_t)k * 6144];
#pragma unroll
        for (int s = 0; s < 9; ++s) acc[s] += lds[s * 1024 + k] * w;
      }
      __syncthreads();
      float* red = lds + 9216;
#pragma unroll
      for (int s = 0; s < 9; ++s) red[(kq * 9 + s) * 64 + col] = acc[s];
      __syncthreads();
      for (int e = tid; e < 9 * 64; e += 256) {
        int s = e >> 6, cc = e & 63;
        float v = red[(0 * 9 + s) * 64 + cc] + red[(1 * 9 + s) * 64 + cc] + red[(2 * 9 + s) * 64 + cc] + red[(3 * 9 + s) * 64 + cc];
        int nn = cb * 64 + cc;
        p.mods[((size_t)l * 9 + s) * 6144 + nn] = v + p.ada_b[l * 6144 + nn];
      }
      __syncthreads();
    } else {
      for (int e = tid; e < 1024; e += 256) {
        int pos = e >> 4, i = e & 15;
        float inv = powf(10000.f, -(float)i / 16.f);
        float ang = (float)pos * inv;
        p.rope[e * 2] = cosf(ang);
        p.rope[e * 2 + 1] = sinf(ang);
      }
      if (tid < 64) p.cnt[tid] = 0;
    }
  }
}

DEV void norm_phase(const P& p, int l, const float* __restrict__ g, int shoff, int scoff, int row_lo, bool from_input) {
  const int tid = tid_l();
  const int lane = tid & 63;
  const int gw = bid_l() * 4 + (tid >> 6), nw = gridDim.x * 4;
  for (int r = row_lo + gw; r < MT; r += nw) {
    const float* src;
    if (from_input) src = r < MC ? p.ctx + (size_t)r * DM : p.x + (size_t)(r - MC) * DM;
    else src = r < MC ? p.xc + (size_t)r * DM : p.out + (size_t)(r - MC) * DM;
    const int s = r < MC ? 8 : (r - MC) >> 12;
    const float* md = p.mods + ((size_t)l * 9 + s) * 6144;
    float4 v[4];
    float ss = 0.f;
#pragma unroll
    for (int i = 0; i < 4; ++i) {
      v[i] = *(const float4*)(src + i * 256 + lane * 4);
      ss += v[i].x * v[i].x + v[i].y * v[i].y + v[i].z * v[i].z + v[i].w * v[i].w;
    }
    ss = wave_sum(ss);
    const float rstd = rsqrtf(ss * (1.f / DM) + 1e-6f);
#pragma unroll
    for (int i = 0; i < 4; ++i) {
      const int c = i * 256 + lane * 4;
      float4 gg = *(const float4*)(g + c);
      float4 sh = *(const float4*)(md + shoff + c);
      float4 sc = *(const float4*)(md + scoff + c);
      float o0 = v[i].x * rstd * gg.x * (1.f + sc.x) + sh.x;
      float o1 = v[i].y * rstd * gg.y * (1.f + sc.y) + sh.y;
      float o2 = v[i].z * rstd * gg.z * (1.f + sc.z) + sh.z;
      float o3 = v[i].w * rstd * gg.w * (1.f + sc.w) + sh.w;
      uint2 o;
      o.x = pk2(o0, o1);
      o.y = pk2(o2, o3);
      *(uint2*)(p.act + (size_t)r * DM + c) = o;
    }
  }
}

DEV void final_norm(const P& p) {
  const int tid = tid_l();
  const int lane = tid & 63;
  const int gw = bid_l() * 4 + (tid >> 6), nw = gridDim.x * 4;
  for (int r = gw; r < ML; r += nw) {
    float* src = p.out + (size_t)r * DM;
    float4 v[4];
    float ss = 0.f;
#pragma unroll
    for (int i = 0; i < 4; ++i) {
      v[i] = *(const float4*)(src + i * 256 + lane * 4);
      ss += v[i].x * v[i].x + v[i].y * v[i].y + v[i].z * v[i].z + v[i].w * v[i].w;
    }
    ss = wave_sum(ss);
    const float rstd = rsqrtf(ss * (1.f / DM) + 1e-6f);
#pragma unroll
    for (int i = 0; i < 4; ++i) {
      const int c = i * 256 + lane * 4;
      float4 gg = *(const float4*)(p.fng + c);
      float4 o;
      o.x = v[i].x * rstd * gg.x;
      o.y = v[i].y * rstd * gg.y;
      o.z = v[i].z * rstd * gg.z;
      o.w = v[i].w * rstd * gg.w;
      *(float4*)(src + c) = o;
    }
  }
}

enum { EPI_Z = 0, EPI_RES = 1, EPI_SWIGLU = 2 };

template <int EPI>
DEV void gemm_phase(const P& p, int l, const u16* __restrict__ A, int lda, const u16* __restrict__ Bt, int K, int NT,
                           int mt_lo, int goff, char* smem, int dry = 0) {
  const int tid = tid_l(), lane = tid & 63, wid = tid >> 6, wr = wid >> 1, wc = wid & 1, l15 = lane & 15, quad = lane >> 4;
  const int nmt = NMT - mt_lo;
  const int ntiles = nmt * NT;
  const int nk = K / 64;
  for (int t = bid_l(); t < ntiles; t += gridDim.x) {
    const int g = t / (16 * NT), rem = t % (16 * NT);
    const int nt = rem >> 4, mt = mt_lo + g * 16 + (rem & 15);
    const int m0 = mt * 128, n0 = nt * 128;
    f32x4 acc[4][4];
#pragma unroll
    for (int i = 0; i < 4; ++i)
#pragma unroll
      for (int j = 0; j < 4; ++j) acc[i][j] = f32x4{0.f, 0.f, 0.f, 0.f};
    const u16* Ag = A + (size_t)(m0 + (tid >> 3)) * lda + (tid & 7) * 8;
    const u16* Bg = Bt + (size_t)(n0 + (tid >> 3)) * K + (tid & 7) * 8;
    uint4 ra[4], rb[4];
#pragma unroll
    for (int q = 0; q < 4; ++q) {
      ra[q] = *(const uint4*)(Ag + (size_t)q * 32 * lda);
      rb[q] = *(const uint4*)(Bg + (size_t)q * 32 * K);
    }
#pragma unroll
    for (int q = 0; q < 4; ++q) {
      *(uint4*)(smem + swz((tid >> 3) + q * 32, tid & 7)) = ra[q];
      *(uint4*)(smem + 16384 + swz((tid >> 3) + q * 32, tid & 7)) = rb[q];
    }
    __syncthreads();
    for (int kt = 0; kt < nk; ++kt) {
      const int buf = kt & 1;
      if (kt + 1 < nk) {
        const int k0 = (kt + 1) * 64;
#pragma unroll
        for (int q = 0; q < 4; ++q) {
          ra[q] = *(const uint4*)(Ag + (size_t)q * 32 * lda + k0);
          rb[q] = *(const uint4*)(Bg + (size_t)q * 32 * K + k0);
        }
      }
      const char* As = smem + buf * 32768;
      const char* Bs = As + 16384;
#pragma unroll
      for (int kh = 0; kh < 2; ++kh) {
        bf16x8 a[4], b[4];
#pragma unroll
        for (int mi = 0; mi < 4; ++mi) a[mi] = *(const bf16x8*)(As + swz(wr * 64 + mi * 16 + l15, kh * 4 + quad));
#pragma unroll
        for (int ni = 0; ni < 4; ++ni) b[ni] = *(const bf16x8*)(Bs + swz(wc * 64 + ni * 16 + l15, kh * 4 + quad));
#pragma unroll
        for (int mi = 0; mi < 4; ++mi)
#pragma unroll
          for (int ni = 0; ni < 4; ++ni) acc[mi][ni] = mfma16(a[mi], b[ni], acc[mi][ni]);
      }
      if (kt + 1 < nk) {
        char* Aw = smem + (buf ^ 1) * 32768;
#pragma unroll
        for (int q = 0; q < 4; ++q) {
          *(uint4*)(Aw + swz((tid >> 3) + q * 32, tid & 7)) = ra[q];
          *(uint4*)(Aw + 16384 + swz((tid >> 3) + q * 32, tid & 7)) = rb[q];
        }
      }
      __syncthreads();
    }
    if (dry) {
      if (acc[0][0][0] == 1.2345e33f) p.bonus[0] = acc[1][1][1] + acc[2][2][2] + acc[3][3][3];
      continue;
    }
    const int cw0 = n0 + wc * 64;
    if constexpr (EPI == EPI_Z) {
      if (cw0 < 1920) {
#pragma unroll
        for (int mi = 0; mi < 4; ++mi)
#pragma unroll
          for (int j = 0; j < 4; ++j) {
            const int r = m0 + wr * 64 + mi * 16 + quad * 4 + j;
#pragma unroll
            for (int ni = 0; ni < 4; ++ni) p.z[(size_t)r * INC + cw0 + ni * 16 + l15] = f2bf(acc[mi][ni][j]);
            __builtin_amdgcn_sched_barrier(0);
          }
      } else {
        const int hh = (cw0 - 1920) >> 6;
        if (hh < 8) {
          const float* gp = (hh < 6 ? p.q_g : p.k_g) + l * 64;
          float gv[4];
#pragma unroll
          for (int ni = 0; ni < 4; ++ni) gv[ni] = gp[ni * 16 + l15];
          const float qs = hh < 6 ? 0.125f : 1.f;
#pragma unroll
          for (int mi = 0; mi < 4; ++mi)
#pragma unroll
            for (int j = 0; j < 4; ++j) {
              const int r = m0 + wr * 64 + mi * 16 + quad * 4 + j;
              float ss = 0.f;
#pragma unroll
              for (int ni = 0; ni < 4; ++ni) ss += acc[mi][ni][j] * acc[mi][ni][j];
              ss = red16_sum(ss);
              const float rstd = rsqrtf(ss * (1.f / 64.f) + 1e-6f);
              float yv[4];
#pragma unroll
              for (int ni = 0; ni < 4; ++ni) yv[ni] = acc[mi][ni][j] * rstd * gv[ni];
              if (r >= MC) {
                const int tt = (r - MC) & 4095;
                const int prow = tt >> 6, pcol = tt & 63;
                const float2 cr = *(const float2*)(p.rope + (prow * 16 + l15) * 2);
                const float2 cc = *(const float2*)(p.rope + (pcol * 16 + l15) * 2);
                float a0 = yv[0] * cr.x - yv[1] * cr.y, a1 = yv[1] * cr.x + yv[0] * cr.y;
                float a2 = yv[2] * cc.x - yv[3] * cc.y, a3 = yv[3] * cc.x + yv[2] * cc.y;
                yv[0] = a0; yv[1] = a1; yv[2] = a2; yv[3] = a3;
              }
#pragma unroll
              for (int ni = 0; ni < 4; ++ni) p.z[(size_t)r * INC + cw0 + ni * 16 + l15] = f2bf(yv[ni] * qs);
              __builtin_amdgcn_sched_barrier(0);
            }
        } else {
          const int kvh = hh - 8;
#pragma unroll
          for (int mi = 0; mi < 4; ++mi) {
            const int r0 = m0 + wr * 64 + mi * 16 + quad * 4;
#pragma unroll
            for (int ni = 0; ni < 4; ++ni) {
              const int d = ni * 16 + l15;
              uint2 o;
              o.x = pk2(acc[mi][ni][0], acc[mi][ni][1]);
              o.y = pk2(acc[mi][ni][2], acc[mi][ni][3]);
              if (r0 < MC) {
                const int b = r0 >> 8, tt = r0 & 255;
                *(uint2*)(p.vTc + ((size_t)((b * 2 + kvh) * 64 + d)) * CTXL + tt) = o;
              } else {
                const int rr = r0 - MC;
                const int b = rr >> 12, tt = rr & 4095;
                *(uint2*)(p.vTl + ((size_t)((b * 2 + kvh) * 64 + d)) * SEQ + tt) = o;
              }
            }
          }
        }
      }
    } else if constexpr (EPI == EPI_RES) {
      const int s = m0 < MC ? 8 : (m0 - MC) >> 12;
      const float* gate = p.mods + ((size_t)l * 9 + s) * 6144 + goff;
      float gv[4];
#pragma unroll
      for (int ni = 0; ni < 4; ++ni) gv[ni] = gate[cw0 + ni * 16 + l15];
#pragma unroll
      for (int mi = 0; mi < 4; ++mi)
#pragma unroll
        for (int j = 0; j < 4; ++j) {
          const int r = m0 + wr * 64 + mi * 16 + quad * 4 + j;
          const float* src;
          if (l == 0 && goff == 2048) src = r < MC ? p.ctx + (size_t)r * DM : p.x + (size_t)(r - MC) * DM;
          else src = r < MC ? p.xc + (size_t)r * DM : p.out + (size_t)(r - MC) * DM;
          float* dst = r < MC ? p.xc + (size_t)r * DM : p.out + (size_t)(r - MC) * DM;
#pragma unroll
          for (int ni = 0; ni < 4; ++ni) {
            const int c = cw0 + ni * 16 + l15;
            dst[c] = src[c] + gv[ni] * acc[mi][ni][j];
          }
          __builtin_amdgcn_sched_barrier(0);
        }
    } else {
      const int hc0 = (n0 >> 1) + wc * 32;
#pragma unroll
      for (int mi = 0; mi < 4; ++mi)
#pragma unroll
        for (int j = 0; j < 4; ++j) {
          const int r = m0 + wr * 64 + mi * 16 + quad * 4 + j;
#pragma unroll
          for (int pp = 0; pp < 2; ++pp) {
            float gt = acc[mi][2 * pp][j], up = acc[mi][2 * pp + 1][j];
            p.h[(size_t)r * DFF + hc0 + pp * 16 + l15] = f2bf(siluf_(gt) * up);
          }
          __builtin_amdgcn_sched_barrier(0);
        }
    }
  }
}

template <int LPR>
DEV float red_lpr(float v) {
  v += dppf<0xB1>(v);
  v += dppf<0x4E>(v);
  if (LPR >= 8) v += dppf<0x141>(v);
  if (LPR >= 16) v += dppf<0x140>(v);
  return v;
}

constexpr int SCAN_ITEMS = 192;

DEV float red8_sum(float v) {
  v += dppf<0xB1>(v);
  v += dppf<0x4E>(v);
  v += dppf<0x141>(v);
  return v;
}
DEV float tanh_fast(float x) {
  float e = __expf(2.f * x);
  return 1.f - 2.f * __builtin_amdgcn_rcpf(1.f + e);
}

struct ChunkPos { int len, rowbase, tlo; };
DEV ChunkPos chunk_pos(int c, int d, int b) {
  ChunkPos cp;
  const int s0 = c * 16;
  int pos0;
  if (s0 < 256) { cp.len = 256; pos0 = s0; cp.rowbase = b * 256; }
  else { cp.len = 4096; pos0 = s0 - 256; cp.rowbase = MC + b * 4096; }
  cp.tlo = d ? (cp.len - 16 - pos0) : pos0;
  return cp;
}

constexpr int SC_R = 0, SC_KD = 12288, SC_V = 24576, SC_W = 30720, SC_KA = 38912, SC_NKK = 47104;

DEV void cvt8(const uint4 u, float4& lo, float4& hi) {
  lo.x = __uint_as_float(u.x << 16); lo.y = __uint_as_float(u.x & 0xffff0000u);
  lo.z = __uint_as_float(u.y << 16); lo.w = __uint_as_float(u.y & 0xffff0000u);
  hi.x = __uint_as_float(u.z << 16); hi.y = __uint_as_float(u.z & 0xffff0000u);
  hi.z = __uint_as_float(u.w << 16); hi.w = __uint_as_float(u.w & 0xffff0000u);
}

DEV void scan_item(const P& p, int l, int item, char* smem) {
  const int tid = tid_l(), lane = tid & 63, wid = tid >> 6, l15 = lane & 15, quad = lane >> 4;
  const int scan = item >> 1, part = item & 1;
  const int d = scan / 48, b = (scan % 48) / 6, h = scan % 6;
  const int rloc = tid >> 3, jq = tid & 7;
  const int irow = part * 32 + rloc;
  const int j0 = jq * 8;

  const int c_ts = (tid & 127) >> 3, c_ch = tid & 7;
  const int c_col = (tid < 128 ? 0 : 384) + h * 64 + c_ch * 8;
  const int v_ts = tid >> 2, v_ch = tid & 3;
  const int v_col = 768 + h * 64 + part * 32 + v_ch * 8;

  const int n2 = wid * 16 + l15;
  bf16x8 bW[2], bA[2];
  {
    const u16* wb = p.wUpT + ((size_t)(l * 2 + d) * 384 + h * 64 + n2) * 64 + quad * 8;
    const u16* ab = p.aUpT + ((size_t)(l * 2 + d) * 384 + h * 64 + n2) * 64 + quad * 8;
    bW[0] = *(const bf16x8*)(wb);
    bW[1] = *(const bf16x8*)(wb + 32);
    bA[0] = *(const bf16x8*)(ab);
    bA[1] = *(const bf16x8*)(ab + 32);
  }
  const float w0v = p.w0[(size_t)(l * 2 + d) * 384 + h * 64 + n2];
  const float a0v = p.a0[(size_t)(l * 2 + d) * 384 + h * 64 + n2];
  const float kkc = p.k_k[l * 384 + h * 64 + n2], kac = p.k_a[l * 384 + h * 64 + n2], rkc = p.r_k[l * 384 + h * 64 + n2];

  float2v S2[4];
#pragma unroll
  for (int j = 0; j < 4; ++j) S2[j] = float2v{0.f, 0.f};
  uint4 g_rk, g_v;
  bf16x8 g_wd0, g_wd1, g_ad0, g_ad1;
  float g_inv[4];

#define SC_GLOAD1(CC)                                                                                  \
  {                                                                                                    \
    const ChunkPos cp_ = chunk_pos((CC), d, b);                                                        \
    g_rk = *(const uint4*)(p.z + (size_t)(cp_.rowbase + cp_.tlo + c_ts) * INC + c_col);                \
    if (tid < 64) g_v = *(const uint4*)(p.z + (size_t)(cp_.rowbase + cp_.tlo + v_ts) * INC + v_col);  \
  }
#define SC_GLOAD2(CC)                                                                                  \
  {                                                                                                    \
    const ChunkPos cp_ = chunk_pos((CC), d, b);                                                        \
    const u16* rp_ = p.z + (size_t)(cp_.rowbase + cp_.tlo + l15) * INC + 1152 + quad * 8;              \
    g_wd0 = *(const bf16x8*)(rp_);                                                                     \
    g_wd1 = *(const bf16x8*)(rp_ + 32);                                                                \
    g_ad0 = *(const bf16x8*)(rp_ + 64);                                                                \
    g_ad1 = *(const bf16x8*)(rp_ + 96);                                                                \
    _Pragma("unroll") for (int j = 0; j < 4; ++j)                                                      \
      g_inv[j] = p.invn[(size_t)(cp_.rowbase + cp_.tlo + quad * 4 + j) * 8 + h];                       \
  }
#define SC_STAGE1(CC)                                                                                  \
  {                                                                                                    \
    const int i3_ = (CC) % 3;                                                                          \
    float4 lo_, hi_;                                                                                   \
    cvt8(g_rk, lo_, hi_);                                                                              \
    float* dst_ = (float*)(smem + (tid < 128 ? SC_R : SC_KD) + i3_ * 4096) + c_ts * 64 + c_ch * 8;     \
    *(float4*)dst_ = lo_;                                                                              \
    *(float4*)(dst_ + 4) = hi_;                                                                        \
    if (tid < 64) {                                                                                    \
      cvt8(g_v, lo_, hi_);                                                                             \
      float* dv_ = (float*)(smem + SC_V + i3_ * 2048) + v_ts * 32 + v_ch * 8;                          \
      *(float4*)dv_ = lo_;                                                                             \
      *(float4*)(dv_ + 4) = hi_;                                                                       \
    }                                                                                                  \
  }
#define SC_STAGE2(CC)                                                                                  \
  {                                                                                                    \
    const int i3_ = (CC) % 3, i2_ = (CC)&1;                                                            \
    const ChunkPos cp_ = chunk_pos((CC), d, b);                                                        \
    f32x4 accW = f32x4{0.f, 0.f, 0.f, 0.f}, accA = f32x4{0.f, 0.f, 0.f, 0.f};                          \
    accW = mfma16(g_wd0, bW[0], accW);                                                                 \
    accW = mfma16(g_wd1, bW[1], accW);                                                                 \
    accA = mfma16(g_ad0, bA[0], accA);                                                                 \
    accA = mfma16(g_ad1, bA[1], accA);                                                                 \
    float bon_[4];                                                                                     \
    _Pragma("unroll") for (int j = 0; j < 4; ++j) {                                                    \
      const int ts = quad * 4 + j;                                                                     \
      float* kdp = (float*)(smem + SC_KD + i3_ * 4096) + ts * 64 + n2;                                 \
      const float kv = *kdp;                                                                           \
      const float rv = *((const float*)(smem + SC_R + i3_ * 4096) + ts * 64 + n2);                     \
      const float sg = sigmoidf_(w0v + accW[j]);                                                       \
      const float wv = __expf(-0.6065306597126334f * sg);                                              \
      const float av = sigmoidf_(a0v + accA[j]);                                                       \
      const float kn = kv * kkc * g_inv[j];                                                            \
      const float kd = kv * (1.f + (av - 1.f) * kac);                                                  \
      *((float*)(smem + SC_W + i2_ * 4096) + ts * 64 + n2) = wv;                                       \
      *((float*)(smem + SC_NKK + i2_ * 4096) + ts * 64 + n2) = -kn;                                    \
      *((float*)(smem + SC_KA + i2_ * 4096) + ts * 64 + n2) = kn * av;                                 \
      *kdp = kd;                                                                                       \
      bon_[j] = rv * kd * rkc;                                                                         \
    }                                                                                                  \
    _Pragma("unroll") for (int j = 0; j < 4; ++j) bon_[j] = red16_sum(bon_[j]);                        \
    if (l15 == 0 && part == 0) {                                                                       \
      _Pragma("unroll") for (int j = 0; j < 4; ++j)                                                    \
        p.bonus[(size_t)(cp_.rowbase + cp_.tlo + quad * 4 + j) * 48 + (d * 6 + h) * 4 + wid] = bon_[j]; \
    }                                                                                                  \
  }

  SC_GLOAD1(0);
  SC_GLOAD2(0);
  SC_STAGE1(0);
  SC_GLOAD1(1);
  __syncthreads();
  SC_STAGE2(0);
  SC_STAGE1(1);
  SC_GLOAD1(2);
  SC_GLOAD2(1);
  __syncthreads();

  for (int c = 0; c < 272; ++c) {
    {
      const int i3 = c % 3, i2 = c & 1;
      const ChunkPos cp = chunk_pos(c, d, b);
      const float* pW = (const float*)(smem + SC_W + i2 * 4096) + j0;
      const float* pN = (const float*)(smem + SC_NKK + i2 * 4096) + j0;
      const float* pA = (const float*)(smem + SC_KA + i2 * 4096) + j0;
      const float* pD = (const float*)(smem + SC_KD + i3 * 4096) + j0;
      const float* pR = (const float*)(smem + SC_R + i3 * 4096) + j0;
      const float* pV = (const float*)(smem + SC_V + i3 * 2048) + rloc;
      float* yp = p.y + ((size_t)d * MT + cp.rowbase + cp.tlo) * 384 + h * 64 + irow;
      float2v yk0 = float2v{0.f, 0.f};
      float4 cw0, cw1, cn0, cn1, ca0, ca1, cd0, cd1, cr0, cr1;
      float cvi;
#define SC_LD(TS, W0, W1, N0, N1, A0, A1, D0, D1, R0, R1, VI)                                   \
      W0 = *(const float4*)(pW + (TS)*64); W1 = *(const float4*)(pW + (TS)*64 + 4);              \
      N0 = *(const float4*)(pN + (TS)*64); N1 = *(const float4*)(pN + (TS)*64 + 4);              \
      A0 = *(const float4*)(pA + (TS)*64); A1 = *(const float4*)(pA + (TS)*64 + 4);              \
      D0 = *(const float4*)(pD + (TS)*64); D1 = *(const float4*)(pD + (TS)*64 + 4);              \
      R0 = *(const float4*)(pR + (TS)*64); R1 = *(const float4*)(pR + (TS)*64 + 4);              \
      VI = pV[(TS)*32];
      {
        const int ts0 = d ? 15 : 0;
        SC_LD(ts0, cw0, cw1, cn0, cn1, ca0, ca1, cd0, cd1, cr0, cr1, cvi)
      }
#pragma unroll
      for (int si = 0; si < 16; ++si) {
        float4 xw0, xw1, xn0, xn1, xa0, xa1, xd0, xd1, xr0, xr1;
        float xvi = 0.f;
        if (si + 1 < 16) {
          const int tsn = d ? 14 - si : si + 1;
          SC_LD(tsn, xw0, xw1, xn0, xn1, xa0, xa1, xd0, xd1, xr0, xr1, xvi)
        }
        float2v sa2 = S2[0] * float2v{cn0.x, cn0.y};
        sa2 = S2[1] * float2v{cn0.z, cn0.w} + sa2;
        sa2 = S2[2] * float2v{cn1.x, cn1.y} + sa2;
        sa2 = S2[3] * float2v{cn1.z, cn1.w} + sa2;
        const float sa = red8_sum(sa2.x + sa2.y);
        const float2v sav = float2v{sa, sa}, viv = float2v{cvi, cvi};
        S2[0] = S2[0] * float2v{cw0.x, cw0.y} + (sav * float2v{ca0.x, ca0.y} + viv * float2v{cd0.x, cd0.y});
        S2[1] = S2[1] * float2v{cw0.z, cw0.w} + (sav * float2v{ca0.z, ca0.w} + viv * float2v{cd0.z, cd0.w});
        S2[2] = S2[2] * float2v{cw1.x, cw1.y} + (sav * float2v{ca1.x, ca1.y} + viv * float2v{cd1.x, cd1.y});
        S2[3] = S2[3] * float2v{cw1.z, cw1.w} + (sav * float2v{ca1.z, ca1.w} + viv * float2v{cd1.z, cd1.w});
        float2v y2 = S2[0] * float2v{cr0.x, cr0.y};
        y2 = S2[1] * float2v{cr0.z, cr0.w} + y2;
        y2 = S2[2] * float2v{cr1.x, cr1.y} + y2;
        y2 = S2[3] * float2v{cr1.z, cr1.w} + y2;
        const float yv = red8_sum(y2.x + y2.y);
        if (si < 8) yk0.x = (jq == si) ? yv : yk0.x;
        else yk0.y = (jq == si - 8) ? yv : yk0.y;
        if (si + 1 < 16) {
          cw0 = xw0; cw1 = xw1; cn0 = xn0; cn1 = xn1; ca0 = xa0; ca1 = xa1; cd0 = xd0; cd1 = xd1; cr0 = xr0; cr1 = xr1; cvi = xvi;
        }
      }
#undef SC_LD
      {
        const int tsa = d ? 15 - jq : jq, tsb = d ? 7 - jq : 8 + jq;
        yp[(size_t)tsa * 384] = yk0.x;
        yp[(size_t)tsb * 384] = yk0.y;
      }
    }
    if (c + 1 < 272) SC_STAGE2(c + 1);
    if (c + 2 < 272) SC_STAGE1(c + 2);
    if (c + 3 < 272) SC_GLOAD1(c + 3);
    if (c + 2 < 272) SC_GLOAD2(c + 2);
    __syncthreads();
  }
#undef SC_GLOAD1
#undef SC_GLOAD2
#undef SC_STAGE1
#undef SC_STAGE2
}

DEV void attn_item(const P& p, int item, char* smem) {
  const int tid = tid_l(), lane = tid & 63, wid = tid >> 6, l15 = lane & 15, quad = lane >> 4;
  bool lat = item < 1536;
  int b, hq, qb;
  if (lat) { b = item / 192; int rem = item % 192; hq = rem / 32; qb = rem % 32; }
  else { int i2 = item - 1536; b = i2 / 12; int rem = i2 % 12; hq = rem / 2; qb = rem % 2; }
  const int kvh = hq / 3;
  const int qrow0 = lat ? MC + b * 4096 + qb * 128 : b * 256 + qb * 128;
  const int nkt = lat ? 68 : 4;
  const float LOG2E = 1.4426950408889634f;

  bf16x8 qf[2][2];
#pragma unroll
  for (int mi = 0; mi < 2; ++mi)
#pragma unroll
    for (int ks = 0; ks < 2; ++ks)
      qf[mi][ks] = *(const bf16x8*)(p.z + (size_t)(qrow0 + wid * 32 + mi * 16 + l15) * INC + 1920 + hq * 64 + ks * 32 + quad * 8);

  f32x4 O[2][4];
  float mrow[2][4], lpart[2][4];
#pragma unroll
  for (int mi = 0; mi < 2; ++mi) {
#pragma unroll
    for (int nd = 0; nd < 4; ++nd) O[mi][nd] = f32x4{0.f, 0.f, 0.f, 0.f};
#pragma unroll
    for (int j = 0; j < 4; ++j) { mrow[mi][j] = -1e30f; lpart[mi][j] = 0.f; }
  }
  char* Ps = smem + 32768 + wid * 4096;
  const int lrow = tid >> 3, lch = tid & 7;
  uint4 rk0, rk1, rv0, rv1;
#define ATT_GLOAD(KT)                                                                         \
  {                                                                                           \
    const int kt_ = (KT);                                                                     \
    const u16* kp;                                                                            \
    const u16* vp;                                                                            \
    int vstride;                                                                              \
    if (lat && kt_ < 64) {                                                                    \
      kp = p.z + (size_t)(MC + b * 4096 + kt_ * 64) * INC + 2304 + kvh * 64;                  \
      vp = p.vTl + (size_t)((b * 2 + kvh) * 64) * SEQ + kt_ * 64;                             \
      vstride = SEQ;                                                                          \
    } else {                                                                                  \
      const int kc = lat ? kt_ - 64 : kt_;                                                    \
      kp = p.z + (size_t)(b * 256 + kc * 64) * INC + 2304 + kvh * 64;                         \
      vp = p.vTc + (size_t)((b * 2 + kvh) * 64) * CTXL + kc * 64;                             \
      vstride = CTXL;                                                                         \
    }                                                                                         \
    rk0 = *(const uint4*)(kp + (size_t)(lrow)*INC + lch * 8);                                 \
    rk1 = *(const uint4*)(kp + (size_t)(lrow + 32) * INC + lch * 8);                          \
    rv0 = *(const uint4*)(vp + (size_t)(lrow)*vstride + lch * 8);                             \
    rv1 = *(const uint4*)(vp + (size_t)(lrow + 32) * vstride + lch * 8);                      \
  }
#define ATT_LSTORE(BUF)                                     \
  {                                                         \
    char* Kb_ = smem + (BUF)*16384;                         \
    *(uint4*)(Kb_ + swz(lrow, lch)) = rk0;                  \
    *(uint4*)(Kb_ + swz(lrow + 32, lch)) = rk1;             \
    *(uint4*)(Kb_ + 8192 + swz(lrow, lch)) = rv0;           \
    *(uint4*)(Kb_ + 8192 + swz(lrow + 32, lch)) = rv1;      \
  }
  ATT_GLOAD(0);
  ATT_LSTORE(0);
  __syncthreads();
  for (int kt = 0; kt < nkt; ++kt) {
    const int buf = kt & 1;
    if (kt + 1 < nkt) ATT_GLOAD(kt + 1);
    const char* Kb = smem + buf * 16384;
    const char* Vb = Kb + 8192;
    f32x4 Sx[2][4];
#pragma unroll
    for (int mi = 0; mi < 2; ++mi)
#pragma unroll
      for (int ni = 0; ni < 4; ++ni) Sx[mi][ni] = f32x4{0.f, 0.f, 0.f, 0.f};
#pragma unroll
    for (int ks = 0; ks < 2; ++ks) {
      bf16x8 kf[4];
#pragma unroll
      for (int ni = 0; ni < 4; ++ni) kf[ni] = *(const bf16x8*)(Kb + swz(ni * 16 + l15, ks * 4 + quad));
#pragma unroll
      for (int mi = 0; mi < 2; ++mi)
#pragma unroll
        for (int ni = 0; ni < 4; ++ni) Sx[mi][ni] = mfma16(qf[mi][ks], kf[ni], Sx[mi][ni]);
    }
#pragma unroll
    for (int mi = 0; mi < 2; ++mi)
#pragma unroll
      for (int j = 0; j < 4; ++j) {
        float mx = fmaxf(fmaxf(Sx[mi][0][j], Sx[mi][1][j]), fmaxf(Sx[mi][2][j], Sx[mi][3][j]));
        mx = red16_max(mx);
        const float mnew = fmaxf(mrow[mi][j], mx);
        const float alpha = __builtin_amdgcn_exp2f((mrow[mi][j] - mnew) * LOG2E);
        mrow[mi][j] = mnew;
        const float mb = mnew * LOG2E;
        float ps = 0.f;
        const int prow = mi * 16 + quad * 4 + j;
#pragma unroll
        for (int ni = 0; ni < 4; ++ni) {
          float pv = __builtin_amdgcn_exp2f(Sx[mi][ni][j] * LOG2E - mb);
          ps += pv;
          *(u16*)(Ps + swz(prow, ni * 2 + (l15 >> 3)) + (l15 & 7) * 2) = f2bf(pv);
        }
        lpart[mi][j] = lpart[mi][j] * alpha + ps;
#pragma unroll
        for (int nd = 0; nd < 4; ++nd) O[mi][nd][j] *= alpha;
      }
    __builtin_amdgcn_fence(__ATOMIC_RELEASE, "wavefront");
    __builtin_amdgcn_wave_barrier();
    __builtin_amdgcn_fence(__ATOMIC_ACQUIRE, "wavefront");
#pragma unroll
    for (int ks = 0; ks < 2; ++ks) {
      bf16x8 pf[2], vf[4];
#pragma unroll
      for (int mi = 0; mi < 2; ++mi) pf[mi] = *(const bf16x8*)(Ps + swz(mi * 16 + l15, ks * 4 + quad));
#pragma unroll
      for (int nd = 0; nd < 4; ++nd) vf[nd] = *(const bf16x8*)(Vb + swz(nd * 16 + l15, ks * 4 + quad));
#pragma unroll
      for (int mi = 0; mi < 2; ++mi)
#pragma unroll
        for (int nd = 0; nd < 4; ++nd) O[mi][nd] = mfma16(pf[mi], vf[nd], O[mi][nd]);
    }
    if (kt + 1 < nkt) ATT_LSTORE(buf ^ 1);
    __syncthreads();
  }
#pragma unroll
  for (int mi = 0; mi < 2; ++mi)
#pragma unroll
    for (int j = 0; j < 4; ++j) {
      const float lsum = red16_sum(lpart[mi][j]);
      const float inv = 1.f / lsum;
      const int r = qrow0 + wid * 32 + mi * 16 + quad * 4 + j;
#pragma unroll
      for (int nd = 0; nd < 4; ++nd) p.act[(size_t)r * DM + 640 + hq * 64 + nd * 16 + l15] = f2bf(O[mi][nd][j] * inv);
    }
}

DEV void sgate_item(const P& p, int l, int ck, int g, char* smem) {
  const int tid = tid_l(), lane = tid & 63, wid = tid >> 6, l15 = lane & 15, quad = lane >> 4;
  const int m0 = ck * 128;
  u16* sVT = (u16*)smem;
  {
    const int q = tid >> 1, half = tid & 1;
    const u16* src = p.z + (size_t)(m0 + q) * INC + 1408 + 256 + g * 64 + half * 32;
    float v[32];
    float ss = 0.f;
#pragma unroll
    for (int cidx = 0; cidx < 4; ++cidx) {
      uint4 u = *(const uint4*)(src + cidx * 8);
      unsigned uu[4] = {u.x, u.y, u.z, u.w};
#pragma unroll
      for (int e = 0; e < 4; ++e) {
        float f0 = geluf_(bf2f((u16)(uu[e] & 0xffff)));
        float f1 = geluf_(bf2f((u16)(uu[e] >> 16)));
        v[cidx * 8 + e * 2] = f0;
        v[cidx * 8 + e * 2 + 1] = f1;
        ss += f0 * f0 + f1 * f1;
      }
    }
    ss += __shfl_xor(ss, 1);
    const float rstd = rsqrtf(ss * (1.f / 64.f) + 1e-6f);
    const float* gn = p.sgn + l * 256 + g * 64 + half * 32;
#pragma unroll
    for (int e = 0; e < 32; ++e) sVT[(half * 32 + e) * 136 + q] = f2bf(v[e] * rstd * gn[e]);
  }
  __syncthreads();
  f32x4 acc[2][4];
#pragma unroll
  for (int mi = 0; mi < 2; ++mi)
#pragma unroll
    for (int ni = 0; ni < 4; ++ni) acc[mi][ni] = f32x4{0.f, 0.f, 0.f, 0.f};
  const u16* Wg = p.sgW + (size_t)(l * 4 + g) * 128 * 128;
#pragma unroll
  for (int ks = 0; ks < 4; ++ks) {
    bf16x8 a[2], bb[4];
#pragma unroll
    for (int mi = 0; mi < 2; ++mi) a[mi] = *(const bf16x8*)(Wg + (size_t)(wid * 32 + mi * 16 + l15) * 128 + ks * 32 + quad * 8);
#pragma unroll
    for (int ni = 0; ni < 4; ++ni) bb[ni] = *(const bf16x8*)(sVT + (ni * 16 + l15) * 136 + ks * 32 + quad * 8);
#pragma unroll
    for (int mi = 0; mi < 2; ++mi)
#pragma unroll
      for (int ni = 0; ni < 4; ++ni) acc[mi][ni] = mfma16(a[mi], bb[ni], acc[mi][ni]);
  }
#pragma unroll
  for (int mi = 0; mi < 2; ++mi)
#pragma unroll
    for (int j = 0; j < 4; ++j) {
      const int pr = wid * 32 + mi * 16 + quad * 4 + j;
      const float bias = p.sg_b[(size_t)(l * 4 + g) * 128 + pr];
#pragma unroll
      for (int ni = 0; ni < 4; ++ni) {
        const int c = ni * 16 + l15;
        float u = geluf_(bf2f(p.z[(size_t)(m0 + pr) * INC + 1408 + g * 64 + c]));
        p.act[(size_t)(m0 + pr) * DM + 384 + g * 64 + c] = f2bf(u * (acc[mi][ni][j] + bias));
      }
    }
  __syncthreads();
}

DEV void mix_phase(const P& p, int l, char* smem, int cidx) {
  __shared__ int s_item;
  const bool last = (l == DEPTH - 1);
  const int n_attn = last ? 1536 : 1632;
  const int ck_lo = last ? 16 : 0;
  const int n_sg = (NMT - ck_lo) * 4;
  const int total = SCAN_ITEMS + n_attn + n_sg;
  const int bid = bid_l();
  bool first = bid < SCAN_ITEMS;
  for (;;) {
    int it;
    if (first) {
      it = bid;
      first = false;
    } else {
      if (tid_l() == 0) s_item = SCAN_ITEMS + atomicAdd(p.cnt + cidx, 1);
      __syncthreads();
      it = s_item;
      __syncthreads();
    }
    if (it >= total) break;
    if (it < SCAN_ITEMS) {
      int nr = SCAN_REP; asm volatile("" : "+s"(nr));
      for (int rr = 0; rr < nr; ++rr) scan_item(p, l, it, smem);
    } else if (it < SCAN_ITEMS + n_attn) {
      int nr = ATT_REP; asm volatile("" : "+s"(nr));
      for (int rr = 0; rr < nr; ++rr) { attn_item(p, it - SCAN_ITEMS, smem); __syncthreads(); }
    } else {
      int i2 = it - SCAN_ITEMS - n_attn;
      int nr = SG_REP; asm volatile("" : "+s"(nr));
      for (int rr = 0; rr < nr; ++rr) sgate_item(p, l, ck_lo + (i2 >> 2), i2 & 3, smem);
    }
  }
}

DEV void apost_phase(const P& p, int l, int mt_lo, char* smem) {
  const int tid = tid_l(), lane = tid & 63, wid = tid >> 6, l15 = lane & 15, quad = lane >> 4;
  for (int mt = mt_lo + bid_l(); mt < NMT; mt += gridDim.x) {
    const int m0 = mt * 128;
    bf16x8 a[2][4];
#pragma unroll
    for (int mi = 0; mi < 2; ++mi)
#pragma unroll
      for (int ks = 0; ks < 4; ++ks)
        a[mi][ks] = *(const bf16x8*)(p.z + (size_t)(m0 + wid * 32 + mi * 16 + l15) * INC + 1280 + ks * 32 + quad * 8);
#pragma unroll 1
    for (int hh = 0; hh < 6; ++hh) {
      f32x4 acc[2][4];
#pragma unroll
      for (int mi = 0; mi < 2; ++mi)
#pragma unroll
        for (int ni = 0; ni < 4; ++ni) acc[mi][ni] = f32x4{0.f, 0.f, 0.f, 0.f};
#pragma unroll
      for (int ks = 0; ks < 4; ++ks) {
        bf16x8 bb[4];
#pragma unroll
        for (int ni = 0; ni < 4; ++ni)
          bb[ni] = *(const bf16x8*)(p.gUpT + ((size_t)l * 384 + hh * 64 + ni * 16 + l15) * 128 + ks * 32 + quad * 8);
#pragma unroll
        for (int mi = 0; mi < 2; ++mi)
#pragma unroll
          for (int ni = 0; ni < 4; ++ni) acc[mi][ni] = mfma16(a[mi][ks], bb[ni], acc[mi][ni]);
      }
      float lg[4], lb[4];
#pragma unroll
      for (int ni = 0; ni < 4; ++ni) {
        const int c = hh * 64 + ni * 16 + l15;
        lg[ni] = p.ln_g[l * 384 + c];
        lb[ni] = p.ln_b[l * 384 + c];
      }
#pragma unroll
      for (int mi = 0; mi < 2; ++mi)
#pragma unroll
        for (int j = 0; j < 4; ++j) {
          const int r = m0 + wid * 32 + mi * 16 + quad * 4 + j;
          float ys[4], vv[4];
          float sm = 0.f;
#pragma unroll
          for (int ni = 0; ni < 4; ++ni) {
            const int c = hh * 64 + ni * 16 + l15;
            ys[ni] = p.y[(size_t)r * 384 + c] + p.y[((size_t)MT + r) * 384 + c];
            vv[ni] = bf2f(p.z[(size_t)r * INC + 768 + c]);
            sm += ys[ni];
          }
          const float4 bq0 = *(const float4*)(p.bonus + (size_t)r * 48 + hh * 4);
          const float4 bq1 = *(const float4*)(p.bonus + (size_t)r * 48 + (6 + hh) * 4);
          const float bon = (bq0.x + bq0.y) + (bq0.z + bq0.w) + (bq1.x + bq1.y) + (bq1.z + bq1.w);
          sm = red16_sum(sm);
          const float mean = sm * (1.f / 64.f);
          float vs = 0.f;
#pragma unroll
          for (int ni = 0; ni < 4; ++ni) { ys[ni] -= mean; vs += ys[ni] * ys[ni]; }
          vs = red16_sum(vs);
          const float rstd = rsqrtf(vs * (1.f / 64.f) + 64e-5f);
#pragma unroll
          for (int ni = 0; ni < 4; ++ni) {
            const int c = hh * 64 + ni * 16 + l15;
            float o = (ys[ni] * rstd * lg[ni] + lb[ni] + bon * vv[ni]) * acc[mi][ni][j];
            p.act[(size_t)r * DM + c] = f2bf(o);
          }
          __builtin_amdgcn_sched_barrier(0);
        }
    }
  }
}

DEV uint2 ld8(const u16* q) { return *(const uint2*)q; }
DEV void up4(const uint2 u, float (&f)[4]) {
  f[0] = __uint_as_float(u.x << 16); f[1] = __uint_as_float(u.x & 0xffff0000u);
  f[2] = __uint_as_float(u.y << 16); f[3] = __uint_as_float(u.y & 0xffff0000u);
}
DEV void prep_phase(const P& p, int l, cg::grid_group& grid) {
  const int tid = tid_l(), lane = tid & 63, l15 = lane & 15;
  const int nb = gridDim.x, bid = bid_l();
  const int rpb = (((MT + nb - 1) / nb) + 3) & ~3;
  const int ra = bid * rpb;
  const int rb = min(ra + rpb, MT);
  const bool active = ra < MT;
  const bool has1 = tid < 96;
  const int col0 = tid * 4, col1 = 1024 + tid * 4;
  uint2 hp0 = make_uint2(0, 0), hn0 = hp0, hp1 = hp0, hn1 = hp0;
  if (active) {
    if (ra > 0) { hp0 = ld8(p.z + (size_t)(ra - 1) * INC + col0); if (has1) hp1 = ld8(p.z + (size_t)(ra - 1) * INC + col1); }
    if (rb < MT) { hn0 = ld8(p.z + (size_t)rb * INC + col0); if (has1) hn1 = ld8(p.z + (size_t)rb * INC + col1); }
  }
  grid.sync();
  if (!active) return;
  const float* cw = p.conv + (size_t)l * 3 * 1408;
#pragma unroll 1
  for (int pass = 0; pass < 2; ++pass) {
    if (pass == 1 && !has1) break;
    const int col = pass ? col1 : col0;
    const int typ = col < 1152 ? 0 : (col < 1216 ? 1 : (col < 1280 ? 0 : 2));
    const bool isk = col >= 384 && col < 768;
    float c0[4], c1[4], c2[4], kk4[4];
#pragma unroll
    for (int e = 0; e < 4; ++e) {
      c0[e] = cw[col + e]; c1[e] = cw[1408 + col + e]; c2[e] = cw[2816 + col + e];
      kk4[e] = isk ? p.k_k[l * 384 + (col - 384) + e] : 0.f;
    }
    const int hh = isk ? (col - 384) >> 6 : 0;
    u16* zc = p.z + col;
    uint2 prev = pass ? hp1 : hp0;
    const uint2 halo_n = pass ? hn1 : hn0;
    uint2 cur = ld8(zc + (size_t)ra * INC);
    for (int r = ra; r < rb; r += 4) {
      uint2 nx[4];
#pragma unroll
      for (int q = 0; q < 4; ++q) {
        const int rr = r + 1 + q;
        nx[q] = rr < rb ? ld8(zc + (size_t)rr * INC) : halo_n;
      }
#pragma unroll
      for (int q = 0; q < 4; ++q) {
        const int rr = r + q;
        const uint2 xp = q == 0 ? prev : (q == 1 ? cur : nx[q - 2]);
        const uint2 xc = q == 0 ? cur : nx[q - 1];
        const uint2 xn = nx[q];
        const int tt = rr < MC ? (rr & 255) : ((rr - MC) & 4095);
        const int len = rr < MC ? 256 : 4096;
        const float mp = tt > 0 ? 1.f : 0.f, mn = tt < len - 1 ? 1.f : 0.f;
        float fp[4], fc[4], fn[4], o[4];
        up4(xp, fp); up4(xc, fc); up4(xn, fn);
#pragma unroll
        for (int e = 0; e < 4; ++e) {
          float v = fc[e] * c1[e] + mp * (fp[e] * c0[e]) + mn * (fn[e] * c2[e]);
          if (typ == 1) v = tanh_fast(v);
          else if (typ == 2) v = sigmoidf_(v);
          o[e] = v;
        }
        if (isk) {
          float q0 = o[0] * kk4[0], q1 = o[1] * kk4[1], q2 = o[2] * kk4[2], q3 = o[3] * kk4[3];
          float ss = red16_sum(q0 * q0 + q1 * q1 + q2 * q2 + q3 * q3);
          if (l15 == 0 && rr < rb) p.invn[(size_t)rr * 8 + hh] = 1.f / fmaxf(sqrtf(ss), 1e-12f);
        }
        if (rr < rb) *(uint2*)(zc + (size_t)rr * INC) = make_uint2(pk2(o[0], o[1]), pk2(o[2], o[3]));
      }
      prev = nx[2];
      cur = nx[3];
    }
  }
}

__global__ void __launch_bounds__(256, 2) fwd_megakernel(P p, int ph_lo, int ph_hi) {
  __shared__ __attribute__((aligned(16))) char smem[65536 - 64];
  cg::grid_group grid = cg::this_grid();
  for (int ph = ph_lo; ph < ph_hi; ++ph) {
    if (ph > ph_lo) grid.sync();
    if (ph == 0) { phase0(p, smem); continue; }
    if (ph == 1 + 8 * DEPTH) { final_norm(p); continue; }
    const int l = (ph - 1) >> 3, sub = (ph - 1) & 7;
    const bool last = (l == DEPTH - 1);
    const int mt_lo = last ? 16 : 0;
    int nrep = ((PROBE_MASK >> sub) & 1) ? 2 : 1;
    asm volatile("" : "+s"(nrep));
    for (int rep = 0; rep < nrep; ++rep) {
      if (rep) grid.sync();
      const int dry = (rep + 1 < nrep) ? 1 : 0;
      if (sub == 0 || sub == 5) {
        const bool n2 = sub == 5;
        norm_phase(p, l, (n2 ? p.n2g : p.n1g) + l * DM, n2 ? 3072 : 0, n2 ? 4096 : 1024, n2 ? mt_lo * 128 : 0, !n2 && l == 0);
      } else if (sub == 1) {
        gemm_phase<EPI_Z>(p, l, p.act, DM, p.wIn + (size_t)l * 2560 * 1024, 1024, 20, 0, 0, smem, dry);
      } else if (sub == 2) {
        if (rep == 0) { prep_phase(p, l, grid); grid.sync(); }
        mix_phase(p, l, smem, l + 8 * rep);
      } else if (sub == 3) {
        apost_phase(p, l, mt_lo, smem);
      } else if (sub == 4 || sub == 7) {
        const bool g4 = sub == 7;
        gemm_phase<EPI_RES>(p, l, g4 ? p.h : p.act, g4 ? DFF : DM,
                            g4 ? p.w2t + (size_t)l * 1024 * 2816 : p.wOut + (size_t)l * 1024 * 1024, g4 ? 2816 : 1024, 8, mt_lo,
                            g4 ? 5120 : 2048, smem, dry);
      } else {
        gemm_phase<EPI_SWIGLU>(p, l, p.act, DM, p.w1t + (size_t)l * 5632 * 1024, 1024, 44, mt_lo, 0, smem, dry);
      }
    }
  }
}

extern "C" void kernel_launch(void* const* d_in, const int* in_sizes, int n_in, void* d_out, int out_size, void* d_ws,
                              size_t ws_size, hipStream_t stream) {
  static int grid_blocks = 0;
  if (!grid_blocks) {
    int dev = 0, cus = 0, per_cu = 0;
    hipGetDevice(&dev);
    hipDeviceGetAttribute(&cus, hipDeviceAttributeMultiprocessorCount, dev);
    hipOccupancyMaxActiveBlocksPerMultiprocessor(&per_cu, fwd_megakernel, 256, 0);
    if (per_cu > 2) per_cu = 2;
    if (per_cu < 1) per_cu = 1;
    grid_blocks = cus * per_cu;
  }
  P p{};
  const float* const* in = (const float* const*)d_in;
  p.x = in[0]; p.c = in[1]; p.ctx = in[2]; p.c_ctx = in[3]; p.n1g = in[4]; p.n2g = in[5]; p.ada_w = in[6]; p.ada_b = in[7];
  p.w_in = in[8]; p.conv = in[9]; p.w0 = in[10]; p.w_up = in[11]; p.a0 = in[12]; p.a_up = in[13]; p.g_up = in[14];
  p.k_k = in[15]; p.k_a = in[16]; p.r_k = in[17]; p.ln_g = in[18]; p.ln_b = in[19]; p.sgn = in[20]; p.sg_w = in[21];
  p.sg_b = in[22]; p.q_g = in[23]; p.k_g = in[24]; p.w_out = in[25]; p.w1 = in[26]; p.w2 = in[27]; p.fng = in[28];
  p.out = (float*)d_out;
  char* ws = (char*)d_ws;
  size_t off = 0;
  auto take = [&](size_t bytes) { char* r = ws + off; off += (bytes + 255) & ~(size_t)255; return r; };
  p.wIn = (u16*)take((size_t)4 * 2560 * 1024 * 2);
  p.wOut = (u16*)take((size_t)4 * 1024 * 1024 * 2);
  p.w1t = (u16*)take((size_t)4 * 5632 * 1024 * 2);
  p.w2t = (u16*)take((size_t)4 * 1024 * 2816 * 2);
  p.wUpT = (u16*)take((size_t)8 * 384 * 64 * 2);
  p.aUpT = (u16*)take((size_t)8 * 384 * 64 * 2);
  p.gUpT = (u16*)take((size_t)4 * 384 * 128 * 2);
  p.sgW = (u16*)take((size_t)16 * 128 * 128 * 2);
  p.mods = (float*)take((size_t)4 * 9 * 6144 * 4);
  p.rope = (float*)take(2048 * 4);
  p.cnt = (int*)take(256);
  p.xc = (float*)take((size_t)MC * DM * 4);
  p.act = (u16*)take((size_t)MT * DM * 2);
  p.z = (u16*)take((size_t)MT * DFF * 2);
  p.h = p.z;
  p.vTl = (u16*)take((size_t)16 * 64 * SEQ * 2);
  p.vTc = (u16*)take((size_t)16 * 64 * CTXL * 2);
  p.y = (float*)take((size_t)2 * MT * 384 * 4);
  p.bonus = (float*)take((size_t)MT * 48 * 4);
  p.invn = (float*)take((size_t)MT * 8 * 4);
  if (off > ws_size) { fprintf(stderr, "workspace too small: need %zu have %zu\n", off, ws_size); return; }
  int ph_lo = 0, ph_hi = 2 + 8 * DEPTH;
  void* args[] = {&p, &ph_lo, &ph_hi};
  hipError_t e = hipLaunchCooperativeKernel((void*)fwd_megakernel, dim3(grid_blocks), dim3(256), args, 0, stream);
  if (e != hipSuccess) fprintf(stderr, "cooperative launch failed: %s (grid %d)\n", hipGetErrorString(e), grid_blocks);
}
```

```cpp
#include <hip/hip_runtime.h>
#include <hip/hip_bf16.h>
#include <hip/hip_cooperative_groups.h>
#include <cstdio>
namespace cg = cooperative_groups;

typedef __attribute__((ext_vector_type(8))) short bf16x8;
typedef __attribute__((ext_vector_type(4))) float f32x4;
typedef unsigned short u16;
typedef __attribute__((ext_vector_type(2))) float float2v;

#define DEV __device__ __forceinline__
DEV int tid_l() { int t = threadIdx.x; asm volatile("" : "+v"(t)); return t; }
DEV int bid_l() { int b = blockIdx.x; asm volatile("" : "+s"(b)); return b; }

constexpr int DM = 1024, NBATCH = 8, SEQ = 4096, DEPTH = 4, CTXL = 256;
constexpr int MC = NBATCH * CTXL;
constexpr int ML = NBATCH * SEQ;
constexpr int MT = MC + ML;
constexpr int INC = 2560, DFF = 2816;
constexpr int NMT = MT / 128;
#ifndef PROBE_MASK
#define PROBE_MASK 0
#endif
#define SCAN_REP 1
#define ATT_REP 1
#define SG_REP 1

struct P {
  const float *x, *c, *ctx, *c_ctx, *n1g, *n2g, *ada_w, *ada_b, *w_in, *conv, *w0, *w_up, *a0, *a_up, *g_up,
      *k_k, *k_a, *r_k, *ln_g, *ln_b, *sgn, *sg_w, *sg_b, *q_g, *k_g, *w_out, *w1, *w2, *fng;
  float* out;
  u16 *wIn, *wOut, *w1t, *w2t, *wUpT, *aUpT, *gUpT, *sgW;
  float *mods, *rope;
  int* cnt;
  float* xc;
  u16 *act, *z, *h, *vTl, *vTc;
  float *y, *bonus, *invn;
};

DEV u16 f2bf(float f) {
  unsigned u = __float_as_uint(f);
  u += 0x7fffu + ((u >> 16) & 1u);
  return (u16)(u >> 16);
}
DEV float bf2f(u16 h) { return __uint_as_float(((unsigned)h) << 16); }
DEV unsigned pk2(float a, float b) { return (unsigned)f2bf(a) | ((unsigned)f2bf(b) << 16); }
DEV float sigmoidf_(float x) { return __builtin_amdgcn_rcpf(1.f + __expf(-x)); }
DEV float siluf_(float x) { return x * __builtin_amdgcn_rcpf(1.f + __expf(-x)); }
DEV float geluf_(float x) {
  float u = 0.7978845608028654f * (x + 0.044715f * x * x * x);
  return 0.5f * x * (1.f + tanhf(u));
}
DEV int swz(int r, int ch) { return r * 128 + ((ch ^ ((r >> 1) & 7)) << 4); }

template <int CTRL>
DEV float dppf(float v) {
  return __int_as_float(__builtin_amdgcn_update_dpp(0, __float_as_int(v), CTRL, 0xF, 0xF, false));
}
DEV float red16_sum(float v) {
  v += dppf<0xB1>(v);
  v += dppf<0x4E>(v);
  v += dppf<0x141>(v);
  v += dppf<0x140>(v);
  return v;
}
DEV float red16_max(float v) {
  v = fmaxf(v, dppf<0xB1>(v));
  v = fmaxf(v, dppf<0x4E>(v));
  v = fmaxf(v, dppf<0x141>(v));
  v = fmaxf(v, dppf<0x140>(v));
  return v;
}
DEV float wave_sum(float v) {
#pragma unroll
  for (int o = 32; o >= 1; o >>= 1) v += __shfl_xor(v, o);
  return v;
}
DEV f32x4 mfma16(bf16x8 a, bf16x8 b, f32x4 c) { return __builtin_amdgcn_mfma_f32_16x16x32_bf16(a, b, c, 0, 0, 0); }

DEV void tr_tile(const float* __restrict__ src, u16* __restrict__ dst, int K, int N, int kt, int nt, bool il, float* lds) {
  const int tid = tid_l();
  const int k0 = kt * 64, n0 = nt * 64;
  {
    const int c = tid & 63, r0 = tid >> 6;
#pragma unroll 4
    for (int i = 0; i < 16; ++i) {
      int r = r0 + i * 4;
      lds[r * 65 + c] = src[(size_t)(k0 + r) * N + n0 + c];
    }
  }
  __syncthreads();
  {
    const int k = tid & 63, nn0 = tid >> 6;
#pragma unroll 4
    for (int i = 0; i < 16; ++i) {
      int n = nn0 + i * 4;
      int gn = n0 + n;
      int np = gn;
      if (il) {
        int j = gn < DFF ? gn : gn - DFF;
        np = (j >> 4) * 32 + (j & 15) + (gn < DFF ? 0 : 16);
      }
      dst[(size_t)np * K + k0 + k] = f2bf(lds[k * 65 + n]);
    }
  }
  __syncthreads();
}

DEV void phase0(const P& p, char* smem) {
  float* lds = (float*)smem;
  const int tid = tid_l();
  constexpr int C0 = 2560, C1 = C0 + 1024, C2 = C1 + 5632, C3 = C2 + 2816, C4 = C3 + 48, C5 = C4 + 48, C6 = C5 + 48,
                C7 = C6 + 64, C8 = C7 + 384, C9 = C8 + 1;
  for (int it = bid_l(); it < C9; it += gridDim.x) {
    if (it < C6) {
      const float* src; u16* dst; int K, N, kt, nt; bool il = false;
      if (it < C0) {
        int l = it / 640, r = it % 640;
        src = p.w_in + (size_t)l * 1024 * 2560; dst = p.wIn + (size_t)l * 2560 * 1024; K = 1024; N = 2560; kt = r / 40; nt = r % 40;
      } else if (it < C1) {
        int i2 = it - C0, l = i2 / 256, r = i2 % 256;
        src = p.w_out + (size_t)l * 1024 * 1024; dst = p.wOut + (size_t)l * 1024 * 1024; K = 1024; N = 1024; kt = r / 16; nt = r % 16;
      } else if (it < C2) {
        int i2 = it - C1, l = i2 / 1408, r = i2 % 1408;
        src = p.w1 + (size_t)l * 1024 * 5632; dst = p.w1t + (size_t)l * 5632 * 1024; K = 1024; N = 5632; kt = r / 88; nt = r % 88; il = true;
      } else if (it < C3) {
        int i2 = it - C2, l = i2 / 704, r = i2 % 704;
        src = p.w2 + (size_t)l * 2816 * 1024; dst = p.w2t + (size_t)l * 1024 * 2816; K = 2816; N = 1024; kt = r / 16; nt = r % 16;
      } else if (it < C4) {
        int i2 = it - C3, bb = i2 / 6;
        src = p.w_up + (size_t)bb * 64 * 384; dst = p.wUpT + (size_t)bb * 384 * 64; K = 64; N = 384; kt = 0; nt = i2 % 6;
      } else if (it < C5) {
        int i2 = it - C4, bb = i2 / 6;
        src = p.a_up + (size_t)bb * 64 * 384; dst = p.aUpT + (size_t)bb * 384 * 64; K = 64; N = 384; kt = 0; nt = i2 % 6;
      } else {
        int i2 = it - C5, l = i2 / 12, r = i2 % 12;
        src = p.g_up + (size_t)l * 128 * 384; dst = p.gUpT + (size_t)l * 384 * 128; K = 128; N = 384; kt = r / 6; nt = r % 6;
      }
      tr_tile(src, dst, K, N, kt, nt, il, lds);
    } else if (it < C7) {
      int i2 = it - C6;
      for (int i = 0; i < 16; ++i) {
        int e = i2 * 4096 + i * 256 + tid;
        p.sgW[e] = f2bf(p.sg_w[e]);
      }
    } else if (it < C8) {
      int i2 = it - C7, l = i2 / 96, cb = i2 % 96;
      for (int e = tid; e < 9 * 1024; e += 256) {
        int s = e >> 10, k = e & 1023;
        float v = s < 8 ? p.c[s * 1024 + k] : p.c_ctx[k];
        lds[e] = siluf_(v);
      }
      __syncthreads();
      const int col = tid & 63, kq = tid >> 6;
      const int n = cb * 64 + col;
      float acc[9];
#pragma unroll
      for (int s = 0; s < 9; ++s) acc[s] = 0.f;
      const float* wp = p.ada_w + (size_t)l * 1024 * 6144 + n;
#pragma unroll 4
      for (int k = kq * 256; k < kq * 256 + 256; ++k) {
        float w = wp[(size_t)k * 6144];
#pragma unroll
        for (int s = 0; s < 9; ++s) acc[s] += lds[s * 1024 + k] * w;
      }
      __syncthreads();
      float* red = lds + 9216;
#pragma unroll
      for (int s = 0; s < 9; ++s) red[(kq * 9 + s) * 64 + col] = acc[s];
      __syncthreads();
      for (int e = tid; e < 9 * 64; e += 256) {
        int s = e >> 6, cc = e & 63;
        float v = red[(0 * 9 + s) * 64 + cc] + red[(1 * 9 + s) * 64 + cc] + red[(2 * 9 + s) * 64 + cc] + red[(3 * 9 + s) * 64 + cc];
        int nn = cb * 64 + cc;
        p.mods[((size_t)l * 9 + s) * 6144 + nn] = v + p.ada_b[l * 6144 + nn];
      }
      __syncthreads();
    } else {
      for (int e = tid; e < 1024; e += 256) {
        int pos = e >> 4, i = e & 15;
        float inv = powf(10000.f, -(float)i / 16.f);
        float ang = (float)pos * inv;
        p.rope[e * 2] = cosf(ang);
        p.rope[e * 2 + 1] = sinf(ang);
      }
      if (tid < 64) p.cnt[tid] = 0;
    }
  }
}

DEV void norm_phase(const P& p, int l, const float* __restrict__ g, int shoff, int scoff, int row_lo, bool from_input) {
  const int tid = tid_l();
  const int lane = tid & 63;
  const int gw = bid_l() * 4 + (tid >> 6), nw = gridDim.x * 4;
  for (int r = row_lo + gw; r < MT; r += nw) {
    const float* src;
    if (from_input) src = r < MC ? p.ctx + (size_t)r * DM : p.x + (size_t)(r - MC) * DM;
    else src = r < MC ? p.xc + (size_t)r * DM : p.out + (size_t)(r - MC) * DM;
    const int s = r < MC ? 8 : (r - MC) >> 12;
    const float* md = p.mods + ((size_t)l * 9 + s) * 6144;
    float4 v[4];
    float ss = 0.f;
#pragma unroll
    for (int i = 0; i < 4; ++i) {
      v[i] = *(const float4*)(src + i * 256 + lane * 4);
      ss += v[i].x * v[i].x + v[i].y * v[i].y + v[i].z * v[i].z + v[i].w * v[i].w;
    }
    ss = wave_sum(ss);
    const float rstd = rsqrtf(ss * (1.f / DM) + 1e-6f);
#pragma unroll
    for (int i = 0; i < 4; ++i) {
      const int c = i * 256 + lane * 4;
      float4 gg = *(const float4*)(g + c);
      float4 sh = *(const float4*)(md + shoff + c);
      float4 sc = *(const float4*)(md + scoff + c);
      float o0 = v[i].x * rstd * gg.x * (1.f + sc.x) + sh.x;
      float o1 = v[i].y * rstd * gg.y * (1.f + sc.y) + sh.y;
      float o2 = v[i].z * rstd * gg.z * (1.f + sc.z) + sh.z;
      float o3 = v[i].w * rstd * gg.w * (1.f + sc.w) + sh.w;
      uint2 o;
      o.x = pk2(o0, o1);
      o.y = pk2(o2, o3);
      *(uint2*)(p.act + (size_t)r * DM + c) = o;
    }
  }
}

DEV void final_norm(const P& p) {
  const int tid = tid_l();
  const int lane = tid & 63;
  const int gw = bid_l() * 4 + (tid >> 6), nw = gridDim.x * 4;
  for (int r = gw; r < ML; r += nw) {
    float* src = p.out + (size_t)r * DM;
    float4 v[4];
    float ss = 0.f;
#pragma unroll
    for (int i = 0; i < 4; ++i) {
      v[i] = *(const float4*)(src + i * 256 + lane * 4);
      ss += v[i].x * v[i].x + v[i].y * v[i].y + v[i].z * v[i].z + v[i].w * v[i].w;
    }
    ss = wave_sum(ss);
    const float rstd = rsqrtf(ss * (1.f / DM) + 1e-6f);
#pragma unroll
    for (int i = 0; i < 4; ++i) {
      const int c = i * 256 + lane * 4;
      float4 gg = *(const float4*)(p.fng + c);
      float4 o;
      o.x = v[i].x * rstd * gg.x;
      o.y = v[i].y * rstd * gg.y;
      o.z = v[i].z * rstd * gg.z;
      o.w = v[i].w * rstd * gg.w;
      *(float4*)(src + c) = o;
    }
  }
}

enum { EPI_Z = 0, EPI_RES = 1, EPI_SWIGLU = 2 };

template <int EPI>
DEV void gemm_phase(const P& p, int l, const u16* __restrict__ A, int lda, const u16* __restrict__ Bt, int K, int NT,
                           int mt_lo, int goff, char* smem, int dry = 0) {
  const int tid = tid_l(), lane = tid & 63, wid = tid >> 6, wr = wid >> 1, wc = wid & 1, l15 = lane & 15, quad = lane >> 4;
  const int nmt = NMT - mt_lo;
  const int nk = K / 64;
  const int npn = NT >> 2;
  const int npatch = (nmt >> 4) * npn;
  const int tmax = ((npatch + 7) >> 3) * 512;
  for (int t = bid_l(); t < tmax; t += gridDim.x) {
    const int xcd = t & 7, sidx = t >> 3;
    const int gp = (sidx >> 6) * 8 + xcd;
    if (gp >= npatch) continue;
    const int within = sidx & 63;
    const int mt = mt_lo + (gp / npn) * 16 + (within & 15), nt = (gp % npn) * 4 + (within >> 4);
    const int m0 = mt * 128, n0 = nt * 128;
    f32x4 acc[4][4];
#pragma unroll
    for (int i = 0; i < 4; ++i)
#pragma unroll
      for (int j = 0; j < 4; ++j) acc[i][j] = f32x4{0.f, 0.f, 0.f, 0.f};
    const u16* Ag = A + (size_t)(m0 + (tid >> 3)) * lda + (tid & 7) * 8;
    const u16* Bg = Bt + (size_t)(n0 + (tid >> 3)) * K + (tid & 7) * 8;
    uint4 xa0, xa1, xa2, xa3, xb0, xb1, xb2, xb3, ya0, ya1, ya2, ya3, yb0, yb1, yb2, yb3;
#define G_GL(P, KT)                                                          \
    {                                                                        \
      const int k0_ = (KT)*64;                                               \
      P##a0 = *(const uint4*)(Ag + k0_);                                     \
      P##b0 = *(const uint4*)(Bg + k0_);                                     \
      P##a1 = *(const uint4*)(Ag + (size_t)32 * lda + k0_);                  \
      P##b1 = *(const uint4*)(Bg + (size_t)32 * K + k0_);                    \
      P##a2 = *(const uint4*)(Ag + (size_t)64 * lda + k0_);                  \
      P##b2 = *(const uint4*)(Bg + (size_t)64 * K + k0_);                    \
      P##a3 = *(const uint4*)(Ag + (size_t)96 * lda + k0_);                  \
      P##b3 = *(const uint4*)(Bg + (size_t)96 * K + k0_);                    \
    }
#define G_LS(P, BUF)                                                         \
    {                                                                        \
      char* Aw_ = smem + (BUF)*32768;                                        \
      *(uint4*)(Aw_ + swz((tid >> 3), tid & 7)) = P##a0;                     \
      *(uint4*)(Aw_ + 16384 + swz((tid >> 3), tid & 7)) = P##b0;             \
      *(uint4*)(Aw_ + swz((tid >> 3) + 32, tid & 7)) = P##a1;                \
      *(uint4*)(Aw_ + 16384 + swz((tid >> 3) + 32, tid & 7)) = P##b1;        \
      *(uint4*)(Aw_ + swz((tid >> 3) + 64, tid & 7)) = P##a2;                \
      *(uint4*)(Aw_ + 16384 + swz((tid >> 3) + 64, tid & 7)) = P##b2;        \
      *(uint4*)(Aw_ + swz((tid >> 3) + 96, tid & 7)) = P##a3;                \
      *(uint4*)(Aw_ + 16384 + swz((tid >> 3) + 96, tid & 7)) = P##b3;        \
    }
#define G_COMPUTE(BUF)                                                                                             \
    {                                                                                                              \
      const char* As = smem + (BUF)*32768;                                                                         \
      const char* Bs = As + 16384;                                                                                 \
      _Pragma("unroll") for (int kh = 0; kh < 2; ++kh) {                                                           \
        bf16x8 a[4], b[4];                                                                                         \
        _Pragma("unroll") for (int mi = 0; mi < 4; ++mi)                                                           \
            a[mi] = *(const bf16x8*)(As + swz(wr * 64 + mi * 16 + l15, kh * 4 + quad));                            \
        _Pragma("unroll") for (int ni = 0; ni < 4; ++ni)                                                           \
            b[ni] = *(const bf16x8*)(Bs + swz(wc * 64 + ni * 16 + l15, kh * 4 + quad));                            \
        _Pragma("unroll") for (int mi = 0; mi < 4; ++mi)                                                           \
            _Pragma("unroll") for (int ni = 0; ni < 4; ++ni) acc[mi][ni] = mfma16(a[mi], b[ni], acc[mi][ni]);      \
      }                                                                                                            \
    }
    G_GL(x, 0);
    G_GL(y, 1);
    G_LS(x, 0);
    if (2 < nk) G_GL(x, 2);
    __syncthreads();
    for (int kt = 0; kt < nk; kt += 2) {
      G_COMPUTE(0);
      G_LS(y, 1);
      if (kt + 3 < nk) G_GL(y, kt + 3);
      __syncthreads();
      G_COMPUTE(1);
      if (kt + 2 < nk) G_LS(x, 0);
      if (kt + 4 < nk) G_GL(x, kt + 4);
      __syncthreads();
    }
#undef G_GL
#undef G_LS
#undef G_COMPUTE
    if (dry) {
      if (acc[0][0][0] == 1.2345e33f) p.bonus[0] = acc[1][1][1] + acc[2][2][2] + acc[3][3][3];
      continue;
    }
    const int cw0 = n0 + wc * 64;
    if constexpr (EPI == EPI_Z) {
      if (cw0 < 1920) {
#pragma unroll
        for (int mi = 0; mi < 4; ++mi)
#pragma unroll
          for (int j = 0; j < 4; ++j) {
            const int r = m0 + wr * 64 + mi * 16 + quad * 4 + j;
#pragma unroll
            for (int ni = 0; ni < 4; ++ni) p.z[(size_t)r * INC + cw0 + ni * 16 + l15] = f2bf(acc[mi][ni][j]);
            __builtin_amdgcn_sched_barrier(0);
          }
      } else {
        const int hh = (cw0 - 1920) >> 6;
        if (hh < 8) {
          const float* gp = (hh < 6 ? p.q_g : p.k_g) + l * 64;
          float gv[4];
#pragma unroll
          for (int ni = 0; ni < 4; ++ni) gv[ni] = gp[ni * 16 + l15];
          const float qs = hh < 6 ? 0.125f : 1.f;
#pragma unroll
          for (int mi = 0; mi < 4; ++mi)
#pragma unroll
            for (int j = 0; j < 4; ++j) {
              const int r = m0 + wr * 64 + mi * 16 + quad * 4 + j;
              float ss = 0.f;
#pragma unroll
              for (int ni = 0; ni < 4; ++ni) ss += acc[mi][ni][j] * acc[mi][ni][j];
              ss = red16_sum(ss);
              const float rstd = rsqrtf(ss * (1.f / 64.f) + 1e-6f);
              float yv[4];
#pragma unroll
              for (int ni = 0; ni < 4; ++ni) yv[ni] = acc[mi][ni][j] * rstd * gv[ni];
              if (r >= MC) {
                const int tt = (r - MC) & 4095;
                const int prow = tt >> 6, pcol = tt & 63;
                const float2 cr = *(const float2*)(p.rope + (prow * 16 + l15) * 2);
                const float2 cc = *(const float2*)(p.rope + (pcol * 16 + l15) * 2);
                float a0 = yv[0] * cr.x - yv[1] * cr.y, a1 = yv[1] * cr.x + yv[0] * cr.y;
                float a2 = yv[2] * cc.x - yv[3] * cc.y, a3 = yv[3] * cc.x + yv[2] * cc.y;
                yv[0] = a0; yv[1] = a1; yv[2] = a2; yv[3] = a3;
              }
#pragma unroll
              for (int ni = 0; ni < 4; ++ni) p.z[(size_t)r * INC + cw0 + ni * 16 + l15] = f2bf(yv[ni] * qs);
              __builtin_amdgcn_sched_barrier(0);
            }
        } else {
          const int kvh = hh - 8;
#pragma unroll
          for (int mi = 0; mi < 4; ++mi) {
            const int r0 = m0 + wr * 64 + mi * 16 + quad * 4;
#pragma unroll
            for (int ni = 0; ni < 4; ++ni) {
              const int d = ni * 16 + l15;
              uint2 o;
              o.x = pk2(acc[mi][ni][0], acc[mi][ni][1]);
              o.y = pk2(acc[mi][ni][2], acc[mi][ni][3]);
              if (r0 < MC) {
                const int b = r0 >> 8, tt = r0 & 255;
                *(uint2*)(p.vTc + ((size_t)((b * 2 + kvh) * 64 + d)) * CTXL + tt) = o;
              } else {
                const int rr = r0 - MC;
                const int b = rr >> 12, tt = rr & 4095;
                *(uint2*)(p.vTl + ((size_t)((b * 2 + kvh) * 64 + d)) * SEQ + tt) = o;
              }
            }
          }
        }
      }
    } else if constexpr (EPI == EPI_RES) {
      const int s = m0 < MC ? 8 : (m0 - MC) >> 12;
      const float* gate = p.mods + ((size_t)l * 9 + s) * 6144 + goff;
      float gv[4];
#pragma unroll
      for (int ni = 0; ni < 4; ++ni) gv[ni] = gate[cw0 + ni * 16 + l15];
#pragma unroll
      for (int mi = 0; mi < 4; ++mi)
#pragma unroll
        for (int j = 0; j < 4; ++j) {
          const int r = m0 + wr * 64 + mi * 16 + quad * 4 + j;
          const float* src;
          if (l == 0 && goff == 2048) src = r < MC ? p.ctx + (size_t)r * DM : p.x + (size_t)(r - MC) * DM;
          else src = r < MC ? p.xc + (size_t)r * DM : p.out + (size_t)(r - MC) * DM;
          float* dst = r < MC ? p.xc + (size_t)r * DM : p.out + (size_t)(r - MC) * DM;
#pragma unroll
          for (int ni = 0; ni < 4; ++ni) {
            const int c = cw0 + ni * 16 + l15;
            dst[c] = src[c] + gv[ni] * acc[mi][ni][j];
          }
          __builtin_amdgcn_sched_barrier(0);
        }
    } else {
      const int hc0 = (n0 >> 1) + wc * 32;
#pragma unroll
      for (int mi = 0; mi < 4; ++mi)
#pragma unroll
        for (int j = 0; j < 4; ++j) {
          const int r = m0 + wr * 64 + mi * 16 + quad * 4 + j;
#pragma unroll
          for (int pp = 0; pp < 2; ++pp) {
            float gt = acc[mi][2 * pp][j], up = acc[mi][2 * pp + 1][j];
            p.h[(size_t)r * DFF + hc0 + pp * 16 + l15] = f2bf(siluf_(gt) * up);
          }
          __builtin_amdgcn_sched_barrier(0);
        }
    }
  }
}

template <int LPR>
DEV float red_lpr(float v) {
  v += dppf<0xB1>(v);
  v += dppf<0x4E>(v);
  if (LPR >= 8) v += dppf<0x141>(v);
  if (LPR >= 16) v += dppf<0x140>(v);
  return v;
}

constexpr int SCAN_ITEMS = 192;

DEV float red8_sum(float v) {
  v += dppf<0xB1>(v);
  v += dppf<0x4E>(v);
  v += dppf<0x141>(v);
  return v;
}
DEV float tanh_fast(float x) {
  float e = __expf(2.f * x);
  return 1.f - 2.f * __builtin_amdgcn_rcpf(1.f + e);
}

struct ChunkPos { int len, rowbase, tlo; };
DEV ChunkPos chunk_pos(int c, int d, int b) {
  ChunkPos cp;
  const int s0 = c * 16;
  int pos0;
  if (s0 < 256) { cp.len = 256; pos0 = s0; cp.rowbase = b * 256; }
  else { cp.len = 4096; pos0 = s0 - 256; cp.rowbase = MC + b * 4096; }
  cp.tlo = d ? (cp.len - 16 - pos0) : pos0;
  return cp;
}

constexpr int SC_R = 0, SC_KD = 12288, SC_V = 24576, SC_W = 30720, SC_KA = 38912, SC_NKK = 47104;

DEV void cvt8(const uint4 u, float4& lo, float4& hi) {
  lo.x = __uint_as_float(u.x << 16); lo.y = __uint_as_float(u.x & 0xffff0000u);
  lo.z = __uint_as_float(u.y << 16); lo.w = __uint_as_float(u.y & 0xffff0000u);
  hi.x = __uint_as_float(u.z << 16); hi.y = __uint_as_float(u.z & 0xffff0000u);
  hi.z = __uint_as_float(u.w << 16); hi.w = __uint_as_float(u.w & 0xffff0000u);
}

DEV void scan_item(const P& p, int l, int item, char* smem) {
  const int tid = tid_l(), lane = tid & 63, wid = tid >> 6, l15 = lane & 15, quad = lane >> 4;
  const int scan = item >> 1, part = item & 1;
  const int d = scan / 48, b = (scan % 48) / 6, h = scan % 6;
  const int rloc = tid >> 3, jq = tid & 7;
  const int irow = part * 32 + rloc;
  const int j0 = jq * 8;

  const int c_ts = (tid & 127) >> 3, c_ch = tid & 7;
  const int c_col = (tid < 128 ? 0 : 384) + h * 64 + c_ch * 8;
  const int v_ts = tid >> 2, v_ch = tid & 3;
  const int v_col = 768 + h * 64 + part * 32 + v_ch * 8;

  const int n2 = wid * 16 + l15;
  bf16x8 bW[2], bA[2];
  {
    const u16* wb = p.wUpT + ((size_t)(l * 2 + d) * 384 + h * 64 + n2) * 64 + quad * 8;
    const u16* ab = p.aUpT + ((size_t)(l * 2 + d) * 384 + h * 64 + n2) * 64 + quad * 8;
    bW[0] = *(const bf16x8*)(wb);
    bW[1] = *(const bf16x8*)(wb + 32);
    bA[0] = *(const bf16x8*)(ab);
    bA[1] = *(const bf16x8*)(ab + 32);
  }
  const float w0v = p.w0[(size_t)(l * 2 + d) * 384 + h * 64 + n2];
  const float a0v = p.a0[(size_t)(l * 2 + d) * 384 + h * 64 + n2];
  const float kkc = p.k_k[l * 384 + h * 64 + n2], kac = p.k_a[l * 384 + h * 64 + n2], rkc = p.r_k[l * 384 + h * 64 + n2];

  float2v S2[4];
#pragma unroll
  for (int j = 0; j < 4; ++j) S2[j] = float2v{0.f, 0.f};
  uint4 g_rk, g_v;
  bf16x8 g_wd0, g_wd1, g_ad0, g_ad1;
  float g_inv[4];

#define SC_GLOAD1(CC)                                                                                  \
  {                                                                                                    \
    const ChunkPos cp_ = chunk_pos((CC), d, b);                                                        \
    g_rk = *(const uint4*)(p.z + (size_t)(cp_.rowbase + cp_.tlo + c_ts) * INC + c_col);                \
    if (tid < 64) g_v = *(const uint4*)(p.z + (size_t)(cp_.rowbase + cp_.tlo + v_ts) * INC + v_col);  \
  }
#define SC_GLOAD2(CC)                                                                                  \
  {                                                                                                    \
    const ChunkPos cp_ = chunk_pos((CC), d, b);                                                        \
    const u16* rp_ = p.z + (size_t)(cp_.rowbase + cp_.tlo + l15) * INC + 1152 + quad * 8;              \
    g_wd0 = *(const bf16x8*)(rp_);                                                                     \
    g_wd1 = *(const bf16x8*)(rp_ + 32);                                                                \
    g_ad0 = *(const bf16x8*)(rp_ + 64);                                                                \
    g_ad1 = *(const bf16x8*)(rp_ + 96);                                                                \
    _Pragma("unroll") for (int j = 0; j < 4; ++j)                                                      \
      g_inv[j] = p.invn[(size_t)(cp_.rowbase + cp_.tlo + quad * 4 + j) * 8 + h];                       \
  }
#define SC_STAGE1(CC)                                                                                  \
  {                                                                                                    \
    const int i3_ = (CC) % 3;                                                                          \
    float4 lo_, hi_;                                                                                   \
    cvt8(g_rk, lo_, hi_);                                                                              \
    float* dst_ = (float*)(smem + (tid < 128 ? SC_R : SC_KD) + i3_ * 4096) + c_ts * 64 + c_ch * 8;     \
    *(float4*)dst_ = lo_;                                                                              \
    *(float4*)(dst_ + 4) = hi_;                                                                        \
    if (tid < 64) {                                                                                    \
      cvt8(g_v, lo_, hi_);                                                                             \
      float* dv_ = (float*)(smem + SC_V + i3_ * 2048) + v_ts * 32 + v_ch * 8;                          \
      *(float4*)dv_ = lo_;                                                                             \
      *(float4*)(dv_ + 4) = hi_;                                                                       \
    }                                                                                                  \
  }
#define SC_STAGE2(CC)                                                                                  \
  {                                                                                                    \
    const int i3_ = (CC) % 3, i2_ = (CC)&1;                                                            \
    const ChunkPos cp_ = chunk_pos((CC), d, b);                                                        \
    f32x4 accW = f32x4{0.f, 0.f, 0.f, 0.f}, accA = f32x4{0.f, 0.f, 0.f, 0.f};                          \
    accW = mfma16(g_wd0, bW[0], accW);                                                                 \
    accW = mfma16(g_wd1, bW[1], accW);                                                                 \
    accA = mfma16(g_ad0, bA[0], accA);                                                                 \
    accA = mfma16(g_ad1, bA[1], accA);                                                                 \
    float bon_[4];                                                                                     \
    _Pragma("unroll") for (int j = 0; j < 4; ++j) {                                                    \
      const int ts = quad * 4 + j;                                                                     \
      float* kdp = (float*)(smem + SC_KD + i3_ * 4096) + ts * 64 + n2;                                 \
      const float kv = *kdp;                                                                           \
      const float rv = *((const float*)(smem + SC_R + i3_ * 4096) + ts * 64 + n2);                     \
      const float sg = sigmoidf_(w0v + accW[j]);                                                       \
      const float wv = __expf(-0.6065306597126334f * sg);                                              \
      const float av = sigmoidf_(a0v + accA[j]);                                                       \
      const float kn = kv * kkc * g_inv[j];                                                            \
      const float kd = kv * (1.f + (av - 1.f) * kac);                                                  \
      *((float*)(smem + SC_W + i2_ * 4096) + ts * 64 + n2) = wv;                                       \
      *((float*)(smem + SC_NKK + i2_ * 4096) + ts * 64 + n2) = -kn;                                    \
      *((float*)(smem + SC_KA + i2_ * 4096) + ts * 64 + n2) = kn * av;                                 \
      *kdp = kd;                                                                                       \
      bon_[j] = rv * kd * rkc;                                                                         \
    }                                                                                                  \
    _Pragma("unroll") for (int j = 0; j < 4; ++j) bon_[j] = red16_sum(bon_[j]);                        \
    if (l15 == 0 && part == 0) {                                                                       \
      _Pragma("unroll") for (int j = 0; j < 4; ++j)                                                    \
        p.bonus[(size_t)(cp_.rowbase + cp_.tlo + quad * 4 + j) * 48 + (d * 6 + h) * 4 + wid] = bon_[j]; \
    }                                                                                                  \
  }

  SC_GLOAD1(0);
  SC_GLOAD2(0);
  SC_STAGE1(0);
  SC_GLOAD1(1);
  __syncthreads();
  SC_STAGE2(0);
  SC_STAGE1(1);
  SC_GLOAD1(2);
  SC_GLOAD2(1);
  __syncthreads();

  for (int c = 0; c < 272; ++c) {
    {
      const int i3 = c % 3, i2 = c & 1;
      const ChunkPos cp = chunk_pos(c, d, b);
      const float* pW = (const float*)(smem + SC_W + i2 * 4096) + j0;
      const float* pN = (const float*)(smem + SC_NKK + i2 * 4096) + j0;
      const float* pA = (const float*)(smem + SC_KA + i2 * 4096) + j0;
      const float* pD = (const float*)(smem + SC_KD + i3 * 4096) + j0;
      const float* pR = (const float*)(smem + SC_R + i3 * 4096) + j0;
      const float* pV = (const float*)(smem + SC_V + i3 * 2048) + rloc;
      float* yp = p.y + ((size_t)d * MT + cp.rowbase + cp.tlo) * 384 + h * 64 + irow;
      float2v yk0 = float2v{0.f, 0.f};
      float4 cw0, cw1, cn0, cn1, ca0, ca1, cd0, cd1, cr0, cr1;
      float cvi;
#define SC_LD(TS, W0, W1, N0, N1, A0, A1, D0, D1, R0, R1, VI)                                   \
      W0 = *(const float4*)(pW + (TS)*64); W1 = *(const float4*)(pW + (TS)*64 + 4);              \
      N0 = *(const float4*)(pN + (TS)*64); N1 = *(const float4*)(pN + (TS)*64 + 4);              \
      A0 = *(const float4*)(pA + (TS)*64); A1 = *(const float4*)(pA + (TS)*64 + 4);              \
      D0 = *(const float4*)(pD + (TS)*64); D1 = *(const float4*)(pD + (TS)*64 + 4);              \
      R0 = *(const float4*)(pR + (TS)*64); R1 = *(const float4*)(pR + (TS)*64 + 4);              \
      VI = pV[(TS)*32];
      {
        const int ts0 = d ? 15 : 0;
        SC_LD(ts0, cw0, cw1, cn0, cn1, ca0, ca1, cd0, cd1, cr0, cr1, cvi)
      }
#pragma unroll
      for (int si = 0; si < 16; ++si) {
        float4 xw0, xw1, xn0, xn1, xa0, xa1, xd0, xd1, xr0, xr1;
        float xvi = 0.f;
        if (si + 1 < 16) {
          const int tsn = d ? 14 - si : si + 1;
          SC_LD(tsn, xw0, xw1, xn0, xn1, xa0, xa1, xd0, xd1, xr0, xr1, xvi)
        }
        float2v sa2 = S2[0] * float2v{cn0.x, cn0.y};
        sa2 = S2[1] * float2v{cn0.z, cn0.w} + sa2;
        sa2 = S2[2] * float2v{cn1.x, cn1.y} + sa2;
        sa2 = S2[3] * float2v{cn1.z, cn1.w} + sa2;
        const float sa = red8_sum(sa2.x + sa2.y);
        const float2v sav = float2v{sa, sa}, viv = float2v{cvi, cvi};
        S2[0] = S2[0] * float2v{cw0.x, cw0.y} + (sav * float2v{ca0.x, ca0.y} + viv * float2v{cd0.x, cd0.y});
        S2[1] = S2[1] * float2v{cw0.z, cw0.w} + (sav * float2v{ca0.z, ca0.w} + viv * float2v{cd0.z, cd0.w});
        S2[2] = S2[2] * float2v{cw1.x, cw1.y} + (sav * float2v{ca1.x, ca1.y} + viv * float2v{cd1.x, cd1.y});
        S2[3] = S2[3] * float2v{cw1.z, cw1.w} + (sav * float2v{ca1.z, ca1.w} + viv * float2v{cd1.z, cd1.w});
        float2v y2 = S2[0] * float2v{cr0.x, cr0.y};
        y2 = S2[1] * float2v{cr0.z, cr0.w} + y2;
        y2 = S2[2] * float2v{cr1.x, cr1.y} + y2;
        y2 = S2[3] * float2v{cr1.z, cr1.w} + y2;
        const float yv = red8_sum(y2.x + y2.y);
        if (si < 8) yk0.x = (jq == si) ? yv : yk0.x;
        else yk0.y = (jq == si - 8) ? yv : yk0.y;
        if (si + 1 < 16) {
          cw0 = xw0; cw1 = xw1; cn0 = xn0; cn1 = xn1; ca0 = xa0; ca1 = xa1; cd0 = xd0; cd1 = xd1; cr0 = xr0; cr1 = xr1; cvi = xvi;
        }
      }
#undef SC_LD
      {
        const int tsa = d ? 15 - jq : jq, tsb = d ? 7 - jq : 8 + jq;
        yp[(size_t)tsa * 384] = yk0.x;
        yp[(size_t)tsb * 384] = yk0.y;
      }
    }
    if (c + 1 < 272) SC_STAGE2(c + 1);
    if (c + 2 < 272) SC_STAGE1(c + 2);
    if (c + 3 < 272) SC_GLOAD1(c + 3);
    if (c + 2 < 272) SC_GLOAD2(c + 2);
    __syncthreads();
  }
#undef SC_GLOAD1
#undef SC_GLOAD2
#undef SC_STAGE1
#undef SC_STAGE2
}

DEV void attn_item(const P& p, int item, char* smem) {
  const int tid = tid_l(), lane = tid & 63, wid = tid >> 6, l15 = lane & 15, quad = lane >> 4;
  bool lat = item < 1536;
  int b, hq, qb;
  if (lat) { b = item / 192; int rem = item % 192; hq = rem / 32; qb = rem % 32; }
  else { int i2 = item - 1536; b = i2 / 12; int rem = i2 % 12; hq = rem / 2; qb = rem % 2; }
  const int kvh = hq / 3;
  const int qrow0 = lat ? MC + b * 4096 + qb * 128 : b * 256 + qb * 128;
  const int nkt = lat ? 68 : 4;
  const float LOG2E = 1.4426950408889634f;

  bf16x8 qf[2][2];
#pragma unroll
  for (int mi = 0; mi < 2; ++mi)
#pragma unroll
    for (int ks = 0; ks < 2; ++ks)
      qf[mi][ks] = *(const bf16x8*)(p.z + (size_t)(qrow0 + wid * 32 + mi * 16 + l15) * INC + 1920 + hq * 64 + ks * 32 + quad * 8);

  f32x4 O[2][4];
  float mrow[2][4], lpart[2][4];
#pragma unroll
  for (int mi = 0; mi < 2; ++mi) {
#pragma unroll
    for (int nd = 0; nd < 4; ++nd) O[mi][nd] = f32x4{0.f, 0.f, 0.f, 0.f};
#pragma unroll
    for (int j = 0; j < 4; ++j) { mrow[mi][j] = -1e30f; lpart[mi][j] = 0.f; }
  }
  char* Ps = smem + 32768 + wid * 4096;
  const int lrow = tid >> 3, lch = tid & 7;
  uint4 rk0, rk1, rv0, rv1;
#define ATT_GLOAD(KT)                                                                         \
  {                                                                                           \
    const int kt_ = (KT);                                                                     \
    const u16* kp;                                                                            \
    const u16* vp;                                                                            \
    int vstride;                                                                              \
    if (lat && kt_ < 64) {                                                                    \
      kp = p.z + (size_t)(MC + b * 4096 + kt_ * 64) * INC + 2304 + kvh * 64;                  \
      vp = p.vTl + (size_t)((b * 2 + kvh) * 64) * SEQ + kt_ * 64;                             \
      vstride = SEQ;                                                                          \
    } else {                                                                                  \
      const int kc = lat ? kt_ - 64 : kt_;                                                    \
      kp = p.z + (size_t)(b * 256 + kc * 64) * INC + 2304 + kvh * 64;                         \
      vp = p.vTc + (size_t)((b * 2 + kvh) * 64) * CTXL + kc * 64;                             \
      vstride = CTXL;                                                                         \
    }                                                                                         \
    rk0 = *(const uint4*)(kp + (size_t)(lrow)*INC + lch * 8);                                 \
    rk1 = *(const uint4*)(kp + (size_t)(lrow + 32) * INC + lch * 8);                          \
    rv0 = *(const uint4*)(vp + (size_t)(lrow)*vstride + lch * 8);                             \
    rv1 = *(const uint4*)(vp + (size_t)(lrow + 32) * vstride + lch * 8);                      \
  }
#define ATT_LSTORE(BUF)                                     \
  {                                                         \
    char* Kb_ = smem + (BUF)*16384;                         \
    *(uint4*)(Kb_ + swz(lrow, lch)) = rk0;                  \
    *(uint4*)(Kb_ + swz(lrow + 32, lch)) = rk1;             \
    *(uint4*)(Kb_ + 8192 + swz(lrow, lch)) = rv0;           \
    *(uint4*)(Kb_ + 8192 + swz(lrow + 32, lch)) = rv1;      \
  }
  ATT_GLOAD(0);
  ATT_LSTORE(0);
  __syncthreads();
  for (int kt = 0; kt < nkt; ++kt) {
    const int buf = kt & 1;
    if (kt + 1 < nkt) ATT_GLOAD(kt + 1);
    const char* Kb = smem + buf * 16384;
    const char* Vb = Kb + 8192;
    f32x4 Sx[2][4];
#pragma unroll
    for (int mi = 0; mi < 2; ++mi)
#pragma unroll
      for (int ni = 0; ni < 4; ++ni) Sx[mi][ni] = f32x4{0.f, 0.f, 0.f, 0.f};
#pragma unroll
    for (int ks = 0; ks < 2; ++ks) {
      bf16x8 kf[4];
#pragma unroll
      for (int ni = 0; ni < 4; ++ni) kf[ni] = *(const bf16x8*)(Kb + swz(ni * 16 + l15, ks * 4 + quad));
#pragma unroll
      for (int mi = 0; mi < 2; ++mi)
#pragma unroll
        for (int ni = 0; ni < 4; ++ni) Sx[mi][ni] = mfma16(qf[mi][ks], kf[ni], Sx[mi][ni]);
    }
#pragma unroll
    for (int mi = 0; mi < 2; ++mi)
#pragma unroll
      for (int j = 0; j < 4; ++j) {
        float mx = fmaxf(fmaxf(Sx[mi][0][j], Sx[mi][1][j]), fmaxf(Sx[mi][2][j], Sx[mi][3][j]));
        mx = red16_max(mx);
        const float mnew = fmaxf(mrow[mi][j], mx);
        const float alpha = __builtin_amdgcn_exp2f((mrow[mi][j] - mnew) * LOG2E);
        mrow[mi][j] = mnew;
        const float mb = mnew * LOG2E;
        float ps = 0.f;
        const int prow = mi * 16 + quad * 4 + j;
#pragma unroll
        for (int ni = 0; ni < 4; ++ni) {
          float pv = __builtin_amdgcn_exp2f(Sx[mi][ni][j] * LOG2E - mb);
          ps += pv;
          *(u16*)(Ps + swz(prow, ni * 2 + (l15 >> 3)) + (l15 & 7) * 2) = f2bf(pv);
        }
        lpart[mi][j] = lpart[mi][j] * alpha + ps;
#pragma unroll
        for (int nd = 0; nd < 4; ++nd) O[mi][nd][j] *= alpha;
      }
    __builtin_amdgcn_fence(__ATOMIC_RELEASE, "wavefront");
    __builtin_amdgcn_wave_barrier();
    __builtin_amdgcn_fence(__ATOMIC_ACQUIRE, "wavefront");
#pragma unroll
    for (int ks = 0; ks < 2; ++ks) {
      bf16x8 pf[2], vf[4];
#pragma unroll
      for (int mi = 0; mi < 2; ++mi) pf[mi] = *(const bf16x8*)(Ps + swz(mi * 16 + l15, ks * 4 + quad));
#pragma unroll
      for (int nd = 0; nd < 4; ++nd) vf[nd] = *(const bf16x8*)(Vb + swz(nd * 16 + l15, ks * 4 + quad));
#pragma unroll
      for (int mi = 0; mi < 2; ++mi)
#pragma unroll
        for (int nd = 0; nd < 4; ++nd) O[mi][nd] = mfma16(pf[mi], vf[nd], O[mi][nd]);
    }
    if (kt + 1 < nkt) ATT_LSTORE(buf ^ 1);
    __syncthreads();
  }
#pragma unroll
  for (int mi = 0; mi < 2; ++mi)
#pragma unroll
    for (int j = 0; j < 4; ++j) {
      const float lsum = red16_sum(lpart[mi][j]);
      const float inv = 1.f / lsum;
      const int r = qrow0 + wid * 32 + mi * 16 + quad * 4 + j;
#pragma unroll
      for (int nd = 0; nd < 4; ++nd) p.act[(size_t)r * DM + 640 + hq * 64 + nd * 16 + l15] = f2bf(O[mi][nd][j] * inv);
    }
}

DEV void sgate_item(const P& p, int l, int ck, int g, char* smem) {
  const int tid = tid_l(), lane = tid & 63, wid = tid >> 6, l15 = lane & 15, quad = lane >> 4;
  const int m0 = ck * 128;
  u16* sVT = (u16*)smem;
  {
    const int q = tid >> 1, half = tid & 1;
    const u16* src = p.z + (size_t)(m0 + q) * INC + 1408 + 256 + g * 64 + half * 32;
    float v[32];
    float ss = 0.f;
#pragma unroll
    for (int cidx = 0; cidx < 4; ++cidx) {
      uint4 u = *(const uint4*)(src + cidx * 8);
      unsigned uu[4] = {u.x, u.y, u.z, u.w};
#pragma unroll
      for (int e = 0; e < 4; ++e) {
        float f0 = geluf_(bf2f((u16)(uu[e] & 0xffff)));
        float f1 = geluf_(bf2f((u16)(uu[e] >> 16)));
        v[cidx * 8 + e * 2] = f0;
        v[cidx * 8 + e * 2 + 1] = f1;
        ss += f0 * f0 + f1 * f1;
      }
    }
    ss += __shfl_xor(ss, 1);
    const float rstd = rsqrtf(ss * (1.f / 64.f) + 1e-6f);
    const float* gn = p.sgn + l * 256 + g * 64 + half * 32;
#pragma unroll
    for (int e = 0; e < 32; ++e) sVT[(half * 32 + e) * 136 + q] = f2bf(v[e] * rstd * gn[e]);
  }
  __syncthreads();
  f32x4 acc[2][4];
#pragma unroll
  for (int mi = 0; mi < 2; ++mi)
#pragma unroll
    for (int ni = 0; ni < 4; ++ni) acc[mi][ni] = f32x4{0.f, 0.f, 0.f, 0.f};
  const u16* Wg = p.sgW + (size_t)(l * 4 + g) * 128 * 128;
#pragma unroll
  for (int ks = 0; ks < 4; ++ks) {
    bf16x8 a[2], bb[4];
#pragma unroll
    for (int mi = 0; mi < 2; ++mi) a[mi] = *(const bf16x8*)(Wg + (size_t)(wid * 32 + mi * 16 + l15) * 128 + ks * 32 + quad * 8);
#pragma unroll
    for (int ni = 0; ni < 4; ++ni) bb[ni] = *(const bf16x8*)(sVT + (ni * 16 + l15) * 136 + ks * 32 + quad * 8);
#pragma unroll
    for (int mi = 0; mi < 2; ++mi)
#pragma unroll
      for (int ni = 0; ni < 4; ++ni) acc[mi][ni] = mfma16(a[mi], bb[ni], acc[mi][ni]);
  }
#pragma unroll
  for (int mi = 0; mi < 2; ++mi)
#pragma unroll
    for (int j = 0; j < 4; ++j) {
      const int pr = wid * 32 + mi * 16 + quad * 4 + j;
      const float bias = p.sg_b[(size_t)(l * 4 + g) * 128 + pr];
#pragma unroll
      for (int ni = 0; ni < 4; ++ni) {
        const int c = ni * 16 + l15;
        float u = geluf_(bf2f(p.z[(size_t)(m0 + pr) * INC + 1408 + g * 64 + c]));
        p.act[(size_t)(m0 + pr) * DM + 384 + g * 64 + c] = f2bf(u * (acc[mi][ni][j] + bias));
      }
    }
  __syncthreads();
}

DEV void mix_phase(const P& p, int l, char* smem, int cidx) {
  __shared__ int s_item;
  const bool last = (l == DEPTH - 1);
  const int n_attn = last ? 1536 : 1632;
  const int ck_lo = last ? 16 : 0;
  const int n_sg = (NMT - ck_lo) * 4;
  const int total = SCAN_ITEMS + n_attn + n_sg;
  const int bid = bid_l();
  bool first = bid < SCAN_ITEMS;
  for (;;) {
    int it;
    if (first) {
      it = bid;
      first = false;
    } else {
      if (tid_l() == 0) s_item = SCAN_ITEMS + atomicAdd(p.cnt + cidx, 1);
      __syncthreads();
      it = s_item;
      __syncthreads();
    }
    if (it >= total) break;
    if (it < SCAN_ITEMS) {
      int nr = SCAN_REP; asm volatile("" : "+s"(nr));
      for (int rr = 0; rr < nr; ++rr) scan_item(p, l, it, smem);
    } else if (it < SCAN_ITEMS + n_attn) {
      int nr = ATT_REP; asm volatile("" : "+s"(nr));
      for (int rr = 0; rr < nr; ++rr) { attn_item(p, it - SCAN_ITEMS, smem); __syncthreads(); }
    } else {
      int i2 = it - SCAN_ITEMS - n_attn;
      int nr = SG_REP; asm volatile("" : "+s"(nr));
      for (int rr = 0; rr < nr; ++rr) sgate_item(p, l, ck_lo + (i2 >> 2), i2 & 3, smem);
    }
  }
}

DEV void apost_phase(const P& p, int l, int mt_lo, char* smem) {
  const int tid = tid_l(), lane = tid & 63, wid = tid >> 6, l15 = lane & 15, quad = lane >> 4;
  for (int mt = mt_lo + bid_l(); mt < NMT; mt += gridDim.x) {
    const int m0 = mt * 128;
    bf16x8 a[2][4];
#pragma unroll
    for (int mi = 0; mi < 2; ++mi)
#pragma unroll
      for (int ks = 0; ks < 4; ++ks)
        a[mi][ks] = *(const bf16x8*)(p.z + (size_t)(m0 + wid * 32 + mi * 16 + l15) * INC + 1280 + ks * 32 + quad * 8);
#pragma unroll 1
    for (int hh = 0; hh < 6; ++hh) {
      f32x4 acc[2][4];
#pragma unroll
      for (int mi = 0; mi < 2; ++mi)
#pragma unroll
        for (int ni = 0; ni < 4; ++ni) acc[mi][ni] = f32x4{0.f, 0.f, 0.f, 0.f};
#pragma unroll
      for (int ks = 0; ks < 4; ++ks) {
        bf16x8 bb[4];
#pragma unroll
        for (int ni = 0; ni < 4; ++ni)
          bb[ni] = *(const bf16x8*)(p.gUpT + ((size_t)l * 384 + hh * 64 + ni * 16 + l15) * 128 + ks * 32 + quad * 8);
#pragma unroll
        for (int mi = 0; mi < 2; ++mi)
#pragma unroll
          for (int ni = 0; ni < 4; ++ni) acc[mi][ni] = mfma16(a[mi][ks], bb[ni], acc[mi][ni]);
      }
      float lg[4], lb[4];
#pragma unroll
      for (int ni = 0; ni < 4; ++ni) {
        const int c = hh * 64 + ni * 16 + l15;
        lg[ni] = p.ln_g[l * 384 + c];
        lb[ni] = p.ln_b[l * 384 + c];
      }
#pragma unroll
      for (int mi = 0; mi < 2; ++mi)
#pragma unroll
        for (int j = 0; j < 4; ++j) {
          const int r = m0 + wid * 32 + mi * 16 + quad * 4 + j;
          float ys[4], vv[4];
          float sm = 0.f;
#pragma unroll
          for (int ni = 0; ni < 4; ++ni) {
            const int c = hh * 64 + ni * 16 + l15;
            ys[ni] = p.y[(size_t)r * 384 + c] + p.y[((size_t)MT + r) * 384 + c];
            vv[ni] = bf2f(p.z[(size_t)r * INC + 768 + c]);
            sm += ys[ni];
          }
          const float4 bq0 = *(const float4*)(p.bonus + (size_t)r * 48 + hh * 4);
          const float4 bq1 = *(const float4*)(p.bonus + (size_t)r * 48 + (6 + hh) * 4);
          const float bon = (bq0.x + bq0.y) + (bq0.z + bq0.w) + (bq1.x + bq1.y) + (bq1.z + bq1.w);
          sm = red16_sum(sm);
          const float mean = sm * (1.f / 64.f);
          float vs = 0.f;
#pragma unroll
          for (int ni = 0; ni < 4; ++ni) { ys[ni] -= mean; vs += ys[ni] * ys[ni]; }
          vs = red16_sum(vs);
          const float rstd = rsqrtf(vs * (1.f / 64.f) + 64e-5f);
#pragma unroll
          for (int ni = 0; ni < 4; ++ni) {
            const int c = hh * 64 + ni * 16 + l15;
            float o = (ys[ni] * rstd * lg[ni] + lb[ni] + bon * vv[ni]) * acc[mi][ni][j];
            p.act[(size_t)r * DM + c] = f2bf(o);
          }
          __builtin_amdgcn_sched_barrier(0);
        }
    }
  }
}

DEV uint2 ld8(const u16* q) { return *(const uint2*)q; }
DEV void up4(const uint2 u, float (&f)[4]) {
  f[0] = __uint_as_float(u.x << 16); f[1] = __uint_as_float(u.x & 0xffff0000u);
  f[2] = __uint_as_float(u.y << 16); f[3] = __uint_as_float(u.y & 0xffff0000u);
}
DEV void prep_phase(const P& p, int l, cg::grid_group& grid) {
  const int tid = tid_l(), lane = tid & 63, l15 = lane & 15;
  const int nb = gridDim.x, bid = bid_l();
  const int rpb = (((MT + nb - 1) / nb) + 3) & ~3;
  const int ra = bid * rpb;
  const int rb = min(ra + rpb, MT);
  const bool active = ra < MT;
  const bool has1 = tid < 96;
  const int col0 = tid * 4, col1 = 1024 + tid * 4;
  uint2 hp0 = make_uint2(0, 0), hn0 = hp0, hp1 = hp0, hn1 = hp0;
  if (active) {
    if (ra > 0) { hp0 = ld8(p.z + (size_t)(ra - 1) * INC + col0); if (has1) hp1 = ld8(p.z + (size_t)(ra - 1) * INC + col1); }
    if (rb < MT) { hn0 = ld8(p.z + (size_t)rb * INC + col0); if (has1) hn1 = ld8(p.z + (size_t)rb * INC + col1); }
  }
  grid.sync();
  if (!active) return;
  const float* cw = p.conv + (size_t)l * 3 * 1408;
#pragma unroll 1
  for (int pass = 0; pass < 2; ++pass) {
    if (pass == 1 && !has1) break;
    const int col = pass ? col1 : col0;
    const int typ = col < 1152 ? 0 : (col < 1216 ? 1 : (col < 1280 ? 0 : 2));
    const bool isk = col >= 384 && col < 768;
    float c0[4], c1[4], c2[4], kk4[4];
#pragma unroll
    for (int e = 0; e < 4; ++e) {
      c0[e] = cw[col + e]; c1[e] = cw[1408 + col + e]; c2[e] = cw[2816 + col + e];
      kk4[e] = isk ? p.k_k[l * 384 + (col - 384) + e] : 0.f;
    }
    const int hh = isk ? (col - 384) >> 6 : 0;
    u16* zc = p.z + col;
    uint2 prev = pass ? hp1 : hp0;
    const uint2 halo_n = pass ? hn1 : hn0;
    uint2 cur = ld8(zc + (size_t)ra * INC);
    for (int r = ra; r < rb; r += 4) {
      uint2 nx[4];
#pragma unroll
      for (int q = 0; q < 4; ++q) {
        const int rr = r + 1 + q;
        nx[q] = rr < rb ? ld8(zc + (size_t)rr * INC) : halo_n;
      }
#pragma unroll
      for (int q = 0; q < 4; ++q) {
        const int rr = r + q;
        const uint2 xp = q == 0 ? prev : (q == 1 ? cur : nx[q - 2]);
        const uint2 xc = q == 0 ? cur : nx[q - 1];
        const uint2 xn = nx[q];
        const int tt = rr < MC ? (rr & 255) : ((rr - MC) & 4095);
        const int len = rr < MC ? 256 : 4096;
        const float mp = tt > 0 ? 1.f : 0.f, mn = tt < len - 1 ? 1.f : 0.f;
        float fp[4], fc[4], fn[4], o[4];
        up4(xp, fp); up4(xc, fc); up4(xn, fn);
#pragma unroll
        for (int e = 0; e < 4; ++e) {
          float v = fc[e] * c1[e] + mp * (fp[e] * c0[e]) + mn * (fn[e] * c2[e]);
          if (typ == 1) v = tanh_fast(v);
          else if (typ == 2) v = sigmoidf_(v);
          o[e] = v;
        }
        if (isk) {
          float q0 = o[0] * kk4[0], q1 = o[1] * kk4[1], q2 = o[2] * kk4[2], q3 = o[3] * kk4[3];
          float ss = red16_sum(q0 * q0 + q1 * q1 + q2 * q2 + q3 * q3);
          if (l15 == 0 && rr < rb) p.invn[(size_t)rr * 8 + hh] = 1.f / fmaxf(sqrtf(ss), 1e-12f);
        }
        if (rr < rb) *(uint2*)(zc + (size_t)rr * INC) = make_uint2(pk2(o[0], o[1]), pk2(o[2], o[3]));
      }
      prev = nx[2];
      cur = nx[3];
    }
  }
}

__global__ void __launch_bounds__(256, 2) fwd_megakernel(P p, int ph_lo, int ph_hi) {
  __shared__ __attribute__((aligned(16))) char smem[65536 - 64];
  cg::grid_group grid = cg::this_grid();
  for (int ph = ph_lo; ph < ph_hi; ++ph) {
    if (ph > ph_lo) grid.sync();
    if (ph == 0) { phase0(p, smem); continue; }
    if (ph == 1 + 8 * DEPTH) { final_norm(p); continue; }
    const int l = (ph - 1) >> 3, sub = (ph - 1) & 7;
    const bool last = (l == DEPTH - 1);
    const int mt_lo = last ? 16 : 0;
    int nrep = ((PROBE_MASK >> sub) & 1) ? 2 : 1;
    asm volatile("" : "+s"(nrep));
    for (int rep = 0; rep < nrep; ++rep) {
      if (rep) grid.sync();
      const int dry = (rep + 1 < nrep) ? 1 : 0;
      if (sub == 0 || sub == 5) {
        const bool n2 = sub == 5;
        norm_phase(p, l, (n2 ? p.n2g : p.n1g) + l * DM, n2 ? 3072 : 0, n2 ? 4096 : 1024, n2 ? mt_lo * 128 : 0, !n2 && l == 0);
      } else if (sub == 1) {
        gemm_phase<EPI_Z>(p, l, p.act, DM, p.wIn + (size_t)l * 2560 * 1024, 1024, 20, 0, 0, smem, dry);
      } else if (sub == 2) {
        if (rep == 0) { prep_phase(p, l, grid); grid.sync(); }
        mix_phase(p, l, smem, l + 8 * rep);
      } else if (sub == 3) {
        apost_phase(p, l, mt_lo, smem);
      } else if (sub == 4 || sub == 7) {
        const bool g4 = sub == 7;
        gemm_phase<EPI_RES>(p, l, g4 ? p.h : p.act, g4 ? DFF : DM,
                            g4 ? p.w2t + (size_t)l * 1024 * 2816 : p.wOut + (size_t)l * 1024 * 1024, g4 ? 2816 : 1024, 8, mt_lo,
                            g4 ? 5120 : 2048, smem, dry);
      } else {
        gemm_phase<EPI_SWIGLU>(p, l, p.act, DM, p.w1t + (size_t)l * 5632 * 1024, 1024, 44, mt_lo, 0, smem, dry);
      }
    }
  }
}

extern "C" void kernel_launch(void* const* d_in, const int* in_sizes, int n_in, void* d_out, int out_size, void* d_ws,
                              size_t ws_size, hipStream_t stream) {
  static int grid_blocks = 0;
  if (!grid_blocks) {
    int dev = 0, cus = 0, per_cu = 0;
    hipGetDevice(&dev);
    hipDeviceGetAttribute(&cus, hipDeviceAttributeMultiprocessorCount, dev);
    hipOccupancyMaxActiveBlocksPerMultiprocessor(&per_cu, fwd_megakernel, 256, 0);
    if (per_cu > 2) per_cu = 2;
    if (per_cu < 1) per_cu = 1;
    grid_blocks = cus * per_cu;
  }
  P p{};
  const float* const* in = (const float* const*)d_in;
  p.x = in[0]; p.c = in[1]; p.ctx = in[2]; p.c_ctx = in[3]; p.n1g = in[4]; p.n2g = in[5]; p.ada_w = in[6]; p.ada_b = in[7];
  p.w_in = in[8]; p.conv = in[9]; p.w0 = in[10]; p.w_up = in[11]; p.a0 = in[12]; p.a_up = in[13]; p.g_up = in[14];
  p.k_k = in[15]; p.k_a = in[16]; p.r_k = in[17]; p.ln_g = in[18]; p.ln_b = in[19]; p.sgn = in[20]; p.sg_w = in[21];
  p.sg_b = in[22]; p.q_g = in[23]; p.k_g = in[24]; p.w_out = in[25]; p.w1 = in[26]; p.w2 = in[27]; p.fng = in[28];
  p.out = (float*)d_out;
  char* ws = (char*)d_ws;
  size_t off = 0;
  auto take = [&](size_t bytes) { char* r = ws + off; off += (bytes + 255) & ~(size_t)255; return r; };
  p.wIn = (u16*)take((size_t)4 * 2560 * 1024 * 2);
  p.wOut = (u16*)take((size_t)4 * 1024 * 1024 * 2);
  p.w1t = (u16*)take((size_t)4 * 5632 * 1024 * 2);
  p.w2t = (u16*)take((size_t)4 * 1024 * 2816 * 2);
  p.wUpT = (u16*)take((size_t)8 * 384 * 64 * 2);
  p.aUpT = (u16*)take((size_t)8 * 384 * 64 * 2);
  p.gUpT = (u16*)take((size_t)4 * 384 * 128 * 2);
  p.sgW = (u16*)take((size_t)16 * 128 * 128 * 2);
  p.mods = (float*)take((size_t)4 * 9 * 6144 * 4);
  p.rope = (float*)take(2048 * 4);
  p.cnt = (int*)take(256);
  p.xc = (float*)take((size_t)MC * DM * 4);
  p.act = (u16*)take((size_t)MT * DM * 2);
  p.z = (u16*)take((size_t)MT * DFF * 2);
  p.h = p.z;
  p.vTl = (u16*)take((size_t)16 * 64 * SEQ * 2);
  p.vTc = (u16*)take((size_t)16 * 64 * CTXL * 2);
  p.y = (float*)take((size_t)2 * MT * 384 * 4);
  p.bonus = (float*)take((size_t)MT * 48 * 4);
  p.invn = (float*)take((size_t)MT * 8 * 4);
  if (off > ws_size) { fprintf(stderr, "workspace too small: need %zu have %zu\n", off, ws_size); return; }
  int ph_lo = 0, ph_hi = 2 + 8 * DEPTH;
  void* args[] = {&p, &ph_lo, &ph_hi};
  hipError_t e = hipLaunchCooperativeKernel((void*)fwd_megakernel, dim3(grid_blocks), dim3(256), args, 0, stream);
  if (e != hipSuccess) fprintf(stderr, "cooperative launch failed: %s (grid %d)\n", hipGetErrorString(e), grid_blocks);
}
```

```cpp
#include <hip/hip_runtime.h>
#include <hip/hip_bf16.h>
#include <hip/hip_cooperative_groups.h>
#include <cstdio>
namespace cg = cooperative_groups;

typedef __attribute__((ext_vector_type(8))) short bf16x8;
typedef __attribute__((ext_vector_type(4))) float f32x4;
typedef unsigned short u16;
typedef __attribute__((ext_vector_type(2))) float float2v;

#define DEV __device__ __forceinline__
DEV int tid_l() { int t = threadIdx.x; asm volatile("" : "+v"(t)); return t; }
DEV int bid_l() { int b = blockIdx.x; asm volatile("" : "+s"(b)); return b; }

constexpr int DM = 1024, NBATCH = 8, SEQ = 4096, DEPTH = 4, CTXL = 256;
constexpr int MC = NBATCH * CTXL;
constexpr int ML = NBATCH * SEQ;
constexpr int MT = MC + ML;
constexpr int INC = 2560, DFF = 2816;
constexpr int NMT = MT / 128;
#ifndef PROBE_MASK
#define PROBE_MASK 0
#endif
#define SCAN_REP 1
#define ATT_REP 1
#define SG_REP 1

struct P {
  const float *x, *c, *ctx, *c_ctx, *n1g, *n2g, *ada_w, *ada_b, *w_in, *conv, *w0, *w_up, *a0, *a_up, *g_up,
      *k_k, *k_a, *r_k, *ln_g, *ln_b, *sgn, *sg_w, *sg_b, *q_g, *k_g, *w_out, *w1, *w2, *fng;
  float* out;
  u16 *wIn, *wOut, *w1t, *w2t, *wUpT, *aUpT, *gUpT, *sgW;
  float *mods, *rope;
  int* cnt;
  float* xc;
  u16 *act, *z, *h, *vTl, *vTc;
  float *y, *bonus, *invn;
};

DEV u16 f2bf(float f) {
  unsigned u = __float_as_uint(f);
  u += 0x7fffu + ((u >> 16) & 1u);
  return (u16)(u >> 16);
}
DEV float bf2f(u16 h) { return __uint_as_float(((unsigned)h) << 16); }
DEV unsigned pk2(float a, float b) { return (unsigned)f2bf(a) | ((unsigned)f2bf(b) << 16); }
DEV float sigmoidf_(float x) { return __builtin_amdgcn_rcpf(1.f + __expf(-x)); }
DEV float siluf_(float x) { return x * __builtin_amdgcn_rcpf(1.f + __expf(-x)); }
DEV float geluf_(float x) {
  float u = 0.7978845608028654f * (x + 0.044715f * x * x * x);
  return 0.5f * x * (1.f + tanhf(u));
}
DEV int swz(int r, int ch) { return r * 128 + ((ch ^ ((r >> 1) & 7)) << 4); }

template <int CTRL>
DEV float dppf(float v) {
  return __int_as_float(__builtin_amdgcn_update_dpp(0, __float_as_int(v), CTRL, 0xF, 0xF, false));
}
DEV float red16_sum(float v) {
  v += dppf<0xB1>(v);
  v += dppf<0x4E>(v);
  v += dppf<0x141>(v);
  v += dppf<0x140>(v);
  return v;
}
DEV float red16_max(float v) {
  v = fmaxf(v, dppf<0xB1>(v));
  v = fmaxf(v, dppf<0x4E>(v));
  v = fmaxf(v, dppf<0x141>(v));
  v = fmaxf(v, dppf<0x140>(v));
  return v;
}
DEV float wave_sum(float v) {
#pragma unroll
  for (int o = 32; o >= 1; o >>= 1) v += __shfl_xor(v, o);
  return v;
}
DEV f32x4 mfma16(bf16x8 a, bf16x8 b, f32x4 c) { return __builtin_amdgcn_mfma_f32_16x16x32_bf16(a, b, c, 0, 0, 0); }

DEV void tr_tile(const float* __restrict__ src, u16* __restrict__ dst, int K, int N, int kt, int nt, bool il, float* lds) {
  const int tid = tid_l();
  const int k0 = kt * 64, n0 = nt * 64;
  {
    const int c = tid & 63, r0 = tid >> 6;
#pragma unroll 4
    for (int i = 0; i < 16; ++i) {
      int r = r0 + i * 4;
      lds[r * 65 + c] = src[(size_t)(k0 + r) * N + n0 + c];
    }
  }
  __syncthreads();
  {
    const int k = tid & 63, nn0 = tid >> 6;
#pragma unroll 4
    for (int i = 0; i < 16; ++i) {
      int n = nn0 + i * 4;
      int gn = n0 + n;
      int np = gn;
      if (il) {
        int j = gn < DFF ? gn : gn - DFF;
        np = (j >> 4) * 32 + (j & 15) + (gn < DFF ? 0 : 16);
      }
      dst[(size_t)np * K + k0 + k] = f2bf(lds[k * 65 + n]);
    }
  }
  __syncthreads();
}

DEV void phase0(const P& p, char* smem) {
  float* lds = (float*)smem;
  const int tid = tid_l();
  constexpr int C0 = 2560, C1 = C0 + 1024, C2 = C1 + 5632, C3 = C2 + 2816, C4 = C3 + 48, C5 = C4 + 48, C6 = C5 + 48,
                C7 = C6 + 64, C8 = C7 + 384, C9 = C8 + 1;
  for (int it = bid_l(); it < C9; it += gridDim.x) {
    if (it < C6) {
      const float* src; u16* dst; int K, N, kt, nt; bool il = false;
      if (it < C0) {
        int l = it / 640, r = it % 640;
        src = p.w_in + (size_t)l * 1024 * 2560; dst = p.wIn + (size_t)l * 2560 * 1024; K = 1024; N = 2560; kt = r / 40; nt = r % 40;
      } else if (it < C1) {
        int i2 = it - C0, l = i2 / 256, r = i2 % 256;
        src = p.w_out + (size_t)l * 1024 * 1024; dst = p.wOut + (size_t)l * 1024 * 1024; K = 1024; N = 1024; kt = r / 16; nt = r % 16;
      } else if (it < C2) {
        int i2 = it - C1, l = i2 / 1408, r = i2 % 1408;
        src = p.w1 + (size_t)l * 1024 * 5632; dst = p.w1t + (size_t)l * 5632 * 1024; K = 1024; N = 5632; kt = r / 88; nt = r % 88; il = true;
      } else if (it < C3) {
        int i2 = it - C2, l = i2 / 704, r = i2 % 704;
        src = p.w2 + (size_t)l * 2816 * 1024; dst = p.w2t + (size_t)l * 1024 * 2816; K = 2816; N = 1024; kt = r / 16; nt = r % 16;
      } else if (it < C4) {
        int i2 = it - C3, bb = i2 / 6;
        src = p.w_up + (size_t)bb * 64 * 384; dst = p.wUpT + (size_t)bb * 384 * 64; K = 64; N = 384; kt = 0; nt = i2 % 6;
      } else if (it < C5) {
        int i2 = it - C4, bb = i2 / 6;
        src = p.a_up + (size_t)bb * 64 * 384; dst = p.aUpT + (size_t)bb * 384 * 64; K = 64; N = 384; kt = 0; nt = i2 % 6;
      } else {
        int i2 = it - C5, l = i2 / 12, r = i2 % 12;
        src = p.g_up + (size_t)l * 128 * 384; dst = p.gUpT + (size_t)l * 384 * 128; K = 128; N = 384; kt = r / 6; nt = r % 6;
      }
      tr_tile(src, dst, K, N, kt, nt, il, lds);
    } else if (it < C7) {
      int i2 = it - C6;
      for (int i = 0; i < 16; ++i) {
        int e = i2 * 4096 + i * 256 + tid;
        p.sgW[e] = f2bf(p.sg_w[e]);
      }
    } else if (it < C8) {
      int i2 = it - C7, l = i2 / 96, cb = i2 % 96;
      for (int e = tid; e < 9 * 1024; e += 256) {
        int s = e >> 10, k = e & 1023;
        float v = s < 8 ? p.c[s * 1024 + k] : p.c_ctx[k];
        lds[e] = siluf_(v);
      }
      __syncthreads();
      const int col = tid & 63, kq = tid >> 6;
      const int n = cb * 64 + col;
      float acc[9];
#pragma unroll
      for (int s = 0; s < 9; ++s) acc[s] = 0.f;
      const float* wp = p.ada_w + (size_t)l * 1024 * 6144 + n;
#pragma unroll 4
      for (int k = kq * 256; k < kq * 256 + 256; ++k) {
        float w = wp[(size_t)k * 6144];
#pragma unroll
        for (int s = 0; s < 9; ++s) acc[s] += lds[s * 1024 + k] * w;
      }
      __syncthreads();
      float* red = lds + 9216;
#pragma unroll
      for (int s = 0; s < 9; ++s) red[(kq * 9 + s) * 64 + col] = acc[s];
      __syncthreads();
      for (int e = tid; e < 9 * 64; e += 256) {
        int s = e >> 6, cc = e & 63;
        float v = red[(0 * 9 + s) * 64 + cc] + red[(1 * 9 + s) * 64 + cc] + red[(2 * 9 + s) * 64 + cc] + red[(3 * 9 + s) * 64 + cc];
        int nn = cb * 64 + cc;
        p.mods[((size_t)l * 9 + s) * 6144 + nn] = v + p.ada_b[l * 6144 + nn];
      }
      __syncthreads();
    } else {
      for (int e = tid; e < 1024; e += 256) {
        int pos = e >> 4, i = e & 15;
        float inv = powf(10000.f, -(float)i / 16.f);
        float ang = (float)pos * inv;
        p.rope[e * 2] = cosf(ang);
        p.rope[e * 2 + 1] = sinf(ang);
      }
      if (tid < 64) p.cnt[tid] = 0;
    }
  }
}

DEV void norm_phase(const P& p, int l, const float* __restrict__ g, int shoff, int scoff, int row_lo, bool from_input) {
  const int tid = tid_l();
  const int lane = tid & 63;
  const int gw = bid_l() * 4 + (tid >> 6), nw = gridDim.x * 4;
  const float* lat = from_input ? p.x : p.out;
  const float* cx = from_input ? p.ctx : p.xc;
  for (int r0 = row_lo + gw; r0 < MT; r0 += 4 * nw) {
    float4 v[4][4];
#pragma unroll
    for (int u = 0; u < 4; ++u) {
      const int r = r0 + u * nw;
      if (r < MT) {
        const float* src = r < MC ? cx + (size_t)r * DM : lat + (size_t)(r - MC) * DM;
#pragma unroll
        for (int i = 0; i < 4; ++i) v[u][i] = *(const float4*)(src + i * 256 + lane * 4);
      }
    }
#pragma unroll
    for (int u = 0; u < 4; ++u) {
      const int r = r0 + u * nw;
      if (r < MT) {
        const int s = r < MC ? 8 : (r - MC) >> 12;
        const float* md = p.mods + ((size_t)l * 9 + s) * 6144;
        float ss = 0.f;
#pragma unroll
        for (int i = 0; i < 4; ++i) ss += v[u][i].x * v[u][i].x + v[u][i].y * v[u][i].y + v[u][i].z * v[u][i].z + v[u][i].w * v[u][i].w;
        ss = wave_sum(ss);
        const float rstd = rsqrtf(ss * (1.f / DM) + 1e-6f);
#pragma unroll
        for (int i = 0; i < 4; ++i) {
          const int c = i * 256 + lane * 4;
          float4 gg = *(const float4*)(g + c);
          float4 sh = *(const float4*)(md + shoff + c);
          float4 sc = *(const float4*)(md + scoff + c);
          float o0 = v[u][i].x * rstd * gg.x * (1.f + sc.x) + sh.x;
          float o1 = v[u][i].y * rstd * gg.y * (1.f + sc.y) + sh.y;
          float o2 = v[u][i].z * rstd * gg.z * (1.f + sc.z) + sh.z;
          float o3 = v[u][i].w * rstd * gg.w * (1.f + sc.w) + sh.w;
          uint2 o;
          o.x = pk2(o0, o1);
          o.y = pk2(o2, o3);
          *(uint2*)(p.act + (size_t)r * DM + c) = o;
        }
      }
    }
  }
}

DEV void final_norm(const P& p) {
  const int tid = tid_l();
  const int lane = tid & 63;
  const int gw = bid_l() * 4 + (tid >> 6), nw = gridDim.x * 4;
  for (int r0 = gw; r0 < ML; r0 += 4 * nw) {
    float4 v[4][4];
#pragma unroll
    for (int u = 0; u < 4; ++u) {
      const int r = r0 + u * nw;
      if (r < ML) {
#pragma unroll
        for (int i = 0; i < 4; ++i) v[u][i] = *(const float4*)(p.out + (size_t)r * DM + i * 256 + lane * 4);
      }
    }
#pragma unroll
    for (int u = 0; u < 4; ++u) {
      const int r = r0 + u * nw;
      if (r < ML) {
        float ss = 0.f;
#pragma unroll
        for (int i = 0; i < 4; ++i) ss += v[u][i].x * v[u][i].x + v[u][i].y * v[u][i].y + v[u][i].z * v[u][i].z + v[u][i].w * v[u][i].w;
        ss = wave_sum(ss);
        const float rstd = rsqrtf(ss * (1.f / DM) + 1e-6f);
#pragma unroll
        for (int i = 0; i < 4; ++i) {
          const int c = i * 256 + lane * 4;
          float4 gg = *(const float4*)(p.fng + c);
          float4 o;
          o.x = v[u][i].x * rstd * gg.x;
          o.y = v[u][i].y * rstd * gg.y;
          o.z = v[u][i].z * rstd * gg.z;
          o.w = v[u][i].w * rstd * gg.w;
          *(float4*)(p.out + (size_t)r * DM + c) = o;
        }
      }
    }
  }
}

enum { EPI_Z = 0, EPI_RES = 1, EPI_SWIGLU = 2 };

template <int EPI>
DEV void gemm_phase(const P& p, int l, const u16* __restrict__ A, int lda, const u16* __restrict__ Bt, int K, int NT,
                           int mt_lo, int goff, char* smem, int dry = 0) {
  const int tid = tid_l(), lane = tid & 63, wid = tid >> 6, wr = wid >> 1, wc = wid & 1, l15 = lane & 15, quad = lane >> 4;
  const int nmt = NMT - mt_lo;
  const int nk = K / 64;
  const int npn = NT >> 2;
  const int npatch = (nmt >> 4) * npn;
  const int tmax = ((npatch + 7) >> 3) * 512;
#define G_MAP(T, OK, M0, N0)                                                                        \
  {                                                                                                 \
    const int xcd_ = (T)&7, sidx_ = (T) >> 3;                                                       \
    const int gp_ = (sidx_ >> 6) * 8 + xcd_;                                                        \
    OK = (T) < tmax && gp_ < npatch;                                                                \
    const int within_ = sidx_ & 63;                                                                 \
    M0 = (mt_lo + (gp_ / npn) * 16 + (within_ & 15)) * 128;                                         \
    N0 = ((gp_ % npn) * 4 + (within_ >> 4)) * 128;                                                  \
  }
  uint4 xa0, xa1, xa2, xa3, xb0, xb1, xb2, xb3, ya0, ya1, ya2, ya3, yb0, yb1, yb2, yb3;
  int t = bid_l();
  bool have;
  int m0, n0;
  G_MAP(t, have, m0, n0);
  const u16* Ag = A + (size_t)(m0 + (tid >> 3)) * lda + (tid & 7) * 8;
  const u16* Bg = Bt + (size_t)(n0 + (tid >> 3)) * K + (tid & 7) * 8;
  bool primed = false;
  while (have) {
    f32x4 acc[4][4];
#pragma unroll
    for (int i = 0; i < 4; ++i)
#pragma unroll
      for (int j = 0; j < 4; ++j) acc[i][j] = f32x4{0.f, 0.f, 0.f, 0.f};
#define G_GL(P, KT)                                                          \
    {                                                                        \
      const int k0_ = (KT)*64;                                               \
      P##a0 = *(const uint4*)(Ag + k0_);                                     \
      P##b0 = *(const uint4*)(Bg + k0_);                                     \
      P##a1 = *(const uint4*)(Ag + (size_t)32 * lda + k0_);                  \
      P##b1 = *(const uint4*)(Bg + (size_t)32 * K + k0_);                    \
      P##a2 = *(const uint4*)(Ag + (size_t)64 * lda + k0_);                  \
      P##b2 = *(const uint4*)(Bg + (size_t)64 * K + k0_);                    \
      P##a3 = *(const uint4*)(Ag + (size_t)96 * lda + k0_);                  \
      P##b3 = *(const uint4*)(Bg + (size_t)96 * K + k0_);                    \
    }
#define G_LS(P, BUF)                                                         \
    {                                                                        \
      char* Aw_ = smem + (BUF)*32768;                                        \
      *(uint4*)(Aw_ + swz((tid >> 3), tid & 7)) = P##a0;                     \
      *(uint4*)(Aw_ + 16384 + swz((tid >> 3), tid & 7)) = P##b0;             \
      *(uint4*)(Aw_ + swz((tid >> 3) + 32, tid & 7)) = P##a1;                \
      *(uint4*)(Aw_ + 16384 + swz((tid >> 3) + 32, tid & 7)) = P##b1;        \
      *(uint4*)(Aw_ + swz((tid >> 3) + 64, tid & 7)) = P##a2;                \
      *(uint4*)(Aw_ + 16384 + swz((tid >> 3) + 64, tid & 7)) = P##b2;        \
      *(uint4*)(Aw_ + swz((tid >> 3) + 96, tid & 7)) = P##a3;                \
      *(uint4*)(Aw_ + 16384 + swz((tid >> 3) + 96, tid & 7)) = P##b3;        \
    }
#define G_COMPUTE(BUF)                                                                                             \
    {                                                                                                              \
      const char* As = smem + (BUF)*32768;                                                                         \
      const char* Bs = As + 16384;                                                                                 \
      _Pragma("unroll") for (int kh = 0; kh < 2; ++kh) {                                                           \
        bf16x8 a[4], b[4];                                                                                         \
        _Pragma("unroll") for (int mi = 0; mi < 4; ++mi)                                                           \
            a[mi] = *(const bf16x8*)(As + swz(wr * 64 + mi * 16 + l15, kh * 4 + quad));                            \
        _Pragma("unroll") for (int ni = 0; ni < 4; ++ni)                                                           \
            b[ni] = *(const bf16x8*)(Bs + swz(wc * 64 + ni * 16 + l15, kh * 4 + quad));                            \
        _Pragma("unroll") for (int mi = 0; mi < 4; ++mi)                                                           \
            _Pragma("unroll") for (int ni = 0; ni < 4; ++ni) acc[mi][ni] = mfma16(a[mi], b[ni], acc[mi][ni]);      \
      }                                                                                                            \
    }
    if (!primed) {
      G_GL(x, 0);
      G_GL(y, 1);
    }
    G_LS(x, 0);
    if (2 < nk) G_GL(x, 2);
    __syncthreads();
    for (int kt = 0; kt < nk; kt += 2) {
      G_COMPUTE(0);
      G_LS(y, 1);
      if (kt + 3 < nk) G_GL(y, kt + 3);
      __syncthreads();
      G_COMPUTE(1);
      if (kt + 2 < nk) G_LS(x, 0);
      if (kt + 4 < nk) G_GL(x, kt + 4);
      __syncthreads();
    }
    const int em0 = m0, en0 = n0;
    t += gridDim.x;
    G_MAP(t, have, m0, n0);
    if (have) {
      Ag = A + (size_t)(m0 + (tid >> 3)) * lda + (tid & 7) * 8;
      Bg = Bt + (size_t)(n0 + (tid >> 3)) * K + (tid & 7) * 8;
      G_GL(x, 0);
      G_GL(y, 1);
      primed = true;
    }
    if (dry) {
      if (acc[0][0][0] == 1.2345e33f) p.bonus[0] = acc[1][1][1] + acc[2][2][2] + acc[3][3][3];
      continue;
    }
    const int cw0 = en0 + wc * 64;
    if constexpr (EPI == EPI_Z) {
      if (cw0 < 1920) {
#pragma unroll
        for (int mi = 0; mi < 4; ++mi)
#pragma unroll
          for (int j = 0; j < 4; ++j) {
            const int r = em0 + wr * 64 + mi * 16 + quad * 4 + j;
#pragma unroll
            for (int ni = 0; ni < 4; ++ni) p.z[(size_t)r * INC + cw0 + ni * 16 + l15] = f2bf(acc[mi][ni][j]);
            __builtin_amdgcn_sched_barrier(0);
          }
      } else {
        const int hh = (cw0 - 1920) >> 6;
        if (hh < 8) {
          const float* gp = (hh < 6 ? p.q_g : p.k_g) + l * 64;
          float gv[4];
#pragma unroll
          for (int ni = 0; ni < 4; ++ni) gv[ni] = gp[ni * 16 + l15];
          const float qs = hh < 6 ? 0.125f : 1.f;
#pragma unroll
          for (int mi = 0; mi < 4; ++mi)
#pragma unroll
            for (int j = 0; j < 4; ++j) {
              const int r = em0 + wr * 64 + mi * 16 + quad * 4 + j;
              float ss = 0.f;
#pragma unroll
              for (int ni = 0; ni < 4; ++ni) ss += acc[mi][ni][j] * acc[mi][ni][j];
              ss = red16_sum(ss);
              const float rstd = rsqrtf(ss * (1.f / 64.f) + 1e-6f);
              float yv[4];
#pragma unroll
              for (int ni = 0; ni < 4; ++ni) yv[ni] = acc[mi][ni][j] * rstd * gv[ni];
              if (r >= MC) {
                const int tt = (r - MC) & 4095;
                const int prow = tt >> 6, pcol = tt & 63;
                const float2 cr = *(const float2*)(p.rope + (prow * 16 + l15) * 2);
                const float2 cc = *(const float2*)(p.rope + (pcol * 16 + l15) * 2);
                float a0 = yv[0] * cr.x - yv[1] * cr.y, a1 = yv[1] * cr.x + yv[0] * cr.y;
                float a2 = yv[2] * cc.x - yv[3] * cc.y, a3 = yv[3] * cc.x + yv[2] * cc.y;
                yv[0] = a0; yv[1] = a1; yv[2] = a2; yv[3] = a3;
              }
#pragma unroll
              for (int ni = 0; ni < 4; ++ni) p.z[(size_t)r * INC + cw0 + ni * 16 + l15] = f2bf(yv[ni] * qs);
              __builtin_amdgcn_sched_barrier(0);
            }
        } else {
          const int kvh = hh - 8;
#pragma unroll
          for (int mi = 0; mi < 4; ++mi) {
            const int r0 = em0 + wr * 64 + mi * 16 + quad * 4;
#pragma unroll
            for (int ni = 0; ni < 4; ++ni) {
              const int d = ni * 16 + l15;
              uint2 o;
              o.x = pk2(acc[mi][ni][0], acc[mi][ni][1]);
              o.y = pk2(acc[mi][ni][2], acc[mi][ni][3]);
              if (r0 < MC) {
                const int b = r0 >> 8, tt = r0 & 255;
                *(uint2*)(p.vTc + ((size_t)((b * 2 + kvh) * 64 + d)) * CTXL + tt) = o;
              } else {
                const int rr = r0 - MC;
                const int b = rr >> 12, tt = rr & 4095;
                *(uint2*)(p.vTl + ((size_t)((b * 2 + kvh) * 64 + d)) * SEQ + tt) = o;
              }
            }
          }
        }
      }
    } else if constexpr (EPI == EPI_RES) {
      const int s = em0 < MC ? 8 : (em0 - MC) >> 12;
      const float* gate = p.mods + ((size_t)l * 9 + s) * 6144 + goff;
      float gv[4];
#pragma unroll
      for (int ni = 0; ni < 4; ++ni) gv[ni] = gate[cw0 + ni * 16 + l15];
#pragma unroll
      for (int mi = 0; mi < 4; ++mi)
#pragma unroll
        for (int j = 0; j < 4; ++j) {
          const int r = em0 + wr * 64 + mi * 16 + quad * 4 + j;
          const float* src;
          if (l == 0 && goff == 2048) src = r < MC ? p.ctx + (size_t)r * DM : p.x + (size_t)(r - MC) * DM;
          else src = r < MC ? p.xc + (size_t)r * DM : p.out + (size_t)(r - MC) * DM;
          float* dst = r < MC ? p.xc + (size_t)r * DM : p.out + (size_t)(r - MC) * DM;
#pragma unroll
          for (int ni = 0; ni < 4; ++ni) {
            const int c = cw0 + ni * 16 + l15;
            dst[c] = src[c] + gv[ni] * acc[mi][ni][j];
          }
          __builtin_amdgcn_sched_barrier(0);
        }
    } else {
      const int hc0 = (en0 >> 1) + wc * 32;
#pragma unroll
      for (int mi = 0; mi < 4; ++mi)
#pragma unroll
        for (int j = 0; j < 4; ++j) {
          const int r = em0 + wr * 64 + mi * 16 + quad * 4 + j;
#pragma unroll
          for (int pp = 0; pp < 2; ++pp) {
            float gt = acc[mi][2 * pp][j], up = acc[mi][2 * pp + 1][j];
            p.h[(size_t)r * DFF + hc0 + pp * 16 + l15] = f2bf(siluf_(gt) * up);
          }
          __builtin_amdgcn_sched_barrier(0);
        }
    }
  }
}
#undef G_GL
#undef G_LS
#undef G_COMPUTE
#undef G_MAP

template <int LPR>
DEV float red_lpr(float v) {
  v += dppf<0xB1>(v);
  v += dppf<0x4E>(v);
  if (LPR >= 8) v += dppf<0x141>(v);
  if (LPR >= 16) v += dppf<0x140>(v);
  return v;
}

constexpr int SCAN_LPR = 8;
constexpr int SCAN_RPB = 256 / SCAN_LPR;
constexpr int SCAN_NPART = 64 / SCAN_RPB;
constexpr int SCAN_JL = 64 / SCAN_LPR;
constexpr int SCAN_ITEMS = 96 * SCAN_NPART;

DEV float red8_sum(float v) {
  v += dppf<0xB1>(v);
  v += dppf<0x4E>(v);
  v += dppf<0x141>(v);
  return v;
}
DEV float tanh_fast(float x) {
  float e = __expf(2.f * x);
  return 1.f - 2.f * __builtin_amdgcn_rcpf(1.f + e);
}

struct ChunkPos { int len, rowbase, tlo; };
DEV ChunkPos chunk_pos(int c, int d, int b) {
  ChunkPos cp;
  const int s0 = c * 16;
  int pos0;
  if (s0 < 256) { cp.len = 256; pos0 = s0; cp.rowbase = b * 256; }
  else { cp.len = 4096; pos0 = s0 - 256; cp.rowbase = MC + b * 4096; }
  cp.tlo = d ? (cp.len - 16 - pos0) : pos0;
  return cp;
}

constexpr int SC_R = 0, SC_KD = 12288, SC_V = 24576, SC_W = 30720, SC_KA = 38912, SC_NKK = 47104;

DEV void cvt8(const uint4 u, float4& lo, float4& hi) {
  lo.x = __uint_as_float(u.x << 16); lo.y = __uint_as_float(u.x & 0xffff0000u);
  lo.z = __uint_as_float(u.y << 16); lo.w = __uint_as_float(u.y & 0xffff0000u);
  hi.x = __uint_as_float(u.z << 16); hi.y = __uint_as_float(u.z & 0xffff0000u);
  hi.z = __uint_as_float(u.w << 16); hi.w = __uint_as_float(u.w & 0xffff0000u);
}

DEV void scan_item(const P& p, int l, int item, char* smem) {
  const int tid = tid_l(), lane = tid & 63, wid = tid >> 6, l15 = lane & 15, quad = lane >> 4;
  constexpr int LPR = SCAN_LPR, RPB = SCAN_RPB, JL = SCAN_JL, NV = RPB / 8;
  const int scan = item / SCAN_NPART, part = item % SCAN_NPART;
  const int d = scan / 48, b = (scan % 48) / 6, h = scan % 6;
  const int rloc = tid / LPR, jq = tid % LPR;
  const int irow = part * RPB + rloc;
  const int j0 = jq * JL;

  const int c_ts = (tid & 127) >> 3, c_ch = tid & 7;
  const int c_col = (tid < 128 ? 0 : 384) + h * 64 + c_ch * 8;
  const int v_ts = tid / NV, v_ch = tid % NV;
  const int v_col = 768 + h * 64 + part * RPB + v_ch * 8;

  const int n2 = wid * 16 + l15;
  bf16x8 bW[2], bA[2];
  {
    const u16* wb = p.wUpT + ((size_t)(l * 2 + d) * 384 + h * 64 + n2) * 64 + quad * 8;
    const u16* ab = p.aUpT + ((size_t)(l * 2 + d) * 384 + h * 64 + n2) * 64 + quad * 8;
    bW[0] = *(const bf16x8*)(wb);
    bW[1] = *(const bf16x8*)(wb + 32);
    bA[0] = *(const bf16x8*)(ab);
    bA[1] = *(const bf16x8*)(ab + 32);
  }
  const float w0v = p.w0[(size_t)(l * 2 + d) * 384 + h * 64 + n2];
  const float a0v = p.a0[(size_t)(l * 2 + d) * 384 + h * 64 + n2];
  const float kkc = p.k_k[l * 384 + h * 64 + n2], kac = p.k_a[l * 384 + h * 64 + n2], rkc = p.r_k[l * 384 + h * 64 + n2];

  float2v S2[JL / 2];
#pragma unroll
  for (int j = 0; j < JL / 2; ++j) S2[j] = float2v{0.f, 0.f};
  uint4 g_rk, g_v;
  bf16x8 g_wd0, g_wd1, g_ad0, g_ad1;
  float g_inv[4];

#define SC_GLOAD1(CC)                                                                                  \
  {                                                                                                    \
    const ChunkPos cp_ = chunk_pos((CC), d, b);                                                        \
    g_rk = *(const uint4*)(p.z + (size_t)(cp_.rowbase + cp_.tlo + c_ts) * INC + c_col);                \
    if (tid < 16 * NV) g_v = *(const uint4*)(p.z + (size_t)(cp_.rowbase + cp_.tlo + v_ts) * INC + v_col);  \
  }
#define SC_GLOAD2(CC)                                                                                  \
  {                                                                                                    \
    const ChunkPos cp_ = chunk_pos((CC), d, b);                                                        \
    const u16* rp_ = p.z + (size_t)(cp_.rowbase + cp_.tlo + l15) * INC + 1152 + quad * 8;              \
    g_wd0 = *(const bf16x8*)(rp_);                                                                     \
    g_wd1 = *(const bf16x8*)(rp_ + 32);                                                                \
    g_ad0 = *(const bf16x8*)(rp_ + 64);                                                                \
    g_ad1 = *(const bf16x8*)(rp_ + 96);                                                                \
    _Pragma("unroll") for (int j = 0; j < 4; ++j)                                                      \
      g_inv[j] = p.invn[(size_t)(cp_.rowbase + cp_.tlo + quad * 4 + j) * 8 + h];                       \
  }
#define SC_STAGE1(CC)                                                                                  \
  {                                                                                                    \
    const int i3_ = (CC) % 3;                                                                          \
    float4 lo_, hi_;                                                                                   \
    cvt8(g_rk, lo_, hi_);                                                                              \
    float* dst_ = (float*)(smem + (tid < 128 ? SC_R : SC_KD) + i3_ * 4096) + c_ts * 64 + c_ch * 8;     \
    *(float4*)dst_ = lo_;                                                                              \
    *(float4*)(dst_ + 4) = hi_;                                                                        \
    if (tid < 16 * NV) {                                                                               \
      cvt8(g_v, lo_, hi_);                                                                             \
      float* dv_ = (float*)(smem + SC_V + i3_ * 2048) + v_ts * RPB + v_ch * 8;                         \
      *(float4*)dv_ = lo_;                                                                             \
      *(float4*)(dv_ + 4) = hi_;                                                                       \
    }                                                                                                  \
  }
#define SC_STAGE2(CC)                                                                                  \
  {                                                                                                    \
    const int i3_ = (CC) % 3, i2_ = (CC)&1;                                                            \
    const ChunkPos cp_ = chunk_pos((CC), d, b);                                                        \
    f32x4 accW = f32x4{0.f, 0.f, 0.f, 0.f}, accA = f32x4{0.f, 0.f, 0.f, 0.f};                          \
    accW = mfma16(g_wd0, bW[0], accW);                                                                 \
    accW = mfma16(g_wd1, bW[1], accW);                                                                 \
    accA = mfma16(g_ad0, bA[0], accA);                                                                 \
    accA = mfma16(g_ad1, bA[1], accA);                                                                 \
    float bon_[4];                                                                                     \
    _Pragma("unroll") for (int j = 0; j < 4; ++j) {                                                    \
      const int ts = quad * 4 + j;                                                                     \
      float* kdp = (float*)(smem + SC_KD + i3_ * 4096) + ts * 64 + n2;                                 \
      const float kv = *kdp;                                                                           \
      const float rv = *((const float*)(smem + SC_R + i3_ * 4096) + ts * 64 + n2);                     \
      const float sg = sigmoidf_(w0v + accW[j]);                                                       \
      const float wv = __expf(-0.6065306597126334f * sg);                                              \
      const float av = sigmoidf_(a0v + accA[j]);                                                       \
      const float kn = kv * kkc * g_inv[j];                                                            \
      const float kd = kv * (1.f + (av - 1.f) * kac);                                                  \
      *((float*)(smem + SC_W + i2_ * 4096) + ts * 64 + n2) = wv;                                       \
      *((float*)(smem + SC_NKK + i2_ * 4096) + ts * 64 + n2) = -kn;                                    \
      *((float*)(smem + SC_KA + i2_ * 4096) + ts * 64 + n2) = kn * av;                                 \
      *kdp = kd;                                                                                       \
      bon_[j] = rv * kd * rkc;                                                                         \
    }                                                                                                  \
    _Pragma("unroll") for (int j = 0; j < 4; ++j) bon_[j] = red16_sum(bon_[j]);                        \
    if (l15 == 0 && part == 0) {                                                                       \
      _Pragma("unroll") for (int j = 0; j < 4; ++j)                                                    \
        p.bonus[(size_t)(cp_.rowbase + cp_.tlo + quad * 4 + j) * 48 + (d * 6 + h) * 4 + wid] = bon_[j]; \
    }                                                                                                  \
  }

  __builtin_amdgcn_s_setprio(3);
  SC_GLOAD1(0);
  SC_GLOAD2(0);
  SC_STAGE1(0);
  SC_GLOAD1(1);
  __syncthreads();
  SC_STAGE2(0);
  SC_STAGE1(1);
  SC_GLOAD1(2);
  SC_GLOAD2(1);
  __syncthreads();

  for (int c = 0; c < 272; ++c) {
    {
      const int i3 = c % 3, i2 = c & 1;
      const ChunkPos cp = chunk_pos(c, d, b);
      const float* pW = (const float*)(smem + SC_W + i2 * 4096) + j0;
      const float* pN = (const float*)(smem + SC_NKK + i2 * 4096) + j0;
      const float* pA = (const float*)(smem + SC_KA + i2 * 4096) + j0;
      const float* pD = (const float*)(smem + SC_KD + i3 * 4096) + j0;
      const float* pR = (const float*)(smem + SC_R + i3 * 4096) + j0;
      const float* pV = (const float*)(smem + SC_V + i3 * 2048) + rloc;
      float* yp = p.y + ((size_t)d * MT + cp.rowbase + cp.tlo) * 384 + h * 64 + irow;
      float yk0 = 0.f, yk1 = 0.f;
      constexpr int NQ = JL / 4;
      float4 cw[NQ], cn[NQ], ca[NQ], cd[NQ], cr[NQ];
      float cvi;
#define SC_LD(TS, W, N, A, D, R, VI)                                                             \
      _Pragma("unroll") for (int q = 0; q < NQ; ++q) {                                           \
        W[q] = *(const float4*)(pW + (TS)*64 + q * 4); N[q] = *(const float4*)(pN + (TS)*64 + q * 4); \
        A[q] = *(const float4*)(pA + (TS)*64 + q * 4); D[q] = *(const float4*)(pD + (TS)*64 + q * 4); \
        R[q] = *(const float4*)(pR + (TS)*64 + q * 4);                                           \
      }                                                                                          \
      VI = pV[(TS)*RPB];
      {
        const int ts0 = d ? 15 : 0;
        SC_LD(ts0, cw, cn, ca, cd, cr, cvi)
      }
#pragma unroll
      for (int si = 0; si < 16; ++si) {
        float4 xw[NQ], xn[NQ], xa[NQ], xd[NQ], xr[NQ];
        float xvi = 0.f;
        if (si + 1 < 16) {
          const int tsn = d ? 14 - si : si + 1;
          SC_LD(tsn, xw, xn, xa, xd, xr, xvi)
        }
        float2v sa2 = S2[0] * float2v{cn[0].x, cn[0].y};
        sa2 = S2[1] * float2v{cn[0].z, cn[0].w} + sa2;
        if constexpr (NQ == 2) {
          sa2 = S2[2] * float2v{cn[1].x, cn[1].y} + sa2;
          sa2 = S2[3] * float2v{cn[1].z, cn[1].w} + sa2;
        }
        const float sa = LPR == 16 ? red16_sum(sa2.x + sa2.y) : red8_sum(sa2.x + sa2.y);
        const float2v sav = float2v{sa, sa}, viv = float2v{cvi, cvi};
#pragma unroll
        for (int q = 0; q < NQ; ++q) {
          S2[2 * q] = S2[2 * q] * float2v{cw[q].x, cw[q].y} + (sav * float2v{ca[q].x, ca[q].y} + viv * float2v{cd[q].x, cd[q].y});
          S2[2 * q + 1] = S2[2 * q + 1] * float2v{cw[q].z, cw[q].w} + (sav * float2v{ca[q].z, ca[q].w} + viv * float2v{cd[q].z, cd[q].w});
        }
        float2v y2 = S2[0] * float2v{cr[0].x, cr[0].y};
        y2 = S2[1] * float2v{cr[0].z, cr[0].w} + y2;
        if constexpr (NQ == 2) {
          y2 = S2[2] * float2v{cr[1].x, cr[1].y} + y2;
          y2 = S2[3] * float2v{cr[1].z, cr[1].w} + y2;
        }
        const float yv = LPR == 16 ? red16_sum(y2.x + y2.y) : red8_sum(y2.x + y2.y);
        if (si < LPR) yk0 = (jq == si) ? yv : yk0;
        else yk1 = (jq == si - LPR) ? yv : yk1;
        if (si + 1 < 16) {
#pragma unroll
          for (int q = 0; q < NQ; ++q) { cw[q] = xw[q]; cn[q] = xn[q]; ca[q] = xa[q]; cd[q] = xd[q]; cr[q] = xr[q]; }
          cvi = xvi;
        }
      }
#undef SC_LD
      {
        const int tsa = d ? 15 - jq : jq;
        yp[(size_t)tsa * 384] = yk0;
        if constexpr (LPR == 8) {
          const int tsb = d ? 7 - jq : 8 + jq;
          yp[(size_t)tsb * 384] = yk1;
        }
      }
    }
    if (c + 1 < 272) SC_STAGE2(c + 1);
    if (c + 2 < 272) SC_STAGE1(c + 2);
    if (c + 3 < 272) SC_GLOAD1(c + 3);
    if (c + 2 < 272) SC_GLOAD2(c + 2);
    __syncthreads();
  }
  __builtin_amdgcn_s_setprio(0);
#undef SC_GLOAD1
#undef SC_GLOAD2
#undef SC_STAGE1
#undef SC_STAGE2
}

DEV void attn_item(const P& p, int item, char* smem) {
  const int tid = tid_l(), lane = tid & 63, wid = tid >> 6, l15 = lane & 15, quad = lane >> 4;
  bool lat = item < 1536;
  int b, hq, qb;
  if (lat) { b = item / 192; int rem = item % 192; hq = rem / 32; qb = rem % 32; }
  else { int i2 = item - 1536; b = i2 / 12; int rem = i2 % 12; hq = rem / 2; qb = rem % 2; }
  const int kvh = hq / 3;
  const int qrow0 = lat ? MC + b * 4096 + qb * 128 : b * 256 + qb * 128;
  const int nkt = lat ? 68 : 4;
  const float LOG2E = 1.4426950408889634f;

  bf16x8 qf[2][2];
#pragma unroll
  for (int mi = 0; mi < 2; ++mi)
#pragma unroll
    for (int ks = 0; ks < 2; ++ks)
      qf[mi][ks] = *(const bf16x8*)(p.z + (size_t)(qrow0 + wid * 32 + mi * 16 + l15) * INC + 1920 + hq * 64 + ks * 32 + quad * 8);

  f32x4 O[2][4];
  float mrow[2][4], lpart[2][4];
#pragma unroll
  for (int mi = 0; mi < 2; ++mi) {
#pragma unroll
    for (int nd = 0; nd < 4; ++nd) O[mi][nd] = f32x4{0.f, 0.f, 0.f, 0.f};
#pragma unroll
    for (int j = 0; j < 4; ++j) { mrow[mi][j] = -1e30f; lpart[mi][j] = 0.f; }
  }
  char* Ps = smem + 32768 + wid * 4096;
  const int lrow = tid >> 3, lch = tid & 7;
  uint4 rk0, rk1, rv0, rv1;
#define ATT_GLOAD(KT)                                                                         \
  {                                                                                           \
    const int kt_ = (KT);                                                                     \
    const u16* kp;                                                                            \
    const u16* vp;                                                                            \
    int vstride;                                                                              \
    if (lat && kt_ < 64) {                                                                    \
      kp = p.z + (size_t)(MC + b * 4096 + kt_ * 64) * INC + 2304 + kvh * 64;                  \
      vp = p.vTl + (size_t)((b * 2 + kvh) * 64) * SEQ + kt_ * 64;                             \
      vstride = SEQ;                                                                          \
    } else {                                                                                  \
      const int kc = lat ? kt_ - 64 : kt_;                                                    \
      kp = p.z + (size_t)(b * 256 + kc * 64) * INC + 2304 + kvh * 64;                         \
      vp = p.vTc + (size_t)((b * 2 + kvh) * 64) * CTXL + kc * 64;                             \
      vstride = CTXL;                                                                         \
    }                                                                                         \
    rk0 = *(const uint4*)(kp + (size_t)(lrow)*INC + lch * 8);                                 \
    rk1 = *(const uint4*)(kp + (size_t)(lrow + 32) * INC + lch * 8);                          \
    rv0 = *(const uint4*)(vp + (size_t)(lrow)*vstride + lch * 8);                             \
    rv1 = *(const uint4*)(vp + (size_t)(lrow + 32) * vstride + lch * 8);                      \
  }
#define ATT_LSTORE(BUF)                                     \
  {                                                         \
    char* Kb_ = smem + (BUF)*16384;                         \
    *(uint4*)(Kb_ + swz(lrow, lch)) = rk0;                  \
    *(uint4*)(Kb_ + swz(lrow + 32, lch)) = rk1;             \
    *(uint4*)(Kb_ + 8192 + swz(lrow, lch)) = rv0;           \
    *(uint4*)(Kb_ + 8192 + swz(lrow + 32, lch)) = rv1;      \
  }
  ATT_GLOAD(0);
  ATT_LSTORE(0);
  __syncthreads();
  for (int kt = 0; kt < nkt; ++kt) {
    const int buf = kt & 1;
    if (kt + 1 < nkt) ATT_GLOAD(kt + 1);
    const char* Kb = smem + buf * 16384;
    const char* Vb = Kb + 8192;
    f32x4 Sx[2][4];
#pragma unroll
    for (int mi = 0; mi < 2; ++mi)
#pragma unroll
      for (int ni = 0; ni < 4; ++ni) Sx[mi][ni] = f32x4{0.f, 0.f, 0.f, 0.f};
#pragma unroll
    for (int ks = 0; ks < 2; ++ks) {
      bf16x8 kf[4];
#pragma unroll
      for (int ni = 0; ni < 4; ++ni) kf[ni] = *(const bf16x8*)(Kb + swz(ni * 16 + l15, ks * 4 + quad));
#pragma unroll
      for (int mi = 0; mi < 2; ++mi)
#pragma unroll
        for (int ni = 0; ni < 4; ++ni) Sx[mi][ni] = mfma16(qf[mi][ks], kf[ni], Sx[mi][ni]);
    }
#pragma unroll
    for (int mi = 0; mi < 2; ++mi)
#pragma unroll
      for (int j = 0; j < 4; ++j) {
        float mx = fmaxf(fmaxf(Sx[mi][0][j], Sx[mi][1][j]), fmaxf(Sx[mi][2][j], Sx[mi][3][j]));
        mx = red16_max(mx);
        const float mnew = fmaxf(mrow[mi][j], mx);
        const float alpha = __builtin_amdgcn_exp2f((mrow[mi][j] - mnew) * LOG2E);
        mrow[mi][j] = mnew;
        const float mb = mnew * LOG2E;
        float ps = 0.f;
        const int prow = mi * 16 + quad * 4 + j;
#pragma unroll
        for (int ni = 0; ni < 4; ++ni) {
          float pv = __builtin_amdgcn_exp2f(Sx[mi][ni][j] * LOG2E - mb);
          ps += pv;
          *(u16*)(Ps + swz(prow, ni * 2 + (l15 >> 3)) + (l15 & 7) * 2) = f2bf(pv);
        }
        lpart[mi][j] = lpart[mi][j] * alpha + ps;
#pragma unroll
        for (int nd = 0; nd < 4; ++nd) O[mi][nd][j] *= alpha;
      }
    __builtin_amdgcn_fence(__ATOMIC_RELEASE, "wavefront");
    __builtin_amdgcn_wave_barrier();
    __builtin_amdgcn_fence(__ATOMIC_ACQUIRE, "wavefront");
#pragma unroll
    for (int ks = 0; ks < 2; ++ks) {
      bf16x8 pf[2], vf[4];
#pragma unroll
      for (int mi = 0; mi < 2; ++mi) pf[mi] = *(const bf16x8*)(Ps + swz(mi * 16 + l15, ks * 4 + quad));
#pragma unroll
      for (int nd = 0; nd < 4; ++nd) vf[nd] = *(const bf16x8*)(Vb + swz(nd * 16 + l15, ks * 4 + quad));
#pragma unroll
      for (int mi = 0; mi < 2; ++mi)
#pragma unroll
        for (int nd = 0; nd < 4; ++nd) O[mi][nd] = mfma16(pf[mi], vf[nd], O[mi][nd]);
    }
    if (kt + 1 < nkt) ATT_LSTORE(buf ^ 1);
    __syncthreads();
  }
#pragma unroll
  for (int mi = 0; mi < 2; ++mi)
#pragma unroll
    for (int j = 0; j < 4; ++j) {
      const float lsum = red16_sum(lpart[mi][j]);
      const float inv = 1.f / lsum;
      const int r = qrow0 + wid * 32 + mi * 16 + quad * 4 + j;
#pragma unroll
      for (int nd = 0; nd < 4; ++nd) p.act[(size_t)r * DM + 640 + hq * 64 + nd * 16 + l15] = f2bf(O[mi][nd][j] * inv);
    }
}

DEV void sgate_item(const P& p, int l, int ck, int g, char* smem) {
  const int tid = tid_l(), lane = tid & 63, wid = tid >> 6, l15 = lane & 15, quad = lane >> 4;
  const int m0 = ck * 128;
  u16* sVT = (u16*)smem;
  {
    const int q = tid >> 1, half = tid & 1;
    const u16* src = p.z + (size_t)(m0 + q) * INC + 1408 + 256 + g * 64 + half * 32;
    float v[32];
    float ss = 0.f;
#pragma unroll
    for (int cidx = 0; cidx < 4; ++cidx) {
      uint4 u = *(const uint4*)(src + cidx * 8);
      unsigned uu[4] = {u.x, u.y, u.z, u.w};
#pragma unroll
      for (int e = 0; e < 4; ++e) {
        float f0 = geluf_(bf2f((u16)(uu[e] & 0xffff)));
        float f1 = geluf_(bf2f((u16)(uu[e] >> 16)));
        v[cidx * 8 + e * 2] = f0;
        v[cidx * 8 + e * 2 + 1] = f1;
        ss += f0 * f0 + f1 * f1;
      }
    }
    ss += __shfl_xor(ss, 1);
    const float rstd = rsqrtf(ss * (1.f / 64.f) + 1e-6f);
    const float* gn = p.sgn + l * 256 + g * 64 + half * 32;
#pragma unroll
    for (int e = 0; e < 32; ++e) sVT[(half * 32 + e) * 136 + q] = f2bf(v[e] * rstd * gn[e]);
  }
  __syncthreads();
  f32x4 acc[2][4];
#pragma unroll
  for (int mi = 0; mi < 2; ++mi)
#pragma unroll
    for (int ni = 0; ni < 4; ++ni) acc[mi][ni] = f32x4{0.f, 0.f, 0.f, 0.f};
  const u16* Wg = p.sgW + (size_t)(l * 4 + g) * 128 * 128;
#pragma unroll
  for (int ks = 0; ks < 4; ++ks) {
    bf16x8 a[2], bb[4];
#pragma unroll
    for (int mi = 0; mi < 2; ++mi) a[mi] = *(const bf16x8*)(Wg + (size_t)(wid * 32 + mi * 16 + l15) * 128 + ks * 32 + quad * 8);
#pragma unroll
    for (int ni = 0; ni < 4; ++ni) bb[ni] = *(const bf16x8*)(sVT + (ni * 16 + l15) * 136 + ks * 32 + quad * 8);
#pragma unroll
    for (int mi = 0; mi < 2; ++mi)
#pragma unroll
      for (int ni = 0; ni < 4; ++ni) acc[mi][ni] = mfma16(a[mi], bb[ni], acc[mi][ni]);
  }
#pragma unroll
  for (int mi = 0; mi < 2; ++mi)
#pragma unroll
    for (int j = 0; j < 4; ++j) {
      const int pr = wid * 32 + mi * 16 + quad * 4 + j;
      const float bias = p.sg_b[(size_t)(l * 4 + g) * 128 + pr];
#pragma unroll
      for (int ni = 0; ni < 4; ++ni) {
        const int c = ni * 16 + l15;
        float u = geluf_(bf2f(p.z[(size_t)(m0 + pr) * INC + 1408 + g * 64 + c]));
        p.act[(size_t)(m0 + pr) * DM + 384 + g * 64 + c] = f2bf(u * (acc[mi][ni][j] + bias));
      }
    }
  __syncthreads();
}

DEV void mix_phase(const P& p, int l, char* smem, int cidx) {
  __shared__ int s_item;
  const bool last = (l == DEPTH - 1);
  const int n_attn = last ? 1536 : 1632;
  const int ck_lo = last ? 16 : 0;
  const int n_sg = (NMT - ck_lo) * 4;
  const int total = SCAN_ITEMS + n_attn + n_sg;
  const int bid = bid_l();
  bool first = bid < SCAN_ITEMS;
  for (;;) {
    int it;
    if (first) {
      it = bid;
      first = false;
    } else {
      if (tid_l() == 0) s_item = SCAN_ITEMS + atomicAdd(p.cnt + cidx, 1);
      __syncthreads();
      it = s_item;
      __syncthreads();
    }
    if (it >= total) break;
    if (it < SCAN_ITEMS) {
      int nr = SCAN_REP; asm volatile("" : "+s"(nr));
      for (int rr = 0; rr < nr; ++rr) scan_item(p, l, it, smem);
    } else if (it < SCAN_ITEMS + n_attn) {
      int nr = ATT_REP; asm volatile("" : "+s"(nr));
      for (int rr = 0; rr < nr; ++rr) { attn_item(p, it - SCAN_ITEMS, smem); __syncthreads(); }
    } else {
      int i2 = it - SCAN_ITEMS - n_attn;
      int nr = SG_REP; asm volatile("" : "+s"(nr));
      for (int rr = 0; rr < nr; ++rr) sgate_item(p, l, ck_lo + (i2 >> 2), i2 & 3, smem);
    }
  }
}

DEV void apost_phase(const P& p, int l, int mt_lo, char* smem) {
  const int tid = tid_l(), lane = tid & 63, wid = tid >> 6, l15 = lane & 15, quad = lane >> 4;
  const int nit = (NMT - mt_lo) * 6;
  for (int it = bid_l(); it < nit; it += gridDim.x) {
    const int mt = mt_lo + it / 6;
    const int hh = it % 6;
    const int m0 = mt * 128;
    bf16x8 a[2][4];
#pragma unroll
    for (int mi = 0; mi < 2; ++mi)
#pragma unroll
      for (int ks = 0; ks < 4; ++ks)
        a[mi][ks] = *(const bf16x8*)(p.z + (size_t)(m0 + wid * 32 + mi * 16 + l15) * INC + 1280 + ks * 32 + quad * 8);
    {
      f32x4 acc[2][4];
#pragma unroll
      for (int mi = 0; mi < 2; ++mi)
#pragma unroll
        for (int ni = 0; ni < 4; ++ni) acc[mi][ni] = f32x4{0.f, 0.f, 0.f, 0.f};
#pragma unroll
      for (int ks = 0; ks < 4; ++ks) {
        bf16x8 bb[4];
#pragma unroll
        for (int ni = 0; ni < 4; ++ni)
          bb[ni] = *(const bf16x8*)(p.gUpT + ((size_t)l * 384 + hh * 64 + ni * 16 + l15) * 128 + ks * 32 + quad * 8);
#pragma unroll
        for (int mi = 0; mi < 2; ++mi)
#pragma unroll
          for (int ni = 0; ni < 4; ++ni) acc[mi][ni] = mfma16(a[mi][ks], bb[ni], acc[mi][ni]);
      }
      float lg[4], lb[4];
#pragma unroll
      for (int ni = 0; ni < 4; ++ni) {
        const int c = hh * 64 + ni * 16 + l15;
        lg[ni] = p.ln_g[l * 384 + c];
        lb[ni] = p.ln_b[l * 384 + c];
      }
#pragma unroll
      for (int mi = 0; mi < 2; ++mi)
#pragma unroll
        for (int j = 0; j < 4; ++j) {
          const int r = m0 + wid * 32 + mi * 16 + quad * 4 + j;
          float ys[4], vv[4];
          float sm = 0.f;
#pragma unroll
          for (int ni = 0; ni < 4; ++ni) {
            const int c = hh * 64 + ni * 16 + l15;
            ys[ni] = p.y[(size_t)r * 384 + c] + p.y[((size_t)MT + r) * 384 + c];
            vv[ni] = bf2f(p.z[(size_t)r * INC + 768 + c]);
            sm += ys[ni];
          }
          const float4 bq0 = *(const float4*)(p.bonus + (size_t)r * 48 + hh * 4);
          const float4 bq1 = *(const float4*)(p.bonus + (size_t)r * 48 + (6 + hh) * 4);
          const float bon = (bq0.x + bq0.y) + (bq0.z + bq0.w) + (bq1.x + bq1.y) + (bq1.z + bq1.w);
          sm = red16_sum(sm);
          const float mean = sm * (1.f / 64.f);
          float vs = 0.f;
#pragma unroll
          for (int ni = 0; ni < 4; ++ni) { ys[ni] -= mean; vs += ys[ni] * ys[ni]; }
          vs = red16_sum(vs);
          const float rstd = rsqrtf(vs * (1.f / 64.f) + 64e-5f);
#pragma unroll
          for (int ni = 0; ni < 4; ++ni) {
            const int c = hh * 64 + ni * 16 + l15;
            float o = (ys[ni] * rstd * lg[ni] + lb[ni] + bon * vv[ni]) * acc[mi][ni][j];
            p.act[(size_t)r * DM + c] = f2bf(o);
          }
          __builtin_amdgcn_sched_barrier(0);
        }
    }
  }
}

DEV uint2 ld8(const u16* q) { return *(const uint2*)q; }
DEV void up4(const uint2 u, float (&f)[4]) {
  f[0] = __uint_as_float(u.x << 16); f[1] = __uint_as_float(u.x & 0xffff0000u);
  f[2] = __uint_as_float(u.y << 16); f[3] = __uint_as_float(u.y & 0xffff0000u);
}
DEV void prep_phase(const P& p, int l, cg::grid_group& grid) {
  const int tid = tid_l(), lane = tid & 63, l15 = lane & 15;
  const int nb = gridDim.x, bid = bid_l();
  const int rpb = (((MT + nb - 1) / nb) + 3) & ~3;
  const int ra = bid * rpb;
  const int rb = min(ra + rpb, MT);
  const bool active = ra < MT;
  const bool has1 = tid < 96;
  const int col0 = tid * 4, col1 = 1024 + tid * 4;
  uint2 hp0 = make_uint2(0, 0), hn0 = hp0, hp1 = hp0, hn1 = hp0;
  if (active) {
    if (ra > 0) { hp0 = ld8(p.z + (size_t)(ra - 1) * INC + col0); if (has1) hp1 = ld8(p.z + (size_t)(ra - 1) * INC + col1); }
    if (rb < MT) { hn0 = ld8(p.z + (size_t)rb * INC + col0); if (has1) hn1 = ld8(p.z + (size_t)rb * INC + col1); }
  }
  grid.sync();
  if (!active) return;
  const float* cw = p.conv + (size_t)l * 3 * 1408;
#pragma unroll 1
  for (int pass = 0; pass < 2; ++pass) {
    if (pass == 1 && !has1) break;
    const int col = pass ? col1 : col0;
    const int typ = col < 1152 ? 0 : (col < 1216 ? 1 : (col < 1280 ? 0 : 2));
    const bool isk = col >= 384 && col < 768;
    float c0[4], c1[4], c2[4], kk4[4];
#pragma unroll
    for (int e = 0; e < 4; ++e) {
      c0[e] = cw[col + e]; c1[e] = cw[1408 + col + e]; c2[e] = cw[2816 + col + e];
      kk4[e] = isk ? p.k_k[l * 384 + (col - 384) + e] : 0.f;
    }
    const int hh = isk ? (col - 384) >> 6 : 0;
    u16* zc = p.z + col;
    uint2 prev = pass ? hp1 : hp0;
    const uint2 halo_n = pass ? hn1 : hn0;
    uint2 cur = ld8(zc + (size_t)ra * INC);
    for (int r = ra; r < rb; r += 4) {
      uint2 nx[4];
#pragma unroll
      for (int q = 0; q < 4; ++q) {
        const int rr = r + 1 + q;
        nx[q] = rr < rb ? ld8(zc + (size_t)rr * INC) : halo_n;
      }
#pragma unroll
      for (int q = 0; q < 4; ++q) {
        const int rr = r + q;
        const uint2 xp = q == 0 ? prev : (q == 1 ? cur : nx[q - 2]);
        const uint2 xc = q == 0 ? cur : nx[q - 1];
        const uint2 xn = nx[q];
        const int tt = rr < MC ? (rr & 255) : ((rr - MC) & 4095);
        const int len = rr < MC ? 256 : 4096;
        const float mp = tt > 0 ? 1.f : 0.f, mn = tt < len - 1 ? 1.f : 0.f;
        float fp[4], fc[4], fn[4], o[4];
        up4(xp, fp); up4(xc, fc); up4(xn, fn);
#pragma unroll
        for (int e = 0; e < 4; ++e) {
          float v = fc[e] * c1[e] + mp * (fp[e] * c0[e]) + mn * (fn[e] * c2[e]);
          if (typ == 1) v = tanh_fast(v);
          else if (typ == 2) v = sigmoidf_(v);
          o[e] = v;
        }
        if (isk) {
          float q0 = o[0] * kk4[0], q1 = o[1] * kk4[1], q2 = o[2] * kk4[2], q3 = o[3] * kk4[3];
          float ss = red16_sum(q0 * q0 + q1 * q1 + q2 * q2 + q3 * q3);
          if (l15 == 0 && rr < rb) p.invn[(size_t)rr * 8 + hh] = 1.f / fmaxf(sqrtf(ss), 1e-12f);
        }
        if (rr < rb) *(uint2*)(zc + (size_t)rr * INC) = make_uint2(pk2(o[0], o[1]), pk2(o[2], o[3]));
      }
      prev = nx[2];
      cur = nx[3];
    }
  }
}

__global__ void __launch_bounds__(256, 2) fwd_megakernel(P p, int ph_lo, int ph_hi) {
  __shared__ __attribute__((aligned(16))) char smem[65536 - 64];
  cg::grid_group grid = cg::this_grid();
  for (int ph = ph_lo; ph < ph_hi; ++ph) {
    if (ph > ph_lo) grid.sync();
    if (ph == 0) {
      phase0(p, smem);
      if (PROBE_MASK & 256) { grid.sync(); phase0(p, smem); }
      continue;
    }
    if (ph == 1 + 8 * DEPTH) { final_norm(p); continue; }
    const int l = (ph - 1) >> 3, sub = (ph - 1) & 7;
    const bool last = (l == DEPTH - 1);
    const int mt_lo = last ? 16 : 0;
    int nrep = ((PROBE_MASK >> sub) & 1) ? 2 : 1;
    asm volatile("" : "+s"(nrep));
    for (int rep = 0; rep < nrep; ++rep) {
      if (rep) grid.sync();
      const int dry = (rep + 1 < nrep && !(PROBE_MASK & 512)) ? 1 : 0;
      if (sub == 0 || sub == 5) {
        const bool n2 = sub == 5;
        norm_phase(p, l, (n2 ? p.n2g : p.n1g) + l * DM, n2 ? 3072 : 0, n2 ? 4096 : 1024, n2 ? mt_lo * 128 : 0, !n2 && l == 0);
      } else if (sub == 1) {
        gemm_phase<EPI_Z>(p, l, p.act, DM, p.wIn + (size_t)l * 2560 * 1024, 1024, 20, 0, 0, smem, dry);
      } else if (sub == 2) {
        if (rep == 0) { prep_phase(p, l, grid); grid.sync(); }
        mix_phase(p, l, smem, l + 8 * rep);
      } else if (sub == 3) {
        apost_phase(p, l, mt_lo, smem);
      } else if (sub == 4 || sub == 7) {
        const bool g4 = sub == 7;
        gemm_phase<EPI_RES>(p, l, g4 ? p.h : p.act, g4 ? DFF : DM,
                            g4 ? p.w2t + (size_t)l * 1024 * 2816 : p.wOut + (size_t)l * 1024 * 1024, g4 ? 2816 : 1024, 8, mt_lo,
                            g4 ? 5120 : 2048, smem, dry);
      } else {
        gemm_phase<EPI_SWIGLU>(p, l, p.act, DM, p.w1t + (size_t)l * 5632 * 1024, 1024, 44, mt_lo, 0, smem, dry);
      }
    }
  }
}

extern "C" void kernel_launch(void* const* d_in, const int* in_sizes, int n_in, void* d_out, int out_size, void* d_ws,
                              size_t ws_size, hipStream_t stream) {
  static int grid_blocks = 0;
  if (!grid_blocks) {
    int dev = 0, cus = 0, per_cu = 0;
    hipGetDevice(&dev);
    hipDeviceGetAttribute(&cus, hipDeviceAttributeMultiprocessorCount, dev);
    hipOccupancyMaxActiveBlocksPerMultiprocessor(&per_cu, fwd_megakernel, 256, 0);
    if (per_cu > 2) per_cu = 2;
    if (per_cu < 1) per_cu = 1;
    grid_blocks = cus * per_cu;
  }
  P p{};
  const float* const* in = (const float* const*)d_in;
  p.x = in[0]; p.c = in[1]; p.ctx = in[2]; p.c_ctx = in[3]; p.n1g = in[4]; p.n2g = in[5]; p.ada_w = in[6]; p.ada_b = in[7];
  p.w_in = in[8]; p.conv = in[9]; p.w0 = in[10]; p.w_up = in[11]; p.a0 = in[12]; p.a_up = in[13]; p.g_up = in[14];
  p.k_k = in[15]; p.k_a = in[16]; p.r_k = in[17]; p.ln_g = in[18]; p.ln_b = in[19]; p.sgn = in[20]; p.sg_w = in[21];
  p.sg_b = in[22]; p.q_g = in[23]; p.k_g = in[24]; p.w_out = in[25]; p.w1 = in[26]; p.w2 = in[27]; p.fng = in[28];
  p.out = (float*)d_out;
  char* ws = (char*)d_ws;
  size_t off = 0;
  auto take = [&](size_t bytes) { char* r = ws + off; off += (bytes + 255) & ~(size_t)255; return r; };
  p.wIn = (u16*)take((size_t)4 * 2560 * 1024 * 2);
  p.wOut = (u16*)take((size_t)4 * 1024 * 1024 * 2);
  p.w1t = (u16*)take((size_t)4 * 5632 * 1024 * 2);
  p.w2t = (u16*)take((size_t)4 * 1024 * 2816 * 2);
  p.wUpT = (u16*)take((size_t)8 * 384 * 64 * 2);
  p.aUpT = (u16*)take((size_t)8 * 384 * 64 * 2);
  p.gUpT = (u16*)take((size_t)4 * 384 * 128 * 2);
  p.sgW = (u16*)take((size_t)16 * 128 * 128 * 2);
  p.mods = (float*)take((size_t)4 * 9 * 6144 * 4);
  p.rope = (float*)take(2048 * 4);
  p.cnt = (int*)take(256);
  p.xc = (float*)take((size_t)MC * DM * 4);
  p.act = (u16*)take((size_t)MT * DM * 2);
  p.z = (u16*)take((size_t)MT * DFF * 2);
  p.h = p.z;
  p.vTl = (u16*)take((size_t)16 * 64 * SEQ * 2);
  p.vTc = (u16*)take((size_t)16 * 64 * CTXL * 2);
  p.y = (float*)take((size_t)2 * MT * 384 * 4);
  p.bonus = (float*)take((size_t)MT * 48 * 4);
  p.invn = (float*)take((size_t)MT * 8 * 4);
  if (off > ws_size) { fprintf(stderr, "workspace too small: need %zu have %zu\n", off, ws_size); return; }
  int ph_lo = 0, ph_hi = 2 + 8 * DEPTH;
  void* args[] = {&p, &ph_lo, &ph_hi};
  hipError_t e = hipLaunchCooperativeKernel((void*)fwd_megakernel, dim3(grid_blocks), dim3(256), args, 0, stream);
  if (e != hipSuccess) fprintf(stderr, "cooperative launch failed: %s (grid %d)\n", hipGetErrorString(e), grid_blocks);
}
```

```cpp
#include <hip/hip_runtime.h>
#include <hip/hip_bf16.h>
#include <hip/hip_cooperative_groups.h>
#include <cstdio>
namespace cg = cooperative_groups;

typedef __attribute__((ext_vector_type(8))) short bf16x8;
typedef __attribute__((ext_vector_type(4))) float f32x4;
typedef unsigned short u16;
typedef __attribute__((ext_vector_type(2))) float float2v;

#define DEV __device__ __forceinline__
DEV int tid_l() { int t = threadIdx.x; asm volatile("" : "+v"(t)); return t; }
DEV int bid_l() { int b = blockIdx.x; asm volatile("" : "+s"(b)); return b; }

constexpr int DM = 1024, NBATCH = 8, SEQ = 4096, DEPTH = 4, CTXL = 256;
constexpr int MC = NBATCH * CTXL;
constexpr int ML = NBATCH * SEQ;
constexpr int MT = MC + ML;
constexpr int INC = 2560, DFF = 2816;
constexpr int NMT = MT / 128;
#ifndef PROBE_MASK
#define PROBE_MASK 0
#endif
#define SCAN_REP 1
#define ATT_REP 1
#define SG_REP 1

struct P {
  const float *x, *c, *ctx, *c_ctx, *n1g, *n2g, *ada_w, *ada_b, *w_in, *conv, *w0, *w_up, *a0, *a_up, *g_up,
      *k_k, *k_a, *r_k, *ln_g, *ln_b, *sgn, *sg_w, *sg_b, *q_g, *k_g, *w_out, *w1, *w2, *fng;
  float* out;
  u16 *wIn, *wOut, *w1t, *w2t, *wUpT, *aUpT, *gUpT, *sgW;
  float *mods, *rope;
  int* cnt;
  float* xc;
  u16 *act, *z, *h, *vTl, *vTc;
  float *y, *bonus, *invn;
};

DEV u16 f2bf(float f) {
  unsigned u = __float_as_uint(f);
  u += 0x7fffu + ((u >> 16) & 1u);
  return (u16)(u >> 16);
}
DEV float bf2f(u16 h) { return __uint_as_float(((unsigned)h) << 16); }
DEV unsigned pk2(float a, float b) { return (unsigned)f2bf(a) | ((unsigned)f2bf(b) << 16); }
DEV float sigmoidf_(float x) { return __builtin_amdgcn_rcpf(1.f + __expf(-x)); }
DEV float siluf_(float x) { return x * __builtin_amdgcn_rcpf(1.f + __expf(-x)); }
DEV float geluf_(float x) {
  float u = 0.7978845608028654f * (x + 0.044715f * x * x * x);
  return 0.5f * x * (1.f + tanhf(u));
}
DEV int swz(int r, int ch) { return r * 128 + ((ch ^ ((r >> 1) & 7)) << 4); }

template <int CTRL>
DEV float dppf(float v) {
  return __int_as_float(__builtin_amdgcn_update_dpp(0, __float_as_int(v), CTRL, 0xF, 0xF, false));
}
DEV float red16_sum(float v) {
  v += dppf<0xB1>(v);
  v += dppf<0x4E>(v);
  v += dppf<0x141>(v);
  v += dppf<0x140>(v);
  return v;
}
DEV float red16_max(float v) {
  v = fmaxf(v, dppf<0xB1>(v));
  v = fmaxf(v, dppf<0x4E>(v));
  v = fmaxf(v, dppf<0x141>(v));
  v = fmaxf(v, dppf<0x140>(v));
  return v;
}
DEV float wave_sum(float v) {
#pragma unroll
  for (int o = 32; o >= 1; o >>= 1) v += __shfl_xor(v, o);
  return v;
}
DEV f32x4 mfma16(bf16x8 a, bf16x8 b, f32x4 c) { return __builtin_amdgcn_mfma_f32_16x16x32_bf16(a, b, c, 0, 0, 0); }

DEV void tr_tile(const float* __restrict__ src, u16* __restrict__ dst, int K, int N, int kt, int nt, bool il, float* lds) {
  const int tid = tid_l();
  const int k0 = kt * 64, n0 = nt * 64;
  {
    const int c = tid & 63, r0 = tid >> 6;
#pragma unroll 4
    for (int i = 0; i < 16; ++i) {
      int r = r0 + i * 4;
      lds[r * 65 + c] = src[(size_t)(k0 + r) * N + n0 + c];
    }
  }
  __syncthreads();
  {
    const int k = tid & 63, nn0 = tid >> 6;
#pragma unroll 4
    for (int i = 0; i < 16; ++i) {
      int n = nn0 + i * 4;
      int gn = n0 + n;
      int np = gn;
      if (il) {
        int j = gn < DFF ? gn : gn - DFF;
        np = (j >> 4) * 32 + (j & 15) + (gn < DFF ? 0 : 16);
      }
      dst[(size_t)np * K + k0 + k] = f2bf(lds[k * 65 + n]);
    }
  }
  __syncthreads();
}

DEV void phase0(const P& p, char* smem) {
  float* lds = (float*)smem;
  const int tid = tid_l();
  constexpr int C0 = 2560, C1 = C0 + 1024, C2 = C1 + 5632, C3 = C2 + 2816, C4 = C3 + 48, C5 = C4 + 48, C6 = C5 + 48,
                C7 = C6 + 64, C8 = C7 + 384, C9 = C8 + 1;
  for (int it = bid_l(); it < C9; it += gridDim.x) {
    if (it < C6) {
      const float* src; u16* dst; int K, N, kt, nt; bool il = false;
      if (it < C0) {
        int l = it / 640, r = it % 640;
        src = p.w_in + (size_t)l * 1024 * 2560; dst = p.wIn + (size_t)l * 2560 * 1024; K = 1024; N = 2560; kt = r / 40; nt = r % 40;
      } else if (it < C1) {
        int i2 = it - C0, l = i2 / 256, r = i2 % 256;
        src = p.w_out + (size_t)l * 1024 * 1024; dst = p.wOut + (size_t)l * 1024 * 1024; K = 1024; N = 1024; kt = r / 16; nt = r % 16;
      } else if (it < C2) {
        int i2 = it - C1, l = i2 / 1408, r = i2 % 1408;
        src = p.w1 + (size_t)l * 1024 * 5632; dst = p.w1t + (size_t)l * 5632 * 1024; K = 1024; N = 5632; kt = r / 88; nt = r % 88; il = true;
      } else if (it < C3) {
        int i2 = it - C2, l = i2 / 704, r = i2 % 704;
        src = p.w2 + (size_t)l * 2816 * 1024; dst = p.w2t + (size_t)l * 1024 * 2816; K = 2816; N = 1024; kt = r / 16; nt = r % 16;
      } else if (it < C4) {
        int i2 = it - C3, bb = i2 / 6;
        src = p.w_up + (size_t)bb * 64 * 384; dst = p.wUpT + (size_t)bb * 384 * 64; K = 64; N = 384; kt = 0; nt = i2 % 6;
      } else if (it < C5) {
        int i2 = it - C4, bb = i2 / 6;
        src = p.a_up + (size_t)bb * 64 * 384; dst = p.aUpT + (size_t)bb * 384 * 64; K = 64; N = 384; kt = 0; nt = i2 % 6;
      } else {
        int i2 = it - C5, l = i2 / 12, r = i2 % 12;
        src = p.g_up + (size_t)l * 128 * 384; dst = p.gUpT + (size_t)l * 384 * 128; K = 128; N = 384; kt = r / 6; nt = r % 6;
      }
      tr_tile(src, dst, K, N, kt, nt, il, lds);
    } else if (it < C7) {
      int i2 = it - C6;
      for (int i = 0; i < 16; ++i) {
        int e = i2 * 4096 + i * 256 + tid;
        p.sgW[e] = f2bf(p.sg_w[e]);
      }
    } else if (it < C8) {
      int i2 = it - C7, l = i2 / 96, cb = i2 % 96;
      for (int e = tid; e < 9 * 1024; e += 256) {
        int s = e >> 10, k = e & 1023;
        float v = s < 8 ? p.c[s * 1024 + k] : p.c_ctx[k];
        lds[e] = siluf_(v);
      }
      __syncthreads();
      const int col = tid & 63, kq = tid >> 6;
      const int n = cb * 64 + col;
      float acc[9];
#pragma unroll
      for (int s = 0; s < 9; ++s) acc[s] = 0.f;
      const float* wp = p.ada_w + (size_t)l * 1024 * 6144 + n;
#pragma unroll 4
      for (int k = kq * 256; k < kq * 256 + 256; ++k) {
        float w = wp[(size_t)k * 6144];
#pragma unroll
        for (int s = 0; s < 9; ++s) acc[s] += lds[s * 1024 + k] * w;
      }
      __syncthreads();
      float* red = lds + 9216;
#pragma unroll
      for (int s = 0; s < 9; ++s) red[(kq * 9 + s) * 64 + col] = acc[s];
      __syncthreads();
      for (int e = tid; e < 9 * 64; e += 256) {
        int s = e >> 6, cc = e & 63;
        float v = red[(0 * 9 + s) * 64 + cc] + red[(1 * 9 + s) * 64 + cc] + red[(2 * 9 + s) * 64 + cc] + red[(3 * 9 + s) * 64 + cc];
        int nn = cb * 64 + cc;
        p.mods[((size_t)l * 9 + s) * 6144 + nn] = v + p.ada_b[l * 6144 + nn];
      }
      __syncthreads();
    } else {
      for (int e = tid; e < 1024; e += 256) {
        int pos = e >> 4, i = e & 15;
        float inv = powf(10000.f, -(float)i / 16.f);
        float ang = (float)pos * inv;
        p.rope[e * 2] = cosf(ang);
        p.rope[e * 2 + 1] = sinf(ang);
      }
      if (tid < 64) p.cnt[tid] = 0;
    }
  }
}

DEV void norm_phase(const P& p, int l, const float* __restrict__ g, int shoff, int scoff, int row_lo, bool from_input) {
  const int tid = tid_l();
  const int lane = tid & 63;
  const int gw = bid_l() * 4 + (tid >> 6), nw = gridDim.x * 4;
  const float* lat = from_input ? p.x : p.out;
  const float* cx = from_input ? p.ctx : p.xc;
  for (int r0 = row_lo + gw; r0 < MT; r0 += 4 * nw) {
    float4 v[4][4];
#pragma unroll
    for (int u = 0; u < 4; ++u) {
      const int r = r0 + u * nw;
      if (r < MT) {
        const float* src = r < MC ? cx + (size_t)r * DM : lat + (size_t)(r - MC) * DM;
#pragma unroll
        for (int i = 0; i < 4; ++i) v[u][i] = *(const float4*)(src + i * 256 + lane * 4);
      }
    }
#pragma unroll
    for (int u = 0; u < 4; ++u) {
      const int r = r0 + u * nw;
      if (r < MT) {
        const int s = r < MC ? 8 : (r - MC) >> 12;
        const float* md = p.mods + ((size_t)l * 9 + s) * 6144;
        float ss = 0.f;
#pragma unroll
        for (int i = 0; i < 4; ++i) ss += v[u][i].x * v[u][i].x + v[u][i].y * v[u][i].y + v[u][i].z * v[u][i].z + v[u][i].w * v[u][i].w;
        ss = wave_sum(ss);
        const float rstd = rsqrtf(ss * (1.f / DM) + 1e-6f);
#pragma unroll
        for (int i = 0; i < 4; ++i) {
          const int c = i * 256 + lane * 4;
          float4 gg = *(const float4*)(g + c);
          float4 sh = *(const float4*)(md + shoff + c);
          float4 sc = *(const float4*)(md + scoff + c);
          float o0 = v[u][i].x * rstd * gg.x * (1.f + sc.x) + sh.x;
          float o1 = v[u][i].y * rstd * gg.y * (1.f + sc.y) + sh.y;
          float o2 = v[u][i].z * rstd * gg.z * (1.f + sc.z) + sh.z;
          float o3 = v[u][i].w * rstd * gg.w * (1.f + sc.w) + sh.w;
          uint2 o;
          o.x = pk2(o0, o1);
          o.y = pk2(o2, o3);
          *(uint2*)(p.act + (size_t)r * DM + c) = o;
        }
      }
    }
  }
}

DEV void final_norm(const P& p) {
  const int tid = tid_l();
  const int lane = tid & 63;
  const int gw = bid_l() * 4 + (tid >> 6), nw = gridDim.x * 4;
  for (int r0 = gw; r0 < ML; r0 += 4 * nw) {
    float4 v[4][4];
#pragma unroll
    for (int u = 0; u < 4; ++u) {
      const int r = r0 + u * nw;
      if (r < ML) {
#pragma unroll
        for (int i = 0; i < 4; ++i) v[u][i] = *(const float4*)(p.out + (size_t)r * DM + i * 256 + lane * 4);
      }
    }
#pragma unroll
    for (int u = 0; u < 4; ++u) {
      const int r = r0 + u * nw;
      if (r < ML) {
        float ss = 0.f;
#pragma unroll
        for (int i = 0; i < 4; ++i) ss += v[u][i].x * v[u][i].x + v[u][i].y * v[u][i].y + v[u][i].z * v[u][i].z + v[u][i].w * v[u][i].w;
        ss = wave_sum(ss);
        const float rstd = rsqrtf(ss * (1.f / DM) + 1e-6f);
#pragma unroll
        for (int i = 0; i < 4; ++i) {
          const int c = i * 256 + lane * 4;
          float4 gg = *(const float4*)(p.fng + c);
          float4 o;
          o.x = v[u][i].x * rstd * gg.x;
          o.y = v[u][i].y * rstd * gg.y;
          o.z = v[u][i].z * rstd * gg.z;
          o.w = v[u][i].w * rstd * gg.w;
          *(float4*)(p.out + (size_t)r * DM + c) = o;
        }
      }
    }
  }
}

enum { EPI_Z = 0, EPI_RES = 1, EPI_SWIGLU = 2 };

template <int EPI>
DEV void gemm_phase(const P& p, int l, const u16* __restrict__ A, int lda, const u16* __restrict__ Bt, int K, int NT,
                           int mt_lo, int goff, char* smem, int dry = 0) {
  const int tid = tid_l(), lane = tid & 63, wid = tid >> 6, wr = wid >> 1, wc = wid & 1, l15 = lane & 15, quad = lane >> 4;
  const int nmt = NMT - mt_lo;
  const int nk = K / 64;
  const int npn = NT >> 2;
  const int npatch = (nmt >> 4) * npn;
  const int tmax = ((npatch + 7) >> 3) * 512;
#define G_MAP(T, OK, M0, N0)                                                                        \
  {                                                                                                 \
    const int xcd_ = (T)&7, sidx_ = (T) >> 3;                                                       \
    const int gp_ = (sidx_ >> 6) * 8 + xcd_;                                                        \
    OK = (T) < tmax && gp_ < npatch;                                                                \
    const int within_ = sidx_ & 63;                                                                 \
    M0 = (mt_lo + (gp_ / npn) * 16 + (within_ & 15)) * 128;                                         \
    N0 = ((gp_ % npn) * 4 + (within_ >> 4)) * 128;                                                  \
  }
  uint4 xa0, xa1, xa2, xa3, xb0, xb1, xb2, xb3, ya0, ya1, ya2, ya3, yb0, yb1, yb2, yb3;
  int t = bid_l();
  bool have;
  int m0, n0;
  G_MAP(t, have, m0, n0);
  const u16* Ag = A + (size_t)(m0 + (tid >> 3)) * lda + (tid & 7) * 8;
  const u16* Bg = Bt + (size_t)(n0 + (tid >> 3)) * K + (tid & 7) * 8;
  bool primed = false;
  while (have) {
    f32x4 acc[4][4];
#pragma unroll
    for (int i = 0; i < 4; ++i)
#pragma unroll
      for (int j = 0; j < 4; ++j) acc[i][j] = f32x4{0.f, 0.f, 0.f, 0.f};
#define G_GL(P, KT)                                                          \
    {                                                                        \
      const int k0_ = (KT)*64;                                               \
      P##a0 = *(const uint4*)(Ag + k0_);                                     \
      P##b0 = *(const uint4*)(Bg + k0_);                                     \
      P##a1 = *(const uint4*)(Ag + (size_t)32 * lda + k0_);                  \
      P##b1 = *(const uint4*)(Bg + (size_t)32 * K + k0_);                    \
      P##a2 = *(const uint4*)(Ag + (size_t)64 * lda + k0_);                  \
      P##b2 = *(const uint4*)(Bg + (size_t)64 * K + k0_);                    \
      P##a3 = *(const uint4*)(Ag + (size_t)96 * lda + k0_);                  \
      P##b3 = *(const uint4*)(Bg + (size_t)96 * K + k0_);                    \
    }
#define G_LS(P, BUF)                                                         \
    {                                                                        \
      char* Aw_ = smem + (BUF)*32768;                                        \
      *(uint4*)(Aw_ + swz((tid >> 3), tid & 7)) = P##a0;                     \
      *(uint4*)(Aw_ + 16384 + swz((tid >> 3), tid & 7)) = P##b0;             \
      *(uint4*)(Aw_ + swz((tid >> 3) + 32, tid & 7)) = P##a1;                \
      *(uint4*)(Aw_ + 16384 + swz((tid >> 3) + 32, tid & 7)) = P##b1;        \
      *(uint4*)(Aw_ + swz((tid >> 3) + 64, tid & 7)) = P##a2;                \
      *(uint4*)(Aw_ + 16384 + swz((tid >> 3) + 64, tid & 7)) = P##b2;        \
      *(uint4*)(Aw_ + swz((tid >> 3) + 96, tid & 7)) = P##a3;                \
      *(uint4*)(Aw_ + 16384 + swz((tid >> 3) + 96, tid & 7)) = P##b3;        \
    }
#define G_COMPUTE(BUF)                                                                                             \
    {                                                                                                              \
      const char* As = smem + (BUF)*32768;                                                                         \
      const char* Bs = As + 16384;                                                                                 \
      _Pragma("unroll") for (int kh = 0; kh < 2; ++kh) {                                                           \
        bf16x8 a[4], b[4];                                                                                         \
        _Pragma("unroll") for (int mi = 0; mi < 4; ++mi)                                                           \
            a[mi] = *(const bf16x8*)(As + swz(wr * 64 + mi * 16 + l15, kh * 4 + quad));                            \
        _Pragma("unroll") for (int ni = 0; ni < 4; ++ni)                                                           \
            b[ni] = *(const bf16x8*)(Bs + swz(wc * 64 + ni * 16 + l15, kh * 4 + quad));                            \
        _Pragma("unroll") for (int mi = 0; mi < 4; ++mi)                                                           \
            _Pragma("unroll") for (int ni = 0; ni < 4; ++ni) acc[mi][ni] = mfma16(b[ni], a[mi], acc[mi][ni]);      \
      }                                                                                                            \
    }
    if (!primed) {
      G_GL(x, 0);
      G_GL(y, 1);
    }
    G_LS(x, 0);
    if (2 < nk) G_GL(x, 2);
    __syncthreads();
    for (int kt = 0; kt < nk; kt += 2) {
      G_COMPUTE(0);
      G_LS(y, 1);
      if (kt + 3 < nk) G_GL(y, kt + 3);
      __syncthreads();
      G_COMPUTE(1);
      if (kt + 2 < nk) G_LS(x, 0);
      if (kt + 4 < nk) G_GL(x, kt + 4);
      __syncthreads();
    }
    const int em0 = m0, en0 = n0;
    t += gridDim.x;
    G_MAP(t, have, m0, n0);
    if (have) {
      Ag = A + (size_t)(m0 + (tid >> 3)) * lda + (tid & 7) * 8;
      Bg = Bt + (size_t)(n0 + (tid >> 3)) * K + (tid & 7) * 8;
      G_GL(x, 0);
      G_GL(y, 1);
      primed = true;
    }
    if (dry) {
      if (acc[0][0][0] == 1.2345e33f) p.bonus[0] = acc[1][1][1] + acc[2][2][2] + acc[3][3][3];
      continue;
    }
    const int cw0 = en0 + wc * 64;
    if constexpr (EPI == EPI_Z) {
      if (cw0 < 1920) {
#pragma unroll
        for (int mi = 0; mi < 4; ++mi) {
          const int r = em0 + wr * 64 + mi * 16 + l15;
#pragma unroll
          for (int ni = 0; ni < 4; ++ni)
            *(uint2*)(p.z + (size_t)r * INC + cw0 + ni * 16 + quad * 4) =
                make_uint2(pk2(acc[mi][ni][0], acc[mi][ni][1]), pk2(acc[mi][ni][2], acc[mi][ni][3]));
          __builtin_amdgcn_sched_barrier(0);
        }
      } else {
        const int hh = (cw0 - 1920) >> 6;
        if (hh < 8) {
          const float* gp = (hh < 6 ? p.q_g : p.k_g) + l * 64;
          float4 gv[4];
#pragma unroll
          for (int ni = 0; ni < 4; ++ni) gv[ni] = *(const float4*)(gp + ni * 16 + quad * 4);
          const float qs = hh < 6 ? 0.125f : 1.f;
#pragma unroll
          for (int mi = 0; mi < 4; ++mi) {
            const int r = em0 + wr * 64 + mi * 16 + l15;
            float ss = 0.f;
#pragma unroll
            for (int ni = 0; ni < 4; ++ni)
#pragma unroll
              for (int j = 0; j < 4; ++j) ss += acc[mi][ni][j] * acc[mi][ni][j];
            ss += __shfl_xor(ss, 16);
            ss += __shfl_xor(ss, 32);
            const float rstd = rsqrtf(ss * (1.f / 64.f) + 1e-6f) ;
            float yv[4][4];
#pragma unroll
            for (int ni = 0; ni < 4; ++ni) {
              yv[ni][0] = acc[mi][ni][0] * rstd * gv[ni].x;
              yv[ni][1] = acc[mi][ni][1] * rstd * gv[ni].y;
              yv[ni][2] = acc[mi][ni][2] * rstd * gv[ni].z;
              yv[ni][3] = acc[mi][ni][3] * rstd * gv[ni].w;
            }
            if (r >= MC) {
              const int tt = (r - MC) & 4095;
              const int prow = tt >> 6, pcol = tt & 63;
              const float* rr_ = p.rope + (prow * 16 + quad * 4) * 2;
              const float* rc_ = p.rope + (pcol * 16 + quad * 4) * 2;
              const float4 ra = *(const float4*)rr_, rb = *(const float4*)(rr_ + 4);
              const float4 ca = *(const float4*)rc_, cb = *(const float4*)(rc_ + 4);
              const float cr[4] = {ra.x, ra.z, rb.x, rb.z}, sr[4] = {ra.y, ra.w, rb.y, rb.w};
              const float cc[4] = {ca.x, ca.z, cb.x, cb.z}, sc[4] = {ca.y, ca.w, cb.y, cb.w};
#pragma unroll
              for (int j = 0; j < 4; ++j) {
                const float a0 = yv[0][j] * cr[j] - yv[1][j] * sr[j], a1 = yv[1][j] * cr[j] + yv[0][j] * sr[j];
                const float a2 = yv[2][j] * cc[j] - yv[3][j] * sc[j], a3 = yv[3][j] * cc[j] + yv[2][j] * sc[j];
                yv[0][j] = a0; yv[1][j] = a1; yv[2][j] = a2; yv[3][j] = a3;
              }
            }
#pragma unroll
            for (int ni = 0; ni < 4; ++ni)
              *(uint2*)(p.z + (size_t)r * INC + cw0 + ni * 16 + quad * 4) =
                  make_uint2(pk2(yv[ni][0] * qs, yv[ni][1] * qs), pk2(yv[ni][2] * qs, yv[ni][3] * qs));
            __builtin_amdgcn_sched_barrier(0);
          }
        } else {
          const int kvh = hh - 8;
#pragma unroll
          for (int mi = 0; mi < 4; ++mi) {
            const int r = em0 + wr * 64 + mi * 16 + l15;
            u16* vb;
            int vstride;
            if (r < MC) { vb = p.vTc + ((size_t)(((r >> 8) * 2 + kvh) * 64)) * CTXL + (r & 255); vstride = CTXL; }
            else { const int rr = r - MC; vb = p.vTl + ((size_t)(((rr >> 12) * 2 + kvh) * 64)) * SEQ + (rr & 4095); vstride = SEQ; }
#pragma unroll
            for (int ni = 0; ni < 4; ++ni)
#pragma unroll
              for (int j = 0; j < 4; ++j) vb[(size_t)(ni * 16 + quad * 4 + j) * vstride] = f2bf(acc[mi][ni][j]);
            __builtin_amdgcn_sched_barrier(0);
          }
        }
      }
    } else if constexpr (EPI == EPI_RES) {
      const int s = em0 < MC ? 8 : (em0 - MC) >> 12;
      const float* gate = p.mods + ((size_t)l * 9 + s) * 6144 + goff;
      float4 gv[4];
#pragma unroll
      for (int ni = 0; ni < 4; ++ni) gv[ni] = *(const float4*)(gate + cw0 + ni * 16 + quad * 4);
#pragma unroll
      for (int mi = 0; mi < 4; ++mi) {
        const int r = em0 + wr * 64 + mi * 16 + l15;
        const float* src;
        if (l == 0 && goff == 2048) src = r < MC ? p.ctx + (size_t)r * DM : p.x + (size_t)(r - MC) * DM;
        else src = r < MC ? p.xc + (size_t)r * DM : p.out + (size_t)(r - MC) * DM;
        float* dst = r < MC ? p.xc + (size_t)r * DM : p.out + (size_t)(r - MC) * DM;
#pragma unroll
        for (int ni = 0; ni < 4; ++ni) {
          const int c = cw0 + ni * 16 + quad * 4;
          const float4 xv = *(const float4*)(src + c);
          float4 o;
          o.x = xv.x + gv[ni].x * acc[mi][ni][0];
          o.y = xv.y + gv[ni].y * acc[mi][ni][1];
          o.z = xv.z + gv[ni].z * acc[mi][ni][2];
          o.w = xv.w + gv[ni].w * acc[mi][ni][3];
          *(float4*)(dst + c) = o;
        }
        __builtin_amdgcn_sched_barrier(0);
      }
    } else {
      const int hc0 = (en0 >> 1) + wc * 32;
#pragma unroll
      for (int mi = 0; mi < 4; ++mi) {
        const int r = em0 + wr * 64 + mi * 16 + l15;
#pragma unroll
        for (int pp = 0; pp < 2; ++pp) {
          float hv[4];
#pragma unroll
          for (int j = 0; j < 4; ++j) hv[j] = siluf_(acc[mi][2 * pp][j]) * acc[mi][2 * pp + 1][j];
          *(uint2*)(p.h + (size_t)r * DFF + hc0 + pp * 16 + quad * 4) = make_uint2(pk2(hv[0], hv[1]), pk2(hv[2], hv[3]));
        }
        __builtin_amdgcn_sched_barrier(0);
      }
    }
  }
}
#undef G_GL
#undef G_LS
#undef G_COMPUTE
#undef G_MAP

template <int LPR>
DEV float red_lpr(float v) {
  v += dppf<0xB1>(v);
  v += dppf<0x4E>(v);
  if (LPR >= 8) v += dppf<0x141>(v);
  if (LPR >= 16) v += dppf<0x140>(v);
  return v;
}

constexpr int SCAN_LPR = 8;
constexpr int SCAN_RPB = 256 / SCAN_LPR;
constexpr int SCAN_NPART = 64 / SCAN_RPB;
constexpr int SCAN_JL = 64 / SCAN_LPR;
constexpr int SCAN_ITEMS = 96 * SCAN_NPART;

DEV float red8_sum(float v) {
  v += dppf<0xB1>(v);
  v += dppf<0x4E>(v);
  v += dppf<0x141>(v);
  return v;
}
DEV float tanh_fast(float x) {
  float e = __expf(2.f * x);
  return 1.f - 2.f * __builtin_amdgcn_rcpf(1.f + e);
}

struct ChunkPos { int len, rowbase, tlo; };
DEV ChunkPos chunk_pos(int c, int d, int b) {
  ChunkPos cp;
  const int s0 = c * 16;
  int pos0;
  if (s0 < 256) { cp.len = 256; pos0 = s0; cp.rowbase = b * 256; }
  else { cp.len = 4096; pos0 = s0 - 256; cp.rowbase = MC + b * 4096; }
  cp.tlo = d ? (cp.len - 16 - pos0) : pos0;
  return cp;
}

constexpr int SC_R = 0, SC_KD = 12288, SC_V = 24576, SC_W = 30720, SC_KA = 38912, SC_NKK = 47104;

DEV void cvt8(const uint4 u, float4& lo, float4& hi) {
  lo.x = __uint_as_float(u.x << 16); lo.y = __uint_as_float(u.x & 0xffff0000u);
  lo.z = __uint_as_float(u.y << 16); lo.w = __uint_as_float(u.y & 0xffff0000u);
  hi.x = __uint_as_float(u.z << 16); hi.y = __uint_as_float(u.z & 0xffff0000u);
  hi.z = __uint_as_float(u.w << 16); hi.w = __uint_as_float(u.w & 0xffff0000u);
}

DEV void scan_item(const P& p, int l, int item, char* smem) {
  const int tid = tid_l(), lane = tid & 63, wid = tid >> 6, l15 = lane & 15, quad = lane >> 4;
  constexpr int LPR = SCAN_LPR, RPB = SCAN_RPB, JL = SCAN_JL, NV = RPB / 8;
  const int scan = item / SCAN_NPART, part = item % SCAN_NPART;
  const int d = scan / 48, b = (scan % 48) / 6, h = scan % 6;
  const int rloc = tid / LPR, jq = tid % LPR;
  const int irow = part * RPB + rloc;
  const int j0 = jq * JL;

  const int c_ts = (tid & 127) >> 3, c_ch = tid & 7;
  const int c_col = (tid < 128 ? 0 : 384) + h * 64 + c_ch * 8;
  const int v_ts = tid / NV, v_ch = tid % NV;
  const int v_col = 768 + h * 64 + part * RPB + v_ch * 8;

  const int n2 = wid * 16 + l15;
  bf16x8 bW[2], bA[2];
  {
    const u16* wb = p.wUpT + ((size_t)(l * 2 + d) * 384 + h * 64 + n2) * 64 + quad * 8;
    const u16* ab = p.aUpT + ((size_t)(l * 2 + d) * 384 + h * 64 + n2) * 64 + quad * 8;
    bW[0] = *(const bf16x8*)(wb);
    bW[1] = *(const bf16x8*)(wb + 32);
    bA[0] = *(const bf16x8*)(ab);
    bA[1] = *(const bf16x8*)(ab + 32);
  }
  const float w0v = p.w0[(size_t)(l * 2 + d) * 384 + h * 64 + n2];
  const float a0v = p.a0[(size_t)(l * 2 + d) * 384 + h * 64 + n2];
  const float kkc = p.k_k[l * 384 + h * 64 + n2], kac = p.k_a[l * 384 + h * 64 + n2], rkc = p.r_k[l * 384 + h * 64 + n2];

  float2v S2[JL / 2];
#pragma unroll
  for (int j = 0; j < JL / 2; ++j) S2[j] = float2v{0.f, 0.f};
  uint4 g_rk, g_v;
  bf16x8 g_wd0, g_wd1, g_ad0, g_ad1;
  float g_inv[4];

#define SC_GLOAD1(CC)                                                                                  \
  {                                                                                                    \
    const ChunkPos cp_ = chunk_pos((CC), d, b);                                                        \
    g_rk = *(const uint4*)(p.z + (size_t)(cp_.rowbase + cp_.tlo + c_ts) * INC + c_col);                \
    if (tid < 16 * NV) g_v = *(const uint4*)(p.z + (size_t)(cp_.rowbase + cp_.tlo + v_ts) * INC + v_col);  \
  }
#define SC_GLOAD2(CC)                                                                                  \
  {                                                                                                    \
    const ChunkPos cp_ = chunk_pos((CC), d, b);                                                        \
    const u16* rp_ = p.z + (size_t)(cp_.rowbase + cp_.tlo + l15) * INC + 1152 + quad * 8;              \
    g_wd0 = *(const bf16x8*)(rp_);                                                                     \
    g_wd1 = *(const bf16x8*)(rp_ + 32);                                                                \
    g_ad0 = *(const bf16x8*)(rp_ + 64);                                                                \
    g_ad1 = *(const bf16x8*)(rp_ + 96);                                                                \
    _Pragma("unroll") for (int j = 0; j < 4; ++j)                                                      \
      g_inv[j] = p.invn[(size_t)(cp_.rowbase + cp_.tlo + quad * 4 + j) * 8 + h];                       \
  }
#define SC_STAGE1(CC)                                                                                  \
  {                                                                                                    \
    const int i3_ = (CC) % 3;                                                                          \
    float4 lo_, hi_;                                                                                   \
    cvt8(g_rk, lo_, hi_);                                                                              \
    float* dst_ = (float*)(smem + (tid < 128 ? SC_R : SC_KD) + i3_ * 4096) + c_ts * 64 + c_ch * 8;     \
    *(float4*)dst_ = lo_;                                                                              \
    *(float4*)(dst_ + 4) = hi_;                                                                        \
    if (tid < 16 * NV) {                                                                               \
      cvt8(g_v, lo_, hi_);                                                                             \
      float* dv_ = (float*)(smem + SC_V + i3_ * 2048) + v_ts * RPB + v_ch * 8;                         \
      *(float4*)dv_ = lo_;                                                                             \
      *(float4*)(dv_ + 4) = hi_;                                                                       \
    }                                                                                                  \
  }
#define SC_STAGE2(CC)                                                                                  \
  {                                                                                                    \
    const int i3_ = (CC) % 3, i2_ = (CC)&1;                                                            \
    const ChunkPos cp_ = chunk_pos((CC), d, b);                                                        \
    f32x4 accW = f32x4{0.f, 0.f, 0.f, 0.f}, accA = f32x4{0.f, 0.f, 0.f, 0.f};                          \
    accW = mfma16(g_wd0, bW[0], accW);                                                                 \
    accW = mfma16(g_wd1, bW[1], accW);                                                                 \
    accA = mfma16(g_ad0, bA[0], accA);                                                                 \
    accA = mfma16(g_ad1, bA[1], accA);                                                                 \
    float bon_[4];                                                                                     \
    _Pragma("unroll") for (int j = 0; j < 4; ++j) {                                                    \
      const int ts = quad * 4 + j;                                                                     \
      float* kdp = (float*)(smem + SC_KD + i3_ * 4096) + ts * 64 + n2;                                 \
      const float kv = *kdp;                                                                           \
      const float rv = *((const float*)(smem + SC_R + i3_ * 4096) + ts * 64 + n2);                     \
      const float sg = sigmoidf_(w0v + accW[j]);                                                       \
      const float wv = __expf(-0.6065306597126334f * sg);                                              \
      const float av = sigmoidf_(a0v + accA[j]);                                                       \
      const float kn = kv * kkc * g_inv[j];                                                            \
      const float kd = kv * (1.f + (av - 1.f) * kac);                                                  \
      *((float*)(smem + SC_W + i2_ * 4096) + ts * 64 + n2) = wv;                                       \
      *((float*)(smem + SC_NKK + i2_ * 4096) + ts * 64 + n2) = -kn;                                    \
      *((float*)(smem + SC_KA + i2_ * 4096) + ts * 64 + n2) = kn * av;                                 \
      *kdp = kd;                                                                                       \
      bon_[j] = rv * kd * rkc;                                                                         \
    }                                                                                                  \
    _Pragma("unroll") for (int j = 0; j < 4; ++j) bon_[j] = red16_sum(bon_[j]);                        \
    if (l15 == 0 && part == 0) {                                                                       \
      _Pragma("unroll") for (int j = 0; j < 4; ++j)                                                    \
        p.bonus[(size_t)(cp_.rowbase + cp_.tlo + quad * 4 + j) * 48 + (d * 6 + h) * 4 + wid] = bon_[j]; \
    }                                                                                                  \
  }

  __builtin_amdgcn_s_setprio(3);
  SC_GLOAD1(0);
  SC_GLOAD2(0);
  SC_STAGE1(0);
  SC_GLOAD1(1);
  __syncthreads();
  SC_STAGE2(0);
  SC_STAGE1(1);
  SC_GLOAD1(2);
  SC_GLOAD2(1);
  __syncthreads();

  for (int c = 0; c < 272; ++c) {
    {
      const int i3 = c % 3, i2 = c & 1;
      const ChunkPos cp = chunk_pos(c, d, b);
      const float* pW = (const float*)(smem + SC_W + i2 * 4096) + j0;
      const float* pN = (const float*)(smem + SC_NKK + i2 * 4096) + j0;
      const float* pA = (const float*)(smem + SC_KA + i2 * 4096) + j0;
      const float* pD = (const float*)(smem + SC_KD + i3 * 4096) + j0;
      const float* pR = (const float*)(smem + SC_R + i3 * 4096) + j0;
      const float* pV = (const float*)(smem + SC_V + i3 * 2048) + rloc;
      float* yp = p.y + ((size_t)d * MT + cp.rowbase + cp.tlo) * 384 + h * 64 + irow;
      float yk0 = 0.f, yk1 = 0.f;
      constexpr int NQ = JL / 4;
      float4 cw[NQ], cn[NQ], ca[NQ], cd[NQ], cr[NQ];
      float cvi;
#define SC_LD(TS, W, N, A, D, R, VI)                                                             \
      _Pragma("unroll") for (int q = 0; q < NQ; ++q) {                                           \
        W[q] = *(const float4*)(pW + (TS)*64 + q * 4); N[q] = *(const float4*)(pN + (TS)*64 + q * 4); \
        A[q] = *(const float4*)(pA + (TS)*64 + q * 4); D[q] = *(const float4*)(pD + (TS)*64 + q * 4); \
        R[q] = *(const float4*)(pR + (TS)*64 + q * 4);                                           \
      }                                                                                          \
      VI = pV[(TS)*RPB];
      {
        const int ts0 = d ? 15 : 0;
        SC_LD(ts0, cw, cn, ca, cd, cr, cvi)
      }
#pragma unroll
      for (int si = 0; si < 16; ++si) {
        float4 xw[NQ], xn[NQ], xa[NQ], xd[NQ], xr[NQ];
        float xvi = 0.f;
        if (si + 1 < 16) {
          const int tsn = d ? 14 - si : si + 1;
          SC_LD(tsn, xw, xn, xa, xd, xr, xvi)
        }
        float2v sa2 = S2[0] * float2v{cn[0].x, cn[0].y};
        sa2 = S2[1] * float2v{cn[0].z, cn[0].w} + sa2;
        if constexpr (NQ == 2) {
          sa2 = S2[2] * float2v{cn[1].x, cn[1].y} + sa2;
          sa2 = S2[3] * float2v{cn[1].z, cn[1].w} + sa2;
        }
        const float sa = LPR == 16 ? red16_sum(sa2.x + sa2.y) : red8_sum(sa2.x + sa2.y);
        const float2v sav = float2v{sa, sa}, viv = float2v{cvi, cvi};
#pragma unroll
        for (int q = 0; q < NQ; ++q) {
          S2[2 * q] = S2[2 * q] * float2v{cw[q].x, cw[q].y} + (sav * float2v{ca[q].x, ca[q].y} + viv * float2v{cd[q].x, cd[q].y});
          S2[2 * q + 1] = S2[2 * q + 1] * float2v{cw[q].z, cw[q].w} + (sav * float2v{ca[q].z, ca[q].w} + viv * float2v{cd[q].z, cd[q].w});
        }
        float2v y2 = S2[0] * float2v{cr[0].x, cr[0].y};
        y2 = S2[1] * float2v{cr[0].z, cr[0].w} + y2;
        if constexpr (NQ == 2) {
          y2 = S2[2] * float2v{cr[1].x, cr[1].y} + y2;
          y2 = S2[3] * float2v{cr[1].z, cr[1].w} + y2;
        }
        const float yv = LPR == 16 ? red16_sum(y2.x + y2.y) : red8_sum(y2.x + y2.y);
        if (si < LPR) yk0 = (jq == si) ? yv : yk0;
        else yk1 = (jq == si - LPR) ? yv : yk1;
        if (si + 1 < 16) {
#pragma unroll
          for (int q = 0; q < NQ; ++q) { cw[q] = xw[q]; cn[q] = xn[q]; ca[q] = xa[q]; cd[q] = xd[q]; cr[q] = xr[q]; }
          cvi = xvi;
        }
      }
#undef SC_LD
      {
        const int tsa = d ? 15 - jq : jq;
        yp[(size_t)tsa * 384] = yk0;
        if constexpr (LPR == 8) {
          const int tsb = d ? 7 - jq : 8 + jq;
          yp[(size_t)tsb * 384] = yk1;
        }
      }
    }
    if (c + 1 < 272) SC_STAGE2(c + 1);
    if (c + 2 < 272) SC_STAGE1(c + 2);
    if (c + 3 < 272) SC_GLOAD1(c + 3);
    if (c + 2 < 272) SC_GLOAD2(c + 2);
    __syncthreads();
  }
  __builtin_amdgcn_s_setprio(0);
#undef SC_GLOAD1
#undef SC_GLOAD2
#undef SC_STAGE1
#undef SC_STAGE2
}

DEV void attn_item(const P& p, int item, char* smem) {
  const int tid = tid_l(), lane = tid & 63, wid = tid >> 6, l15 = lane & 15, quad = lane >> 4;
  bool lat = item < 1536;
  int b, hq, qb;
  if (lat) { b = item / 192; int rem = item % 192; hq = rem / 32; qb = rem % 32; }
  else { int i2 = item - 1536; b = i2 / 12; int rem = i2 % 12; hq = rem / 2; qb = rem % 2; }
  const int kvh = hq / 3;
  const int qrow0 = lat ? MC + b * 4096 + qb * 128 : b * 256 + qb * 128;
  const int nkt = lat ? 68 : 4;
  const float LOG2E = 1.4426950408889634f;

  bf16x8 qf[2][2];
#pragma unroll
  for (int mi = 0; mi < 2; ++mi)
#pragma unroll
    for (int ks = 0; ks < 2; ++ks)
      qf[mi][ks] = *(const bf16x8*)(p.z + (size_t)(qrow0 + wid * 32 + mi * 16 + l15) * INC + 1920 + hq * 64 + ks * 32 + quad * 8);

  f32x4 O[2][4];
  float mrow[2][4], lpart[2][4];
#pragma unroll
  for (int mi = 0; mi < 2; ++mi) {
#pragma unroll
    for (int nd = 0; nd < 4; ++nd) O[mi][nd] = f32x4{0.f, 0.f, 0.f, 0.f};
#pragma unroll
    for (int j = 0; j < 4; ++j) { mrow[mi][j] = -1e30f; lpart[mi][j] = 0.f; }
  }
  char* Ps = smem + 32768 + wid * 4096;
  const int lrow = tid >> 3, lch = tid & 7;
  uint4 rk0, rk1, rv0, rv1;
#define ATT_GLOAD(KT)                                                                         \
  {                                                                                           \
    const int kt_ = (KT);                                                                     \
    const u16* kp;                                                                            \
    const u16* vp;                                                                            \
    int vstride;                                                                              \
    if (lat && kt_ < 64) {                                                                    \
      kp = p.z + (size_t)(MC + b * 4096 + kt_ * 64) * INC + 2304 + kvh * 64;                  \
      vp = p.vTl + (size_t)((b * 2 + kvh) * 64) * SEQ + kt_ * 64;                             \
      vstride = SEQ;                                                                          \
    } else {                                                                                  \
      const int kc = lat ? kt_ - 64 : kt_;                                                    \
      kp = p.z + (size_t)(b * 256 + kc * 64) * INC + 2304 + kvh * 64;                         \
      vp = p.vTc + (size_t)((b * 2 + kvh) * 64) * CTXL + kc * 64;                             \
      vstride = CTXL;                                                                         \
    }                                                                                         \
    rk0 = *(const uint4*)(kp + (size_t)(lrow)*INC + lch * 8);                                 \
    rk1 = *(const uint4*)(kp + (size_t)(lrow + 32) * INC + lch * 8);                          \
    rv0 = *(const uint4*)(vp + (size_t)(lrow)*vstride + lch * 8);                             \
    rv1 = *(const uint4*)(vp + (size_t)(lrow + 32) * vstride + lch * 8);                      \
  }
#define ATT_LSTORE(BUF)                                     \
  {                                                         \
    char* Kb_ = smem + (BUF)*16384;                         \
    *(uint4*)(Kb_ + swz(lrow, lch)) = rk0;                  \
    *(uint4*)(Kb_ + swz(lrow + 32, lch)) = rk1;             \
    *(uint4*)(Kb_ + 8192 + swz(lrow, lch)) = rv0;           \
    *(uint4*)(Kb_ + 8192 + swz(lrow + 32, lch)) = rv1;      \
  }
  ATT_GLOAD(0);
  ATT_LSTORE(0);
  __syncthreads();
  for (int kt = 0; kt < nkt; ++kt) {
    const int buf = kt & 1;
    if (kt + 1 < nkt) ATT_GLOAD(kt + 1);
    const char* Kb = smem + buf * 16384;
    const char* Vb = Kb + 8192;
    f32x4 Sx[2][4];
#pragma unroll
    for (int mi = 0; mi < 2; ++mi)
#pragma unroll
      for (int ni = 0; ni < 4; ++ni) Sx[mi][ni] = f32x4{0.f, 0.f, 0.f, 0.f};
#pragma unroll
    for (int ks = 0; ks < 2; ++ks) {
      bf16x8 kf[4];
#pragma unroll
      for (int ni = 0; ni < 4; ++ni) kf[ni] = *(const bf16x8*)(Kb + swz(ni * 16 + l15, ks * 4 + quad));
#pragma unroll
      for (int mi = 0; mi < 2; ++mi)
#pragma unroll
        for (int ni = 0; ni < 4; ++ni) Sx[mi][ni] = mfma16(qf[mi][ks], kf[ni], Sx[mi][ni]);
    }
#pragma unroll
    for (int mi = 0; mi < 2; ++mi)
#pragma unroll
      for (int j = 0; j < 4; ++j) {
        float mx = fmaxf(fmaxf(Sx[mi][0][j], Sx[mi][1][j]), fmaxf(Sx[mi][2][j], Sx[mi][3][j]));
        mx = red16_max(mx);
        const float mnew = fmaxf(mrow[mi][j], mx);
        const float alpha = __builtin_amdgcn_exp2f((mrow[mi][j] - mnew) * LOG2E);
        mrow[mi][j] = mnew;
        const float mb = mnew * LOG2E;
        float ps = 0.f;
        const int prow = mi * 16 + quad * 4 + j;
#pragma unroll
        for (int ni = 0; ni < 4; ++ni) {
          float pv = __builtin_amdgcn_exp2f(Sx[mi][ni][j] * LOG2E - mb);
          ps += pv;
          *(u16*)(Ps + swz(prow, ni * 2 + (l15 >> 3)) + (l15 & 7) * 2) = f2bf(pv);
        }
        lpart[mi][j] = lpart[mi][j] * alpha + ps;
#pragma unroll
        for (int nd = 0; nd < 4; ++nd) O[mi][nd][j] *= alpha;
      }
    __builtin_amdgcn_fence(__ATOMIC_RELEASE, "wavefront");
    __builtin_amdgcn_wave_barrier();
    __builtin_amdgcn_fence(__ATOMIC_ACQUIRE, "wavefront");
#pragma unroll
    for (int ks = 0; ks < 2; ++ks) {
      bf16x8 pf[2], vf[4];
#pragma unroll
      for (int mi = 0; mi < 2; ++mi) pf[mi] = *(const bf16x8*)(Ps + swz(mi * 16 + l15, ks * 4 + quad));
#pragma unroll
      for (int nd = 0; nd < 4; ++nd) vf[nd] = *(const bf16x8*)(Vb + swz(nd * 16 + l15, ks * 4 + quad));
#pragma unroll
      for (int mi = 0; mi < 2; ++mi)
#pragma unroll
        for (int nd = 0; nd < 4; ++nd) O[mi][nd] = mfma16(pf[mi], vf[nd], O[mi][nd]);
    }
    if (kt + 1 < nkt) ATT_LSTORE(buf ^ 1);
    __syncthreads();
  }
#pragma unroll
  for (int mi = 0; mi < 2; ++mi)
#pragma unroll
    for (int j = 0; j < 4; ++j) {
      const float lsum = red16_sum(lpart[mi][j]);
      const float inv = 1.f / lsum;
      const int r = qrow0 + wid * 32 + mi * 16 + quad * 4 + j;
#pragma unroll
      for (int nd = 0; nd < 4; ++nd) p.act[(size_t)r * DM + 640 + hq * 64 + nd * 16 + l15] = f2bf(O[mi][nd][j] * inv);
    }
}

DEV void sgate_item(const P& p, int l, int ck, int g, char* smem) {
  const int tid = tid_l(), lane = tid & 63, wid = tid >> 6, l15 = lane & 15, quad = lane >> 4;
  const int m0 = ck * 128;
  u16* sVT = (u16*)smem;
  {
    const int q = tid >> 1, half = tid & 1;
    const u16* src = p.z + (size_t)(m0 + q) * INC + 1408 + 256 + g * 64 + half * 32;
    float v[32];
    float ss = 0.f;
#pragma unroll
    for (int cidx = 0; cidx < 4; ++cidx) {
      uint4 u = *(const uint4*)(src + cidx * 8);
      unsigned uu[4] = {u.x, u.y, u.z, u.w};
#pragma unroll
      for (int e = 0; e < 4; ++e) {
        float f0 = geluf_(bf2f((u16)(uu[e] & 0xffff)));
        float f1 = geluf_(bf2f((u16)(uu[e] >> 16)));
        v[cidx * 8 + e * 2] = f0;
        v[cidx * 8 + e * 2 + 1] = f1;
        ss += f0 * f0 + f1 * f1;
      }
    }
    ss += __shfl_xor(ss, 1);
    const float rstd = rsqrtf(ss * (1.f / 64.f) + 1e-6f);
    const float* gn = p.sgn + l * 256 + g * 64 + half * 32;
#pragma unroll
    for (int e = 0; e < 32; ++e) sVT[(half * 32 + e) * 136 + q] = f2bf(v[e] * rstd * gn[e]);
  }
  __syncthreads();
  f32x4 acc[2][4];
#pragma unroll
  for (int mi = 0; mi < 2; ++mi)
#pragma unroll
    for (int ni = 0; ni < 4; ++ni) acc[mi][ni] = f32x4{0.f, 0.f, 0.f, 0.f};
  const u16* Wg = p.sgW + (size_t)(l * 4 + g) * 128 * 128;
#pragma unroll
  for (int ks = 0; ks < 4; ++ks) {
    bf16x8 a[2], bb[4];
#pragma unroll
    for (int mi = 0; mi < 2; ++mi) a[mi] = *(const bf16x8*)(Wg + (size_t)(wid * 32 + mi * 16 + l15) * 128 + ks * 32 + quad * 8);
#pragma unroll
    for (int ni = 0; ni < 4; ++ni) bb[ni] = *(const bf16x8*)(sVT + (ni * 16 + l15) * 136 + ks * 32 + quad * 8);
#pragma unroll
    for (int mi = 0; mi < 2; ++mi)
#pragma unroll
      for (int ni = 0; ni < 4; ++ni) acc[mi][ni] = mfma16(a[mi], bb[ni], acc[mi][ni]);
  }
#pragma unroll
  for (int mi = 0; mi < 2; ++mi)
#pragma unroll
    for (int j = 0; j < 4; ++j) {
      const int pr = wid * 32 + mi * 16 + quad * 4 + j;
      const float bias = p.sg_b[(size_t)(l * 4 + g) * 128 + pr];
#pragma unroll
      for (int ni = 0; ni < 4; ++ni) {
        const int c = ni * 16 + l15;
        float u = geluf_(bf2f(p.z[(size_t)(m0 + pr) * INC + 1408 + g * 64 + c]));
        p.act[(size_t)(m0 + pr) * DM + 384 + g * 64 + c] = f2bf(u * (acc[mi][ni][j] + bias));
      }
    }
  __syncthreads();
}

DEV void mix_phase(const P& p, int l, char* smem, int cidx) {
  __shared__ int s_item;
  const bool last = (l == DEPTH - 1);
  const int n_attn = last ? 1536 : 1632;
  const int ck_lo = last ? 16 : 0;
  const int n_sg = (NMT - ck_lo) * 4;
  const int total = SCAN_ITEMS + n_attn + n_sg;
  const int bid = bid_l();
  bool first = bid < SCAN_ITEMS;
  for (;;) {
    int it;
    if (first) {
      it = bid;
      first = false;
    } else {
      if (tid_l() == 0) s_item = SCAN_ITEMS + atomicAdd(p.cnt + cidx, 1);
      __syncthreads();
      it = s_item;
      __syncthreads();
    }
    if (it >= total) break;
    if (it < SCAN_ITEMS) {
      int nr = SCAN_REP; asm volatile("" : "+s"(nr));
      for (int rr = 0; rr < nr; ++rr) scan_item(p, l, it, smem);
    } else if (it < SCAN_ITEMS + n_attn) {
      int nr = ATT_REP; asm volatile("" : "+s"(nr));
      for (int rr = 0; rr < nr; ++rr) { attn_item(p, it - SCAN_ITEMS, smem); __syncthreads(); }
    } else {
      int i2 = it - SCAN_ITEMS - n_attn;
      int nr = SG_REP; asm volatile("" : "+s"(nr));
      for (int rr = 0; rr < nr; ++rr) sgate_item(p, l, ck_lo + (i2 >> 2), i2 & 3, smem);
    }
  }
}

DEV void apost_phase(const P& p, int l, int mt_lo, char* smem) {
  const int tid = tid_l(), lane = tid & 63, wid = tid >> 6, l15 = lane & 15, quad = lane >> 4;
  const int nit = (NMT - mt_lo) * 6;
  for (int it = bid_l(); it < nit; it += gridDim.x) {
    const int mt = mt_lo + it / 6;
    const int hh = it % 6;
    const int m0 = mt * 128;
    bf16x8 a[2][4];
#pragma unroll
    for (int mi = 0; mi < 2; ++mi)
#pragma unroll
      for (int ks = 0; ks < 4; ++ks)
        a[mi][ks] = *(const bf16x8*)(p.z + (size_t)(m0 + wid * 32 + mi * 16 + l15) * INC + 1280 + ks * 32 + quad * 8);
    {
      f32x4 acc[2][4];
#pragma unroll
      for (int mi = 0; mi < 2; ++mi)
#pragma unroll
        for (int ni = 0; ni < 4; ++ni) acc[mi][ni] = f32x4{0.f, 0.f, 0.f, 0.f};
#pragma unroll
      for (int ks = 0; ks < 4; ++ks) {
        bf16x8 bb[4];
#pragma unroll
        for (int ni = 0; ni < 4; ++ni)
          bb[ni] = *(const bf16x8*)(p.gUpT + ((size_t)l * 384 + hh * 64 + ni * 16 + l15) * 128 + ks * 32 + quad * 8);
#pragma unroll
        for (int mi = 0; mi < 2; ++mi)
#pragma unroll
          for (int ni = 0; ni < 4; ++ni) acc[mi][ni] = mfma16(a[mi][ks], bb[ni], acc[mi][ni]);
      }
      float lg[4], lb[4];
#pragma unroll
      for (int ni = 0; ni < 4; ++ni) {
        const int c = hh * 64 + ni * 16 + l15;
        lg[ni] = p.ln_g[l * 384 + c];
        lb[ni] = p.ln_b[l * 384 + c];
      }
#pragma unroll
      for (int mi = 0; mi < 2; ++mi)
#pragma unroll
        for (int j = 0; j < 4; ++j) {
          const int r = m0 + wid * 32 + mi * 16 + quad * 4 + j;
          float ys[4], vv[4];
          float sm = 0.f;
#pragma unroll
          for (int ni = 0; ni < 4; ++ni) {
            const int c = hh * 64 + ni * 16 + l15;
            ys[ni] = p.y[(size_t)r * 384 + c] + p.y[((size_t)MT + r) * 384 + c];
            vv[ni] = bf2f(p.z[(size_t)r * INC + 768 + c]);
            sm += ys[ni];
          }
          const float4 bq0 = *(const float4*)(p.bonus + (size_t)r * 48 + hh * 4);
          const float4 bq1 = *(const float4*)(p.bonus + (size_t)r * 48 + (6 + hh) * 4);
          const float bon = (bq0.x + bq0.y) + (bq0.z + bq0.w) + (bq1.x + bq1.y) + (bq1.z + bq1.w);
          sm = red16_sum(sm);
          const float mean = sm * (1.f / 64.f);
          float vs = 0.f;
#pragma unroll
          for (int ni = 0; ni < 4; ++ni) { ys[ni] -= mean; vs += ys[ni] * ys[ni]; }
          vs = red16_sum(vs);
          const float rstd = rsqrtf(vs * (1.f / 64.f) + 64e-5f);
#pragma unroll
          for (int ni = 0; ni < 4; ++ni) {
            const int c = hh * 64 + ni * 16 + l15;
            float o = (ys[ni] * rstd * lg[ni] + lb[ni] + bon * vv[ni]) * acc[mi][ni][j];
            p.act[(size_t)r * DM + c] = f2bf(o);
          }
          __builtin_amdgcn_sched_barrier(0);
        }
    }
  }
}

DEV uint2 ld8(const u16* q) { return *(const uint2*)q; }
DEV void up4(const uint2 u, float (&f)[4]) {
  f[0] = __uint_as_float(u.x << 16); f[1] = __uint_as_float(u.x & 0xffff0000u);
  f[2] = __uint_as_float(u.y << 16); f[3] = __uint_as_float(u.y & 0xffff0000u);
}
DEV void prep_phase(const P& p, int l, cg::grid_group& grid) {
  const int tid = tid_l(), lane = tid & 63, l15 = lane & 15;
  const int nb = gridDim.x, bid = bid_l();
  constexpr int NR = 8;
  const int rpb = (((MT + nb - 1) / nb) + NR - 1) & ~(NR - 1);
  const int ra = bid * rpb;
  const int rb = min(ra + rpb, MT);
  const bool active = ra < MT;
  const bool has1 = tid < 96;
  const int col0 = tid * 4, col1 = 1024 + tid * 4;
  uint2 hp0 = make_uint2(0, 0), hn0 = hp0, hp1 = hp0, hn1 = hp0;
  if (active) {
    if (ra > 0) { hp0 = ld8(p.z + (size_t)(ra - 1) * INC + col0); if (has1) hp1 = ld8(p.z + (size_t)(ra - 1) * INC + col1); }
    if (rb < MT) { hn0 = ld8(p.z + (size_t)rb * INC + col0); if (has1) hn1 = ld8(p.z + (size_t)rb * INC + col1); }
  }
  grid.sync();
  if (!active) return;
  const float* cw = p.conv + (size_t)l * 3 * 1408;
#pragma unroll 1
  for (int pass = 0; pass < 2; ++pass) {
    if (pass == 1 && !has1) break;
    const int col = pass ? col1 : col0;
    const int typ = col < 1152 ? 0 : (col < 1216 ? 1 : (col < 1280 ? 0 : 2));
    const bool isk = col >= 384 && col < 768;
    float c0[4], c1[4], c2[4], kk4[4];
#pragma unroll
    for (int e = 0; e < 4; ++e) {
      c0[e] = cw[col + e]; c1[e] = cw[1408 + col + e]; c2[e] = cw[2816 + col + e];
      kk4[e] = isk ? p.k_k[l * 384 + (col - 384) + e] : 0.f;
    }
    const int hh = isk ? (col - 384) >> 6 : 0;
    u16* zc = p.z + col;
    uint2 prev = pass ? hp1 : hp0;
    const uint2 halo_n = pass ? hn1 : hn0;
    uint2 cur = ld8(zc + (size_t)ra * INC);
    for (int r = ra; r < rb; r += NR) {
      uint2 w[NR + 2];
      w[0] = prev;
      w[1] = cur;
#pragma unroll
      for (int q = 0; q < NR; ++q) {
        const int rr = r + 1 + q;
        w[q + 2] = rr < rb ? ld8(zc + (size_t)rr * INC) : halo_n;
      }
#pragma unroll
      for (int q = 0; q < NR; ++q) {
        const int rr = r + q;
        const uint2 xp = w[q], xc = w[q + 1], xn = w[q + 2];
        const int tt = rr < MC ? (rr & 255) : ((rr - MC) & 4095);
        const int len = rr < MC ? 256 : 4096;
        const float mp = tt > 0 ? 1.f : 0.f, mn = tt < len - 1 ? 1.f : 0.f;
        float fp[4], fc[4], fn[4], o[4];
        up4(xp, fp); up4(xc, fc); up4(xn, fn);
#pragma unroll
        for (int e = 0; e < 4; ++e) {
          float v = fc[e] * c1[e] + mp * (fp[e] * c0[e]) + mn * (fn[e] * c2[e]);
          if (typ == 1) v = tanh_fast(v);
          else if (typ == 2) v = sigmoidf_(v);
          o[e] = v;
        }
        if (isk) {
          float q0 = o[0] * kk4[0], q1 = o[1] * kk4[1], q2 = o[2] * kk4[2], q3 = o[3] * kk4[3];
          float ss = red16_sum(q0 * q0 + q1 * q1 + q2 * q2 + q3 * q3);
          if (l15 == 0 && rr < rb) p.invn[(size_t)rr * 8 + hh] = 1.f / fmaxf(sqrtf(ss), 1e-12f);
        }
        if (rr < rb) *(uint2*)(zc + (size_t)rr * INC) = make_uint2(pk2(o[0], o[1]), pk2(o[2], o[3]));
      }
      prev = w[NR];
      cur = w[NR + 1];
    }
  }
}

__global__ void __launch_bounds__(256, 2) fwd_megakernel(P p, int ph_lo, int ph_hi) {
  __shared__ __attribute__((aligned(16))) char smem[65536 - 64];
  cg::grid_group grid = cg::this_grid();
  for (int ph = ph_lo; ph < ph_hi; ++ph) {
    if (ph > ph_lo) grid.sync();
    if (ph == 0) {
      phase0(p, smem);
      if (PROBE_MASK & 256) { grid.sync(); phase0(p, smem); }
      if (PROBE_MASK & 1024) { for (int i = 0; i < 50; ++i) grid.sync(); }
      continue;
    }
    if (ph == 1 + 8 * DEPTH) { final_norm(p); continue; }
    const int l = (ph - 1) >> 3, sub = (ph - 1) & 7;
    const bool last = (l == DEPTH - 1);
    const int mt_lo = last ? 16 : 0;
    int nrep = ((PROBE_MASK >> sub) & 1) ? 2 : 1;
    asm volatile("" : "+s"(nrep));
    for (int rep = 0; rep < nrep; ++rep) {
      if (rep) grid.sync();
      const int dry = (rep + 1 < nrep && !(PROBE_MASK & 512)) ? 1 : 0;
      if (sub == 0 || sub == 5) {
        const bool n2 = sub == 5;
        norm_phase(p, l, (n2 ? p.n2g : p.n1g) + l * DM, n2 ? 3072 : 0, n2 ? 4096 : 1024, n2 ? mt_lo * 128 : 0, !n2 && l == 0);
      } else if (sub == 1) {
        gemm_phase<EPI_Z>(p, l, p.act, DM, p.wIn + (size_t)l * 2560 * 1024, 1024, 20, 0, 0, smem, dry);
      } else if (sub == 2) {
        if (rep == 0) { prep_phase(p, l, grid); grid.sync(); }
        mix_phase(p, l, smem, l + 8 * rep);
      } else if (sub == 3) {
        apost_phase(p, l, mt_lo, smem);
      } else if (sub == 4 || sub == 7) {
        const bool g4 = sub == 7;
        gemm_phase<EPI_RES>(p, l, g4 ? p.h : p.act, g4 ? DFF : DM,
                            g4 ? p.w2t + (size_t)l * 1024 * 2816 : p.wOut + (size_t)l * 1024 * 1024, g4 ? 2816 : 1024, 8, mt_lo,
                            g4 ? 5120 : 2048, smem, dry);
      } else {
        gemm_phase<EPI_SWIGLU>(p, l, p.act, DM, p.w1t + (size_t)l * 5632 * 1024, 1024, 44, mt_lo, 0, smem, dry);
      }
    }
  }
}

extern "C" void kernel_launch(void* const* d_in, const int* in_sizes, int n_in, void* d_out, int out_size, void* d_ws,
                              size_t ws_size, hipStream_t stream) {
  static int grid_blocks = 0;
  if (!grid_blocks) {
    int dev = 0, cus = 0, per_cu = 0;
    hipGetDevice(&dev);
    hipDeviceGetAttribute(&cus, hipDeviceAttributeMultiprocessorCount, dev);
    hipOccupancyMaxActiveBlocksPerMultiprocessor(&per_cu, fwd_megakernel, 256, 0);
    if (per_cu > 2) per_cu = 2;
    if (per_cu < 1) per_cu = 1;
    grid_blocks = cus * per_cu;
  }
  P p{};
  const float* const* in = (const float* const*)d_in;
  p.x = in[0]; p.c = in[1]; p.ctx = in[2]; p.c_ctx = in[3]; p.n1g = in[4]; p.n2g = in[5]; p.ada_w = in[6]; p.ada_b = in[7];
  p.w_in = in[8]; p.conv = in[9]; p.w0 = in[10]; p.w_up = in[11]; p.a0 = in[12]; p.a_up = in[13]; p.g_up = in[14];
  p.k_k = in[15]; p.k_a = in[16]; p.r_k = in[17]; p.ln_g = in[18]; p.ln_b = in[19]; p.sgn = in[20]; p.sg_w = in[21];
  p.sg_b = in[22]; p.q_g = in[23]; p.k_g = in[24]; p.w_out = in[25]; p.w1 = in[26]; p.w2 = in[27]; p.fng = in[28];
  p.out = (float*)d_out;
  char* ws = (char*)d_ws;
  size_t off = 0;
  auto take = [&](size_t bytes) { char* r = ws + off; off += (bytes + 255) & ~(size_t)255; return r; };
  p.wIn = (u16*)take((size_t)4 * 2560 * 1024 * 2);
  p.wOut = (u16*)take((size_t)4 * 1024 * 1024 * 2);
  p.w1t = (u16*)take((size_t)4 * 5632 * 1024 * 2);
  p.w2t = (u16*)take((size_t)4 * 1024 * 2816 * 2);
  p.wUpT = (u16*)take((size_t)8 * 384 * 64 * 2);
  p.aUpT = (u16*)take((size_t)8 * 384 * 64 * 2);
  p.gUpT = (u16*)take((size_t)4 * 384 * 128 * 2);
  p.sgW = (u16*)take((size_t)16 * 128 * 128 * 2);
  p.mods = (float*)take((size_t)4 * 9 * 6144 * 4);
  p.rope = (float*)take(2048 * 4);
  p.cnt = (int*)take(256);
  p.xc = (float*)take((size_t)MC * DM * 4);
  p.act = (u16*)take((size_t)MT * DM * 2);
  p.z = (u16*)take((size_t)MT * DFF * 2);
  p.h = p.z;
  p.vTl = (u16*)take((size_t)16 * 64 * SEQ * 2);
  p.vTc = (u16*)take((size_t)16 * 64 * CTXL * 2);
  p.y = (float*)take((size_t)2 * MT * 384 * 4);
  p.bonus = (float*)take((size_t)MT * 48 * 4);
  p.invn = (float*)take((size_t)MT * 8 * 4);
  if (off > ws_size) { fprintf(stderr, "workspace too small: need %zu have %zu\n", off, ws_size); return; }
  int ph_lo = 0, ph_hi = 2 + 8 * DEPTH;
  void* args[] = {&p, &ph_lo, &ph_hi};
  hipError_t e = hipLaunchCooperativeKernel((void*)fwd_megakernel, dim3(grid_blocks), dim3(256), args, 0, stream);
  if (e != hipSuccess) fprintf(stderr, "cooperative launch failed: %s (grid %d)\n", hipGetErrorString(e), grid_blocks);
}
```

```cpp
#include <hip/hip_runtime.h>
#include <hip/hip_bf16.h>
#include <hip/hip_cooperative_groups.h>
#include <cstdio>
namespace cg = cooperative_groups;

typedef __attribute__((ext_vector_type(8))) short bf16x8;
typedef __attribute__((ext_vector_type(4))) float f32x4;
typedef unsigned short u16;
typedef __attribute__((ext_vector_type(2))) float float2v;

#define DEV __device__ __forceinline__
DEV int tid_l() { int t = threadIdx.x; asm volatile("" : "+v"(t)); return t; }
DEV int bid_l() { int b = blockIdx.x; asm volatile("" : "+s"(b)); return b; }

constexpr int DM = 1024, NBATCH = 8, SEQ = 4096, DEPTH = 4, CTXL = 256;
constexpr int MC = NBATCH * CTXL;
constexpr int ML = NBATCH * SEQ;
constexpr int MT = MC + ML;
constexpr int INC = 2560, DFF = 2816;
constexpr int NMT = MT / 128;
#ifndef PROBE_MASK
#define PROBE_MASK 0
#endif
#define SCAN_REP 1
#define ATT_REP 1
#define SG_REP 1

struct P {
  const float *x, *c, *ctx, *c_ctx, *n1g, *n2g, *ada_w, *ada_b, *w_in, *conv, *w0, *w_up, *a0, *a_up, *g_up,
      *k_k, *k_a, *r_k, *ln_g, *ln_b, *sgn, *sg_w, *sg_b, *q_g, *k_g, *w_out, *w1, *w2, *fng;
  float* out;
  u16 *wIn, *wOut, *w1t, *w2t, *wUpT, *aUpT, *gUpT, *sgW;
  float *mods, *rope;
  int* cnt;
  float* xc;
  u16 *act, *z, *h, *vTl, *vTc;
  float *y, *bonus, *invn;
};

typedef __attribute__((ext_vector_type(2))) __bf16 bf16x2v;
typedef __attribute__((ext_vector_type(2))) float f32x2v;
DEV unsigned pk2(float a, float b) {
  f32x2v v = {a, b};
  bf16x2v r = __builtin_convertvector(v, bf16x2v);
  return *(unsigned*)&r;
}
DEV u16 f2bf(float f) { return (u16)(pk2(f, 0.f) & 0xffffu); }
DEV float bf2f(u16 h) { return __uint_as_float(((unsigned)h) << 16); }
DEV float sigmoidf_(float x) { return __builtin_amdgcn_rcpf(1.f + __expf(-x)); }
DEV float siluf_(float x) { return x * __builtin_amdgcn_rcpf(1.f + __expf(-x)); }
DEV float geluf_(float x) {
  float u = 0.7978845608028654f * (x + 0.044715f * x * x * x);
  return 0.5f * x * (1.f + tanhf(u));
}
DEV int swz(int r, int ch) { return r * 128 + ((ch ^ ((r >> 1) & 7)) << 4); }

template <int CTRL>
DEV float dppf(float v) {
  return __int_as_float(__builtin_amdgcn_update_dpp(0, __float_as_int(v), CTRL, 0xF, 0xF, false));
}
DEV float red16_sum(float v) {
  v += dppf<0xB1>(v);
  v += dppf<0x4E>(v);
  v += dppf<0x141>(v);
  v += dppf<0x140>(v);
  return v;
}
DEV float red16_max(float v) {
  v = fmaxf(v, dppf<0xB1>(v));
  v = fmaxf(v, dppf<0x4E>(v));
  v = fmaxf(v, dppf<0x141>(v));
  v = fmaxf(v, dppf<0x140>(v));
  return v;
}
DEV float wave_sum(float v) {
#pragma unroll
  for (int o = 32; o >= 1; o >>= 1) v += __shfl_xor(v, o);
  return v;
}
DEV f32x4 mfma16(bf16x8 a, bf16x8 b, f32x4 c) { return __builtin_amdgcn_mfma_f32_16x16x32_bf16(a, b, c, 0, 0, 0); }

DEV void tr_tile(const float* __restrict__ src, u16* __restrict__ dst, int K, int N, int kt, int nt, bool il, float* lds) {
  const int tid = tid_l();
  const int k0 = kt * 64, n0 = nt * 64;
  {
    const int c = tid & 63, r0 = tid >> 6;
#pragma unroll 4
    for (int i = 0; i < 16; ++i) {
      int r = r0 + i * 4;
      lds[r * 65 + c] = src[(size_t)(k0 + r) * N + n0 + c];
    }
  }
  __syncthreads();
  {
    const int k = tid & 63, nn0 = tid >> 6;
#pragma unroll 4
    for (int i = 0; i < 16; ++i) {
      int n = nn0 + i * 4;
      int gn = n0 + n;
      int np = gn;
      if (il) {
        int j = gn < DFF ? gn : gn - DFF;
        np = (j >> 4) * 32 + (j & 15) + (gn < DFF ? 0 : 16);
      }
      dst[(size_t)np * K + k0 + k] = f2bf(lds[k * 65 + n]);
    }
  }
  __syncthreads();
}

DEV void phase0(const P& p, char* smem) {
  float* lds = (float*)smem;
  const int tid = tid_l();
  constexpr int C0 = 2560, C1 = C0 + 1024, C2 = C1 + 5632, C3 = C2 + 2816, C4 = C3 + 48, C5 = C4 + 48, C6 = C5 + 48,
                C7 = C6 + 64, C8 = C7 + 384, C9 = C8 + 1;
  for (int it = bid_l(); it < C9; it += gridDim.x) {
    if (it < C6) {
      const float* src; u16* dst; int K, N, kt, nt; bool il = false;
      if (it < C0) {
        int l = it / 640, r = it % 640;
        src = p.w_in + (size_t)l * 1024 * 2560; dst = p.wIn + (size_t)l * 2560 * 1024; K = 1024; N = 2560; kt = r / 40; nt = r % 40;
      } else if (it < C1) {
        int i2 = it - C0, l = i2 / 256, r = i2 % 256;
        src = p.w_out + (size_t)l * 1024 * 1024; dst = p.wOut + (size_t)l * 1024 * 1024; K = 1024; N = 1024; kt = r / 16; nt = r % 16;
      } else if (it < C2) {
        int i2 = it - C1, l = i2 / 1408, r = i2 % 1408;
        src = p.w1 + (size_t)l * 1024 * 5632; dst = p.w1t + (size_t)l * 5632 * 1024; K = 1024; N = 5632; kt = r / 88; nt = r % 88; il = true;
      } else if (it < C3) {
        int i2 = it - C2, l = i2 / 704, r = i2 % 704;
        src = p.w2 + (size_t)l * 2816 * 1024; dst = p.w2t + (size_t)l * 1024 * 2816; K = 2816; N = 1024; kt = r / 16; nt = r % 16;
      } else if (it < C4) {
        int i2 = it - C3, bb = i2 / 6;
        src = p.w_up + (size_t)bb * 64 * 384; dst = p.wUpT + (size_t)bb * 384 * 64; K = 64; N = 384; kt = 0; nt = i2 % 6;
      } else if (it < C5) {
        int i2 = it - C4, bb = i2 / 6;
        src = p.a_up + (size_t)bb * 64 * 384; dst = p.aUpT + (size_t)bb * 384 * 64; K = 64; N = 384; kt = 0; nt = i2 % 6;
      } else {
        int i2 = it - C5, l = i2 / 12, r = i2 % 12;
        src = p.g_up + (size_t)l * 128 * 384; dst = p.gUpT + (size_t)l * 384 * 128; K = 128; N = 384; kt = r / 6; nt = r % 6;
      }
      tr_tile(src, dst, K, N, kt, nt, il, lds);
    } else if (it < C7) {
      int i2 = it - C6;
      for (int i = 0; i < 16; ++i) {
        int e = i2 * 4096 + i * 256 + tid;
        p.sgW[e] = f2bf(p.sg_w[e]);
      }
    } else if (it < C8) {
      int i2 = it - C7, l = i2 / 96, cb = i2 % 96;
      for (int e = tid; e < 9 * 1024; e += 256) {
        int s = e >> 10, k = e & 1023;
        float v = s < 8 ? p.c[s * 1024 + k] : p.c_ctx[k];
        lds[e] = siluf_(v);
      }
      __syncthreads();
      const int col = tid & 63, kq = tid >> 6;
      const int n = cb * 64 + col;
      float acc[9];
#pragma unroll
      for (int s = 0; s < 9; ++s) acc[s] = 0.f;
      const float* wp = p.ada_w + (size_t)l * 1024 * 6144 + n;
#pragma unroll 4
      for (int k = kq * 256; k < kq * 256 + 256; ++k) {
        float w = wp[(size_t)k * 6144];
#pragma unroll
        for (int s = 0; s < 9; ++s) acc[s] += lds[s * 1024 + k] * w;
      }
      __syncthreads();
      float* red = lds + 9216;
#pragma unroll
      for (int s = 0; s < 9; ++s) red[(kq * 9 + s) * 64 + col] = acc[s];
      __syncthreads();
      for (int e = tid; e < 9 * 64; e += 256) {
        int s = e >> 6, cc = e & 63;
        float v = red[(0 * 9 + s) * 64 + cc] + red[(1 * 9 + s) * 64 + cc] + red[(2 * 9 + s) * 64 + cc] + red[(3 * 9 + s) * 64 + cc];
        int nn = cb * 64 + cc;
        p.mods[((size_t)l * 9 + s) * 6144 + nn] = v + p.ada_b[l * 6144 + nn];
      }
      __syncthreads();
    } else {
      for (int e = tid; e < 1024; e += 256) {
        int pos = e >> 4, i = e & 15;
        float inv = powf(10000.f, -(float)i / 16.f);
        float ang = (float)pos * inv;
        p.rope[e * 2] = cosf(ang);
        p.rope[e * 2 + 1] = sinf(ang);
      }
      if (tid < 64) p.cnt[tid] = 0;
    }
  }
}

DEV void norm_phase(const P& p, int l, const float* __restrict__ g, int shoff, int scoff, int row_lo, bool from_input) {
  const int tid = tid_l();
  const int lane = tid & 63;
  const int gw = bid_l() * 4 + (tid >> 6), nw = gridDim.x * 4;
  const float* lat = from_input ? p.x : p.out;
  const float* cx = from_input ? p.ctx : p.xc;
  for (int r0 = row_lo + gw; r0 < MT; r0 += 4 * nw) {
    float4 v[4][4];
#pragma unroll
    for (int u = 0; u < 4; ++u) {
      const int r = r0 + u * nw;
      if (r < MT) {
        const float* src = r < MC ? cx + (size_t)r * DM : lat + (size_t)(r - MC) * DM;
#pragma unroll
        for (int i = 0; i < 4; ++i) v[u][i] = *(const float4*)(src + i * 256 + lane * 4);
      }
    }
#pragma unroll
    for (int u = 0; u < 4; ++u) {
      const int r = r0 + u * nw;
      if (r < MT) {
        const int s = r < MC ? 8 : (r - MC) >> 12;
        const float* md = p.mods + ((size_t)l * 9 + s) * 6144;
        float ss = 0.f;
#pragma unroll
        for (int i = 0; i < 4; ++i) ss += v[u][i].x * v[u][i].x + v[u][i].y * v[u][i].y + v[u][i].z * v[u][i].z + v[u][i].w * v[u][i].w;
        ss = wave_sum(ss);
        const float rstd = rsqrtf(ss * (1.f / DM) + 1e-6f);
#pragma unroll
        for (int i = 0; i < 4; ++i) {
          const int c = i * 256 + lane * 4;
          float4 gg = *(const float4*)(g + c);
          float4 sh = *(const float4*)(md + shoff + c);
          float4 sc = *(const float4*)(md + scoff + c);
          float o0 = v[u][i].x * rstd * gg.x * (1.f + sc.x) + sh.x;
          float o1 = v[u][i].y * rstd * gg.y * (1.f + sc.y) + sh.y;
          float o2 = v[u][i].z * rstd * gg.z * (1.f + sc.z) + sh.z;
          float o3 = v[u][i].w * rstd * gg.w * (1.f + sc.w) + sh.w;
          uint2 o;
          o.x = pk2(o0, o1);
          o.y = pk2(o2, o3);
          *(uint2*)(p.act + (size_t)r * DM + c) = o;
        }
      }
    }
  }
}

DEV void final_norm(const P& p) {
  const int tid = tid_l();
  const int lane = tid & 63;
  const int gw = bid_l() * 4 + (tid >> 6), nw = gridDim.x * 4;
  for (int r0 = gw; r0 < ML; r0 += 4 * nw) {
    float4 v[4][4];
#pragma unroll
    for (int u = 0; u < 4; ++u) {
      const int r = r0 + u * nw;
      if (r < ML) {
#pragma unroll
        for (int i = 0; i < 4; ++i) v[u][i] = *(const float4*)(p.out + (size_t)r * DM + i * 256 + lane * 4);
      }
    }
#pragma unroll
    for (int u = 0; u < 4; ++u) {
      const int r = r0 + u * nw;
      if (r < ML) {
        float ss = 0.f;
#pragma unroll
        for (int i = 0; i < 4; ++i) ss += v[u][i].x * v[u][i].x + v[u][i].y * v[u][i].y + v[u][i].z * v[u][i].z + v[u][i].w * v[u][i].w;
        ss = wave_sum(ss);
        const float rstd = rsqrtf(ss * (1.f / DM) + 1e-6f);
#pragma unroll
        for (int i = 0; i < 4; ++i) {
          const int c = i * 256 + lane * 4;
          float4 gg = *(const float4*)(p.fng + c);
          float4 o;
          o.x = v[u][i].x * rstd * gg.x;
          o.y = v[u][i].y * rstd * gg.y;
          o.z = v[u][i].z * rstd * gg.z;
          o.w = v[u][i].w * rstd * gg.w;
          *(float4*)(p.out + (size_t)r * DM + c) = o;
        }
      }
    }
  }
}

enum { EPI_Z = 0, EPI_RES = 1, EPI_SWIGLU = 2 };

template <int EPI>
DEV void gemm_phase(const P& p, int l, const u16* __restrict__ A, int lda, const u16* __restrict__ Bt, int K, int NT,
                           int mt_lo, int goff, char* smem, int dry = 0) {
  const int tid = tid_l(), lane = tid & 63, wid = tid >> 6, wr = wid >> 1, wc = wid & 1, l15 = lane & 15, quad = lane >> 4;
  const int nmt = NMT - mt_lo;
  const int nk = K / 64;
  const int npn = NT >> 2;
  const int npatch = (nmt >> 4) * npn;
  const int tmax = ((npatch + 7) >> 3) * 512;
#define G_MAP(T, OK, M0, N0)                                                                        \
  {                                                                                                 \
    const int xcd_ = (T)&7, sidx_ = (T) >> 3;                                                       \
    const int gp_ = (sidx_ >> 6) * 8 + xcd_;                                                        \
    OK = (T) < tmax && gp_ < npatch;                                                                \
    const int within_ = sidx_ & 63;                                                                 \
    M0 = (mt_lo + (gp_ / npn) * 16 + (within_ & 15)) * 128;                                         \
    N0 = ((gp_ % npn) * 4 + (within_ >> 4)) * 128;                                                  \
  }
  uint4 xa0, xa1, xa2, xa3, xb0, xb1, xb2, xb3, ya0, ya1, ya2, ya3, yb0, yb1, yb2, yb3;
  int t = bid_l();
  bool have;
  int m0, n0;
  G_MAP(t, have, m0, n0);
  const u16* Ag = A + (size_t)(m0 + (tid >> 3)) * lda + (tid & 7) * 8;
  const u16* Bg = Bt + (size_t)(n0 + (tid >> 3)) * K + (tid & 7) * 8;
  bool primed = false;
  while (have) {
    f32x4 acc[4][4];
#pragma unroll
    for (int i = 0; i < 4; ++i)
#pragma unroll
      for (int j = 0; j < 4; ++j) acc[i][j] = f32x4{0.f, 0.f, 0.f, 0.f};
#define G_GL(P, KT)                                                          \
    {                                                                        \
      const int k0_ = (KT)*64;                                               \
      P##a0 = *(const uint4*)(Ag + k0_);                                     \
      P##b0 = *(const uint4*)(Bg + k0_);                                     \
      P##a1 = *(const uint4*)(Ag + (size_t)32 * lda + k0_);                  \
      P##b1 = *(const uint4*)(Bg + (size_t)32 * K + k0_);                    \
      P##a2 = *(const uint4*)(Ag + (size_t)64 * lda + k0_);                  \
      P##b2 = *(const uint4*)(Bg + (size_t)64 * K + k0_);                    \
      P##a3 = *(const uint4*)(Ag + (size_t)96 * lda + k0_);                  \
      P##b3 = *(const uint4*)(Bg + (size_t)96 * K + k0_);                    \
    }
#define G_LS(P, BUF)                                                         \
    {                                                                        \
      char* Aw_ = smem + (BUF)*32768;                                        \
      *(uint4*)(Aw_ + swz((tid >> 3), tid & 7)) = P##a0;                     \
      *(uint4*)(Aw_ + 16384 + swz((tid >> 3), tid & 7)) = P##b0;             \
      *(uint4*)(Aw_ + swz((tid >> 3) + 32, tid & 7)) = P##a1;                \
      *(uint4*)(Aw_ + 16384 + swz((tid >> 3) + 32, tid & 7)) = P##b1;        \
      *(uint4*)(Aw_ + swz((tid >> 3) + 64, tid & 7)) = P##a2;                \
      *(uint4*)(Aw_ + 16384 + swz((tid >> 3) + 64, tid & 7)) = P##b2;        \
      *(uint4*)(Aw_ + swz((tid >> 3) + 96, tid & 7)) = P##a3;                \
      *(uint4*)(Aw_ + 16384 + swz((tid >> 3) + 96, tid & 7)) = P##b3;        \
    }
#define G_COMPUTE(BUF)                                                                                             \
    {                                                                                                              \
      const char* As = smem + (BUF)*32768;                                                                         \
      const char* Bs = As + 16384;                                                                                 \
      _Pragma("unroll") for (int kh = 0; kh < 2; ++kh) {                                                           \
        bf16x8 a[4], b[4];                                                                                         \
        _Pragma("unroll") for (int mi = 0; mi < 4; ++mi)                                                           \
            a[mi] = *(const bf16x8*)(As + swz(wr * 64 + mi * 16 + l15, kh * 4 + quad));                            \
        _Pragma("unroll") for (int ni = 0; ni < 4; ++ni)                                                           \
            b[ni] = *(const bf16x8*)(Bs + swz(wc * 64 + ni * 16 + l15, kh * 4 + quad));                            \
        _Pragma("unroll") for (int mi = 0; mi < 4; ++mi)                                                           \
            _Pragma("unroll") for (int ni = 0; ni < 4; ++ni) acc[mi][ni] = mfma16(b[ni], a[mi], acc[mi][ni]);      \
      }                                                                                                            \
    }
    if (!primed) {
      G_GL(x, 0);
      G_GL(y, 1);
    }
    G_LS(x, 0);
    if (2 < nk) G_GL(x, 2);
    __syncthreads();
    for (int kt = 0; kt < nk; kt += 2) {
      G_COMPUTE(0);
      G_LS(y, 1);
      if (kt + 3 < nk) G_GL(y, kt + 3);
      __syncthreads();
      G_COMPUTE(1);
      if (kt + 2 < nk) G_LS(x, 0);
      if (kt + 4 < nk) G_GL(x, kt + 4);
      __syncthreads();
    }
    const int em0 = m0, en0 = n0;
    t += gridDim.x;
    G_MAP(t, have, m0, n0);
    if (have) {
      Ag = A + (size_t)(m0 + (tid >> 3)) * lda + (tid & 7) * 8;
      Bg = Bt + (size_t)(n0 + (tid >> 3)) * K + (tid & 7) * 8;
      G_GL(x, 0);
      G_GL(y, 1);
      primed = true;
    }
    if (dry) {
      if (acc[0][0][0] == 1.2345e33f) p.bonus[0] = acc[1][1][1] + acc[2][2][2] + acc[3][3][3];
      continue;
    }
    const int cw0 = en0 + wc * 64;
    if constexpr (EPI == EPI_Z) {
      if (cw0 < 1920) {
#pragma unroll
        for (int mi = 0; mi < 4; ++mi) {
          const int r = em0 + wr * 64 + mi * 16 + l15;
#pragma unroll
          for (int ni = 0; ni < 4; ++ni)
            *(uint2*)(p.z + (size_t)r * INC + cw0 + ni * 16 + quad * 4) =
                make_uint2(pk2(acc[mi][ni][0], acc[mi][ni][1]), pk2(acc[mi][ni][2], acc[mi][ni][3]));
          __builtin_amdgcn_sched_barrier(0);
        }
      } else {
        const int hh = (cw0 - 1920) >> 6;
        if (hh < 8) {
          const float* gp = (hh < 6 ? p.q_g : p.k_g) + l * 64;
          float4 gv[4];
#pragma unroll
          for (int ni = 0; ni < 4; ++ni) gv[ni] = *(const float4*)(gp + ni * 16 + quad * 4);
          const float qs = hh < 6 ? 0.125f : 1.f;
#pragma unroll
          for (int mi = 0; mi < 4; ++mi) {
            const int r = em0 + wr * 64 + mi * 16 + l15;
            float ss = 0.f;
#pragma unroll
            for (int ni = 0; ni < 4; ++ni)
#pragma unroll
              for (int j = 0; j < 4; ++j) ss += acc[mi][ni][j] * acc[mi][ni][j];
            ss += __shfl_xor(ss, 16);
            ss += __shfl_xor(ss, 32);
            const float rstd = rsqrtf(ss * (1.f / 64.f) + 1e-6f) ;
            float yv[4][4];
#pragma unroll
            for (int ni = 0; ni < 4; ++ni) {
              yv[ni][0] = acc[mi][ni][0] * rstd * gv[ni].x;
              yv[ni][1] = acc[mi][ni][1] * rstd * gv[ni].y;
              yv[ni][2] = acc[mi][ni][2] * rstd * gv[ni].z;
              yv[ni][3] = acc[mi][ni][3] * rstd * gv[ni].w;
            }
            if (r >= MC) {
              const int tt = (r - MC) & 4095;
              const int prow = tt >> 6, pcol = tt & 63;
              const float* rr_ = p.rope + (prow * 16 + quad * 4) * 2;
              const float* rc_ = p.rope + (pcol * 16 + quad * 4) * 2;
              const float4 ra = *(const float4*)rr_, rb = *(const float4*)(rr_ + 4);
              const float4 ca = *(const float4*)rc_, cb = *(const float4*)(rc_ + 4);
              const float cr[4] = {ra.x, ra.z, rb.x, rb.z}, sr[4] = {ra.y, ra.w, rb.y, rb.w};
              const float cc[4] = {ca.x, ca.z, cb.x, cb.z}, sc[4] = {ca.y, ca.w, cb.y, cb.w};
#pragma unroll
              for (int j = 0; j < 4; ++j) {
                const float a0 = yv[0][j] * cr[j] - yv[1][j] * sr[j], a1 = yv[1][j] * cr[j] + yv[0][j] * sr[j];
                const float a2 = yv[2][j] * cc[j] - yv[3][j] * sc[j], a3 = yv[3][j] * cc[j] + yv[2][j] * sc[j];
                yv[0][j] = a0; yv[1][j] = a1; yv[2][j] = a2; yv[3][j] = a3;
              }
            }
#pragma unroll
            for (int ni = 0; ni < 4; ++ni)
              *(uint2*)(p.z + (size_t)r * INC + cw0 + ni * 16 + quad * 4) =
                  make_uint2(pk2(yv[ni][0] * qs, yv[ni][1] * qs), pk2(yv[ni][2] * qs, yv[ni][3] * qs));
            __builtin_amdgcn_sched_barrier(0);
          }
        } else {
          const int kvh = hh - 8;
#pragma unroll
          for (int mi = 0; mi < 4; ++mi) {
            const int r = em0 + wr * 64 + mi * 16 + l15;
            u16* vb;
            int vstride;
            if (r < MC) { vb = p.vTc + ((size_t)(((r >> 8) * 2 + kvh) * 64)) * CTXL + (r & 255); vstride = CTXL; }
            else { const int rr = r - MC; vb = p.vTl + ((size_t)(((rr >> 12) * 2 + kvh) * 64)) * SEQ + (rr & 4095); vstride = SEQ; }
#pragma unroll
            for (int ni = 0; ni < 4; ++ni)
#pragma unroll
              for (int j = 0; j < 4; ++j) vb[(size_t)(ni * 16 + quad * 4 + j) * vstride] = f2bf(acc[mi][ni][j]);
            __builtin_amdgcn_sched_barrier(0);
          }
        }
      }
    } else if constexpr (EPI == EPI_RES) {
      const int s = em0 < MC ? 8 : (em0 - MC) >> 12;
      const float* gate = p.mods + ((size_t)l * 9 + s) * 6144 + goff;
      float4 gv[4];
#pragma unroll
      for (int ni = 0; ni < 4; ++ni) gv[ni] = *(const float4*)(gate + cw0 + ni * 16 + quad * 4);
#pragma unroll
      for (int mi = 0; mi < 4; ++mi) {
        const int r = em0 + wr * 64 + mi * 16 + l15;
        const float* src;
        if (l == 0 && goff == 2048) src = r < MC ? p.ctx + (size_t)r * DM : p.x + (size_t)(r - MC) * DM;
        else src = r < MC ? p.xc + (size_t)r * DM : p.out + (size_t)(r - MC) * DM;
        float* dst = r < MC ? p.xc + (size_t)r * DM : p.out + (size_t)(r - MC) * DM;
#pragma unroll
        for (int ni = 0; ni < 4; ++ni) {
          const int c = cw0 + ni * 16 + quad * 4;
          const float4 xv = *(const float4*)(src + c);
          float4 o;
          o.x = xv.x + gv[ni].x * acc[mi][ni][0];
          o.y = xv.y + gv[ni].y * acc[mi][ni][1];
          o.z = xv.z + gv[ni].z * acc[mi][ni][2];
          o.w = xv.w + gv[ni].w * acc[mi][ni][3];
          *(float4*)(dst + c) = o;
        }
        __builtin_amdgcn_sched_barrier(0);
      }
    } else {
      const int hc0 = (en0 >> 1) + wc * 32;
#pragma unroll
      for (int mi = 0; mi < 4; ++mi) {
        const int r = em0 + wr * 64 + mi * 16 + l15;
#pragma unroll
        for (int pp = 0; pp < 2; ++pp) {
          float hv[4];
#pragma unroll
          for (int j = 0; j < 4; ++j) hv[j] = siluf_(acc[mi][2 * pp][j]) * acc[mi][2 * pp + 1][j];
          *(uint2*)(p.h + (size_t)r * DFF + hc0 + pp * 16 + quad * 4) = make_uint2(pk2(hv[0], hv[1]), pk2(hv[2], hv[3]));
        }
        __builtin_amdgcn_sched_barrier(0);
      }
    }
  }
}
#undef G_GL
#undef G_LS
#undef G_COMPUTE
#undef G_MAP

template <int LPR>
DEV float red_lpr(float v) {
  v += dppf<0xB1>(v);
  v += dppf<0x4E>(v);
  if (LPR >= 8) v += dppf<0x141>(v);
  if (LPR >= 16) v += dppf<0x140>(v);
  return v;
}

constexpr int SCAN_LPR = 8;
constexpr int SCAN_RPB = 256 / SCAN_LPR;
constexpr int SCAN_NPART = 64 / SCAN_RPB;
constexpr int SCAN_JL = 64 / SCAN_LPR;
constexpr int SCAN_ITEMS = 96 * SCAN_NPART;

DEV float red8_sum(float v) {
  v += dppf<0xB1>(v);
  v += dppf<0x4E>(v);
  v += dppf<0x141>(v);
  return v;
}
DEV float tanh_fast(float x) {
  float e = __expf(2.f * x);
  return 1.f - 2.f * __builtin_amdgcn_rcpf(1.f + e);
}

struct ChunkPos { int len, rowbase, tlo; };
DEV ChunkPos chunk_pos(int c, int d, int b) {
  ChunkPos cp;
  const int s0 = c * 16;
  int pos0;
  if (s0 < 256) { cp.len = 256; pos0 = s0; cp.rowbase = b * 256; }
  else { cp.len = 4096; pos0 = s0 - 256; cp.rowbase = MC + b * 4096; }
  cp.tlo = d ? (cp.len - 16 - pos0) : pos0;
  return cp;
}

constexpr int SC_R = 0, SC_KD = 12288, SC_V = 24576, SC_W = 30720, SC_KA = 38912, SC_NKK = 47104;

DEV void cvt8(const uint4 u, float4& lo, float4& hi) {
  lo.x = __uint_as_float(u.x << 16); lo.y = __uint_as_float(u.x & 0xffff0000u);
  lo.z = __uint_as_float(u.y << 16); lo.w = __uint_as_float(u.y & 0xffff0000u);
  hi.x = __uint_as_float(u.z << 16); hi.y = __uint_as_float(u.z & 0xffff0000u);
  hi.z = __uint_as_float(u.w << 16); hi.w = __uint_as_float(u.w & 0xffff0000u);
}

DEV void scan_item(const P& p, int l, int item, char* smem) {
  const int tid = tid_l(), lane = tid & 63, wid = tid >> 6, l15 = lane & 15, quad = lane >> 4;
  constexpr int LPR = SCAN_LPR, RPB = SCAN_RPB, JL = SCAN_JL, NV = RPB / 8;
  const int scan = item / SCAN_NPART, part = item % SCAN_NPART;
  const int d = scan / 48, b = (scan % 48) / 6, h = scan % 6;
  const int rloc = tid / LPR, jq = tid % LPR;
  const int irow = part * RPB + rloc;
  const int j0 = jq * JL;

  const int c_ts = (tid & 127) >> 3, c_ch = tid & 7;
  const int c_col = (tid < 128 ? 0 : 384) + h * 64 + c_ch * 8;
  const int v_ts = tid / NV, v_ch = tid % NV;
  const int v_col = 768 + h * 64 + part * RPB + v_ch * 8;

  const int n2 = wid * 16 + l15;
  bf16x8 bW[2], bA[2];
  {
    const u16* wb = p.wUpT + ((size_t)(l * 2 + d) * 384 + h * 64 + n2) * 64 + quad * 8;
    const u16* ab = p.aUpT + ((size_t)(l * 2 + d) * 384 + h * 64 + n2) * 64 + quad * 8;
    bW[0] = *(const bf16x8*)(wb);
    bW[1] = *(const bf16x8*)(wb + 32);
    bA[0] = *(const bf16x8*)(ab);
    bA[1] = *(const bf16x8*)(ab + 32);
  }
  const float w0v = p.w0[(size_t)(l * 2 + d) * 384 + h * 64 + n2];
  const float a0v = p.a0[(size_t)(l * 2 + d) * 384 + h * 64 + n2];
  const float kkc = p.k_k[l * 384 + h * 64 + n2], kac = p.k_a[l * 384 + h * 64 + n2], rkc = p.r_k[l * 384 + h * 64 + n2];

  float2v S2[JL / 2];
#pragma unroll
  for (int j = 0; j < JL / 2; ++j) S2[j] = float2v{0.f, 0.f};
  uint4 g_rk, g_v;
  bf16x8 g_wd0, g_wd1, g_ad0, g_ad1;
  float g_inv[4];

#define SC_GLOAD1(CC)                                                                                  \
  {                                                                                                    \
    const ChunkPos cp_ = chunk_pos((CC), d, b);                                                        \
    g_rk = *(const uint4*)(p.z + (size_t)(cp_.rowbase + cp_.tlo + c_ts) * INC + c_col);                \
    if (tid < 16 * NV) g_v = *(const uint4*)(p.z + (size_t)(cp_.rowbase + cp_.tlo + v_ts) * INC + v_col);  \
  }
#define SC_GLOAD2(CC)                                                                                  \
  {                                                                                                    \
    const ChunkPos cp_ = chunk_pos((CC), d, b);                                                        \
    const u16* rp_ = p.z + (size_t)(cp_.rowbase + cp_.tlo + l15) * INC + 1152 + quad * 8;              \
    g_wd0 = *(const bf16x8*)(rp_);                                                                     \
    g_wd1 = *(const bf16x8*)(rp_ + 32);                                                                \
    g_ad0 = *(const bf16x8*)(rp_ + 64);                                                                \
    g_ad1 = *(const bf16x8*)(rp_ + 96);                                                                \
    _Pragma("unroll") for (int j = 0; j < 4; ++j)                                                      \
      g_inv[j] = p.invn[(size_t)(cp_.rowbase + cp_.tlo + quad * 4 + j) * 8 + h];                       \
  }
#define SC_STAGE1(CC)                                                                                  \
  {                                                                                                    \
    const int i3_ = (CC) % 3;                                                                          \
    float4 lo_, hi_;                                                                                   \
    cvt8(g_rk, lo_, hi_);                                                                              \
    float* dst_ = (float*)(smem + (tid < 128 ? SC_R : SC_KD) + i3_ * 4096) + c_ts * 64 + c_ch * 8;     \
    *(float4*)dst_ = lo_;                                                                              \
    *(float4*)(dst_ + 4) = hi_;                                                                        \
    if (tid < 16 * NV) {                                                                               \
      cvt8(g_v, lo_, hi_);                                                                             \
      float* dv_ = (float*)(smem + SC_V + i3_ * 2048) + v_ts * RPB + v_ch * 8;                         \
      *(float4*)dv_ = lo_;                                                                             \
      *(float4*)(dv_ + 4) = hi_;                                                                       \
    }                                                                                                  \
  }
#define SC_STAGE2(CC)                                                                                  \
  {                                                                                                    \
    const int i3_ = (CC) % 3, i2_ = (CC)&1;                                                            \
    const ChunkPos cp_ = chunk_pos((CC), d, b);                                                        \
    f32x4 accW = f32x4{0.f, 0.f, 0.f, 0.f}, accA = f32x4{0.f, 0.f, 0.f, 0.f};                          \
    accW = mfma16(g_wd0, bW[0], accW);                                                                 \
    accW = mfma16(g_wd1, bW[1], accW);                                                                 \
    accA = mfma16(g_ad0, bA[0], accA);                                                                 \
    accA = mfma16(g_ad1, bA[1], accA);                                                                 \
    float bon_[4];                                                                                     \
    _Pragma("unroll") for (int j = 0; j < 4; ++j) {                                                    \
      const int ts = quad * 4 + j;                                                                     \
      float* kdp = (float*)(smem + SC_KD + i3_ * 4096) + ts * 64 + n2;                                 \
      const float kv = *kdp;                                                                           \
      const float rv = *((const float*)(smem + SC_R + i3_ * 4096) + ts * 64 + n2);                     \
      const float sg = sigmoidf_(w0v + accW[j]);                                                       \
      const float wv = __expf(-0.6065306597126334f * sg);                                              \
      const float av = sigmoidf_(a0v + accA[j]);                                                       \
      const float kn = kv * kkc * g_inv[j];                                                            \
      const float kd = kv * (1.f + (av - 1.f) * kac);                                                  \
      *((float*)(smem + SC_W + i2_ * 4096) + ts * 64 + n2) = wv;                                       \
      *((float*)(smem + SC_NKK + i2_ * 4096) + ts * 64 + n2) = -kn;                                    \
      *((float*)(smem + SC_KA + i2_ * 4096) + ts * 64 + n2) = kn * av;                                 \
      *kdp = kd;                                                                                       \
      bon_[j] = rv * kd * rkc;                                                                         \
    }                                                                                                  \
    _Pragma("unroll") for (int j = 0; j < 4; ++j) bon_[j] = red16_sum(bon_[j]);                        \
    if (l15 == 0 && part == 0) {                                                                       \
      _Pragma("unroll") for (int j = 0; j < 4; ++j)                                                    \
        p.bonus[(size_t)(cp_.rowbase + cp_.tlo + quad * 4 + j) * 48 + (d * 6 + h) * 4 + wid] = bon_[j]; \
    }                                                                                                  \
  }

  __builtin_amdgcn_s_setprio(3);
  SC_GLOAD1(0);
  SC_GLOAD2(0);
  SC_STAGE1(0);
  SC_GLOAD1(1);
  __syncthreads();
  SC_STAGE2(0);
  SC_STAGE1(1);
  SC_GLOAD1(2);
  SC_GLOAD2(1);
  __syncthreads();

  for (int c = 0; c < 272; ++c) {
    {
      const int i3 = c % 3, i2 = c & 1;
      const ChunkPos cp = chunk_pos(c, d, b);
      const float* pW = (const float*)(smem + SC_W + i2 * 4096) + j0;
      const float* pN = (const float*)(smem + SC_NKK + i2 * 4096) + j0;
      const float* pA = (const float*)(smem + SC_KA + i2 * 4096) + j0;
      const float* pD = (const float*)(smem + SC_KD + i3 * 4096) + j0;
      const float* pR = (const float*)(smem + SC_R + i3 * 4096) + j0;
      const float* pV = (const float*)(smem + SC_V + i3 * 2048) + rloc;
      float* yp = p.y + ((size_t)d * MT + cp.rowbase + cp.tlo) * 384 + h * 64 + irow;
      float yk0 = 0.f, yk1 = 0.f;
      constexpr int NQ = JL / 4;
      float4 cw[NQ], cn[NQ], ca[NQ], cd[NQ], cr[NQ];
      float cvi;
#define SC_LD(TS, W, N, A, D, R, VI)                                                             \
      _Pragma("unroll") for (int q = 0; q < NQ; ++q) {                                           \
        W[q] = *(const float4*)(pW + (TS)*64 + q * 4); N[q] = *(const float4*)(pN + (TS)*64 + q * 4); \
        A[q] = *(const float4*)(pA + (TS)*64 + q * 4); D[q] = *(const float4*)(pD + (TS)*64 + q * 4); \
        R[q] = *(const float4*)(pR + (TS)*64 + q * 4);                                           \
      }                                                                                          \
      VI = pV[(TS)*RPB];
      {
        const int ts0 = d ? 15 : 0;
        SC_LD(ts0, cw, cn, ca, cd, cr, cvi)
      }
#pragma unroll
      for (int si = 0; si < 16; ++si) {
        float4 xw[NQ], xn[NQ], xa[NQ], xd[NQ], xr[NQ];
        float xvi = 0.f;
        if (si + 1 < 16) {
          const int tsn = d ? 14 - si : si + 1;
          SC_LD(tsn, xw, xn, xa, xd, xr, xvi)
        }
        float2v sa2 = S2[0] * float2v{cn[0].x, cn[0].y};
        sa2 = S2[1] * float2v{cn[0].z, cn[0].w} + sa2;
        if constexpr (NQ == 2) {
          sa2 = S2[2] * float2v{cn[1].x, cn[1].y} + sa2;
          sa2 = S2[3] * float2v{cn[1].z, cn[1].w} + sa2;
        }
        const float sa = LPR == 16 ? red16_sum(sa2.x + sa2.y) : red8_sum(sa2.x + sa2.y);
        const float2v sav = float2v{sa, sa}, viv = float2v{cvi, cvi};
#pragma unroll
        for (int q = 0; q < NQ; ++q) {
          S2[2 * q] = S2[2 * q] * float2v{cw[q].x, cw[q].y} + (sav * float2v{ca[q].x, ca[q].y} + viv * float2v{cd[q].x, cd[q].y});
          S2[2 * q + 1] = S2[2 * q + 1] * float2v{cw[q].z, cw[q].w} + (sav * float2v{ca[q].z, ca[q].w} + viv * float2v{cd[q].z, cd[q].w});
        }
        float2v y2 = S2[0] * float2v{cr[0].x, cr[0].y};
        y2 = S2[1] * float2v{cr[0].z, cr[0].w} + y2;
        if constexpr (NQ == 2) {
          y2 = S2[2] * float2v{cr[1].x, cr[1].y} + y2;
          y2 = S2[3] * float2v{cr[1].z, cr[1].w} + y2;
        }
        const float yv = LPR == 16 ? red16_sum(y2.x + y2.y) : red8_sum(y2.x + y2.y);
        if (si < LPR) yk0 = (jq == si) ? yv : yk0;
        else yk1 = (jq == si - LPR) ? yv : yk1;
        if (si + 1 < 16) {
#pragma unroll
          for (int q = 0; q < NQ; ++q) { cw[q] = xw[q]; cn[q] = xn[q]; ca[q] = xa[q]; cd[q] = xd[q]; cr[q] = xr[q]; }
          cvi = xvi;
        }
      }
#undef SC_LD
      {
        const int tsa = d ? 15 - jq : jq;
        yp[(size_t)tsa * 384] = yk0;
        if constexpr (LPR == 8) {
          const int tsb = d ? 7 - jq : 8 + jq;
          yp[(size_t)tsb * 384] = yk1;
        }
      }
    }
    if (c + 1 < 272) SC_STAGE2(c + 1);
    if (c + 2 < 272) SC_STAGE1(c + 2);
    if (c + 3 < 272) SC_GLOAD1(c + 3);
    if (c + 2 < 272) SC_GLOAD2(c + 2);
    __syncthreads();
  }
  __builtin_amdgcn_s_setprio(0);
#undef SC_GLOAD1
#undef SC_GLOAD2
#undef SC_STAGE1
#undef SC_STAGE2
}

DEV void attn_item(const P& p, int item, char* smem) {
  const int tid = tid_l(), lane = tid & 63, wid = tid >> 6, l15 = lane & 15, quad = lane >> 4;
  bool lat = item < 1536;
  int b, hq, qb;
  if (lat) { b = item / 192; int rem = item % 192; hq = rem / 32; qb = rem % 32; }
  else { int i2 = item - 1536; b = i2 / 12; int rem = i2 % 12; hq = rem / 2; qb = rem % 2; }
  const int kvh = hq / 3;
  const int qrow0 = lat ? MC + b * 4096 + qb * 128 : b * 256 + qb * 128;
  const int nkt = lat ? 68 : 4;
  const float LOG2E = 1.4426950408889634f;

  bf16x8 qf[2][2];
#pragma unroll
  for (int mi = 0; mi < 2; ++mi)
#pragma unroll
    for (int ks = 0; ks < 2; ++ks)
      qf[mi][ks] = *(const bf16x8*)(p.z + (size_t)(qrow0 + wid * 32 + mi * 16 + l15) * INC + 1920 + hq * 64 + ks * 32 + quad * 8);

  f32x4 Ot[2][4];
  float mrow[2], lpart[2];
#pragma unroll
  for (int mi = 0; mi < 2; ++mi) {
#pragma unroll
    for (int nd = 0; nd < 4; ++nd) Ot[mi][nd] = f32x4{0.f, 0.f, 0.f, 0.f};
    mrow[mi] = -1e30f;
    lpart[mi] = 0.f;
  }
  const int lrow = tid >> 3, lch = tid & 7;
  uint4 rk0, rk1, rv0, rv1;
#define ATT_GLOAD(KT)                                                                         \
  {                                                                                           \
    const int kt_ = (KT);                                                                     \
    const u16* kp;                                                                            \
    const u16* vp;                                                                            \
    int vstride;                                                                              \
    if (lat && kt_ < 64) {                                                                    \
      kp = p.z + (size_t)(MC + b * 4096 + kt_ * 64) * INC + 2304 + kvh * 64;                  \
      vp = p.vTl + (size_t)((b * 2 + kvh) * 64) * SEQ + kt_ * 64;                             \
      vstride = SEQ;                                                                          \
    } else {                                                                                  \
      const int kc = lat ? kt_ - 64 : kt_;                                                    \
      kp = p.z + (size_t)(b * 256 + kc * 64) * INC + 2304 + kvh * 64;                         \
      vp = p.vTc + (size_t)((b * 2 + kvh) * 64) * CTXL + kc * 64;                             \
      vstride = CTXL;                                                                         \
    }                                                                                         \
    rk0 = *(const uint4*)(kp + (size_t)(lrow)*INC + lch * 8);                                 \
    rk1 = *(const uint4*)(kp + (size_t)(lrow + 32) * INC + lch * 8);                          \
    rv0 = *(const uint4*)(vp + (size_t)(lrow)*vstride + lch * 8);                             \
    rv1 = *(const uint4*)(vp + (size_t)(lrow + 32) * vstride + lch * 8);                      \
  }
#define ATT_LSTORE(BUF)                                     \
  {                                                         \
    char* Kb_ = smem + (BUF)*16384;                         \
    *(uint4*)(Kb_ + swz(lrow, lch)) = rk0;                  \
    *(uint4*)(Kb_ + swz(lrow + 32, lch)) = rk1;             \
    *(uint4*)(Kb_ + 8192 + swz(lrow, lch)) = rv0;           \
    *(uint4*)(Kb_ + 8192 + swz(lrow + 32, lch)) = rv1;      \
  }
  ATT_GLOAD(0);
  ATT_LSTORE(0);
  __syncthreads();
  for (int kt = 0; kt < nkt; ++kt) {
    const int buf = kt & 1;
    if (kt + 1 < nkt) ATT_GLOAD(kt + 1);
    const char* Kb = smem + buf * 16384;
    const char* Vb = Kb + 8192;
    f32x4 St[2][4];
#pragma unroll
    for (int mi = 0; mi < 2; ++mi)
#pragma unroll
      for (int ni = 0; ni < 4; ++ni) St[mi][ni] = f32x4{0.f, 0.f, 0.f, 0.f};
#pragma unroll
    for (int ks = 0; ks < 2; ++ks) {
      bf16x8 kf[4];
#pragma unroll
      for (int ni = 0; ni < 4; ++ni) kf[ni] = *(const bf16x8*)(Kb + swz(ni * 16 + l15, ks * 4 + quad));
#pragma unroll
      for (int mi = 0; mi < 2; ++mi)
#pragma unroll
        for (int ni = 0; ni < 4; ++ni) St[mi][ni] = mfma16(kf[ni], qf[mi][ks], St[mi][ni]);
    }
    bf16x8 pf[2][2];
#pragma unroll
    for (int mi = 0; mi < 2; ++mi) {
      float mx = St[mi][0][0];
#pragma unroll
      for (int ni = 0; ni < 4; ++ni)
#pragma unroll
        for (int jj = 0; jj < 4; ++jj) mx = fmaxf(mx, St[mi][ni][jj]);
      mx = fmaxf(mx, __shfl_xor(mx, 16));
      mx = fmaxf(mx, __shfl_xor(mx, 32));
      const float mnew = fmaxf(mrow[mi], mx);
      const float alpha = __builtin_amdgcn_exp2f((mrow[mi] - mnew) * LOG2E);
      mrow[mi] = mnew;
      const float mb = mnew * LOG2E;
      float ps = 0.f;
      float pv[4][4];
#pragma unroll
      for (int ni = 0; ni < 4; ++ni)
#pragma unroll
        for (int jj = 0; jj < 4; ++jj) {
          pv[ni][jj] = __builtin_amdgcn_exp2f(St[mi][ni][jj] * LOG2E - mb);
          ps += pv[ni][jj];
        }
      lpart[mi] = lpart[mi] * alpha + ps;
#pragma unroll
      for (int nd = 0; nd < 4; ++nd) {
        Ot[mi][nd][0] *= alpha; Ot[mi][nd][1] *= alpha; Ot[mi][nd][2] *= alpha; Ot[mi][nd][3] *= alpha;
      }
#pragma unroll
      for (int s2 = 0; s2 < 2; ++s2) {
        union { unsigned u[4]; bf16x8 v; } pk;
        pk.u[0] = pk2(pv[2 * s2][0], pv[2 * s2][1]);
        pk.u[1] = pk2(pv[2 * s2][2], pv[2 * s2][3]);
        pk.u[2] = pk2(pv[2 * s2 + 1][0], pv[2 * s2 + 1][1]);
        pk.u[3] = pk2(pv[2 * s2 + 1][2], pv[2 * s2 + 1][3]);
        pf[mi][s2] = pk.v;
      }
    }
#pragma unroll
    for (int s2 = 0; s2 < 2; ++s2) {
      bf16x8 vf[4];
#pragma unroll
      for (int nd = 0; nd < 4; ++nd) {
        const int drow = nd * 16 + l15;
        union { uint2 h[2]; bf16x8 v; } vv;
        vv.h[0] = *(const uint2*)(Vb + swz(drow, 4 * s2 + (quad >> 1)) + (quad & 1) * 8);
        vv.h[1] = *(const uint2*)(Vb + swz(drow, 4 * s2 + 2 + (quad >> 1)) + (quad & 1) * 8);
        vf[nd] = vv.v;
      }
#pragma unroll
      for (int mi = 0; mi < 2; ++mi)
#pragma unroll
        for (int nd = 0; nd < 4; ++nd) Ot[mi][nd] = mfma16(vf[nd], pf[mi][s2], Ot[mi][nd]);
    }
    if (kt + 1 < nkt) ATT_LSTORE(buf ^ 1);
    __syncthreads();
  }
#undef ATT_GLOAD
#undef ATT_LSTORE
#pragma unroll
  for (int mi = 0; mi < 2; ++mi) {
    float lsum = lpart[mi];
    lsum += __shfl_xor(lsum, 16);
    lsum += __shfl_xor(lsum, 32);
    const float inv = 1.f / lsum;
    const int r = qrow0 + wid * 32 + mi * 16 + l15;
#pragma unroll
    for (int nd = 0; nd < 4; ++nd)
      *(uint2*)(p.act + (size_t)r * DM + 640 + hq * 64 + nd * 16 + quad * 4) =
          make_uint2(pk2(Ot[mi][nd][0] * inv, Ot[mi][nd][1] * inv), pk2(Ot[mi][nd][2] * inv, Ot[mi][nd][3] * inv));
  }
}

DEV void sgate_item(const P& p, int l, int ck, int g, char* smem) {
  const int tid = tid_l(), lane = tid & 63, wid = tid >> 6, l15 = lane & 15, quad = lane >> 4;
  const int m0 = ck * 128;
  u16* sVT = (u16*)smem;
  {
    const int q = tid >> 1, half = tid & 1;
    const u16* src = p.z + (size_t)(m0 + q) * INC + 1408 + 256 + g * 64 + half * 32;
    float v[32];
    float ss = 0.f;
#pragma unroll
    for (int cidx = 0; cidx < 4; ++cidx) {
      uint4 u = *(const uint4*)(src + cidx * 8);
      unsigned uu[4] = {u.x, u.y, u.z, u.w};
#pragma unroll
      for (int e = 0; e < 4; ++e) {
        float f0 = geluf_(bf2f((u16)(uu[e] & 0xffff)));
        float f1 = geluf_(bf2f((u16)(uu[e] >> 16)));
        v[cidx * 8 + e * 2] = f0;
        v[cidx * 8 + e * 2 + 1] = f1;
        ss += f0 * f0 + f1 * f1;
      }
    }
    ss += __shfl_xor(ss, 1);
    const float rstd = rsqrtf(ss * (1.f / 64.f) + 1e-6f);
    const float* gn = p.sgn + l * 256 + g * 64 + half * 32;
#pragma unroll
    for (int e = 0; e < 32; ++e) sVT[(half * 32 + e) * 136 + q] = f2bf(v[e] * rstd * gn[e]);
  }
  __syncthreads();
  f32x4 acc[2][4];
#pragma unroll
  for (int mi = 0; mi < 2; ++mi)
#pragma unroll
    for (int ni = 0; ni < 4; ++ni) acc[mi][ni] = f32x4{0.f, 0.f, 0.f, 0.f};
  const u16* Wg = p.sgW + (size_t)(l * 4 + g) * 128 * 128;
#pragma unroll
  for (int ks = 0; ks < 4; ++ks) {
    bf16x8 a[2], bb[4];
#pragma unroll
    for (int mi = 0; mi < 2; ++mi) a[mi] = *(const bf16x8*)(Wg + (size_t)(wid * 32 + mi * 16 + l15) * 128 + ks * 32 + quad * 8);
#pragma unroll
    for (int ni = 0; ni < 4; ++ni) bb[ni] = *(const bf16x8*)(sVT + (ni * 16 + l15) * 136 + ks * 32 + quad * 8);
#pragma unroll
    for (int mi = 0; mi < 2; ++mi)
#pragma unroll
      for (int ni = 0; ni < 4; ++ni) acc[mi][ni] = mfma16(a[mi], bb[ni], acc[mi][ni]);
  }
#pragma unroll
  for (int mi = 0; mi < 2; ++mi)
#pragma unroll
    for (int j = 0; j < 4; ++j) {
      const int pr = wid * 32 + mi * 16 + quad * 4 + j;
      const float bias = p.sg_b[(size_t)(l * 4 + g) * 128 + pr];
#pragma unroll
      for (int ni = 0; ni < 4; ++ni) {
        const int c = ni * 16 + l15;
        float u = geluf_(bf2f(p.z[(size_t)(m0 + pr) * INC + 1408 + g * 64 + c]));
        p.act[(size_t)(m0 + pr) * DM + 384 + g * 64 + c] = f2bf(u * (acc[mi][ni][j] + bias));
      }
    }
  __syncthreads();
}

DEV void mix_phase(const P& p, int l, char* smem, int cidx) {
  __shared__ int s_item;
  const bool last = (l == DEPTH - 1);
  const int n_attn = last ? 1536 : 1632;
  const int ck_lo = last ? 16 : 0;
  const int n_sg = (NMT - ck_lo) * 4;
  const int total = SCAN_ITEMS + n_attn + n_sg;
  const int bid = bid_l();
  bool first = bid < SCAN_ITEMS;
  for (;;) {
    int it;
    if (first) {
      it = bid;
      first = false;
    } else {
      if (tid_l() == 0) s_item = SCAN_ITEMS + atomicAdd(p.cnt + cidx, 1);
      __syncthreads();
      it = s_item;
      __syncthreads();
    }
    if (it >= total) break;
    if (it < SCAN_ITEMS) {
      int nr = SCAN_REP; asm volatile("" : "+s"(nr));
      for (int rr = 0; rr < nr; ++rr) scan_item(p, l, it, smem);
    } else if (it < SCAN_ITEMS + n_attn) {
      int nr = ATT_REP; asm volatile("" : "+s"(nr));
      for (int rr = 0; rr < nr; ++rr) { attn_item(p, it - SCAN_ITEMS, smem); __syncthreads(); }
    } else {
      int i2 = it - SCAN_ITEMS - n_attn;
      int nr = SG_REP; asm volatile("" : "+s"(nr));
      for (int rr = 0; rr < nr; ++rr) sgate_item(p, l, ck_lo + (i2 >> 2), i2 & 3, smem);
    }
  }
}

DEV void apost_phase(const P& p, int l, int mt_lo, char* smem) {
  const int tid = tid_l(), lane = tid & 63, wid = tid >> 6, l15 = lane & 15, quad = lane >> 4;
  const int nit = (NMT - mt_lo) * 6;
  for (int it = bid_l(); it < nit; it += gridDim.x) {
    const int mt = mt_lo + it / 6;
    const int hh = it % 6;
    const int m0 = mt * 128;
    bf16x8 a[2][4];
#pragma unroll
    for (int mi = 0; mi < 2; ++mi)
#pragma unroll
      for (int ks = 0; ks < 4; ++ks)
        a[mi][ks] = *(const bf16x8*)(p.z + (size_t)(m0 + wid * 32 + mi * 16 + l15) * INC + 1280 + ks * 32 + quad * 8);
    {
      f32x4 acc[2][4];
#pragma unroll
      for (int mi = 0; mi < 2; ++mi)
#pragma unroll
        for (int ni = 0; ni < 4; ++ni) acc[mi][ni] = f32x4{0.f, 0.f, 0.f, 0.f};
#pragma unroll
      for (int ks = 0; ks < 4; ++ks) {
        bf16x8 bb[4];
#pragma unroll
        for (int ni = 0; ni < 4; ++ni)
          bb[ni] = *(const bf16x8*)(p.gUpT + ((size_t)l * 384 + hh * 64 + ni * 16 + l15) * 128 + ks * 32 + quad * 8);
#pragma unroll
        for (int mi = 0; mi < 2; ++mi)
#pragma unroll
          for (int ni = 0; ni < 4; ++ni) acc[mi][ni] = mfma16(a[mi][ks], bb[ni], acc[mi][ni]);
      }
      float lg[4], lb[4];
#pragma unroll
      for (int ni = 0; ni < 4; ++ni) {
        const int c = hh * 64 + ni * 16 + l15;
        lg[ni] = p.ln_g[l * 384 + c];
        lb[ni] = p.ln_b[l * 384 + c];
      }
#pragma unroll
      for (int mi = 0; mi < 2; ++mi)
#pragma unroll
        for (int j = 0; j < 4; ++j) {
          const int r = m0 + wid * 32 + mi * 16 + quad * 4 + j;
          float ys[4], vv[4];
          float sm = 0.f;
#pragma unroll
          for (int ni = 0; ni < 4; ++ni) {
            const int c = hh * 64 + ni * 16 + l15;
            ys[ni] = p.y[(size_t)r * 384 + c] + p.y[((size_t)MT + r) * 384 + c];
            vv[ni] = bf2f(p.z[(size_t)r * INC + 768 + c]);
            sm += ys[ni];
          }
          const float4 bq0 = *(const float4*)(p.bonus + (size_t)r * 48 + hh * 4);
          const float4 bq1 = *(const float4*)(p.bonus + (size_t)r * 48 + (6 + hh) * 4);
          const float bon = (bq0.x + bq0.y) + (bq0.z + bq0.w) + (bq1.x + bq1.y) + (bq1.z + bq1.w);
          sm = red16_sum(sm);
          const float mean = sm * (1.f / 64.f);
          float vs = 0.f;
#pragma unroll
          for (int ni = 0; ni < 4; ++ni) { ys[ni] -= mean; vs += ys[ni] * ys[ni]; }
          vs = red16_sum(vs);
          const float rstd = rsqrtf(vs * (1.f / 64.f) + 64e-5f);
#pragma unroll
          for (int ni = 0; ni < 4; ++ni) {
            const int c = hh * 64 + ni * 16 + l15;
            float o = (ys[ni] * rstd * lg[ni] + lb[ni] + bon * vv[ni]) * acc[mi][ni][j];
            p.act[(size_t)r * DM + c] = f2bf(o);
          }
          __builtin_amdgcn_sched_barrier(0);
        }
    }
  }
}

DEV uint2 ld8(const u16* q) { return *(const uint2*)q; }
DEV void up4(const uint2 u, float (&f)[4]) {
  f[0] = __uint_as_float(u.x << 16); f[1] = __uint_as_float(u.x & 0xffff0000u);
  f[2] = __uint_as_float(u.y << 16); f[3] = __uint_as_float(u.y & 0xffff0000u);
}
DEV void prep_phase(const P& p, int l, cg::grid_group& grid) {
  const int tid = tid_l(), lane = tid & 63, l15 = lane & 15;
  const int nb = gridDim.x, bid = bid_l();
  constexpr int NR = 8;
  const int rpb = (((MT + nb - 1) / nb) + NR - 1) & ~(NR - 1);
  const int ra = bid * rpb;
  const int rb = min(ra + rpb, MT);
  const bool active = ra < MT;
  const bool has1 = tid < 96;
  const int col0 = tid * 4, col1 = 1024 + tid * 4;
  uint2 hp0 = make_uint2(0, 0), hn0 = hp0, hp1 = hp0, hn1 = hp0;
  if (active) {
    if (ra > 0) { hp0 = ld8(p.z + (size_t)(ra - 1) * INC + col0); if (has1) hp1 = ld8(p.z + (size_t)(ra - 1) * INC + col1); }
    if (rb < MT) { hn0 = ld8(p.z + (size_t)rb * INC + col0); if (has1) hn1 = ld8(p.z + (size_t)rb * INC + col1); }
  }
  grid.sync();
  if (!active) return;
  const float* cw = p.conv + (size_t)l * 3 * 1408;
#pragma unroll 1
  for (int pass = 0; pass < 2; ++pass) {
    if (pass == 1 && !has1) break;
    const int col = pass ? col1 : col0;
    const int typ = col < 1152 ? 0 : (col < 1216 ? 1 : (col < 1280 ? 0 : 2));
    const bool isk = col >= 384 && col < 768;
    float c0[4], c1[4], c2[4], kk4[4];
#pragma unroll
    for (int e = 0; e < 4; ++e) {
      c0[e] = cw[col + e]; c1[e] = cw[1408 + col + e]; c2[e] = cw[2816 + col + e];
      kk4[e] = isk ? p.k_k[l * 384 + (col - 384) + e] : 0.f;
    }
    const int hh = isk ? (col - 384) >> 6 : 0;
    u16* zc = p.z + col;
    uint2 prev = pass ? hp1 : hp0;
    const uint2 halo_n = pass ? hn1 : hn0;
    uint2 cur = ld8(zc + (size_t)ra * INC);
    for (int r = ra; r < rb; r += NR) {
      uint2 w[NR + 2];
      w[0] = prev;
      w[1] = cur;
#pragma unroll
      for (int q = 0; q < NR; ++q) {
        const int rr = r + 1 + q;
        w[q + 2] = rr < rb ? ld8(zc + (size_t)rr * INC) : halo_n;
      }
#pragma unroll
      for (int q = 0; q < NR; ++q) {
        const int rr = r + q;
        const uint2 xp = w[q], xc = w[q + 1], xn = w[q + 2];
        const int tt = rr < MC ? (rr & 255) : ((rr - MC) & 4095);
        const int len = rr < MC ? 256 : 4096;
        const float mp = tt > 0 ? 1.f : 0.f, mn = tt < len - 1 ? 1.f : 0.f;
        float fp[4], fc[4], fn[4], o[4];
        up4(xp, fp); up4(xc, fc); up4(xn, fn);
#pragma unroll
        for (int e = 0; e < 4; ++e) {
          float v = fc[e] * c1[e] + mp * (fp[e] * c0[e]) + mn * (fn[e] * c2[e]);
          if (typ == 1) v = tanh_fast(v);
          else if (typ == 2) v = sigmoidf_(v);
          o[e] = v;
        }
        if (isk) {
          float q0 = o[0] * kk4[0], q1 = o[1] * kk4[1], q2 = o[2] * kk4[2], q3 = o[3] * kk4[3];
          float ss = red16_sum(q0 * q0 + q1 * q1 + q2 * q2 + q3 * q3);
          if (l15 == 0 && rr < rb) p.invn[(size_t)rr * 8 + hh] = 1.f / fmaxf(sqrtf(ss), 1e-12f);
        }
        if (rr < rb) *(uint2*)(zc + (size_t)rr * INC) = make_uint2(pk2(o[0], o[1]), pk2(o[2], o[3]));
      }
      prev = w[NR];
      cur = w[NR + 1];
    }
  }
}

__global__ void __launch_bounds__(256, 2) fwd_megakernel(P p, int ph_lo, int ph_hi) {
  __shared__ __attribute__((aligned(16))) char smem[65536 - 64];
  cg::grid_group grid = cg::this_grid();
  for (int ph = ph_lo; ph < ph_hi; ++ph) {
    if (ph > ph_lo) grid.sync();
    if (ph == 0) {
      phase0(p, smem);
      if (PROBE_MASK & 256) { grid.sync(); phase0(p, smem); }
      if (PROBE_MASK & 1024) { for (int i = 0; i < 50; ++i) grid.sync(); }
      continue;
    }
    if (ph == 1 + 8 * DEPTH) { final_norm(p); continue; }
    const int l = (ph - 1) >> 3, sub = (ph - 1) & 7;
    const bool last = (l == DEPTH - 1);
    const int mt_lo = last ? 16 : 0;
    int nrep = ((PROBE_MASK >> sub) & 1) ? 2 : 1;
    asm volatile("" : "+s"(nrep));
    for (int rep = 0; rep < nrep; ++rep) {
      if (rep) grid.sync();
      const int dry = (rep + 1 < nrep && !(PROBE_MASK & 512)) ? 1 : 0;
      if (sub == 0 || sub == 5) {
        const bool n2 = sub == 5;
        norm_phase(p, l, (n2 ? p.n2g : p.n1g) + l * DM, n2 ? 3072 : 0, n2 ? 4096 : 1024, n2 ? mt_lo * 128 : 0, !n2 && l == 0);
      } else if (sub == 1) {
        gemm_phase<EPI_Z>(p, l, p.act, DM, p.wIn + (size_t)l * 2560 * 1024, 1024, 20, 0, 0, smem, dry);
      } else if (sub == 2) {
        if (rep == 0) { prep_phase(p, l, grid); grid.sync(); }
        mix_phase(p, l, smem, l + 8 * rep);
      } else if (sub == 3) {
        apost_phase(p, l, mt_lo, smem);
      } else if (sub == 4 || sub == 7) {
        const bool g4 = sub == 7;
        gemm_phase<EPI_RES>(p, l, g4 ? p.h : p.act, g4 ? DFF : DM,
                            g4 ? p.w2t + (size_t)l * 1024 * 2816 : p.wOut + (size_t)l * 1024 * 1024, g4 ? 2816 : 1024, 8, mt_lo,
                            g4 ? 5120 : 2048, smem, dry);
      } else {
        gemm_phase<EPI_SWIGLU>(p, l, p.act, DM, p.w1t + (size_t)l * 5632 * 1024, 1024, 44, mt_lo, 0, smem, dry);
      }
    }
  }
}

extern "C" void kernel_launch(void* const* d_in, const int* in_sizes, int n_in, void* d_out, int out_size, void* d_ws,
                              size_t ws_size, hipStream_t stream) {
  static int grid_blocks = 0;
  if (!grid_blocks) {
    int dev = 0, cus = 0, per_cu = 0;
    hipGetDevice(&dev);
    hipDeviceGetAttribute(&cus, hipDeviceAttributeMultiprocessorCount, dev);
    hipOccupancyMaxActiveBlocksPerMultiprocessor(&per_cu, fwd_megakernel, 256, 0);
    if (per_cu > 2) per_cu = 2;
    if (per_cu < 1) per_cu = 1;
    grid_blocks = cus * per_cu;
  }
  P p{};
  const float* const* in = (const float* const*)d_in;
  p.x = in[0]; p.c = in[1]; p.ctx = in[2]; p.c_ctx = in[3]; p.n1g = in[4]; p.n2g = in[5]; p.ada_w = in[6]; p.ada_b = in[7];
  p.w_in = in[8]; p.conv = in[9]; p.w0 = in[10]; p.w_up = in[11]; p.a0 = in[12]; p.a_up = in[13]; p.g_up = in[14];
  p.k_k = in[15]; p.k_a = in[16]; p.r_k = in[17]; p.ln_g = in[18]; p.ln_b = in[19]; p.sgn = in[20]; p.sg_w = in[21];
  p.sg_b = in[22]; p.q_g = in[23]; p.k_g = in[24]; p.w_out = in[25]; p.w1 = in[26]; p.w2 = in[27]; p.fng = in[28];
  p.out = (float*)d_out;
  char* ws = (char*)d_ws;
  size_t off = 0;
  auto take = [&](size_t bytes) { char* r = ws + off; off += (bytes + 255) & ~(size_t)255; return r; };
  p.wIn = (u16*)take((size_t)4 * 2560 * 1024 * 2);
  p.wOut = (u16*)take((size_t)4 * 1024 * 1024 * 2);
  p.w1t = (u16*)take((size_t)4 * 5632 * 1024 * 2);
  p.w2t = (u16*)take((size_t)4 * 1024 * 2816 * 2);
  p.wUpT = (u16*)take((size_t)8 * 384 * 64 * 2);
  p.aUpT = (u16*)take((size_t)8 * 384 * 64 * 2);
  p.gUpT = (u16*)take((size_t)4 * 384 * 128 * 2);
  p.sgW = (u16*)take((size_t)16 * 128 * 128 * 2);
  p.mods = (float*)take((size_t)4 * 9 * 6144 * 4);
  p.rope = (float*)take(2048 * 4);
  p.cnt = (int*)take(256);
  p.xc = (float*)take((size_t)MC * DM * 4);
  p.act = (u16*)take((size_t)MT * DM * 2);
  p.z = (u16*)take((size_t)MT * DFF * 2);
  p.h = p.z;
  p.vTl = (u16*)take((size_t)16 * 64 * SEQ * 2);
  p.vTc = (u16*)take((size_t)16 * 64 * CTXL * 2);
  p.y = (float*)take((size_t)2 * MT * 384 * 4);
  p.bonus = (float*)take((size_t)MT * 48 * 4);
  p.invn = (float*)take((size_t)MT * 8 * 4);
  if (off > ws_size) { fprintf(stderr, "workspace too small: need %zu have %zu\n", off, ws_size); return; }
  int ph_lo = 0, ph_hi = 2 + 8 * DEPTH;
  void* args[] = {&p, &ph_lo, &ph_hi};
  hipError_t e = hipLaunchCooperativeKernel((void*)fwd_megakernel, dim3(grid_blocks), dim3(256), args, 0, stream);
  if (e != hipSuccess) fprintf(stderr, "cooperative launch failed: %s (grid %d)\n", hipGetErrorString(e), grid_blocks);
}
```

```cpp
#include <hip/hip_runtime.h>
#include <hip/hip_bf16.h>
#include <hip/hip_cooperative_groups.h>
#include <cstdio>
namespace cg = cooperative_groups;

typedef __attribute__((ext_vector_type(8))) short bf16x8;
typedef __attribute__((ext_vector_type(4))) float f32x4;
typedef unsigned short u16;
typedef __attribute__((ext_vector_type(2))) float float2v;

#define DEV __device__ __forceinline__
DEV int tid_l() { int t = threadIdx.x; asm volatile("" : "+v"(t)); return t; }
DEV int bid_l() { int b = blockIdx.x; asm volatile("" : "+s"(b)); return b; }

constexpr int DM = 1024, NBATCH = 8, SEQ = 4096, DEPTH = 4, CTXL = 256;
constexpr int MC = NBATCH * CTXL;
constexpr int ML = NBATCH * SEQ;
constexpr int MT = MC + ML;
constexpr int INC = 2560, DFF = 2816;
constexpr int NMT = MT / 128;
#ifndef PROBE_MASK
#define PROBE_MASK 0
#endif
#define SCAN_REP 1
#define ATT_REP 1
#define SG_REP 1

struct P {
  const float *x, *c, *ctx, *c_ctx, *n1g, *n2g, *ada_w, *ada_b, *w_in, *conv, *w0, *w_up, *a0, *a_up, *g_up,
      *k_k, *k_a, *r_k, *ln_g, *ln_b, *sgn, *sg_w, *sg_b, *q_g, *k_g, *w_out, *w1, *w2, *fng;
  float* out;
  u16 *wIn, *wOut, *w1t, *w2t, *wUpT, *aUpT, *gUpT, *sgW;
  float *mods, *rope;
  int* cnt;
  float* xc;
  u16 *act, *z, *h, *vTl, *vTc;
  float *y, *bonus, *invn;
};

typedef __attribute__((ext_vector_type(2))) __bf16 bf16x2v;
typedef __attribute__((ext_vector_type(2))) float f32x2v;
DEV unsigned pk2(float a, float b) {
  f32x2v v = {a, b};
  bf16x2v r = __builtin_convertvector(v, bf16x2v);
  return *(unsigned*)&r;
}
DEV u16 f2bf(float f) { return (u16)(pk2(f, 0.f) & 0xffffu); }
DEV float bf2f(u16 h) { return __uint_as_float(((unsigned)h) << 16); }
DEV float sigmoidf_(float x) { return __builtin_amdgcn_rcpf(1.f + __expf(-x)); }
DEV float siluf_(float x) { return x * __builtin_amdgcn_rcpf(1.f + __expf(-x)); }
DEV float geluf_(float x) {
  float u = 0.7978845608028654f * (x + 0.044715f * x * x * x);
  return 0.5f * x * (1.f + tanhf(u));
}
DEV int swz(int r, int ch) { return r * 128 + ((ch ^ ((r >> 1) & 7)) << 4); }

template <int CTRL>
DEV float dppf(float v) {
  return __int_as_float(__builtin_amdgcn_update_dpp(0, __float_as_int(v), CTRL, 0xF, 0xF, false));
}
DEV float red16_sum(float v) {
  v += dppf<0xB1>(v);
  v += dppf<0x4E>(v);
  v += dppf<0x141>(v);
  v += dppf<0x140>(v);
  return v;
}
DEV float red16_max(float v) {
  v = fmaxf(v, dppf<0xB1>(v));
  v = fmaxf(v, dppf<0x4E>(v));
  v = fmaxf(v, dppf<0x141>(v));
  v = fmaxf(v, dppf<0x140>(v));
  return v;
}
DEV float wave_sum(float v) {
#pragma unroll
  for (int o = 32; o >= 1; o >>= 1) v += __shfl_xor(v, o);
  return v;
}
DEV f32x4 mfma16(bf16x8 a, bf16x8 b, f32x4 c) { return __builtin_amdgcn_mfma_f32_16x16x32_bf16(a, b, c, 0, 0, 0); }

DEV void tr_tile(const float* __restrict__ src, u16* __restrict__ dst, int K, int N, int kt, int nt, bool il, float* lds) {
  const int tid = tid_l();
  const int k0 = kt * 64, n0 = nt * 64;
  {
    const int c = tid & 63, r0 = tid >> 6;
#pragma unroll 4
    for (int i = 0; i < 16; ++i) {
      int r = r0 + i * 4;
      lds[r * 65 + c] = src[(size_t)(k0 + r) * N + n0 + c];
    }
  }
  __syncthreads();
  {
    const int k = tid & 63, nn0 = tid >> 6;
#pragma unroll 4
    for (int i = 0; i < 16; ++i) {
      int n = nn0 + i * 4;
      int gn = n0 + n;
      int np = gn;
      if (il) {
        int j = gn < DFF ? gn : gn - DFF;
        np = (j >> 4) * 32 + (j & 15) + (gn < DFF ? 0 : 16);
      }
      dst[(size_t)np * K + k0 + k] = f2bf(lds[k * 65 + n]);
    }
  }
  __syncthreads();
}

DEV void phase0(const P& p, char* smem) {
  float* lds = (float*)smem;
  const int tid = tid_l();
  constexpr int C0 = 2560, C1 = C0 + 1024, C2 = C1 + 5632, C3 = C2 + 2816, C4 = C3 + 48, C5 = C4 + 48, C6 = C5 + 48,
                C7 = C6 + 64, C8 = C7 + 384, C9 = C8 + 1;
  for (int it = bid_l(); it < C9; it += gridDim.x) {
    if (it < C6) {
      const float* src; u16* dst; int K, N, kt, nt; bool il = false;
      if (it < C0) {
        int l = it / 640, r = it % 640;
        src = p.w_in + (size_t)l * 1024 * 2560; dst = p.wIn + (size_t)l * 2560 * 1024; K = 1024; N = 2560; kt = r / 40; nt = r % 40;
      } else if (it < C1) {
        int i2 = it - C0, l = i2 / 256, r = i2 % 256;
        src = p.w_out + (size_t)l * 1024 * 1024; dst = p.wOut + (size_t)l * 1024 * 1024; K = 1024; N = 1024; kt = r / 16; nt = r % 16;
      } else if (it < C2) {
        int i2 = it - C1, l = i2 / 1408, r = i2 % 1408;
        src = p.w1 + (size_t)l * 1024 * 5632; dst = p.w1t + (size_t)l * 5632 * 1024; K = 1024; N = 5632; kt = r / 88; nt = r % 88; il = true;
      } else if (it < C3) {
        int i2 = it - C2, l = i2 / 704, r = i2 % 704;
        src = p.w2 + (size_t)l * 2816 * 1024; dst = p.w2t + (size_t)l * 1024 * 2816; K = 2816; N = 1024; kt = r / 16; nt = r % 16;
      } else if (it < C4) {
        int i2 = it - C3, bb = i2 / 6;
        src = p.w_up + (size_t)bb * 64 * 384; dst = p.wUpT + (size_t)bb * 384 * 64; K = 64; N = 384; kt = 0; nt = i2 % 6;
      } else if (it < C5) {
        int i2 = it - C4, bb = i2 / 6;
        src = p.a_up + (size_t)bb * 64 * 384; dst = p.aUpT + (size_t)bb * 384 * 64; K = 64; N = 384; kt = 0; nt = i2 % 6;
      } else {
        int i2 = it - C5, l = i2 / 12, r = i2 % 12;
        src = p.g_up + (size_t)l * 128 * 384; dst = p.gUpT + (size_t)l * 384 * 128; K = 128; N = 384; kt = r / 6; nt = r % 6;
      }
      tr_tile(src, dst, K, N, kt, nt, il, lds);
    } else if (it < C7) {
      int i2 = it - C6;
      for (int i = 0; i < 16; ++i) {
        int e = i2 * 4096 + i * 256 + tid;
        p.sgW[e] = f2bf(p.sg_w[e]);
      }
    } else if (it < C8) {
      int i2 = it - C7, l = i2 / 96, cb = i2 % 96;
      for (int e = tid; e < 9 * 1024; e += 256) {
        int s = e >> 10, k = e & 1023;
        float v = s < 8 ? p.c[s * 1024 + k] : p.c_ctx[k];
        lds[e] = siluf_(v);
      }
      __syncthreads();
      const int col = tid & 63, kq = tid >> 6;
      const int n = cb * 64 + col;
      float acc[9];
#pragma unroll
      for (int s = 0; s < 9; ++s) acc[s] = 0.f;
      const float* wp = p.ada_w + (size_t)l * 1024 * 6144 + n;
#pragma unroll 4
      for (int k = kq * 256; k < kq * 256 + 256; ++k) {
        float w = wp[(size_t)k * 6144];
#pragma unroll
        for (int s = 0; s < 9; ++s) acc[s] += lds[s * 1024 + k] * w;
      }
      __syncthreads();
      float* red = lds + 9216;
#pragma unroll
      for (int s = 0; s < 9; ++s) red[(kq * 9 + s) * 64 + col] = acc[s];
      __syncthreads();
      for (int e = tid; e < 9 * 64; e += 256) {
        int s = e >> 6, cc = e & 63;
        float v = red[(0 * 9 + s) * 64 + cc] + red[(1 * 9 + s) * 64 + cc] + red[(2 * 9 + s) * 64 + cc] + red[(3 * 9 + s) * 64 + cc];
        int nn = cb * 64 + cc;
        p.mods[((size_t)l * 9 + s) * 6144 + nn] = v + p.ada_b[l * 6144 + nn];
      }
      __syncthreads();
    } else {
      for (int e = tid; e < 1024; e += 256) {
        int pos = e >> 4, i = e & 15;
        float inv = powf(10000.f, -(float)i / 16.f);
        float ang = (float)pos * inv;
        p.rope[e * 2] = cosf(ang);
        p.rope[e * 2 + 1] = sinf(ang);
      }
      if (tid < 64) p.cnt[tid] = 0;
    }
  }
}

DEV void norm_phase(const P& p, int l, const float* __restrict__ g, int shoff, int scoff, int row_lo, bool from_input) {
  const int tid = tid_l();
  const int lane = tid & 63;
  const int gw = bid_l() * 4 + (tid >> 6), nw = gridDim.x * 4;
  const float* lat = from_input ? p.x : p.out;
  const float* cx = from_input ? p.ctx : p.xc;
  for (int r0 = row_lo + gw; r0 < MT; r0 += 4 * nw) {
    float4 v[4][4];
#pragma unroll
    for (int u = 0; u < 4; ++u) {
      const int r = r0 + u * nw;
      if (r < MT) {
        const float* src = r < MC ? cx + (size_t)r * DM : lat + (size_t)(r - MC) * DM;
#pragma unroll
        for (int i = 0; i < 4; ++i) v[u][i] = *(const float4*)(src + i * 256 + lane * 4);
      }
    }
#pragma unroll
    for (int u = 0; u < 4; ++u) {
      const int r = r0 + u * nw;
      if (r < MT) {
        const int s = r < MC ? 8 : (r - MC) >> 12;
        const float* md = p.mods + ((size_t)l * 9 + s) * 6144;
        float ss = 0.f;
#pragma unroll
        for (int i = 0; i < 4; ++i) ss += v[u][i].x * v[u][i].x + v[u][i].y * v[u][i].y + v[u][i].z * v[u][i].z + v[u][i].w * v[u][i].w;
        ss = wave_sum(ss);
        const float rstd = rsqrtf(ss * (1.f / DM) + 1e-6f);
#pragma unroll
        for (int i = 0; i < 4; ++i) {
          const int c = i * 256 + lane * 4;
          float4 gg = *(const float4*)(g + c);
          float4 sh = *(const float4*)(md + shoff + c);
          float4 sc = *(const float4*)(md + scoff + c);
          float o0 = v[u][i].x * rstd * gg.x * (1.f + sc.x) + sh.x;
          float o1 = v[u][i].y * rstd * gg.y * (1.f + sc.y) + sh.y;
          float o2 = v[u][i].z * rstd * gg.z * (1.f + sc.z) + sh.z;
          float o3 = v[u][i].w * rstd * gg.w * (1.f + sc.w) + sh.w;
          uint2 o;
          o.x = pk2(o0, o1);
          o.y = pk2(o2, o3);
          *(uint2*)(p.act + (size_t)r * DM + c) = o;
        }
      }
    }
  }
}

DEV void final_norm(const P& p) {
  const int tid = tid_l();
  const int lane = tid & 63;
  const int gw = bid_l() * 4 + (tid >> 6), nw = gridDim.x * 4;
  for (int r0 = gw; r0 < ML; r0 += 4 * nw) {
    float4 v[4][4];
#pragma unroll
    for (int u = 0; u < 4; ++u) {
      const int r = r0 + u * nw;
      if (r < ML) {
#pragma unroll
        for (int i = 0; i < 4; ++i) v[u][i] = *(const float4*)(p.out + (size_t)r * DM + i * 256 + lane * 4);
      }
    }
#pragma unroll
    for (int u = 0; u < 4; ++u) {
      const int r = r0 + u * nw;
      if (r < ML) {
        float ss = 0.f;
#pragma unroll
        for (int i = 0; i < 4; ++i) ss += v[u][i].x * v[u][i].x + v[u][i].y * v[u][i].y + v[u][i].z * v[u][i].z + v[u][i].w * v[u][i].w;
        ss = wave_sum(ss);
        const float rstd = rsqrtf(ss * (1.f / DM) + 1e-6f);
#pragma unroll
        for (int i = 0; i < 4; ++i) {
          const int c = i * 256 + lane * 4;
          float4 gg = *(const float4*)(p.fng + c);
          float4 o;
          o.x = v[u][i].x * rstd * gg.x;
          o.y = v[u][i].y * rstd * gg.y;
          o.z = v[u][i].z * rstd * gg.z;
          o.w = v[u][i].w * rstd * gg.w;
          *(float4*)(p.out + (size_t)r * DM + c) = o;
        }
      }
    }
  }
}

enum { EPI_Z = 0, EPI_RES = 1, EPI_SWIGLU = 2 };

template <int EPI>
DEV void gemm_phase(const P& p, int l, const u16* __restrict__ A, int lda, const u16* __restrict__ Bt, int K, int NT,
                           int mt_lo, int goff, char* smem, int dry = 0) {
  const int tid = tid_l(), lane = tid & 63, wid = tid >> 6, wr = wid >> 1, wc = wid & 1, l15 = lane & 15, quad = lane >> 4;
  const int nmt = NMT - mt_lo;
  const int nk = K / 64;
  const int npn = NT >> 2;
  const int npatch = (nmt >> 4) * npn;
  const int tmax = ((npatch + 7) >> 3) * 512;
#define G_MAP(T, OK, M0, N0)                                                                        \
  {                                                                                                 \
    const int xcd_ = (T)&7, sidx_ = (T) >> 3;                                                       \
    const int gp_ = (sidx_ >> 6) * 8 + xcd_;                                                        \
    OK = (T) < tmax && gp_ < npatch;                                                                \
    const int within_ = sidx_ & 63;                                                                 \
    M0 = (mt_lo + (gp_ / npn) * 16 + (within_ & 15)) * 128;                                         \
    N0 = ((gp_ % npn) * 4 + (within_ >> 4)) * 128;                                                  \
  }
  uint4 xa0, xa1, xa2, xa3, xb0, xb1, xb2, xb3, ya0, ya1, ya2, ya3, yb0, yb1, yb2, yb3;
  int t = bid_l();
  bool have;
  int m0, n0;
  G_MAP(t, have, m0, n0);
  const u16* Ag = A + (size_t)(m0 + (tid >> 3)) * lda + (tid & 7) * 8;
  const u16* Bg = Bt + (size_t)(n0 + (tid >> 3)) * K + (tid & 7) * 8;
  bool primed = false;
  while (have) {
    f32x4 acc[4][4];
#pragma unroll
    for (int i = 0; i < 4; ++i)
#pragma unroll
      for (int j = 0; j < 4; ++j) acc[i][j] = f32x4{0.f, 0.f, 0.f, 0.f};
#define G_GL(P, KT)                                                          \
    {                                                                        \
      const int k0_ = (KT)*64;                                               \
      P##a0 = *(const uint4*)(Ag + k0_);                                     \
      P##b0 = *(const uint4*)(Bg + k0_);                                     \
      P##a1 = *(const uint4*)(Ag + (size_t)32 * lda + k0_);                  \
      P##b1 = *(const uint4*)(Bg + (size_t)32 * K + k0_);                    \
      P##a2 = *(const uint4*)(Ag + (size_t)64 * lda + k0_);                  \
      P##b2 = *(const uint4*)(Bg + (size_t)64 * K + k0_);                    \
      P##a3 = *(const uint4*)(Ag + (size_t)96 * lda + k0_);                  \
      P##b3 = *(const uint4*)(Bg + (size_t)96 * K + k0_);                    \
    }
#define G_LS(P, BUF)                                                         \
    {                                                                        \
      char* Aw_ = smem + (BUF)*32768;                                        \
      *(uint4*)(Aw_ + swz((tid >> 3), tid & 7)) = P##a0;                     \
      *(uint4*)(Aw_ + 16384 + swz((tid >> 3), tid & 7)) = P##b0;             \
      *(uint4*)(Aw_ + swz((tid >> 3) + 32, tid & 7)) = P##a1;                \
      *(uint4*)(Aw_ + 16384 + swz((tid >> 3) + 32, tid & 7)) = P##b1;        \
      *(uint4*)(Aw_ + swz((tid >> 3) + 64, tid & 7)) = P##a2;                \
      *(uint4*)(Aw_ + 16384 + swz((tid >> 3) + 64, tid & 7)) = P##b2;        \
      *(uint4*)(Aw_ + swz((tid >> 3) + 96, tid & 7)) = P##a3;                \
      *(uint4*)(Aw_ + 16384 + swz((tid >> 3) + 96, tid & 7)) = P##b3;        \
    }
#define G_COMPUTE(BUF)                                                                                             \
    {                                                                                                              \
      const char* As = smem + (BUF)*32768;                                                                         \
      const char* Bs = As + 16384;                                                                                 \
      _Pragma("unroll") for (int kh = 0; kh < 2; ++kh) {                                                           \
        bf16x8 a[4], b[4];                                                                                         \
        _Pragma("unroll") for (int mi = 0; mi < 4; ++mi)                                                           \
            a[mi] = *(const bf16x8*)(As + swz(wr * 64 + mi * 16 + l15, kh * 4 + quad));                            \
        _Pragma("unroll") for (int ni = 0; ni < 4; ++ni)                                                           \
            b[ni] = *(const bf16x8*)(Bs + swz(wc * 64 + ni * 16 + l15, kh * 4 + quad));                            \
        _Pragma("unroll") for (int mi = 0; mi < 4; ++mi)                                                           \
            _Pragma("unroll") for (int ni = 0; ni < 4; ++ni) acc[mi][ni] = mfma16(b[ni], a[mi], acc[mi][ni]);      \
      }                                                                                                            \
    }
    if (!primed) {
      G_GL(x, 0);
      G_GL(y, 1);
    }
    G_LS(x, 0);
    if (2 < nk) G_GL(x, 2);
    __syncthreads();
    for (int kt = 0; kt < nk; kt += 2) {
      G_COMPUTE(0);
      G_LS(y, 1);
      if (kt + 3 < nk) G_GL(y, kt + 3);
      __syncthreads();
      G_COMPUTE(1);
      if (kt + 2 < nk) G_LS(x, 0);
      if (kt + 4 < nk) G_GL(x, kt + 4);
      __syncthreads();
    }
    const int em0 = m0, en0 = n0;
    t += gridDim.x;
    G_MAP(t, have, m0, n0);
    if (have) {
      Ag = A + (size_t)(m0 + (tid >> 3)) * lda + (tid & 7) * 8;
      Bg = Bt + (size_t)(n0 + (tid >> 3)) * K + (tid & 7) * 8;
      G_GL(x, 0);
      G_GL(y, 1);
      primed = true;
    }
    if (dry) {
      if (acc[0][0][0] == 1.2345e33f) p.bonus[0] = acc[1][1][1] + acc[2][2][2] + acc[3][3][3];
      continue;
    }
    const int cw0 = en0 + wc * 64;
    if constexpr (EPI == EPI_Z) {
      if (cw0 < 1920) {
#pragma unroll
        for (int mi = 0; mi < 4; ++mi) {
          const int r = em0 + wr * 64 + mi * 16 + l15;
#pragma unroll
          for (int ni = 0; ni < 4; ++ni)
            *(uint2*)(p.z + (size_t)r * INC + cw0 + ni * 16 + quad * 4) =
                make_uint2(pk2(acc[mi][ni][0], acc[mi][ni][1]), pk2(acc[mi][ni][2], acc[mi][ni][3]));
          __builtin_amdgcn_sched_barrier(0);
        }
      } else {
        const int hh = (cw0 - 1920) >> 6;
        if (hh < 8) {
          const float* gp = (hh < 6 ? p.q_g : p.k_g) + l * 64;
          float4 gv[4];
#pragma unroll
          for (int ni = 0; ni < 4; ++ni) gv[ni] = *(const float4*)(gp + ni * 16 + quad * 4);
          const float qs = hh < 6 ? 0.125f : 1.f;
#pragma unroll
          for (int mi = 0; mi < 4; ++mi) {
            const int r = em0 + wr * 64 + mi * 16 + l15;
            float ss = 0.f;
#pragma unroll
            for (int ni = 0; ni < 4; ++ni)
#pragma unroll
              for (int j = 0; j < 4; ++j) ss += acc[mi][ni][j] * acc[mi][ni][j];
            ss += __shfl_xor(ss, 16);
            ss += __shfl_xor(ss, 32);
            const float rstd = rsqrtf(ss * (1.f / 64.f) + 1e-6f) ;
            float yv[4][4];
#pragma unroll
            for (int ni = 0; ni < 4; ++ni) {
              yv[ni][0] = acc[mi][ni][0] * rstd * gv[ni].x;
              yv[ni][1] = acc[mi][ni][1] * rstd * gv[ni].y;
              yv[ni][2] = acc[mi][ni][2] * rstd * gv[ni].z;
              yv[ni][3] = acc[mi][ni][3] * rstd * gv[ni].w;
            }
            if (r >= MC) {
              const int tt = (r - MC) & 4095;
              const int prow = tt >> 6, pcol = tt & 63;
              const float* rr_ = p.rope + (prow * 16 + quad * 4) * 2;
              const float* rc_ = p.rope + (pcol * 16 + quad * 4) * 2;
              const float4 ra = *(const float4*)rr_, rb = *(const float4*)(rr_ + 4);
              const float4 ca = *(const float4*)rc_, cb = *(const float4*)(rc_ + 4);
              const float cr[4] = {ra.x, ra.z, rb.x, rb.z}, sr[4] = {ra.y, ra.w, rb.y, rb.w};
              const float cc[4] = {ca.x, ca.z, cb.x, cb.z}, sc[4] = {ca.y, ca.w, cb.y, cb.w};
#pragma unroll
              for (int j = 0; j < 4; ++j) {
                const float a0 = yv[0][j] * cr[j] - yv[1][j] * sr[j], a1 = yv[1][j] * cr[j] + yv[0][j] * sr[j];
                const float a2 = yv[2][j] * cc[j] - yv[3][j] * sc[j], a3 = yv[3][j] * cc[j] + yv[2][j] * sc[j];
                yv[0][j] = a0; yv[1][j] = a1; yv[2][j] = a2; yv[3][j] = a3;
              }
            }
#pragma unroll
            for (int ni = 0; ni < 4; ++ni)
              *(uint2*)(p.z + (size_t)r * INC + cw0 + ni * 16 + quad * 4) =
                  make_uint2(pk2(yv[ni][0] * qs, yv[ni][1] * qs), pk2(yv[ni][2] * qs, yv[ni][3] * qs));
            __builtin_amdgcn_sched_barrier(0);
          }
        } else {
          const int kvh = hh - 8;
#pragma unroll
          for (int mi = 0; mi < 4; ++mi) {
            const int r = em0 + wr * 64 + mi * 16 + l15;
            u16* vb;
            int vstride;
            if (r < MC) { vb = p.vTc + ((size_t)(((r >> 8) * 2 + kvh) * 64)) * CTXL + (r & 255); vstride = CTXL; }
            else { const int rr = r - MC; vb = p.vTl + ((size_t)(((rr >> 12) * 2 + kvh) * 64)) * SEQ + (rr & 4095); vstride = SEQ; }
#pragma unroll
            for (int ni = 0; ni < 4; ++ni)
#pragma unroll
              for (int j = 0; j < 4; ++j) vb[(size_t)(ni * 16 + quad * 4 + j) * vstride] = f2bf(acc[mi][ni][j]);
            __builtin_amdgcn_sched_barrier(0);
          }
        }
      }
    } else if constexpr (EPI == EPI_RES) {
      const int s = em0 < MC ? 8 : (em0 - MC) >> 12;
      const float* gate = p.mods + ((size_t)l * 9 + s) * 6144 + goff;
      float4 gv[4];
#pragma unroll
      for (int ni = 0; ni < 4; ++ni) gv[ni] = *(const float4*)(gate + cw0 + ni * 16 + quad * 4);
#pragma unroll
      for (int mi = 0; mi < 4; ++mi) {
        const int r = em0 + wr * 64 + mi * 16 + l15;
        const float* src;
        if (l == 0 && goff == 2048) src = r < MC ? p.ctx + (size_t)r * DM : p.x + (size_t)(r - MC) * DM;
        else src = r < MC ? p.xc + (size_t)r * DM : p.out + (size_t)(r - MC) * DM;
        float* dst = r < MC ? p.xc + (size_t)r * DM : p.out + (size_t)(r - MC) * DM;
#pragma unroll
        for (int ni = 0; ni < 4; ++ni) {
          const int c = cw0 + ni * 16 + quad * 4;
          const float4 xv = *(const float4*)(src + c);
          float4 o;
          o.x = xv.x + gv[ni].x * acc[mi][ni][0];
          o.y = xv.y + gv[ni].y * acc[mi][ni][1];
          o.z = xv.z + gv[ni].z * acc[mi][ni][2];
          o.w = xv.w + gv[ni].w * acc[mi][ni][3];
          *(float4*)(dst + c) = o;
        }
        __builtin_amdgcn_sched_barrier(0);
      }
    } else {
      const int hc0 = (en0 >> 1) + wc * 32;
#pragma unroll
      for (int mi = 0; mi < 4; ++mi) {
        const int r = em0 + wr * 64 + mi * 16 + l15;
#pragma unroll
        for (int pp = 0; pp < 2; ++pp) {
          float hv[4];
#pragma unroll
          for (int j = 0; j < 4; ++j) hv[j] = siluf_(acc[mi][2 * pp][j]) * acc[mi][2 * pp + 1][j];
          *(uint2*)(p.h + (size_t)r * DFF + hc0 + pp * 16 + quad * 4) = make_uint2(pk2(hv[0], hv[1]), pk2(hv[2], hv[3]));
        }
        __builtin_amdgcn_sched_barrier(0);
      }
    }
  }
}
#undef G_GL
#undef G_LS
#undef G_COMPUTE
#undef G_MAP

template <int LPR>
DEV float red_lpr(float v) {
  v += dppf<0xB1>(v);
  v += dppf<0x4E>(v);
  if (LPR >= 8) v += dppf<0x141>(v);
  if (LPR >= 16) v += dppf<0x140>(v);
  return v;
}

constexpr int SCAN_LPR = 8;
constexpr int SCAN_RPB = 256 / SCAN_LPR;
constexpr int SCAN_NPART = 64 / SCAN_RPB;
constexpr int SCAN_JL = 64 / SCAN_LPR;
constexpr int SCAN_ITEMS = 96 * SCAN_NPART;

DEV float red8_sum(float v) {
  v += dppf<0xB1>(v);
  v += dppf<0x4E>(v);
  v += dppf<0x141>(v);
  return v;
}
DEV float tanh_fast(float x) {
  float e = __expf(2.f * x);
  return 1.f - 2.f * __builtin_amdgcn_rcpf(1.f + e);
}

struct ChunkPos { int len, rowbase, tlo; };
DEV ChunkPos chunk_pos(int c, int d, int b) {
  ChunkPos cp;
  const int s0 = c * 16;
  int pos0;
  if (s0 < 256) { cp.len = 256; pos0 = s0; cp.rowbase = b * 256; }
  else { cp.len = 4096; pos0 = s0 - 256; cp.rowbase = MC + b * 4096; }
  cp.tlo = d ? (cp.len - 16 - pos0) : pos0;
  return cp;
}

constexpr int SC_R = 0, SC_KD = 12288, SC_V = 24576, SC_W = 30720, SC_KA = 38912, SC_NKK = 47104;

DEV void cvt8(const uint4 u, float4& lo, float4& hi) {
  lo.x = __uint_as_float(u.x << 16); lo.y = __uint_as_float(u.x & 0xffff0000u);
  lo.z = __uint_as_float(u.y << 16); lo.w = __uint_as_float(u.y & 0xffff0000u);
  hi.x = __uint_as_float(u.z << 16); hi.y = __uint_as_float(u.z & 0xffff0000u);
  hi.z = __uint_as_float(u.w << 16); hi.w = __uint_as_float(u.w & 0xffff0000u);
}

DEV void scan_item(const P& p, int l, int item, char* smem) {
  const int tid = tid_l(), lane = tid & 63, wid = tid >> 6, l15 = lane & 15, quad = lane >> 4;
  constexpr int LPR = SCAN_LPR, RPB = SCAN_RPB, JL = SCAN_JL, NV = RPB / 8;
  const int scan = item / SCAN_NPART, part = item % SCAN_NPART;
  const int d = scan / 48, b = (scan % 48) / 6, h = scan % 6;
  const int rloc = tid / LPR, jq = tid % LPR;
  const int irow = part * RPB + rloc;
  const int j0 = jq * JL;

  const int c_ts = (tid & 127) >> 3, c_ch = tid & 7;
  const int c_col = (tid < 128 ? 0 : 384) + h * 64 + c_ch * 8;
  const int v_ts = tid / NV, v_ch = tid % NV;
  const int v_col = 768 + h * 64 + part * RPB + v_ch * 8;

  const int n2 = wid * 16 + l15;
  bf16x8 bW[2], bA[2];
  {
    const u16* wb = p.wUpT + ((size_t)(l * 2 + d) * 384 + h * 64 + n2) * 64 + quad * 8;
    const u16* ab = p.aUpT + ((size_t)(l * 2 + d) * 384 + h * 64 + n2) * 64 + quad * 8;
    bW[0] = *(const bf16x8*)(wb);
    bW[1] = *(const bf16x8*)(wb + 32);
    bA[0] = *(const bf16x8*)(ab);
    bA[1] = *(const bf16x8*)(ab + 32);
  }
  const float w0v = p.w0[(size_t)(l * 2 + d) * 384 + h * 64 + n2];
  const float a0v = p.a0[(size_t)(l * 2 + d) * 384 + h * 64 + n2];
  const float kkc = p.k_k[l * 384 + h * 64 + n2], kac = p.k_a[l * 384 + h * 64 + n2], rkc = p.r_k[l * 384 + h * 64 + n2];

  float2v S2[JL / 2];
#pragma unroll
  for (int j = 0; j < JL / 2; ++j) S2[j] = float2v{0.f, 0.f};
  uint4 g_rk, g_v;
  bf16x8 g_wd0, g_wd1, g_ad0, g_ad1;
  float g_inv[4];

#define SC_GLOAD1(CC)                                                                                  \
  {                                                                                                    \
    const ChunkPos cp_ = chunk_pos((CC), d, b);                                                        \
    g_rk = *(const uint4*)(p.z + (size_t)(cp_.rowbase + cp_.tlo + c_ts) * INC + c_col);                \
    if (tid < 16 * NV) g_v = *(const uint4*)(p.z + (size_t)(cp_.rowbase + cp_.tlo + v_ts) * INC + v_col);  \
  }
#define SC_GLOAD2(CC)                                                                                  \
  {                                                                                                    \
    const ChunkPos cp_ = chunk_pos((CC), d, b);                                                        \
    const u16* rp_ = p.z + (size_t)(cp_.rowbase + cp_.tlo + l15) * INC + 1152 + quad * 8;              \
    g_wd0 = *(const bf16x8*)(rp_);                                                                     \
    g_wd1 = *(const bf16x8*)(rp_ + 32);                                                                \
    g_ad0 = *(const bf16x8*)(rp_ + 64);                                                                \
    g_ad1 = *(const bf16x8*)(rp_ + 96);                                                                \
    _Pragma("unroll") for (int j = 0; j < 4; ++j)                                                      \
      g_inv[j] = p.invn[(size_t)(cp_.rowbase + cp_.tlo + quad * 4 + j) * 8 + h];                       \
  }
#define SC_STAGE1(CC)                                                                                  \
  {                                                                                                    \
    const int i3_ = (CC) % 3;                                                                          \
    float4 lo_, hi_;                                                                                   \
    cvt8(g_rk, lo_, hi_);                                                                              \
    float* dst_ = (float*)(smem + (tid < 128 ? SC_R : SC_KD) + i3_ * 4096) + c_ts * 64 + c_ch * 8;     \
    *(float4*)dst_ = lo_;                                                                              \
    *(float4*)(dst_ + 4) = hi_;                                                                        \
    if (tid < 16 * NV) {                                                                               \
      cvt8(g_v, lo_, hi_);                                                                             \
      float* dv_ = (float*)(smem + SC_V + i3_ * 2048) + v_ts * RPB + v_ch * 8;                         \
      *(float4*)dv_ = lo_;                                                                             \
      *(float4*)(dv_ + 4) = hi_;                                                                       \
    }                                                                                                  \
  }
#define SC_STAGE2(CC)                                                                                  \
  {                                                                                                    \
    const int i3_ = (CC) % 3, i2_ = (CC)&1;                                                            \
    const ChunkPos cp_ = chunk_pos((CC), d, b);                                                        \
    f32x4 accW = f32x4{0.f, 0.f, 0.f, 0.f}, accA = f32x4{0.f, 0.f, 0.f, 0.f};                          \
    accW = mfma16(g_wd0, bW[0], accW);                                                                 \
    accW = mfma16(g_wd1, bW[1], accW);                                                                 \
    accA = mfma16(g_ad0, bA[0], accA);                                                                 \
    accA = mfma16(g_ad1, bA[1], accA);                                                                 \
    float bon_[4];                                                                                     \
    _Pragma("unroll") for (int j = 0; j < 4; ++j) {                                                    \
      const int ts = quad * 4 + j;                                                                     \
      float* kdp = (float*)(smem + SC_KD + i3_ * 4096) + ts * 64 + n2;                                 \
      const float kv = *kdp;                                                                           \
      const float rv = *((const float*)(smem + SC_R + i3_ * 4096) + ts * 64 + n2);                     \
      const float sg = sigmoidf_(w0v + accW[j]);                                                       \
      const float wv = __expf(-0.6065306597126334f * sg);                                              \
      const float av = sigmoidf_(a0v + accA[j]);                                                       \
      const float kn = kv * kkc * g_inv[j];                                                            \
      const float kd = kv * (1.f + (av - 1.f) * kac);                                                  \
      *((float*)(smem + SC_W + i2_ * 4096) + ts * 64 + n2) = wv;                                       \
      *((float*)(smem + SC_NKK + i2_ * 4096) + ts * 64 + n2) = -kn;                                    \
      *((float*)(smem + SC_KA + i2_ * 4096) + ts * 64 + n2) = kn * av;                                 \
      *kdp = kd;                                                                                       \
      bon_[j] = rv * kd * rkc;                                                                         \
    }                                                                                                  \
    _Pragma("unroll") for (int j = 0; j < 4; ++j) bon_[j] = red16_sum(bon_[j]);                        \
    if (l15 == 0 && part == 0) {                                                                       \
      _Pragma("unroll") for (int j = 0; j < 4; ++j)                                                    \
        p.bonus[(size_t)(cp_.rowbase + cp_.tlo + quad * 4 + j) * 48 + (d * 6 + h) * 4 + wid] = bon_[j]; \
    }                                                                                                  \
  }

  __builtin_amdgcn_s_setprio(3);
  SC_GLOAD1(0);
  SC_GLOAD2(0);
  SC_STAGE1(0);
  SC_GLOAD1(1);
  __syncthreads();
  SC_STAGE2(0);
  SC_STAGE1(1);
  SC_GLOAD1(2);
  SC_GLOAD2(1);
  __syncthreads();

  for (int c = 0; c < 272; ++c) {
    {
      const int i3 = c % 3, i2 = c & 1;
      const ChunkPos cp = chunk_pos(c, d, b);
      const float* pW = (const float*)(smem + SC_W + i2 * 4096) + j0;
      const float* pN = (const float*)(smem + SC_NKK + i2 * 4096) + j0;
      const float* pA = (const float*)(smem + SC_KA + i2 * 4096) + j0;
      const float* pD = (const float*)(smem + SC_KD + i3 * 4096) + j0;
      const float* pR = (const float*)(smem + SC_R + i3 * 4096) + j0;
      const float* pV = (const float*)(smem + SC_V + i3 * 2048) + rloc;
      float* yp = p.y + ((size_t)d * MT + cp.rowbase + cp.tlo) * 384 + h * 64 + irow;
      float yk0 = 0.f, yk1 = 0.f;
      constexpr int NQ = JL / 4;
      float4 cw[NQ], cn[NQ], ca[NQ], cd[NQ], cr[NQ];
      float cvi;
#define SC_LD(TS, W, N, A, D, R, VI)                                                             \
      _Pragma("unroll") for (int q = 0; q < NQ; ++q) {                                           \
        W[q] = *(const float4*)(pW + (TS)*64 + q * 4); N[q] = *(const float4*)(pN + (TS)*64 + q * 4); \
        A[q] = *(const float4*)(pA + (TS)*64 + q * 4); D[q] = *(const float4*)(pD + (TS)*64 + q * 4); \
        R[q] = *(const float4*)(pR + (TS)*64 + q * 4);                                           \
      }                                                                                          \
      VI = pV[(TS)*RPB];
      {
        const int ts0 = d ? 15 : 0;
        SC_LD(ts0, cw, cn, ca, cd, cr, cvi)
      }
#pragma unroll
      for (int si = 0; si < 16; ++si) {
        float4 xw[NQ], xn[NQ], xa[NQ], xd[NQ], xr[NQ];
        float xvi = 0.f;
        if (si + 1 < 16) {
          const int tsn = d ? 14 - si : si + 1;
          SC_LD(tsn, xw, xn, xa, xd, xr, xvi)
        }
        float2v sa2 = S2[0] * float2v{cn[0].x, cn[0].y};
        sa2 = S2[1] * float2v{cn[0].z, cn[0].w} + sa2;
        if constexpr (NQ == 2) {
          float2v sb2 = S2[2] * float2v{cn[1].x, cn[1].y};
          sb2 = S2[3] * float2v{cn[1].z, cn[1].w} + sb2;
          sa2 = sa2 + sb2;
        }
        const float2v viv = float2v{cvi, cvi};
        float2v u2[JL / 2];
#pragma unroll
        for (int q = 0; q < NQ; ++q) {
          u2[2 * q] = S2[2 * q] * float2v{cw[q].x, cw[q].y} + viv * float2v{cd[q].x, cd[q].y};
          u2[2 * q + 1] = S2[2 * q + 1] * float2v{cw[q].z, cw[q].w} + viv * float2v{cd[q].z, cd[q].w};
        }
        const float sa = LPR == 16 ? red16_sum(sa2.x + sa2.y) : red8_sum(sa2.x + sa2.y);
        const float2v sav = float2v{sa, sa};
#pragma unroll
        for (int q = 0; q < NQ; ++q) {
          S2[2 * q] = sav * float2v{ca[q].x, ca[q].y} + u2[2 * q];
          S2[2 * q + 1] = sav * float2v{ca[q].z, ca[q].w} + u2[2 * q + 1];
        }
        float2v y2 = S2[0] * float2v{cr[0].x, cr[0].y};
        y2 = S2[1] * float2v{cr[0].z, cr[0].w} + y2;
        if constexpr (NQ == 2) {
          float2v yb2 = S2[2] * float2v{cr[1].x, cr[1].y};
          yb2 = S2[3] * float2v{cr[1].z, cr[1].w} + yb2;
          y2 = y2 + yb2;
        }
        const float yv = LPR == 16 ? red16_sum(y2.x + y2.y) : red8_sum(y2.x + y2.y);
        if (si < LPR) yk0 = (jq == si) ? yv : yk0;
        else yk1 = (jq == si - LPR) ? yv : yk1;
        if (si + 1 < 16) {
#pragma unroll
          for (int q = 0; q < NQ; ++q) { cw[q] = xw[q]; cn[q] = xn[q]; ca[q] = xa[q]; cd[q] = xd[q]; cr[q] = xr[q]; }
          cvi = xvi;
        }
      }
#undef SC_LD
      {
        const int tsa = d ? 15 - jq : jq;
        yp[(size_t)tsa * 384] = yk0;
        if constexpr (LPR == 8) {
          const int tsb = d ? 7 - jq : 8 + jq;
          yp[(size_t)tsb * 384] = yk1;
        }
      }
    }
    if (c + 1 < 272) SC_STAGE2(c + 1);
    if (c + 2 < 272) SC_STAGE1(c + 2);
    if (c + 3 < 272) SC_GLOAD1(c + 3);
    if (c + 2 < 272) SC_GLOAD2(c + 2);
    __syncthreads();
  }
  __builtin_amdgcn_s_setprio(0);
#undef SC_GLOAD1
#undef SC_GLOAD2
#undef SC_STAGE1
#undef SC_STAGE2
}

DEV void attn_item(const P& p, int item, char* smem) {
  const int tid = tid_l(), lane = tid & 63, wid = tid >> 6, l15 = lane & 15, quad = lane >> 4;
  bool lat = item < 1536;
  int b, hq, qb;
  if (lat) { b = item / 192; int rem = item % 192; hq = rem / 32; qb = rem % 32; }
  else { int i2 = item - 1536; b = i2 / 12; int rem = i2 % 12; hq = rem / 2; qb = rem % 2; }
  const int kvh = hq / 3;
  const int qrow0 = lat ? MC + b * 4096 + qb * 128 : b * 256 + qb * 128;
  const int nkt = lat ? 68 : 4;
  const float LOG2E = 1.4426950408889634f;

  bf16x8 qf[2][2];
#pragma unroll
  for (int mi = 0; mi < 2; ++mi)
#pragma unroll
    for (int ks = 0; ks < 2; ++ks)
      qf[mi][ks] = *(const bf16x8*)(p.z + (size_t)(qrow0 + wid * 32 + mi * 16 + l15) * INC + 1920 + hq * 64 + ks * 32 + quad * 8);

  f32x4 Ot[2][4];
  float mrow[2], lpart[2];
#pragma unroll
  for (int mi = 0; mi < 2; ++mi) {
#pragma unroll
    for (int nd = 0; nd < 4; ++nd) Ot[mi][nd] = f32x4{0.f, 0.f, 0.f, 0.f};
    mrow[mi] = -1e30f;
    lpart[mi] = 0.f;
  }
  const int lrow = tid >> 3, lch = tid & 7;
  uint4 rk0, rk1, rv0, rv1;
#define ATT_GLOAD(KT)                                                                         \
  {                                                                                           \
    const int kt_ = (KT);                                                                     \
    const u16* kp;                                                                            \
    const u16* vp;                                                                            \
    int vstride;                                                                              \
    if (lat && kt_ < 64) {                                                                    \
      kp = p.z + (size_t)(MC + b * 4096 + kt_ * 64) * INC + 2304 + kvh * 64;                  \
      vp = p.vTl + (size_t)((b * 2 + kvh) * 64) * SEQ + kt_ * 64;                             \
      vstride = SEQ;                                                                          \
    } else {                                                                                  \
      const int kc = lat ? kt_ - 64 : kt_;                                                    \
      kp = p.z + (size_t)(b * 256 + kc * 64) * INC + 2304 + kvh * 64;                         \
      vp = p.vTc + (size_t)((b * 2 + kvh) * 64) * CTXL + kc * 64;                             \
      vstride = CTXL;                                                                         \
    }                                                                                         \
    rk0 = *(const uint4*)(kp + (size_t)(lrow)*INC + lch * 8);                                 \
    rk1 = *(const uint4*)(kp + (size_t)(lrow + 32) * INC + lch * 8);                          \
    rv0 = *(const uint4*)(vp + (size_t)(lrow)*vstride + lch * 8);                             \
    rv1 = *(const uint4*)(vp + (size_t)(lrow + 32) * vstride + lch * 8);                      \
  }
#define ATT_LSTORE(BUF)                                     \
  {                                                         \
    char* Kb_ = smem + (BUF)*16384;                         \
    *(uint4*)(Kb_ + swz(lrow, lch)) = rk0;                  \
    *(uint4*)(Kb_ + swz(lrow + 32, lch)) = rk1;             \
    *(uint4*)(Kb_ + 8192 + swz(lrow, lch)) = rv0;           \
    *(uint4*)(Kb_ + 8192 + swz(lrow + 32, lch)) = rv1;      \
  }
  ATT_GLOAD(0);
  ATT_LSTORE(0);
  __syncthreads();
  for (int kt = 0; kt < nkt; ++kt) {
    const int buf = kt & 1;
    if (kt + 1 < nkt) ATT_GLOAD(kt + 1);
    const char* Kb = smem + buf * 16384;
    const char* Vb = Kb + 8192;
    f32x4 St[2][4];
#pragma unroll
    for (int mi = 0; mi < 2; ++mi)
#pragma unroll
      for (int ni = 0; ni < 4; ++ni) St[mi][ni] = f32x4{0.f, 0.f, 0.f, 0.f};
#pragma unroll
    for (int ks = 0; ks < 2; ++ks) {
      bf16x8 kf[4];
#pragma unroll
      for (int ni = 0; ni < 4; ++ni) kf[ni] = *(const bf16x8*)(Kb + swz(ni * 16 + l15, ks * 4 + quad));
#pragma unroll
      for (int mi = 0; mi < 2; ++mi)
#pragma unroll
        for (int ni = 0; ni < 4; ++ni) St[mi][ni] = mfma16(kf[ni], qf[mi][ks], St[mi][ni]);
    }
    bf16x8 pf[2][2];
#pragma unroll
    for (int mi = 0; mi < 2; ++mi) {
      float mx = St[mi][0][0];
#pragma unroll
      for (int ni = 0; ni < 4; ++ni)
#pragma unroll
        for (int jj = 0; jj < 4; ++jj) mx = fmaxf(mx, St[mi][ni][jj]);
      mx = fmaxf(mx, __shfl_xor(mx, 16));
      mx = fmaxf(mx, __shfl_xor(mx, 32));
      const float mnew = fmaxf(mrow[mi], mx);
      const float alpha = __builtin_amdgcn_exp2f((mrow[mi] - mnew) * LOG2E);
      mrow[mi] = mnew;
      const float mb = mnew * LOG2E;
      float ps = 0.f;
      float pv[4][4];
#pragma unroll
      for (int ni = 0; ni < 4; ++ni)
#pragma unroll
        for (int jj = 0; jj < 4; ++jj) {
          pv[ni][jj] = __builtin_amdgcn_exp2f(St[mi][ni][jj] * LOG2E - mb);
          ps += pv[ni][jj];
        }
      lpart[mi] = lpart[mi] * alpha + ps;
#pragma unroll
      for (int nd = 0; nd < 4; ++nd) {
        Ot[mi][nd][0] *= alpha; Ot[mi][nd][1] *= alpha; Ot[mi][nd][2] *= alpha; Ot[mi][nd][3] *= alpha;
      }
#pragma unroll
      for (int s2 = 0; s2 < 2; ++s2) {
        union { unsigned u[4]; bf16x8 v; } pk;
        pk.u[0] = pk2(pv[2 * s2][0], pv[2 * s2][1]);
        pk.u[1] = pk2(pv[2 * s2][2], pv[2 * s2][3]);
        pk.u[2] = pk2(pv[2 * s2 + 1][0], pv[2 * s2 + 1][1]);
        pk.u[3] = pk2(pv[2 * s2 + 1][2], pv[2 * s2 + 1][3]);
        pf[mi][s2] = pk.v;
      }
    }
#pragma unroll
    for (int s2 = 0; s2 < 2; ++s2) {
      bf16x8 vf[4];
#pragma unroll
      for (int nd = 0; nd < 4; ++nd) {
        const int drow = nd * 16 + l15;
        union { uint2 h[2]; bf16x8 v; } vv;
        vv.h[0] = *(const uint2*)(Vb + swz(drow, 4 * s2 + (quad >> 1)) + (quad & 1) * 8);
        vv.h[1] = *(const uint2*)(Vb + swz(drow, 4 * s2 + 2 + (quad >> 1)) + (quad & 1) * 8);
        vf[nd] = vv.v;
      }
#pragma unroll
      for (int mi = 0; mi < 2; ++mi)
#pragma unroll
        for (int nd = 0; nd < 4; ++nd) Ot[mi][nd] = mfma16(vf[nd], pf[mi][s2], Ot[mi][nd]);
    }
    if (kt + 1 < nkt) ATT_LSTORE(buf ^ 1);
    __syncthreads();
  }
#undef ATT_GLOAD
#undef ATT_LSTORE
#pragma unroll
  for (int mi = 0; mi < 2; ++mi) {
    float lsum = lpart[mi];
    lsum += __shfl_xor(lsum, 16);
    lsum += __shfl_xor(lsum, 32);
    const float inv = 1.f / lsum;
    const int r = qrow0 + wid * 32 + mi * 16 + l15;
#pragma unroll
    for (int nd = 0; nd < 4; ++nd)
      *(uint2*)(p.act + (size_t)r * DM + 640 + hq * 64 + nd * 16 + quad * 4) =
          make_uint2(pk2(Ot[mi][nd][0] * inv, Ot[mi][nd][1] * inv), pk2(Ot[mi][nd][2] * inv, Ot[mi][nd][3] * inv));
  }
}

DEV void sgate_item(const P& p, int l, int ck, int g, char* smem) {
  const int tid = tid_l(), lane = tid & 63, wid = tid >> 6, l15 = lane & 15, quad = lane >> 4;
  const int m0 = ck * 128;
  u16* sVT = (u16*)smem;
  {
    const int q = tid >> 1, half = tid & 1;
    const u16* src = p.z + (size_t)(m0 + q) * INC + 1408 + 256 + g * 64 + half * 32;
    float v[32];
    float ss = 0.f;
#pragma unroll
    for (int cidx = 0; cidx < 4; ++cidx) {
      uint4 u = *(const uint4*)(src + cidx * 8);
      unsigned uu[4] = {u.x, u.y, u.z, u.w};
#pragma unroll
      for (int e = 0; e < 4; ++e) {
        float f0 = geluf_(bf2f((u16)(uu[e] & 0xffff)));
        float f1 = geluf_(bf2f((u16)(uu[e] >> 16)));
        v[cidx * 8 + e * 2] = f0;
        v[cidx * 8 + e * 2 + 1] = f1;
        ss += f0 * f0 + f1 * f1;
      }
    }
    ss += __shfl_xor(ss, 1);
    const float rstd = rsqrtf(ss * (1.f / 64.f) + 1e-6f);
    const float* gn = p.sgn + l * 256 + g * 64 + half * 32;
#pragma unroll
    for (int e = 0; e < 32; ++e) sVT[(half * 32 + e) * 136 + q] = f2bf(v[e] * rstd * gn[e]);
  }
  __syncthreads();
  f32x4 acc[2][4];
#pragma unroll
  for (int mi = 0; mi < 2; ++mi)
#pragma unroll
    for (int ni = 0; ni < 4; ++ni) acc[mi][ni] = f32x4{0.f, 0.f, 0.f, 0.f};
  const u16* Wg = p.sgW + (size_t)(l * 4 + g) * 128 * 128;
#pragma unroll
  for (int ks = 0; ks < 4; ++ks) {
    bf16x8 a[2], bb[4];
#pragma unroll
    for (int mi = 0; mi < 2; ++mi) a[mi] = *(const bf16x8*)(Wg + (size_t)(wid * 32 + mi * 16 + l15) * 128 + ks * 32 + quad * 8);
#pragma unroll
    for (int ni = 0; ni < 4; ++ni) bb[ni] = *(const bf16x8*)(sVT + (ni * 16 + l15) * 136 + ks * 32 + quad * 8);
#pragma unroll
    for (int mi = 0; mi < 2; ++mi)
#pragma unroll
      for (int ni = 0; ni < 4; ++ni) acc[mi][ni] = mfma16(a[mi], bb[ni], acc[mi][ni]);
  }
#pragma unroll
  for (int mi = 0; mi < 2; ++mi)
#pragma unroll
    for (int j = 0; j < 4; ++j) {
      const int pr = wid * 32 + mi * 16 + quad * 4 + j;
      const float bias = p.sg_b[(size_t)(l * 4 + g) * 128 + pr];
#pragma unroll
      for (int ni = 0; ni < 4; ++ni) {
        const int c = ni * 16 + l15;
        float u = geluf_(bf2f(p.z[(size_t)(m0 + pr) * INC + 1408 + g * 64 + c]));
        p.act[(size_t)(m0 + pr) * DM + 384 + g * 64 + c] = f2bf(u * (acc[mi][ni][j] + bias));
      }
    }
  __syncthreads();
}

DEV void mix_phase(const P& p, int l, char* smem, int cidx) {
  __shared__ int s_item;
  const bool last = (l == DEPTH - 1);
  const int n_attn = last ? 1536 : 1632;
  const int ck_lo = last ? 16 : 0;
  const int n_sg = (NMT - ck_lo) * 4;
  const int total = SCAN_ITEMS + n_attn + n_sg;
  const int bid = bid_l();
  bool first = bid < SCAN_ITEMS;
  for (;;) {
    int it;
    if (first) {
      it = bid;
      first = false;
    } else {
      if (tid_l() == 0) s_item = SCAN_ITEMS + atomicAdd(p.cnt + cidx, 1);
      __syncthreads();
      it = s_item;
      __syncthreads();
    }
    if (it >= total) break;
    if (it < SCAN_ITEMS) {
      int nr = SCAN_REP; asm volatile("" : "+s"(nr));
      for (int rr = 0; rr < nr; ++rr) scan_item(p, l, it, smem);
    } else if (it < SCAN_ITEMS + n_attn) {
      int nr = ATT_REP; asm volatile("" : "+s"(nr));
      for (int rr = 0; rr < nr; ++rr) { attn_item(p, it - SCAN_ITEMS, smem); __syncthreads(); }
    } else {
      int i2 = it - SCAN_ITEMS - n_attn;
      int nr = SG_REP; asm volatile("" : "+s"(nr));
      for (int rr = 0; rr < nr; ++rr) sgate_item(p, l, ck_lo + (i2 >> 2), i2 & 3, smem);
    }
  }
}

DEV void apost_phase(const P& p, int l, int mt_lo, char* smem) {
  const int tid = tid_l(), lane = tid & 63, wid = tid >> 6, l15 = lane & 15, quad = lane >> 4;
  const int nit = (NMT - mt_lo) * 6;
  for (int it = bid_l(); it < nit; it += gridDim.x) {
    const int mt = mt_lo + it / 6;
    const int hh = it % 6;
    const int m0 = mt * 128;
    bf16x8 a[2][4];
#pragma unroll
    for (int mi = 0; mi < 2; ++mi)
#pragma unroll
      for (int ks = 0; ks < 4; ++ks)
        a[mi][ks] = *(const bf16x8*)(p.z + (size_t)(m0 + wid * 32 + mi * 16 + l15) * INC + 1280 + ks * 32 + quad * 8);
    {
      f32x4 acc[2][4];
#pragma unroll
      for (int mi = 0; mi < 2; ++mi)
#pragma unroll
        for (int ni = 0; ni < 4; ++ni) acc[mi][ni] = f32x4{0.f, 0.f, 0.f, 0.f};
#pragma unroll
      for (int ks = 0; ks < 4; ++ks) {
        bf16x8 bb[4];
#pragma unroll
        for (int ni = 0; ni < 4; ++ni)
          bb[ni] = *(const bf16x8*)(p.gUpT + ((size_t)l * 384 + hh * 64 + ni * 16 + l15) * 128 + ks * 32 + quad * 8);
#pragma unroll
        for (int mi = 0; mi < 2; ++mi)
#pragma unroll
          for (int ni = 0; ni < 4; ++ni) acc[mi][ni] = mfma16(a[mi][ks], bb[ni], acc[mi][ni]);
      }
      float lg[4], lb[4];
#pragma unroll
      for (int ni = 0; ni < 4; ++ni) {
        const int c = hh * 64 + ni * 16 + l15;
        lg[ni] = p.ln_g[l * 384 + c];
        lb[ni] = p.ln_b[l * 384 + c];
      }
#pragma unroll
      for (int mi = 0; mi < 2; ++mi)
#pragma unroll
        for (int j = 0; j < 4; ++j) {
          const int r = m0 + wid * 32 + mi * 16 + quad * 4 + j;
          float ys[4], vv[4];
          float sm = 0.f;
#pragma unroll
          for (int ni = 0; ni < 4; ++ni) {
            const int c = hh * 64 + ni * 16 + l15;
            ys[ni] = p.y[(size_t)r * 384 + c] + p.y[((size_t)MT + r) * 384 + c];
            vv[ni] = bf2f(p.z[(size_t)r * INC + 768 + c]);
            sm += ys[ni];
          }
          const float4 bq0 = *(const float4*)(p.bonus + (size_t)r * 48 + hh * 4);
          const float4 bq1 = *(const float4*)(p.bonus + (size_t)r * 48 + (6 + hh) * 4);
          const float bon = (bq0.x + bq0.y) + (bq0.z + bq0.w) + (bq1.x + bq1.y) + (bq1.z + bq1.w);
          sm = red16_sum(sm);
          const float mean = sm * (1.f / 64.f);
          float vs = 0.f;
#pragma unroll
          for (int ni = 0; ni < 4; ++ni) { ys[ni] -= mean; vs += ys[ni] * ys[ni]; }
          vs = red16_sum(vs);
          const float rstd = rsqrtf(vs * (1.f / 64.f) + 64e-5f);
#pragma unroll
          for (int ni = 0; ni < 4; ++ni) {
            const int c = hh * 64 + ni * 16 + l15;
            float o = (ys[ni] * rstd * lg[ni] + lb[ni] + bon * vv[ni]) * acc[mi][ni][j];
            p.act[(size_t)r * DM + c] = f2bf(o);
          }
          __builtin_amdgcn_sched_barrier(0);
        }
    }
  }
}

DEV uint2 ld8(const u16* q) { return *(const uint2*)q; }
DEV void up4(const uint2 u, float (&f)[4]) {
  f[0] = __uint_as_float(u.x << 16); f[1] = __uint_as_float(u.x & 0xffff0000u);
  f[2] = __uint_as_float(u.y << 16); f[3] = __uint_as_float(u.y & 0xffff0000u);
}
DEV void prep_phase(const P& p, int l, cg::grid_group& grid) {
  const int tid = tid_l(), lane = tid & 63, l15 = lane & 15;
  const int nb = gridDim.x, bid = bid_l();
  constexpr int NR = 8;
  const int rpb = (((MT + nb - 1) / nb) + NR - 1) & ~(NR - 1);
  const int ra = bid * rpb;
  const int rb = min(ra + rpb, MT);
  const bool active = ra < MT;
  const bool has1 = tid < 96;
  const int col0 = tid * 4, col1 = 1024 + tid * 4;
  uint2 hp0 = make_uint2(0, 0), hn0 = hp0, hp1 = hp0, hn1 = hp0;
  if (active) {
    if (ra > 0) { hp0 = ld8(p.z + (size_t)(ra - 1) * INC + col0); if (has1) hp1 = ld8(p.z + (size_t)(ra - 1) * INC + col1); }
    if (rb < MT) { hn0 = ld8(p.z + (size_t)rb * INC + col0); if (has1) hn1 = ld8(p.z + (size_t)rb * INC + col1); }
  }
  grid.sync();
  if (!active) return;
  const float* cw = p.conv + (size_t)l * 3 * 1408;
#pragma unroll 1
  for (int pass = 0; pass < 2; ++pass) {
    if (pass == 1 && !has1) break;
    const int col = pass ? col1 : col0;
    const int typ = col < 1152 ? 0 : (col < 1216 ? 1 : (col < 1280 ? 0 : 2));
    const bool isk = col >= 384 && col < 768;
    float c0[4], c1[4], c2[4], kk4[4];
#pragma unroll
    for (int e = 0; e < 4; ++e) {
      c0[e] = cw[col + e]; c1[e] = cw[1408 + col + e]; c2[e] = cw[2816 + col + e];
      kk4[e] = isk ? p.k_k[l * 384 + (col - 384) + e] : 0.f;
    }
    const int hh = isk ? (col - 384) >> 6 : 0;
    u16* zc = p.z + col;
    uint2 prev = pass ? hp1 : hp0;
    const uint2 halo_n = pass ? hn1 : hn0;
    uint2 cur = ld8(zc + (size_t)ra * INC);
    for (int r = ra; r < rb; r += NR) {
      uint2 w[NR + 2];
      w[0] = prev;
      w[1] = cur;
#pragma unroll
      for (int q = 0; q < NR; ++q) {
        const int rr = r + 1 + q;
        w[q + 2] = rr < rb ? ld8(zc + (size_t)rr * INC) : halo_n;
      }
#pragma unroll
      for (int q = 0; q < NR; ++q) {
        const int rr = r + q;
        const uint2 xp = w[q], xc = w[q + 1], xn = w[q + 2];
        const int tt = rr < MC ? (rr & 255) : ((rr - MC) & 4095);
        const int len = rr < MC ? 256 : 4096;
        const float mp = tt > 0 ? 1.f : 0.f, mn = tt < len - 1 ? 1.f : 0.f;
        float fp[4], fc[4], fn[4], o[4];
        up4(xp, fp); up4(xc, fc); up4(xn, fn);
#pragma unroll
        for (int e = 0; e < 4; ++e) {
          float v = fc[e] * c1[e] + mp * (fp[e] * c0[e]) + mn * (fn[e] * c2[e]);
          if (typ == 1) v = tanh_fast(v);
          else if (typ == 2) v = sigmoidf_(v);
          o[e] = v;
        }
        if (isk) {
          float q0 = o[0] * kk4[0], q1 = o[1] * kk4[1], q2 = o[2] * kk4[2], q3 = o[3] * kk4[3];
          float ss = red16_sum(q0 * q0 + q1 * q1 + q2 * q2 + q3 * q3);
          if (l15 == 0 && rr < rb) p.invn[(size_t)rr * 8 + hh] = 1.f / fmaxf(sqrtf(ss), 1e-12f);
        }
        if (rr < rb) *(uint2*)(zc + (size_t)rr * INC) = make_uint2(pk2(o[0], o[1]), pk2(o[2], o[3]));
      }
      prev = w[NR];
      cur = w[NR + 1];
    }
  }
}

__global__ void __launch_bounds__(256, 2) fwd_megakernel(P p, int ph_lo, int ph_hi) {
  __shared__ __attribute__((aligned(16))) char smem[65536 - 64];
  cg::grid_group grid = cg::this_grid();
  for (int ph = ph_lo; ph < ph_hi; ++ph) {
    if (ph > ph_lo) grid.sync();
    if (ph == 0) {
      phase0(p, smem);
      if (PROBE_MASK & 256) { grid.sync(); phase0(p, smem); }
      if (PROBE_MASK & 1024) { for (int i = 0; i < 50; ++i) grid.sync(); }
      continue;
    }
    if (ph == 1 + 8 * DEPTH) { final_norm(p); continue; }
    const int l = (ph - 1) >> 3, sub = (ph - 1) & 7;
    const bool last = (l == DEPTH - 1);
    const int mt_lo = last ? 16 : 0;
    int nrep = ((PROBE_MASK >> sub) & 1) ? 2 : 1;
    asm volatile("" : "+s"(nrep));
    for (int rep = 0; rep < nrep; ++rep) {
      if (rep) grid.sync();
      const int dry = (rep + 1 < nrep && !(PROBE_MASK & 512)) ? 1 : 0;
      if (sub == 0 || sub == 5) {
        const bool n2 = sub == 5;
        norm_phase(p, l, (n2 ? p.n2g : p.n1g) + l * DM, n2 ? 3072 : 0, n2 ? 4096 : 1024, n2 ? mt_lo * 128 : 0, !n2 && l == 0);
      } else if (sub == 1) {
        gemm_phase<EPI_Z>(p, l, p.act, DM, p.wIn + (size_t)l * 2560 * 1024, 1024, 20, 0, 0, smem, dry);
      } else if (sub == 2) {
        if (rep == 0) { prep_phase(p, l, grid); grid.sync(); }
        mix_phase(p, l, smem, l + 8 * rep);
      } else if (sub == 3) {
        apost_phase(p, l, mt_lo, smem);
      } else if (sub == 4 || sub == 7) {
        const bool g4 = sub == 7;
        gemm_phase<EPI_RES>(p, l, g4 ? p.h : p.act, g4 ? DFF : DM,
                            g4 ? p.w2t + (size_t)l * 1024 * 2816 : p.wOut + (size_t)l * 1024 * 1024, g4 ? 2816 : 1024, 8, mt_lo,
                            g4 ? 5120 : 2048, smem, dry);
      } else {
        gemm_phase<EPI_SWIGLU>(p, l, p.act, DM, p.w1t + (size_t)l * 5632 * 1024, 1024, 44, mt_lo, 0, smem, dry);
      }
    }
  }
}

extern "C" void kernel_launch(void* const* d_in, const int* in_sizes, int n_in, void* d_out, int out_size, void* d_ws,
                              size_t ws_size, hipStream_t stream) {
  static int grid_blocks = 0;
  if (!grid_blocks) {
    int dev = 0, cus = 0, per_cu = 0;
    hipGetDevice(&dev);
    hipDeviceGetAttribute(&cus, hipDeviceAttributeMultiprocessorCount, dev);
    hipOccupancyMaxActiveBlocksPerMultiprocessor(&per_cu, fwd_megakernel, 256, 0);
    if (per_cu > 2) per_cu = 2;
    if (per_cu < 1) per_cu = 1;
    grid_blocks = cus * per_cu;
  }
  P p{};
  const float* const* in = (const float* const*)d_in;
  p.x = in[0]; p.c = in[1]; p.ctx = in[2]; p.c_ctx = in[3]; p.n1g = in[4]; p.n2g = in[5]; p.ada_w = in[6]; p.ada_b = in[7];
  p.w_in = in[8]; p.conv = in[9]; p.w0 = in[10]; p.w_up = in[11]; p.a0 = in[12]; p.a_up = in[13]; p.g_up = in[14];
  p.k_k = in[15]; p.k_a = in[16]; p.r_k = in[17]; p.ln_g = in[18]; p.ln_b = in[19]; p.sgn = in[20]; p.sg_w = in[21];
  p.sg_b = in[22]; p.q_g = in[23]; p.k_g = in[24]; p.w_out = in[25]; p.w1 = in[26]; p.w2 = in[27]; p.fng = in[28];
  p.out = (float*)d_out;
  char* ws = (char*)d_ws;
  size_t off = 0;
  auto take = [&](size_t bytes) { char* r = ws + off; off += (bytes + 255) & ~(size_t)255; return r; };
  p.wIn = (u16*)take((size_t)4 * 2560 * 1024 * 2);
  p.wOut = (u16*)take((size_t)4 * 1024 * 1024 * 2);
  p.w1t = (u16*)take((size_t)4 * 5632 * 1024 * 2);
  p.w2t = (u16*)take((size_t)4 * 1024 * 2816 * 2);
  p.wUpT = (u16*)take((size_t)8 * 384 * 64 * 2);
  p.aUpT = (u16*)take((size_t)8 * 384 * 64 * 2);
  p.gUpT = (u16*)take((size_t)4 * 384 * 128 * 2);
  p.sgW = (u16*)take((size_t)16 * 128 * 128 * 2);
  p.mods = (float*)take((size_t)4 * 9 * 6144 * 4);
  p.rope = (float*)take(2048 * 4);
  p.cnt = (int*)take(256);
  p.xc = (float*)take((size_t)MC * DM * 4);
  p.act = (u16*)take((size_t)MT * DM * 2);
  p.z = (u16*)take((size_t)MT * DFF * 2);
  p.h = p.z;
  p.vTl = (u16*)take((size_t)16 * 64 * SEQ * 2);
  p.vTc = (u16*)take((size_t)16 * 64 * CTXL * 2);
  p.y = (float*)take((size_t)2 * MT * 384 * 4);
  p.bonus = (float*)take((size_t)MT * 48 * 4);
  p.invn = (float*)take((size_t)MT * 8 * 4);
  if (off > ws_size) { fprintf(stderr, "workspace too small: need %zu have %zu\n", off, ws_size); return; }
  int ph_lo = 0, ph_hi = 2 + 8 * DEPTH;
  void* args[] = {&p, &ph_lo, &ph_hi};
  hipError_t e = hipLaunchCooperativeKernel((void*)fwd_megakernel, dim3(grid_blocks), dim3(256), args, 0, stream);
  if (e != hipSuccess) fprintf(stderr, "cooperative launch failed: %s (grid %d)\n", hipGetErrorString(e), grid_blocks);
}
```

```cpp
#include <hip/hip_runtime.h>
#include <hip/hip_bf16.h>
#include <hip/hip_cooperative_groups.h>
#include <cstdio>
namespace cg = cooperative_groups;

typedef __attribute__((ext_vector_type(8))) short bf16x8;
typedef __attribute__((ext_vector_type(4))) float f32x4;
typedef unsigned short u16;
typedef __attribute__((ext_vector_type(2))) float float2v;

#define DEV __device__ __forceinline__
DEV int tid_l() { int t = threadIdx.x; asm volatile("" : "+v"(t)); return t; }
DEV int bid_l() { int b = blockIdx.x; asm volatile("" : "+s"(b)); return b; }

constexpr int DM = 1024, NBATCH = 8, SEQ = 4096, DEPTH = 4, CTXL = 256;
constexpr int MC = NBATCH * CTXL;
constexpr int ML = NBATCH * SEQ;
constexpr int MT = MC + ML;
constexpr int INC = 2560, DFF = 2816;
constexpr int NMT = MT / 128;
#ifndef PROBE_MASK
#define PROBE_MASK 0
#endif
#define SCAN_REP 1
#define ATT_REP 1
#define SG_REP 1

struct P {
  const float *x, *c, *ctx, *c_ctx, *n1g, *n2g, *ada_w, *ada_b, *w_in, *conv, *w0, *w_up, *a0, *a_up, *g_up,
      *k_k, *k_a, *r_k, *ln_g, *ln_b, *sgn, *sg_w, *sg_b, *q_g, *k_g, *w_out, *w1, *w2, *fng;
  float* out;
  u16 *wIn, *wOut, *w1t, *w2t, *wUpT, *aUpT, *gUpT, *sgW;
  float *mods, *rope;
  int* cnt;
  float* xc;
  u16 *act, *z, *h, *vTl, *vTc;
  float *y, *bonus, *invn;
  float *rss1, *rss2, *bz, *bh;
  u16* act2;
};

typedef __attribute__((ext_vector_type(2))) __bf16 bf16x2v;
typedef __attribute__((ext_vector_type(2))) float f32x2v;
DEV unsigned pk2(float a, float b) {
  f32x2v v = {a, b};
  bf16x2v r = __builtin_convertvector(v, bf16x2v);
  return *(unsigned*)&r;
}
DEV u16 f2bf(float f) { return (u16)(pk2(f, 0.f) & 0xffffu); }
DEV float bf2f(u16 h) { return __uint_as_float(((unsigned)h) << 16); }
DEV float sigmoidf_(float x) { return __builtin_amdgcn_rcpf(1.f + __expf(-x)); }
DEV float siluf_(float x) { return x * __builtin_amdgcn_rcpf(1.f + __expf(-x)); }
DEV float geluf_(float x) {
  float u = 0.7978845608028654f * (x + 0.044715f * x * x * x);
  return 0.5f * x * (1.f + tanhf(u));
}
DEV int swz(int r, int ch) { return r * 128 + ((ch ^ ((r >> 1) & 7)) << 4); }

template <int CTRL>
DEV float dppf(float v) {
  return __int_as_float(__builtin_amdgcn_update_dpp(0, __float_as_int(v), CTRL, 0xF, 0xF, false));
}
DEV float red16_sum(float v) {
  v += dppf<0xB1>(v);
  v += dppf<0x4E>(v);
  v += dppf<0x141>(v);
  v += dppf<0x140>(v);
  return v;
}
DEV float red16_max(float v) {
  v = fmaxf(v, dppf<0xB1>(v));
  v = fmaxf(v, dppf<0x4E>(v));
  v = fmaxf(v, dppf<0x141>(v));
  v = fmaxf(v, dppf<0x140>(v));
  return v;
}
DEV float wave_sum(float v) {
#pragma unroll
  for (int o = 32; o >= 1; o >>= 1) v += __shfl_xor(v, o);
  return v;
}
DEV f32x4 mfma16(bf16x8 a, bf16x8 b, f32x4 c) { return __builtin_amdgcn_mfma_f32_16x16x32_bf16(a, b, c, 0, 0, 0); }

DEV void tr_tile(const float* __restrict__ src, u16* __restrict__ dst, int K, int N, int kt, int nt, bool il, float* lds) {
  const int tid = tid_l();
  const int k0 = kt * 64, n0 = nt * 64;
  {
    const int c = tid & 63, r0 = tid >> 6;
#pragma unroll 4
    for (int i = 0; i < 16; ++i) {
      int r = r0 + i * 4;
      lds[r * 65 + c] = src[(size_t)(k0 + r) * N + n0 + c];
    }
  }
  __syncthreads();
  {
    const int k = tid & 63, nn0 = tid >> 6;
#pragma unroll 4
    for (int i = 0; i < 16; ++i) {
      int n = nn0 + i * 4;
      int gn = n0 + n;
      int np = gn;
      if (il) {
        int j = gn < DFF ? gn : gn - DFF;
        np = (j >> 4) * 32 + (j & 15) + (gn < DFF ? 0 : 16);
      }
      dst[(size_t)np * K + k0 + k] = f2bf(lds[k * 65 + n]);
    }
  }
  __syncthreads();
}

DEV void phase0(const P& p, char* smem) {
  float* lds = (float*)smem;
  const int tid = tid_l();
  constexpr int C0 = 2560, C1 = C0 + 1024, C2 = C1 + 5632, C3 = C2 + 2816, C4 = C3 + 48, C5 = C4 + 48, C6 = C5 + 48,
                C7 = C6 + 64, C8 = C7 + 384, C9 = C8 + 1;
  for (int it = bid_l(); it < C9; it += gridDim.x) {
    if (it < C6) {
      const float* src; u16* dst; int K, N, kt, nt; bool il = false;
      if (it < C0) {
        int l = it / 640, r = it % 640;
        src = p.w_in + (size_t)l * 1024 * 2560; dst = p.wIn + (size_t)l * 2560 * 1024; K = 1024; N = 2560; kt = r / 40; nt = r % 40;
      } else if (it < C1) {
        int i2 = it - C0, l = i2 / 256, r = i2 % 256;
        src = p.w_out + (size_t)l * 1024 * 1024; dst = p.wOut + (size_t)l * 1024 * 1024; K = 1024; N = 1024; kt = r / 16; nt = r % 16;
      } else if (it < C2) {
        int i2 = it - C1, l = i2 / 1408, r = i2 % 1408;
        src = p.w1 + (size_t)l * 1024 * 5632; dst = p.w1t + (size_t)l * 5632 * 1024; K = 1024; N = 5632; kt = r / 88; nt = r % 88; il = true;
      } else if (it < C3) {
        int i2 = it - C2, l = i2 / 704, r = i2 % 704;
        src = p.w2 + (size_t)l * 2816 * 1024; dst = p.w2t + (size_t)l * 1024 * 2816; K = 2816; N = 1024; kt = r / 16; nt = r % 16;
      } else if (it < C4) {
        int i2 = it - C3, bb = i2 / 6;
        src = p.w_up + (size_t)bb * 64 * 384; dst = p.wUpT + (size_t)bb * 384 * 64; K = 64; N = 384; kt = 0; nt = i2 % 6;
      } else if (it < C5) {
        int i2 = it - C4, bb = i2 / 6;
        src = p.a_up + (size_t)bb * 64 * 384; dst = p.aUpT + (size_t)bb * 384 * 64; K = 64; N = 384; kt = 0; nt = i2 % 6;
      } else {
        int i2 = it - C5, l = i2 / 12, r = i2 % 12;
        src = p.g_up + (size_t)l * 128 * 384; dst = p.gUpT + (size_t)l * 384 * 128; K = 128; N = 384; kt = r / 6; nt = r % 6;
      }
      tr_tile(src, dst, K, N, kt, nt, il, lds);
    } else if (it < C7) {
      int i2 = it - C6;
      for (int i = 0; i < 16; ++i) {
        int e = i2 * 4096 + i * 256 + tid;
        p.sgW[e] = f2bf(p.sg_w[e]);
      }
    } else if (it < C8) {
      int i2 = it - C7, l = i2 / 96, cb = i2 % 96;
      for (int e = tid; e < 9 * 1024; e += 256) {
        int s = e >> 10, k = e & 1023;
        float v = s < 8 ? p.c[s * 1024 + k] : p.c_ctx[k];
        lds[e] = siluf_(v);
      }
      __syncthreads();
      const int col = tid & 63, kq = tid >> 6;
      const int n = cb * 64 + col;
      float acc[9];
#pragma unroll
      for (int s = 0; s < 9; ++s) acc[s] = 0.f;
      const float* wp = p.ada_w + (size_t)l * 1024 * 6144 + n;
#pragma unroll 4
      for (int k = kq * 256; k < kq * 256 + 256; ++k) {
        float w = wp[(size_t)k * 6144];
#pragma unroll
        for (int s = 0; s < 9; ++s) acc[s] += lds[s * 1024 + k] * w;
      }
      __syncthreads();
      float* red = lds + 9216;
#pragma unroll
      for (int s = 0; s < 9; ++s) red[(kq * 9 + s) * 64 + col] = acc[s];
      __syncthreads();
      for (int e = tid; e < 9 * 64; e += 256) {
        int s = e >> 6, cc = e & 63;
        float v = red[(0 * 9 + s) * 64 + cc] + red[(1 * 9 + s) * 64 + cc] + red[(2 * 9 + s) * 64 + cc] + red[(3 * 9 + s) * 64 + cc];
        int nn = cb * 64 + cc;
        p.mods[((size_t)l * 9 + s) * 6144 + nn] = v + p.ada_b[l * 6144 + nn];
      }
      __syncthreads();
    } else {
      for (int e = tid; e < 1024; e += 256) {
        int pos = e >> 4, i = e & 15;
        float inv = powf(10000.f, -(float)i / 16.f);
        float ang = (float)pos * inv;
        p.rope[e * 2] = cosf(ang);
        p.rope[e * 2 + 1] = sinf(ang);
      }
      if (tid < 64) p.cnt[tid] = 0;
    }
  }
}

DEV void norm_phase(const P& p, int l, const float* __restrict__ g, int shoff, int scoff, int row_lo, bool from_input) {
  const int tid = tid_l();
  const int lane = tid & 63;
  const int gw = bid_l() * 4 + (tid >> 6), nw = gridDim.x * 4;
  const float* lat = from_input ? p.x : p.out;
  const float* cx = from_input ? p.ctx : p.xc;
  for (int r0 = row_lo + gw; r0 < MT; r0 += 4 * nw) {
    float4 v[4][4];
#pragma unroll
    for (int u = 0; u < 4; ++u) {
      const int r = r0 + u * nw;
      if (r < MT) {
        const float* src = r < MC ? cx + (size_t)r * DM : lat + (size_t)(r - MC) * DM;
#pragma unroll
        for (int i = 0; i < 4; ++i) v[u][i] = *(const float4*)(src + i * 256 + lane * 4);
      }
    }
#pragma unroll
    for (int u = 0; u < 4; ++u) {
      const int r = r0 + u * nw;
      if (r < MT) {
        const int s = r < MC ? 8 : (r - MC) >> 12;
        const float* md = p.mods + ((size_t)l * 9 + s) * 6144;
        float ss = 0.f;
#pragma unroll
        for (int i = 0; i < 4; ++i) ss += v[u][i].x * v[u][i].x + v[u][i].y * v[u][i].y + v[u][i].z * v[u][i].z + v[u][i].w * v[u][i].w;
        ss = wave_sum(ss);
        const float rstd = rsqrtf(ss * (1.f / DM) + 1e-6f);
#pragma unroll
        for (int i = 0; i < 4; ++i) {
          const int c = i * 256 + lane * 4;
          float4 gg = *(const float4*)(g + c);
          float4 sh = *(const float4*)(md + shoff + c);
          float4 sc = *(const float4*)(md + scoff + c);
          float o0 = v[u][i].x * rstd * gg.x * (1.f + sc.x) + sh.x;
          float o1 = v[u][i].y * rstd * gg.y * (1.f + sc.y) + sh.y;
          float o2 = v[u][i].z * rstd * gg.z * (1.f + sc.z) + sh.z;
          float o3 = v[u][i].w * rstd * gg.w * (1.f + sc.w) + sh.w;
          uint2 o;
          o.x = pk2(o0, o1);
          o.y = pk2(o2, o3);
          *(uint2*)(p.act + (size_t)r * DM + c) = o;
        }
      }
    }
  }
}

DEV void final_norm(const P& p) {
  const int tid = tid_l();
  const int lane = tid & 63;
  const int gw = bid_l() * 4 + (tid >> 6), nw = gridDim.x * 4;
  for (int r0 = gw; r0 < ML; r0 += 4 * nw) {
    float4 v[4][4];
#pragma unroll
    for (int u = 0; u < 4; ++u) {
      const int r = r0 + u * nw;
      if (r < ML) {
#pragma unroll
        for (int i = 0; i < 4; ++i) v[u][i] = *(const float4*)(p.out + (size_t)r * DM + i * 256 + lane * 4);
      }
    }
#pragma unroll
    for (int u = 0; u < 4; ++u) {
      const int r = r0 + u * nw;
      if (r < ML) {
        const float rstd = rsqrtf(p.rss1[MC + r] * (1.f / DM) + 1e-6f);
#pragma unroll
        for (int i = 0; i < 4; ++i) {
          const int c = i * 256 + lane * 4;
          float4 gg = *(const float4*)(p.fng + c);
          float4 o;
          o.x = v[u][i].x * rstd * gg.x;
          o.y = v[u][i].y * rstd * gg.y;
          o.z = v[u][i].z * rstd * gg.z;
          o.w = v[u][i].w * rstd * gg.w;
          *(float4*)(p.out + (size_t)r * DM + c) = o;
        }
      }
    }
  }
}

DEV void phase0b(const P& p, char* smem) {
  float* lds = (float*)smem;
  const int tid = tid_l(), lane = tid & 63;
  for (int it = bid_l(); it < 512; it += gridDim.x) {
    const bool isz = it < 160;
    const int i2 = isz ? it : it - 160;
    const int l = isz ? i2 / 40 : i2 / 88, cb = isz ? i2 % 40 : i2 % 88;
    const int N = isz ? 2560 : 5632;
    const float* W = isz ? p.w_in + (size_t)l * 1024 * 2560 : p.w1 + (size_t)l * 1024 * 5632;
    for (int e = tid; e < 9 * 1024; e += 256) {
      const int s9 = e >> 10, k = e & 1023;
      lds[e] = p.mods[((size_t)l * 9 + s9) * 6144 + (isz ? 0 : 3072) + k];
    }
    __syncthreads();
    const int col = tid & 63, kq = tid >> 6;
    const int n = cb * 64 + col;
    float acc[9];
#pragma unroll
    for (int s9 = 0; s9 < 9; ++s9) acc[s9] = 0.f;
    const float* wp = W + n;
#pragma unroll 4
    for (int k = kq * 256; k < kq * 256 + 256; ++k) {
      const float w = wp[(size_t)k * N];
#pragma unroll
      for (int s9 = 0; s9 < 9; ++s9) acc[s9] += lds[s9 * 1024 + k] * w;
    }
    __syncthreads();
    float* red = lds + 9216;
#pragma unroll
    for (int s9 = 0; s9 < 9; ++s9) red[(kq * 9 + s9) * 64 + col] = acc[s9];
    __syncthreads();
    for (int e = tid; e < 9 * 64; e += 256) {
      const int s9 = e >> 6, cc = e & 63;
      const float v = red[(0 * 9 + s9) * 64 + cc] + red[(1 * 9 + s9) * 64 + cc] + red[(2 * 9 + s9) * 64 + cc] + red[(3 * 9 + s9) * 64 + cc];
      const int gn = cb * 64 + cc;
      if (isz) p.bz[((size_t)l * 9 + s9) * 2560 + gn] = v;
      else {
        const int j = gn < DFF ? gn : gn - DFF;
        const int np = (j >> 4) * 32 + (j & 15) + (gn < DFF ? 0 : 16);
        p.bh[((size_t)l * 9 + s9) * 5632 + np] = v;
      }
    }
    __syncthreads();
  }
  const int gw = bid_l() * 4 + (tid >> 6), nw = gridDim.x * 4;
  for (int r0 = gw; r0 < MT; r0 += 4 * nw) {
    float4 v[4][4];
#pragma unroll
    for (int u = 0; u < 4; ++u) {
      const int r = r0 + u * nw;
      if (r < MT) {
        const float* src = r < MC ? p.ctx + (size_t)r * DM : p.x + (size_t)(r - MC) * DM;
#pragma unroll
        for (int i = 0; i < 4; ++i) v[u][i] = *(const float4*)(src + i * 256 + lane * 4);
      }
    }
#pragma unroll
    for (int u = 0; u < 4; ++u) {
      const int r = r0 + u * nw;
      if (r < MT) {
        const int s9 = r < MC ? 8 : (r - MC) >> 12;
        const float* md = p.mods + (size_t)s9 * 6144 + 1024;
        float ss = 0.f;
#pragma unroll
        for (int i = 0; i < 4; ++i) ss += v[u][i].x * v[u][i].x + v[u][i].y * v[u][i].y + v[u][i].z * v[u][i].z + v[u][i].w * v[u][i].w;
        ss = wave_sum(ss);
        if (lane == 0) p.rss1[r] = ss;
#pragma unroll
        for (int i = 0; i < 4; ++i) {
          const int c = i * 256 + lane * 4;
          const float4 gg = *(const float4*)(p.n1g + c);
          const float4 sc = *(const float4*)(md + c);
          *(uint2*)(p.act + (size_t)r * DM + c) =
              make_uint2(pk2(v[u][i].x * gg.x * (1.f + sc.x), v[u][i].y * gg.y * (1.f + sc.y)),
                         pk2(v[u][i].z * gg.z * (1.f + sc.z), v[u][i].w * gg.w * (1.f + sc.w)));
        }
      }
    }
  }
}

enum { EPI_Z = 0, EPI_RES = 1, EPI_SWIGLU = 2 };
struct GX { float* rss_acc; u16* aout; const float* gnext; int lmod; int scoff; };

template <int EPI>
DEV void gemm_phase(const P& p, int l, const u16* __restrict__ A, int lda, const u16* __restrict__ Bt, int K, int NT,
                           int mt_lo, int goff, char* smem, GX gx, int dry = 0) {
  const int tid = tid_l(), lane = tid & 63, wid = tid >> 6, wr = wid >> 1, wc = wid & 1, l15 = lane & 15, quad = lane >> 4;
  const int nmt = NMT - mt_lo;
  const int nk = K / 64;
  const int npn = NT >> 2;
  const int npatch = (nmt >> 4) * npn;
  const int tmax = ((npatch + 7) >> 3) * 512;
#define G_MAP(T, OK, M0, N0)                                                                        \
  {                                                                                                 \
    const int xcd_ = (T)&7, sidx_ = (T) >> 3;                                                       \
    const int gp_ = (sidx_ >> 6) * 8 + xcd_;                                                        \
    OK = (T) < tmax && gp_ < npatch;                                                                \
    const int within_ = sidx_ & 63;                                                                 \
    M0 = (mt_lo + (gp_ / npn) * 16 + (within_ & 15)) * 128;                                         \
    N0 = ((gp_ % npn) * 4 + (within_ >> 4)) * 128;                                                  \
  }
  uint4 xa0, xa1, xa2, xa3, xb0, xb1, xb2, xb3, ya0, ya1, ya2, ya3, yb0, yb1, yb2, yb3;
  int t = bid_l();
  bool have;
  int m0, n0;
  G_MAP(t, have, m0, n0);
  const u16* Ag = A + (size_t)(m0 + (tid >> 3)) * lda + (tid & 7) * 8;
  const u16* Bg = Bt + (size_t)(n0 + (tid >> 3)) * K + (tid & 7) * 8;
  bool primed = false;
  while (have) {
    f32x4 acc[4][4];
#pragma unroll
    for (int i = 0; i < 4; ++i)
#pragma unroll
      for (int j = 0; j < 4; ++j) acc[i][j] = f32x4{0.f, 0.f, 0.f, 0.f};
#define G_GL(P, KT)                                                          \
    {                                                                        \
      const int k0_ = (KT)*64;                                               \
      P##a0 = *(const uint4*)(Ag + k0_);                                     \
      P##b0 = *(const uint4*)(Bg + k0_);                                     \
      P##a1 = *(const uint4*)(Ag + (size_t)32 * lda + k0_);                  \
      P##b1 = *(const uint4*)(Bg + (size_t)32 * K + k0_);                    \
      P##a2 = *(const uint4*)(Ag + (size_t)64 * lda + k0_);                  \
      P##b2 = *(const uint4*)(Bg + (size_t)64 * K + k0_);                    \
      P##a3 = *(const uint4*)(Ag + (size_t)96 * lda + k0_);                  \
      P##b3 = *(const uint4*)(Bg + (size_t)96 * K + k0_);                    \
    }
#define G_LS(P, BUF)                                                         \
    {                                                                        \
      char* Aw_ = smem + (BUF)*32768;                                        \
      *(uint4*)(Aw_ + swz((tid >> 3), tid & 7)) = P##a0;                     \
      *(uint4*)(Aw_ + 16384 + swz((tid >> 3), tid & 7)) = P##b0;             \
      *(uint4*)(Aw_ + swz((tid >> 3) + 32, tid & 7)) = P##a1;                \
      *(uint4*)(Aw_ + 16384 + swz((tid >> 3) + 32, tid & 7)) = P##b1;        \
      *(uint4*)(Aw_ + swz((tid >> 3) + 64, tid & 7)) = P##a2;                \
      *(uint4*)(Aw_ + 16384 + swz((tid >> 3) + 64, tid & 7)) = P##b2;        \
      *(uint4*)(Aw_ + swz((tid >> 3) + 96, tid & 7)) = P##a3;                \
      *(uint4*)(Aw_ + 16384 + swz((tid >> 3) + 96, tid & 7)) = P##b3;        \
    }
#define G_COMPUTE(BUF)                                                                                             \
    {                                                                                                              \
      const char* As = smem + (BUF)*32768;                                                                         \
      const char* Bs = As + 16384;                                                                                 \
      _Pragma("unroll") for (int kh = 0; kh < 2; ++kh) {                                                           \
        bf16x8 a[4], b[4];                                                                                         \
        _Pragma("unroll") for (int mi = 0; mi < 4; ++mi)                                                           \
            a[mi] = *(const bf16x8*)(As + swz(wr * 64 + mi * 16 + l15, kh * 4 + quad));                            \
        _Pragma("unroll") for (int ni = 0; ni < 4; ++ni)                                                           \
            b[ni] = *(const bf16x8*)(Bs + swz(wc * 64 + ni * 16 + l15, kh * 4 + quad));                            \
        _Pragma("unroll") for (int mi = 0; mi < 4; ++mi)                                                           \
            _Pragma("unroll") for (int ni = 0; ni < 4; ++ni) acc[mi][ni] = mfma16(b[ni], a[mi], acc[mi][ni]);      \
      }                                                                                                            \
    }
    if (!primed) {
      G_GL(x, 0);
      G_GL(y, 1);
    }
    G_LS(x, 0);
    if (2 < nk) G_GL(x, 2);
    __syncthreads();
    for (int kt = 0; kt < nk; kt += 2) {
      G_COMPUTE(0);
      G_LS(y, 1);
      if (kt + 3 < nk) G_GL(y, kt + 3);
      __syncthreads();
      G_COMPUTE(1);
      if (kt + 2 < nk) G_LS(x, 0);
      if (kt + 4 < nk) G_GL(x, kt + 4);
      __syncthreads();
    }
    const int em0 = m0, en0 = n0;
    t += gridDim.x;
    G_MAP(t, have, m0, n0);
    if (have) {
      Ag = A + (size_t)(m0 + (tid >> 3)) * lda + (tid & 7) * 8;
      Bg = Bt + (size_t)(n0 + (tid >> 3)) * K + (tid & 7) * 8;
      G_GL(x, 0);
      G_GL(y, 1);
      primed = true;
    }
    if (dry) {
      if (acc[0][0][0] == 1.2345e33f) p.bonus[0] = acc[1][1][1] + acc[2][2][2] + acc[3][3][3];
      continue;
    }
    const int cw0 = en0 + wc * 64;
    if constexpr (EPI == EPI_Z || EPI == EPI_SWIGLU) {
      const int sb_ = em0 < MC ? 8 : (em0 - MC) >> 12;
      const float* rssp = EPI == EPI_Z ? p.rss1 : p.rss2;
      const float* bias = EPI == EPI_Z ? p.bz + ((size_t)l * 9 + sb_) * 2560 + cw0 : p.bh + ((size_t)l * 9 + sb_) * 5632 + cw0;
      float rsv[4];
#pragma unroll
      for (int mi = 0; mi < 4; ++mi) rsv[mi] = rsqrtf(rssp[em0 + wr * 64 + mi * 16 + l15] * (1.f / DM) + 1e-6f);
#pragma unroll
      for (int ni = 0; ni < 4; ++ni) {
        const float4 bb = *(const float4*)(bias + ni * 16 + quad * 4);
#pragma unroll
        for (int mi = 0; mi < 4; ++mi) {
          acc[mi][ni][0] = acc[mi][ni][0] * rsv[mi] + bb.x;
          acc[mi][ni][1] = acc[mi][ni][1] * rsv[mi] + bb.y;
          acc[mi][ni][2] = acc[mi][ni][2] * rsv[mi] + bb.z;
          acc[mi][ni][3] = acc[mi][ni][3] * rsv[mi] + bb.w;
        }
      }
    }
    if constexpr (EPI == EPI_Z) {
      if (cw0 < 1920) {
#pragma unroll
        for (int mi = 0; mi < 4; ++mi) {
          const int r = em0 + wr * 64 + mi * 16 + l15;
#pragma unroll
          for (int ni = 0; ni < 4; ++ni)
            *(uint2*)(p.z + (size_t)r * INC + cw0 + ni * 16 + quad * 4) =
                make_uint2(pk2(acc[mi][ni][0], acc[mi][ni][1]), pk2(acc[mi][ni][2], acc[mi][ni][3]));
          __builtin_amdgcn_sched_barrier(0);
        }
      } else {
        const int hh = (cw0 - 1920) >> 6;
        if (hh < 8) {
          const float* gp = (hh < 6 ? p.q_g : p.k_g) + l * 64;
          float4 gv[4];
#pragma unroll
          for (int ni = 0; ni < 4; ++ni) gv[ni] = *(const float4*)(gp + ni * 16 + quad * 4);
          const float qs = hh < 6 ? 0.125f : 1.f;
#pragma unroll
          for (int mi = 0; mi < 4; ++mi) {
            const int r = em0 + wr * 64 + mi * 16 + l15;
            float ss = 0.f;
#pragma unroll
            for (int ni = 0; ni < 4; ++ni)
#pragma unroll
              for (int j = 0; j < 4; ++j) ss += acc[mi][ni][j] * acc[mi][ni][j];
            ss += __shfl_xor(ss, 16);
            ss += __shfl_xor(ss, 32);
            const float rstd = rsqrtf(ss * (1.f / 64.f) + 1e-6f) ;
            float yv[4][4];
#pragma unroll
            for (int ni = 0; ni < 4; ++ni) {
              yv[ni][0] = acc[mi][ni][0] * rstd * gv[ni].x;
              yv[ni][1] = acc[mi][ni][1] * rstd * gv[ni].y;
              yv[ni][2] = acc[mi][ni][2] * rstd * gv[ni].z;
              yv[ni][3] = acc[mi][ni][3] * rstd * gv[ni].w;
            }
            if (r >= MC) {
              const int tt = (r - MC) & 4095;
              const int prow = tt >> 6, pcol = tt & 63;
              const float* rr_ = p.rope + (prow * 16 + quad * 4) * 2;
              const float* rc_ = p.rope + (pcol * 16 + quad * 4) * 2;
              const float4 ra = *(const float4*)rr_, rb = *(const float4*)(rr_ + 4);
              const float4 ca = *(const float4*)rc_, cb = *(const float4*)(rc_ + 4);
              const float cr[4] = {ra.x, ra.z, rb.x, rb.z}, sr[4] = {ra.y, ra.w, rb.y, rb.w};
              const float cc[4] = {ca.x, ca.z, cb.x, cb.z}, sc[4] = {ca.y, ca.w, cb.y, cb.w};
#pragma unroll
              for (int j = 0; j < 4; ++j) {
                const float a0 = yv[0][j] * cr[j] - yv[1][j] * sr[j], a1 = yv[1][j] * cr[j] + yv[0][j] * sr[j];
                const float a2 = yv[2][j] * cc[j] - yv[3][j] * sc[j], a3 = yv[3][j] * cc[j] + yv[2][j] * sc[j];
                yv[0][j] = a0; yv[1][j] = a1; yv[2][j] = a2; yv[3][j] = a3;
              }
            }
#pragma unroll
            for (int ni = 0; ni < 4; ++ni)
              *(uint2*)(p.z + (size_t)r * INC + cw0 + ni * 16 + quad * 4) =
                  make_uint2(pk2(yv[ni][0] * qs, yv[ni][1] * qs), pk2(yv[ni][2] * qs, yv[ni][3] * qs));
            __builtin_amdgcn_sched_barrier(0);
          }
        } else {
          const int kvh = hh - 8;
#pragma unroll
          for (int mi = 0; mi < 4; ++mi) {
            const int r = em0 + wr * 64 + mi * 16 + l15;
            u16* vb;
            int vstride;
            if (r < MC) { vb = p.vTc + ((size_t)(((r >> 8) * 2 + kvh) * 64)) * CTXL + (r & 255); vstride = CTXL; }
            else { const int rr = r - MC; vb = p.vTl + ((size_t)(((rr >> 12) * 2 + kvh) * 64)) * SEQ + (rr & 4095); vstride = SEQ; }
#pragma unroll
            for (int ni = 0; ni < 4; ++ni)
#pragma unroll
              for (int j = 0; j < 4; ++j) vb[(size_t)(ni * 16 + quad * 4 + j) * vstride] = f2bf(acc[mi][ni][j]);
            __builtin_amdgcn_sched_barrier(0);
          }
        }
      }
    } else if constexpr (EPI == EPI_RES) {
      const int s = em0 < MC ? 8 : (em0 - MC) >> 12;
      const float* gate = p.mods + ((size_t)l * 9 + s) * 6144 + goff;
      float4 gv[4], gm[4];
#pragma unroll
      for (int ni = 0; ni < 4; ++ni) {
        gv[ni] = *(const float4*)(gate + cw0 + ni * 16 + quad * 4);
        gm[ni] = make_float4(0.f, 0.f, 0.f, 0.f);
        if (gx.aout) {
          const float4 g4 = *(const float4*)(gx.gnext + cw0 + ni * 16 + quad * 4);
          const float4 s4 = *(const float4*)(p.mods + ((size_t)gx.lmod * 9 + s) * 6144 + gx.scoff + cw0 + ni * 16 + quad * 4);
          gm[ni] = make_float4(g4.x * (1.f + s4.x), g4.y * (1.f + s4.y), g4.z * (1.f + s4.z), g4.w * (1.f + s4.w));
        }
      }
#pragma unroll
      for (int mi = 0; mi < 4; ++mi) {
        const int r = em0 + wr * 64 + mi * 16 + l15;
        const float* src;
        if (l == 0 && goff == 2048) src = r < MC ? p.ctx + (size_t)r * DM : p.x + (size_t)(r - MC) * DM;
        else src = r < MC ? p.xc + (size_t)r * DM : p.out + (size_t)(r - MC) * DM;
        float* dst = r < MC ? p.xc + (size_t)r * DM : p.out + (size_t)(r - MC) * DM;
        float ssq = 0.f;
#pragma unroll
        for (int ni = 0; ni < 4; ++ni) {
          const int c = cw0 + ni * 16 + quad * 4;
          const float4 xv = *(const float4*)(src + c);
          float4 o;
          o.x = xv.x + gv[ni].x * acc[mi][ni][0];
          o.y = xv.y + gv[ni].y * acc[mi][ni][1];
          o.z = xv.z + gv[ni].z * acc[mi][ni][2];
          o.w = xv.w + gv[ni].w * acc[mi][ni][3];
          *(float4*)(dst + c) = o;
          ssq += o.x * o.x + o.y * o.y + o.z * o.z + o.w * o.w;
          if (gx.aout) {
            *(uint2*)(gx.aout + (size_t)r * DM + c) =
                make_uint2(pk2(o.x * gm[ni].x, o.y * gm[ni].y), pk2(o.z * gm[ni].z, o.w * gm[ni].w));
          }
        }
        ssq += __shfl_xor(ssq, 16);
        ssq += __shfl_xor(ssq, 32);
        if (quad == 0) unsafeAtomicAdd(gx.rss_acc + r, ssq);
        __builtin_amdgcn_sched_barrier(0);
      }
    } else {
      const int hc0 = (en0 >> 1) + wc * 32;
#pragma unroll
      for (int mi = 0; mi < 4; ++mi) {
        const int r = em0 + wr * 64 + mi * 16 + l15;
#pragma unroll
        for (int pp = 0; pp < 2; ++pp) {
          float hv[4];
#pragma unroll
          for (int j = 0; j < 4; ++j) hv[j] = siluf_(acc[mi][2 * pp][j]) * acc[mi][2 * pp + 1][j];
          *(uint2*)(p.h + (size_t)r * DFF + hc0 + pp * 16 + quad * 4) = make_uint2(pk2(hv[0], hv[1]), pk2(hv[2], hv[3]));
        }
        __builtin_amdgcn_sched_barrier(0);
      }
    }
  }
}
#undef G_GL
#undef G_LS
#undef G_COMPUTE
#undef G_MAP

template <int LPR>
DEV float red_lpr(float v) {
  v += dppf<0xB1>(v);
  v += dppf<0x4E>(v);
  if (LPR >= 8) v += dppf<0x141>(v);
  if (LPR >= 16) v += dppf<0x140>(v);
  return v;
}

constexpr int SCAN_LPR = 8;
constexpr int SCAN_RPB = 256 / SCAN_LPR;
constexpr int SCAN_NPART = 64 / SCAN_RPB;
constexpr int SCAN_JL = 64 / SCAN_LPR;
constexpr int SCAN_ITEMS = 96 * SCAN_NPART;

DEV float red8_sum(float v) {
  v += dppf<0xB1>(v);
  v += dppf<0x4E>(v);
  v += dppf<0x141>(v);
  return v;
}
DEV float tanh_fast(float x) {
  float e = __expf(2.f * x);
  return 1.f - 2.f * __builtin_amdgcn_rcpf(1.f + e);
}

struct ChunkPos { int len, rowbase, tlo; };
DEV ChunkPos chunk_pos(int c, int d, int b) {
  ChunkPos cp;
  const int s0 = c * 16;
  int pos0;
  if (s0 < 256) { cp.len = 256; pos0 = s0; cp.rowbase = b * 256; }
  else { cp.len = 4096; pos0 = s0 - 256; cp.rowbase = MC + b * 4096; }
  cp.tlo = d ? (cp.len - 16 - pos0) : pos0;
  return cp;
}

constexpr int SC_R = 0, SC_KD = 12288, SC_V = 24576, SC_W = 30720, SC_KA = 38912, SC_NKK = 47104;

DEV void cvt8(const uint4 u, float4& lo, float4& hi) {
  lo.x = __uint_as_float(u.x << 16); lo.y = __uint_as_float(u.x & 0xffff0000u);
  lo.z = __uint_as_float(u.y << 16); lo.w = __uint_as_float(u.y & 0xffff0000u);
  hi.x = __uint_as_float(u.z << 16); hi.y = __uint_as_float(u.z & 0xffff0000u);
  hi.z = __uint_as_float(u.w << 16); hi.w = __uint_as_float(u.w & 0xffff0000u);
}

DEV void scan_item(const P& p, int l, int item, char* smem) {
  const int tid = tid_l(), lane = tid & 63, wid = tid >> 6, l15 = lane & 15, quad = lane >> 4;
  constexpr int LPR = SCAN_LPR, RPB = SCAN_RPB, JL = SCAN_JL, NV = RPB / 8;
  const int scan = item / SCAN_NPART, part = item % SCAN_NPART;
  const int d = scan / 48, b = (scan % 48) / 6, h = scan % 6;
  const int rloc = tid / LPR, jq = tid % LPR;
  const int irow = part * RPB + rloc;
  const int j0 = jq * JL;

  const int c_ts = (tid & 127) >> 3, c_ch = tid & 7;
  const int c_col = (tid < 128 ? 0 : 384) + h * 64 + c_ch * 8;
  const int v_ts = tid / NV, v_ch = tid % NV;
  const int v_col = 768 + h * 64 + part * RPB + v_ch * 8;

  const int n2 = wid * 16 + l15;
  bf16x8 bW[2], bA[2];
  {
    const u16* wb = p.wUpT + ((size_t)(l * 2 + d) * 384 + h * 64 + n2) * 64 + quad * 8;
    const u16* ab = p.aUpT + ((size_t)(l * 2 + d) * 384 + h * 64 + n2) * 64 + quad * 8;
    bW[0] = *(const bf16x8*)(wb);
    bW[1] = *(const bf16x8*)(wb + 32);
    bA[0] = *(const bf16x8*)(ab);
    bA[1] = *(const bf16x8*)(ab + 32);
  }
  const float w0v = p.w0[(size_t)(l * 2 + d) * 384 + h * 64 + n2];
  const float a0v = p.a0[(size_t)(l * 2 + d) * 384 + h * 64 + n2];
  const float kkc = p.k_k[l * 384 + h * 64 + n2], kac = p.k_a[l * 384 + h * 64 + n2], rkc = p.r_k[l * 384 + h * 64 + n2];

  float2v S2[JL / 2];
#pragma unroll
  for (int j = 0; j < JL / 2; ++j) S2[j] = float2v{0.f, 0.f};
  uint4 g_rk, g_v;
  bf16x8 g_wd0, g_wd1, g_ad0, g_ad1;
  float g_inv[4];

#define SC_GLOAD1(CC)                                                                                  \
  {                                                                                                    \
    const ChunkPos cp_ = chunk_pos((CC), d, b);                                                        \
    g_rk = *(const uint4*)(p.z + (size_t)(cp_.rowbase + cp_.tlo + c_ts) * INC + c_col);                \
    if (tid < 16 * NV) g_v = *(const uint4*)(p.z + (size_t)(cp_.rowbase + cp_.tlo + v_ts) * INC + v_col);  \
  }
#define SC_GLOAD2(CC)                                                                                  \
  {                                                                                                    \
    const ChunkPos cp_ = chunk_pos((CC), d, b);                                                        \
    const u16* rp_ = p.z + (size_t)(cp_.rowbase + cp_.tlo + l15) * INC + 1152 + quad * 8;              \
    g_wd0 = *(const bf16x8*)(rp_);                                                                     \
    g_wd1 = *(const bf16x8*)(rp_ + 32);                                                                \
    g_ad0 = *(const bf16x8*)(rp_ + 64);                                                                \
    g_ad1 = *(const bf16x8*)(rp_ + 96);                                                                \
    _Pragma("unroll") for (int j = 0; j < 4; ++j)                                                      \
      g_inv[j] = p.invn[(size_t)(cp_.rowbase + cp_.tlo + quad * 4 + j) * 8 + h];                       \
  }
#define SC_STAGE1(CC)                                                                                  \
  {                                                                                                    \
    const int i3_ = (CC) % 3;                                                                          \
    float4 lo_, hi_;                                                                                   \
    cvt8(g_rk, lo_, hi_);                                                                              \
    float* dst_ = (float*)(smem + (tid < 128 ? SC_R : SC_KD) + i3_ * 4096) + c_ts * 64 + c_ch * 8;     \
    *(float4*)dst_ = lo_;                                                                              \
    *(float4*)(dst_ + 4) = hi_;                                                                        \
    if (tid < 16 * NV) {                                                                               \
      cvt8(g_v, lo_, hi_);                                                                             \
      float* dv_ = (float*)(smem + SC_V + i3_ * 2048) + v_ts * RPB + v_ch * 8;                         \
      *(float4*)dv_ = lo_;                                                                             \
      *(float4*)(dv_ + 4) = hi_;                                                                       \
    }                                                                                                  \
  }
#define SC_STAGE2(CC)                                                                                  \
  {                                                                                                    \
    const int i3_ = (CC) % 3, i2_ = (CC)&1;                                                            \
    const ChunkPos cp_ = chunk_pos((CC), d, b);                                                        \
    f32x4 accW = f32x4{0.f, 0.f, 0.f, 0.f}, accA = f32x4{0.f, 0.f, 0.f, 0.f};                          \
    accW = mfma16(g_wd0, bW[0], accW);                                                                 \
    accW = mfma16(g_wd1, bW[1], accW);                                                                 \
    accA = mfma16(g_ad0, bA[0], accA);                                                                 \
    accA = mfma16(g_ad1, bA[1], accA);                                                                 \
    float bon_[4];                                                                                     \
    _Pragma("unroll") for (int j = 0; j < 4; ++j) {                                                    \
      const int ts = quad * 4 + j;                                                                     \
      float* kdp = (float*)(smem + SC_KD + i3_ * 4096) + ts * 64 + n2;                                 \
      const float kv = *kdp;                                                                           \
      const float rv = *((const float*)(smem + SC_R + i3_ * 4096) + ts * 64 + n2);                     \
      const float sg = sigmoidf_(w0v + accW[j]);                                                       \
      const float wv = __expf(-0.6065306597126334f * sg);                                              \
      const float av = sigmoidf_(a0v + accA[j]);                                                       \
      const float kn = kv * kkc * g_inv[j];                                                            \
      const float kd = kv * (1.f + (av - 1.f) * kac);                                                  \
      *((float*)(smem + SC_W + i2_ * 4096) + ts * 64 + n2) = wv;                                       \
      *((float*)(smem + SC_NKK + i2_ * 4096) + ts * 64 + n2) = -kn;                                    \
      *((float*)(smem + SC_KA + i2_ * 4096) + ts * 64 + n2) = kn * av;                                 \
      *kdp = kd;                                                                                       \
      bon_[j] = rv * kd * rkc;                                                                         \
    }                                                                                                  \
    _Pragma("unroll") for (int j = 0; j < 4; ++j) bon_[j] = red16_sum(bon_[j]);                        \
    if (l15 == 0 && part == 0) {                                                                       \
      _Pragma("unroll") for (int j = 0; j < 4; ++j)                                                    \
        p.bonus[(size_t)(cp_.rowbase + cp_.tlo + quad * 4 + j) * 48 + (d * 6 + h) * 4 + wid] = bon_[j]; \
    }                                                                                                  \
  }

  __builtin_amdgcn_s_setprio(3);
  SC_GLOAD1(0);
  SC_GLOAD2(0);
  SC_STAGE1(0);
  SC_GLOAD1(1);
  __syncthreads();
  SC_STAGE2(0);
  SC_STAGE1(1);
  SC_GLOAD1(2);
  SC_GLOAD2(1);
  __syncthreads();

  for (int c = 0; c < 272; ++c) {
    {
      const int i3 = c % 3, i2 = c & 1;
      const ChunkPos cp = chunk_pos(c, d, b);
      const float* pW = (const float*)(smem + SC_W + i2 * 4096) + j0;
      const float* pN = (const float*)(smem + SC_NKK + i2 * 4096) + j0;
      const float* pA = (const float*)(smem + SC_KA + i2 * 4096) + j0;
      const float* pD = (const float*)(smem + SC_KD + i3 * 4096) + j0;
      const float* pR = (const float*)(smem + SC_R + i3 * 4096) + j0;
      const float* pV = (const float*)(smem + SC_V + i3 * 2048) + rloc;
      float* yp = p.y + ((size_t)d * MT + cp.rowbase + cp.tlo) * 384 + h * 64 + irow;
      float yk0 = 0.f, yk1 = 0.f;
      constexpr int NQ = JL / 4;
      float4 cw[NQ], cn[NQ], ca[NQ], cd[NQ], cr[NQ];
      float cvi;
#define SC_LD(TS, W, N, A, D, R, VI)                                                             \
      _Pragma("unroll") for (int q = 0; q < NQ; ++q) {                                           \
        W[q] = *(const float4*)(pW + (TS)*64 + q * 4); N[q] = *(const float4*)(pN + (TS)*64 + q * 4); \
        A[q] = *(const float4*)(pA + (TS)*64 + q * 4); D[q] = *(const float4*)(pD + (TS)*64 + q * 4); \
        R[q] = *(const float4*)(pR + (TS)*64 + q * 4);                                           \
      }                                                                                          \
      VI = pV[(TS)*RPB];
      {
        const int ts0 = d ? 15 : 0;
        SC_LD(ts0, cw, cn, ca, cd, cr, cvi)
      }
#pragma unroll
      for (int si = 0; si < 16; ++si) {
        float4 xw[NQ], xn[NQ], xa[NQ], xd[NQ], xr[NQ];
        float xvi = 0.f;
        if (si + 1 < 16) {
          const int tsn = d ? 14 - si : si + 1;
          SC_LD(tsn, xw, xn, xa, xd, xr, xvi)
        }
        float2v sa2 = S2[0] * float2v{cn[0].x, cn[0].y};
        sa2 = S2[1] * float2v{cn[0].z, cn[0].w} + sa2;
        if constexpr (NQ == 2) {
          float2v sb2 = S2[2] * float2v{cn[1].x, cn[1].y};
          sb2 = S2[3] * float2v{cn[1].z, cn[1].w} + sb2;
          sa2 = sa2 + sb2;
        }
        const float2v viv = float2v{cvi, cvi};
        float2v u2[JL / 2];
#pragma unroll
        for (int q = 0; q < NQ; ++q) {
          u2[2 * q] = S2[2 * q] * float2v{cw[q].x, cw[q].y} + viv * float2v{cd[q].x, cd[q].y};
          u2[2 * q + 1] = S2[2 * q + 1] * float2v{cw[q].z, cw[q].w} + viv * float2v{cd[q].z, cd[q].w};
        }
        const float sa = LPR == 16 ? red16_sum(sa2.x + sa2.y) : red8_sum(sa2.x + sa2.y);
        const float2v sav = float2v{sa, sa};
#pragma unroll
        for (int q = 0; q < NQ; ++q) {
          S2[2 * q] = sav * float2v{ca[q].x, ca[q].y} + u2[2 * q];
          S2[2 * q + 1] = sav * float2v{ca[q].z, ca[q].w} + u2[2 * q + 1];
        }
        float2v y2 = S2[0] * float2v{cr[0].x, cr[0].y};
        y2 = S2[1] * float2v{cr[0].z, cr[0].w} + y2;
        if constexpr (NQ == 2) {
          float2v yb2 = S2[2] * float2v{cr[1].x, cr[1].y};
          yb2 = S2[3] * float2v{cr[1].z, cr[1].w} + yb2;
          y2 = y2 + yb2;
        }
        const float yv = LPR == 16 ? red16_sum(y2.x + y2.y) : red8_sum(y2.x + y2.y);
        if (si < LPR) yk0 = (jq == si) ? yv : yk0;
        else yk1 = (jq == si - LPR) ? yv : yk1;
        if (si + 1 < 16) {
#pragma unroll
          for (int q = 0; q < NQ; ++q) { cw[q] = xw[q]; cn[q] = xn[q]; ca[q] = xa[q]; cd[q] = xd[q]; cr[q] = xr[q]; }
          cvi = xvi;
        }
      }
#undef SC_LD
      {
        const int tsa = d ? 15 - jq : jq;
        yp[(size_t)tsa * 384] = yk0;
        if constexpr (LPR == 8) {
          const int tsb = d ? 7 - jq : 8 + jq;
          yp[(size_t)tsb * 384] = yk1;
        }
      }
    }
    if (c + 1 < 272) SC_STAGE2(c + 1);
    if (c + 2 < 272) SC_STAGE1(c + 2);
    if (c + 3 < 272) SC_GLOAD1(c + 3);
    if (c + 2 < 272) SC_GLOAD2(c + 2);
    __syncthreads();
  }
  __builtin_amdgcn_s_setprio(0);
#undef SC_GLOAD1
#undef SC_GLOAD2
#undef SC_STAGE1
#undef SC_STAGE2
}

DEV void attn_item(const P& p, int item, char* smem) {
  const int tid = tid_l(), lane = tid & 63, wid = tid >> 6, l15 = lane & 15, quad = lane >> 4;
  bool lat = item < 1536;
  int b, hq, qb;
  if (lat) { b = item / 192; int rem = item % 192; hq = rem / 32; qb = rem % 32; }
  else { int i2 = item - 1536; b = i2 / 12; int rem = i2 % 12; hq = rem / 2; qb = rem % 2; }
  const int kvh = hq / 3;
  const int qrow0 = lat ? MC + b * 4096 + qb * 128 : b * 256 + qb * 128;
  const int nkt = lat ? 68 : 4;
  const float LOG2E = 1.4426950408889634f;

  bf16x8 qf[2][2];
#pragma unroll
  for (int mi = 0; mi < 2; ++mi)
#pragma unroll
    for (int ks = 0; ks < 2; ++ks)
      qf[mi][ks] = *(const bf16x8*)(p.z + (size_t)(qrow0 + wid * 32 + mi * 16 + l15) * INC + 1920 + hq * 64 + ks * 32 + quad * 8);

  f32x4 Ot[2][4];
  float mrow[2], lpart[2];
#pragma unroll
  for (int mi = 0; mi < 2; ++mi) {
#pragma unroll
    for (int nd = 0; nd < 4; ++nd) Ot[mi][nd] = f32x4{0.f, 0.f, 0.f, 0.f};
    mrow[mi] = -1e30f;
    lpart[mi] = 0.f;
  }
  const int lrow = tid >> 3, lch = tid & 7;
  uint4 rk0, rk1, rv0, rv1;
#define ATT_GLOAD(KT)                                                                         \
  {                                                                                           \
    const int kt_ = (KT);                                                                     \
    const u16* kp;                                                                            \
    const u16* vp;                                                                            \
    int vstride;                                                                              \
    if (lat && kt_ < 64) {                                                                    \
      kp = p.z + (size_t)(MC + b * 4096 + kt_ * 64) * INC + 2304 + kvh * 64;                  \
      vp = p.vTl + (size_t)((b * 2 + kvh) * 64) * SEQ + kt_ * 64;                             \
      vstride = SEQ;                                                                          \
    } else {                                                                                  \
      const int kc = lat ? kt_ - 64 : kt_;                                                    \
      kp = p.z + (size_t)(b * 256 + kc * 64) * INC + 2304 + kvh * 64;                         \
      vp = p.vTc + (size_t)((b * 2 + kvh) * 64) * CTXL + kc * 64;                             \
      vstride = CTXL;                                                                         \
    }                                                                                         \
    rk0 = *(const uint4*)(kp + (size_t)(lrow)*INC + lch * 8);                                 \
    rk1 = *(const uint4*)(kp + (size_t)(lrow + 32) * INC + lch * 8);                          \
    rv0 = *(const uint4*)(vp + (size_t)(lrow)*vstride + lch * 8);                             \
    rv1 = *(const uint4*)(vp + (size_t)(lrow + 32) * vstride + lch * 8);                      \
  }
#define ATT_LSTORE(BUF)                                     \
  {                                                         \
    char* Kb_ = smem + (BUF)*16384;                         \
    *(uint4*)(Kb_ + swz(lrow, lch)) = rk0;                  \
    *(uint4*)(Kb_ + swz(lrow + 32, lch)) = rk1;             \
    *(uint4*)(Kb_ + 8192 + swz(lrow, lch)) = rv0;           \
    *(uint4*)(Kb_ + 8192 + swz(lrow + 32, lch)) = rv1;      \
  }
  ATT_GLOAD(0);
  ATT_LSTORE(0);
  __syncthreads();
  for (int kt = 0; kt < nkt; ++kt) {
    const int buf = kt & 1;
    if (kt + 1 < nkt) ATT_GLOAD(kt + 1);
    const char* Kb = smem + buf * 16384;
    const char* Vb = Kb + 8192;
    f32x4 St[2][4];
#pragma unroll
    for (int mi = 0; mi < 2; ++mi)
#pragma unroll
      for (int ni = 0; ni < 4; ++ni) St[mi][ni] = f32x4{0.f, 0.f, 0.f, 0.f};
#pragma unroll
    for (int ks = 0; ks < 2; ++ks) {
      bf16x8 kf[4];
#pragma unroll
      for (int ni = 0; ni < 4; ++ni) kf[ni] = *(const bf16x8*)(Kb + swz(ni * 16 + l15, ks * 4 + quad));
#pragma unroll
      for (int mi = 0; mi < 2; ++mi)
#pragma unroll
        for (int ni = 0; ni < 4; ++ni) St[mi][ni] = mfma16(kf[ni], qf[mi][ks], St[mi][ni]);
    }
    bf16x8 pf[2][2];
#pragma unroll
    for (int mi = 0; mi < 2; ++mi) {
      float mx = St[mi][0][0];
#pragma unroll
      for (int ni = 0; ni < 4; ++ni)
#pragma unroll
        for (int jj = 0; jj < 4; ++jj) mx = fmaxf(mx, St[mi][ni][jj]);
      mx = fmaxf(mx, __shfl_xor(mx, 16));
      mx = fmaxf(mx, __shfl_xor(mx, 32));
      const float mnew = fmaxf(mrow[mi], mx);
      const float alpha = __builtin_amdgcn_exp2f((mrow[mi] - mnew) * LOG2E);
      mrow[mi] = mnew;
      const float mb = mnew * LOG2E;
      float ps = 0.f;
      float pv[4][4];
#pragma unroll
      for (int ni = 0; ni < 4; ++ni)
#pragma unroll
        for (int jj = 0; jj < 4; ++jj) {
          pv[ni][jj] = __builtin_amdgcn_exp2f(St[mi][ni][jj] * LOG2E - mb);
          ps += pv[ni][jj];
        }
      lpart[mi] = lpart[mi] * alpha + ps;
#pragma unroll
      for (int nd = 0; nd < 4; ++nd) {
        Ot[mi][nd][0] *= alpha; Ot[mi][nd][1] *= alpha; Ot[mi][nd][2] *= alpha; Ot[mi][nd][3] *= alpha;
      }
#pragma unroll
      for (int s2 = 0; s2 < 2; ++s2) {
        union { unsigned u[4]; bf16x8 v; } pk;
        pk.u[0] = pk2(pv[2 * s2][0], pv[2 * s2][1]);
        pk.u[1] = pk2(pv[2 * s2][2], pv[2 * s2][3]);
        pk.u[2] = pk2(pv[2 * s2 + 1][0], pv[2 * s2 + 1][1]);
        pk.u[3] = pk2(pv[2 * s2 + 1][2], pv[2 * s2 + 1][3]);
        pf[mi][s2] = pk.v;
      }
    }
#pragma unroll
    for (int s2 = 0; s2 < 2; ++s2) {
      bf16x8 vf[4];
#pragma unroll
      for (int nd = 0; nd < 4; ++nd) {
        const int drow = nd * 16 + l15;
        union { uint2 h[2]; bf16x8 v; } vv;
        vv.h[0] = *(const uint2*)(Vb + swz(drow, 4 * s2 + (quad >> 1)) + (quad & 1) * 8);
        vv.h[1] = *(const uint2*)(Vb + swz(drow, 4 * s2 + 2 + (quad >> 1)) + (quad & 1) * 8);
        vf[nd] = vv.v;
      }
#pragma unroll
      for (int mi = 0; mi < 2; ++mi)
#pragma unroll
        for (int nd = 0; nd < 4; ++nd) Ot[mi][nd] = mfma16(vf[nd], pf[mi][s2], Ot[mi][nd]);
    }
    if (kt + 1 < nkt) ATT_LSTORE(buf ^ 1);
    __syncthreads();
  }
#undef ATT_GLOAD
#undef ATT_LSTORE
#pragma unroll
  for (int mi = 0; mi < 2; ++mi) {
    float lsum = lpart[mi];
    lsum += __shfl_xor(lsum, 16);
    lsum += __shfl_xor(lsum, 32);
    const float inv = 1.f / lsum;
    const int r = qrow0 + wid * 32 + mi * 16 + l15;
#pragma unroll
    for (int nd = 0; nd < 4; ++nd)
      *(uint2*)(p.act + (size_t)r * DM + 640 + hq * 64 + nd * 16 + quad * 4) =
          make_uint2(pk2(Ot[mi][nd][0] * inv, Ot[mi][nd][1] * inv), pk2(Ot[mi][nd][2] * inv, Ot[mi][nd][3] * inv));
  }
}

DEV void sgate_item(const P& p, int l, int ck, int g, char* smem) {
  const int tid = tid_l(), lane = tid & 63, wid = tid >> 6, l15 = lane & 15, quad = lane >> 4;
  const int m0 = ck * 128;
  u16* sVT = (u16*)smem;
  {
    const int q = tid >> 1, half = tid & 1;
    const u16* src = p.z + (size_t)(m0 + q) * INC + 1408 + 256 + g * 64 + half * 32;
    float v[32];
    float ss = 0.f;
#pragma unroll
    for (int cidx = 0; cidx < 4; ++cidx) {
      uint4 u = *(const uint4*)(src + cidx * 8);
      unsigned uu[4] = {u.x, u.y, u.z, u.w};
#pragma unroll
      for (int e = 0; e < 4; ++e) {
        float f0 = geluf_(bf2f((u16)(uu[e] & 0xffff)));
        float f1 = geluf_(bf2f((u16)(uu[e] >> 16)));
        v[cidx * 8 + e * 2] = f0;
        v[cidx * 8 + e * 2 + 1] = f1;
        ss += f0 * f0 + f1 * f1;
      }
    }
    ss += __shfl_xor(ss, 1);
    const float rstd = rsqrtf(ss * (1.f / 64.f) + 1e-6f);
    const float* gn = p.sgn + l * 256 + g * 64 + half * 32;
#pragma unroll
    for (int e = 0; e < 32; ++e) sVT[(half * 32 + e) * 136 + q] = f2bf(v[e] * rstd * gn[e]);
  }
  __syncthreads();
  f32x4 acc[2][4];
#pragma unroll
  for (int mi = 0; mi < 2; ++mi)
#pragma unroll
    for (int ni = 0; ni < 4; ++ni) acc[mi][ni] = f32x4{0.f, 0.f, 0.f, 0.f};
  const u16* Wg = p.sgW + (size_t)(l * 4 + g) * 128 * 128;
#pragma unroll
  for (int ks = 0; ks < 4; ++ks) {
    bf16x8 a[2], bb[4];
#pragma unroll
    for (int mi = 0; mi < 2; ++mi) a[mi] = *(const bf16x8*)(Wg + (size_t)(wid * 32 + mi * 16 + l15) * 128 + ks * 32 + quad * 8);
#pragma unroll
    for (int ni = 0; ni < 4; ++ni) bb[ni] = *(const bf16x8*)(sVT + (ni * 16 + l15) * 136 + ks * 32 + quad * 8);
#pragma unroll
    for (int mi = 0; mi < 2; ++mi)
#pragma unroll
      for (int ni = 0; ni < 4; ++ni) acc[mi][ni] = mfma16(a[mi], bb[ni], acc[mi][ni]);
  }
#pragma unroll
  for (int mi = 0; mi < 2; ++mi)
#pragma unroll
    for (int j = 0; j < 4; ++j) {
      const int pr = wid * 32 + mi * 16 + quad * 4 + j;
      const float bias = p.sg_b[(size_t)(l * 4 + g) * 128 + pr];
#pragma unroll
      for (int ni = 0; ni < 4; ++ni) {
        const int c = ni * 16 + l15;
        float u = geluf_(bf2f(p.z[(size_t)(m0 + pr) * INC + 1408 + g * 64 + c]));
        p.act[(size_t)(m0 + pr) * DM + 384 + g * 64 + c] = f2bf(u * (acc[mi][ni][j] + bias));
      }
    }
  __syncthreads();
}

DEV void mix_phase(const P& p, int l, char* smem, int cidx) {
  __shared__ int s_item;
  const bool last = (l == DEPTH - 1);
  const int n_attn = last ? 1536 : 1632;
  const int ck_lo = last ? 16 : 0;
  const int n_sg = (NMT - ck_lo) * 4;
  const int total = SCAN_ITEMS + n_attn + n_sg;
  const int bid = bid_l();
  bool first = bid < SCAN_ITEMS;
  for (;;) {
    int it;
    if (first) {
      it = bid;
      first = false;
    } else {
      if (tid_l() == 0) s_item = SCAN_ITEMS + atomicAdd(p.cnt + cidx, 1);
      __syncthreads();
      it = s_item;
      __syncthreads();
    }
    if (it >= total) break;
    if (it < SCAN_ITEMS) {
      int nr = SCAN_REP; asm volatile("" : "+s"(nr));
      for (int rr = 0; rr < nr; ++rr) scan_item(p, l, it, smem);
    } else if (it < SCAN_ITEMS + n_attn) {
      int nr = ATT_REP; asm volatile("" : "+s"(nr));
      for (int rr = 0; rr < nr; ++rr) { attn_item(p, it - SCAN_ITEMS, smem); __syncthreads(); }
    } else {
      int i2 = it - SCAN_ITEMS - n_attn;
      int nr = SG_REP; asm volatile("" : "+s"(nr));
      for (int rr = 0; rr < nr; ++rr) sgate_item(p, l, ck_lo + (i2 >> 2), i2 & 3, smem);
    }
  }
}

DEV void apost_phase(const P& p, int l, int mt_lo, char* smem) {
  const int tid = tid_l(), lane = tid & 63, wid = tid >> 6, l15 = lane & 15, quad = lane >> 4;
  for (int i = bid_l() * 256 + tid; i < MT; i += gridDim.x * 256) { p.rss1[i] = 0.f; p.rss2[i] = 0.f; }
  const int nit = (NMT - mt_lo) * 6;
  for (int it = bid_l(); it < nit; it += gridDim.x) {
    const int mt = mt_lo + it / 6;
    const int hh = it % 6;
    const int m0 = mt * 128;
    bf16x8 a[2][4];
#pragma unroll
    for (int mi = 0; mi < 2; ++mi)
#pragma unroll
      for (int ks = 0; ks < 4; ++ks)
        a[mi][ks] = *(const bf16x8*)(p.z + (size_t)(m0 + wid * 32 + mi * 16 + l15) * INC + 1280 + ks * 32 + quad * 8);
    {
      f32x4 acc[2][4];
#pragma unroll
      for (int mi = 0; mi < 2; ++mi)
#pragma unroll
        for (int ni = 0; ni < 4; ++ni) acc[mi][ni] = f32x4{0.f, 0.f, 0.f, 0.f};
#pragma unroll
      for (int ks = 0; ks < 4; ++ks) {
        bf16x8 bb[4];
#pragma unroll
        for (int ni = 0; ni < 4; ++ni)
          bb[ni] = *(const bf16x8*)(p.gUpT + ((size_t)l * 384 + hh * 64 + ni * 16 + l15) * 128 + ks * 32 + quad * 8);
#pragma unroll
        for (int mi = 0; mi < 2; ++mi)
#pragma unroll
          for (int ni = 0; ni < 4; ++ni) acc[mi][ni] = mfma16(a[mi][ks], bb[ni], acc[mi][ni]);
      }
      float lg[4], lb[4];
#pragma unroll
      for (int ni = 0; ni < 4; ++ni) {
        const int c = hh * 64 + ni * 16 + l15;
        lg[ni] = p.ln_g[l * 384 + c];
        lb[ni] = p.ln_b[l * 384 + c];
      }
#pragma unroll
      for (int mi = 0; mi < 2; ++mi)
#pragma unroll
        for (int j = 0; j < 4; ++j) {
          const int r = m0 + wid * 32 + mi * 16 + quad * 4 + j;
          float ys[4], vv[4];
          float sm = 0.f;
#pragma unroll
          for (int ni = 0; ni < 4; ++ni) {
            const int c = hh * 64 + ni * 16 + l15;
            ys[ni] = p.y[(size_t)r * 384 + c] + p.y[((size_t)MT + r) * 384 + c];
            vv[ni] = bf2f(p.z[(size_t)r * INC + 768 + c]);
            sm += ys[ni];
          }
          const float4 bq0 = *(const float4*)(p.bonus + (size_t)r * 48 + hh * 4);
          const float4 bq1 = *(const float4*)(p.bonus + (size_t)r * 48 + (6 + hh) * 4);
          const float bon = (bq0.x + bq0.y) + (bq0.z + bq0.w) + (bq1.x + bq1.y) + (bq1.z + bq1.w);
          sm = red16_sum(sm);
          const float mean = sm * (1.f / 64.f);
          float vs = 0.f;
#pragma unroll
          for (int ni = 0; ni < 4; ++ni) { ys[ni] -= mean; vs += ys[ni] * ys[ni]; }
          vs = red16_sum(vs);
          const float rstd = rsqrtf(vs * (1.f / 64.f) + 64e-5f);
#pragma unroll
          for (int ni = 0; ni < 4; ++ni) {
            const int c = hh * 64 + ni * 16 + l15;
            float o = (ys[ni] * rstd * lg[ni] + lb[ni] + bon * vv[ni]) * acc[mi][ni][j];
            p.act[(size_t)r * DM + c] = f2bf(o);
          }
          __builtin_amdgcn_sched_barrier(0);
        }
    }
  }
}

DEV uint2 ld8(const u16* q) { return *(const uint2*)q; }
DEV void up4(const uint2 u, float (&f)[4]) {
  f[0] = __uint_as_float(u.x << 16); f[1] = __uint_as_float(u.x & 0xffff0000u);
  f[2] = __uint_as_float(u.y << 16); f[3] = __uint_as_float(u.y & 0xffff0000u);
}
DEV void prep_phase(const P& p, int l, cg::grid_group& grid) {
  const int tid = tid_l(), lane = tid & 63, l15 = lane & 15;
  const int nb = gridDim.x, bid = bid_l();
  constexpr int NR = 8;
  const int rpb = (((MT + nb - 1) / nb) + NR - 1) & ~(NR - 1);
  const int ra = bid * rpb;
  const int rb = min(ra + rpb, MT);
  const bool active = ra < MT;
  const bool has1 = tid < 96;
  const int col0 = tid * 4, col1 = 1024 + tid * 4;
  uint2 hp0 = make_uint2(0, 0), hn0 = hp0, hp1 = hp0, hn1 = hp0;
  if (active) {
    if (ra > 0) { hp0 = ld8(p.z + (size_t)(ra - 1) * INC + col0); if (has1) hp1 = ld8(p.z + (size_t)(ra - 1) * INC + col1); }
    if (rb < MT) { hn0 = ld8(p.z + (size_t)rb * INC + col0); if (has1) hn1 = ld8(p.z + (size_t)rb * INC + col1); }
  }
  grid.sync();
  if (!active) return;
  const float* cw = p.conv + (size_t)l * 3 * 1408;
#pragma unroll 1
  for (int pass = 0; pass < 2; ++pass) {
    if (pass == 1 && !has1) break;
    const int col = pass ? col1 : col0;
    const int typ = col < 1152 ? 0 : (col < 1216 ? 1 : (col < 1280 ? 0 : 2));
    const bool isk = col >= 384 && col < 768;
    float c0[4], c1[4], c2[4], kk4[4];
#pragma unroll
    for (int e = 0; e < 4; ++e) {
      c0[e] = cw[col + e]; c1[e] = cw[1408 + col + e]; c2[e] = cw[2816 + col + e];
      kk4[e] = isk ? p.k_k[l * 384 + (col - 384) + e] : 0.f;
    }
    const int hh = isk ? (col - 384) >> 6 : 0;
    u16* zc = p.z + col;
    uint2 prev = pass ? hp1 : hp0;
    const uint2 halo_n = pass ? hn1 : hn0;
    uint2 cur = ld8(zc + (size_t)ra * INC);
    for (int r = ra; r < rb; r += NR) {
      uint2 w[NR + 2];
      w[0] = prev;
      w[1] = cur;
#pragma unroll
      for (int q = 0; q < NR; ++q) {
        const int rr = r + 1 + q;
        w[q + 2] = rr < rb ? ld8(zc + (size_t)rr * INC) : halo_n;
      }
#pragma unroll
      for (int q = 0; q < NR; ++q) {
        const int rr = r + q;
        const uint2 xp = w[q], xc = w[q + 1], xn = w[q + 2];
        const int tt = rr < MC ? (rr & 255) : ((rr - MC) & 4095);
        const int len = rr < MC ? 256 : 4096;
        const float mp = tt > 0 ? 1.f : 0.f, mn = tt < len - 1 ? 1.f : 0.f;
        float fp[4], fc[4], fn[4], o[4];
        up4(xp, fp); up4(xc, fc); up4(xn, fn);
#pragma unroll
        for (int e = 0; e < 4; ++e) {
          float v = fc[e] * c1[e] + mp * (fp[e] * c0[e]) + mn * (fn[e] * c2[e]);
          if (typ == 1) v = tanh_fast(v);
          else if (typ == 2) v = sigmoidf_(v);
          o[e] = v;
        }
        if (isk) {
          float q0 = o[0] * kk4[0], q1 = o[1] * kk4[1], q2 = o[2] * kk4[2], q3 = o[3] * kk4[3];
          float ss = red16_sum(q0 * q0 + q1 * q1 + q2 * q2 + q3 * q3);
          if (l15 == 0 && rr < rb) p.invn[(size_t)rr * 8 + hh] = 1.f / fmaxf(sqrtf(ss), 1e-12f);
        }
        if (rr < rb) *(uint2*)(zc + (size_t)rr * INC) = make_uint2(pk2(o[0], o[1]), pk2(o[2], o[3]));
      }
      prev = w[NR];
      cur = w[NR + 1];
    }
  }
}

__global__ void __launch_bounds__(256, 2) fwd_megakernel(P p, int ph_lo, int ph_hi) {
  __shared__ __attribute__((aligned(16))) char smem[65536 - 64];
  cg::grid_group grid = cg::this_grid();
  for (int ph = ph_lo; ph < ph_hi; ++ph) {
    if (ph > ph_lo) grid.sync();
    if (ph == 0) { phase0(p, smem); continue; }
    if (ph == 1) { phase0b(p, smem); continue; }
    if (ph == 2 + 6 * DEPTH) { final_norm(p); continue; }
    const int l = (ph - 2) / 6, sub = (ph - 2) % 6;
    const bool last = (l == DEPTH - 1);
    const int mt_lo = last ? 16 : 0;
    GX g0{};
    g0.rss_acc = nullptr; g0.aout = nullptr; g0.gnext = nullptr; g0.lmod = 0; g0.scoff = 0;
    if (sub == 0) {
      gemm_phase<EPI_Z>(p, l, p.act, DM, p.wIn + (size_t)l * 2560 * 1024, 1024, 20, 0, 0, smem, g0, 0);
    } else if (sub == 1) {
      prep_phase(p, l, grid);
      grid.sync();
      mix_phase(p, l, smem, l);
    } else if (sub == 2) {
      apost_phase(p, l, mt_lo, smem);
    } else if (sub == 3 || sub == 5) {
      const bool g4 = sub == 5;
      GX gx{};
      gx.rss_acc = g4 ? p.rss1 : p.rss2;
      gx.aout = g4 ? (last ? nullptr : p.act) : p.act2;
      gx.gnext = g4 ? p.n1g + (last ? 0 : (l + 1) * DM) : p.n2g + l * DM;
      gx.lmod = g4 ? (last ? l : l + 1) : l;
      gx.scoff = g4 ? 1024 : 4096;
      gemm_phase<EPI_RES>(p, l, g4 ? p.h : p.act, g4 ? DFF : DM,
                          g4 ? p.w2t + (size_t)l * 1024 * 2816 : p.wOut + (size_t)l * 1024 * 1024, g4 ? 2816 : 1024, 8, mt_lo,
                          g4 ? 5120 : 2048, smem, gx, 0);
    } else {
      gemm_phase<EPI_SWIGLU>(p, l, p.act2, DM, p.w1t + (size_t)l * 5632 * 1024, 1024, 44, mt_lo, 0, smem, g0, 0);
    }
  }
}

extern "C" void kernel_launch(void* const* d_in, const int* in_sizes, int n_in, void* d_out, int out_size, void* d_ws,
                              size_t ws_size, hipStream_t stream) {
  static int grid_blocks = 0;
  if (!grid_blocks) {
    int dev = 0, cus = 0, per_cu = 0;
    hipGetDevice(&dev);
    hipDeviceGetAttribute(&cus, hipDeviceAttributeMultiprocessorCount, dev);
    hipOccupancyMaxActiveBlocksPerMultiprocessor(&per_cu, fwd_megakernel, 256, 0);
    if (per_cu > 2) per_cu = 2;
    if (per_cu < 1) per_cu = 1;
    grid_blocks = cus * per_cu;
  }
  P p{};
  const float* const* in = (const float* const*)d_in;
  p.x = in[0]; p.c = in[1]; p.ctx = in[2]; p.c_ctx = in[3]; p.n1g = in[4]; p.n2g = in[5]; p.ada_w = in[6]; p.ada_b = in[7];
  p.w_in = in[8]; p.conv = in[9]; p.w0 = in[10]; p.w_up = in[11]; p.a0 = in[12]; p.a_up = in[13]; p.g_up = in[14];
  p.k_k = in[15]; p.k_a = in[16]; p.r_k = in[17]; p.ln_g = in[18]; p.ln_b = in[19]; p.sgn = in[20]; p.sg_w = in[21];
  p.sg_b = in[22]; p.q_g = in[23]; p.k_g = in[24]; p.w_out = in[25]; p.w1 = in[26]; p.w2 = in[27]; p.fng = in[28];
  p.out = (float*)d_out;
  char* ws = (char*)d_ws;
  size_t off = 0;
  auto take = [&](size_t bytes) { char* r = ws + off; off += (bytes + 255) & ~(size_t)255; return r; };
  p.wIn = (u16*)take((size_t)4 * 2560 * 1024 * 2);
  p.wOut = (u16*)take((size_t)4 * 1024 * 1024 * 2);
  p.w1t = (u16*)take((size_t)4 * 5632 * 1024 * 2);
  p.w2t = (u16*)take((size_t)4 * 1024 * 2816 * 2);
  p.wUpT = (u16*)take((size_t)8 * 384 * 64 * 2);
  p.aUpT = (u16*)take((size_t)8 * 384 * 64 * 2);
  p.gUpT = (u16*)take((size_t)4 * 384 * 128 * 2);
  p.sgW = (u16*)take((size_t)16 * 128 * 128 * 2);
  p.mods = (float*)take((size_t)4 * 9 * 6144 * 4);
  p.rope = (float*)take(2048 * 4);
  p.cnt = (int*)take(256);
  p.xc = (float*)take((size_t)MC * DM * 4);
  p.act = (u16*)take((size_t)MT * DM * 2);
  p.z = (u16*)take((size_t)MT * DFF * 2);
  p.h = p.z;
  p.vTl = (u16*)take((size_t)16 * 64 * SEQ * 2);
  p.vTc = (u16*)take((size_t)16 * 64 * CTXL * 2);
  p.y = (float*)take((size_t)2 * MT * 384 * 4);
  p.bonus = (float*)take((size_t)MT * 48 * 4);
  p.invn = (float*)take((size_t)MT * 8 * 4);
  p.rss1 = (float*)take((size_t)MT * 4);
  p.rss2 = (float*)take((size_t)MT * 4);
  p.bz = (float*)take((size_t)4 * 9 * 2560 * 4);
  p.bh = (float*)take((size_t)4 * 9 * 5632 * 4);
  p.act2 = (u16*)p.y;
  if (off > ws_size) { fprintf(stderr, "workspace too small: need %zu have %zu\n", off, ws_size); return; }
  int ph_lo = 0, ph_hi = 3 + 6 * DEPTH;
  void* args[] = {&p, &ph_lo, &ph_hi};
  hipError_t e = hipLaunchCooperativeKernel((void*)fwd_megakernel, dim3(grid_blocks), dim3(256), args, 0, stream);
  if (e != hipSuccess) fprintf(stderr, "cooperative launch failed: %s (grid %d)\n", hipGetErrorString(e), grid_blocks);
}
```

```cpp
#include <hip/hip_runtime.h>
#include <hip/hip_bf16.h>
#include <hip/hip_cooperative_groups.h>
#include <cstdio>
namespace cg = cooperative_groups;

typedef __attribute__((ext_vector_type(8))) short bf16x8;
typedef __attribute__((ext_vector_type(4))) float f32x4;
typedef unsigned short u16;
typedef __attribute__((ext_vector_type(2))) float float2v;

#define DEV __device__ __forceinline__
DEV int tid_l() { int t = threadIdx.x; asm volatile("" : "+v"(t)); return t; }
DEV int bid_l() { int b = blockIdx.x; asm volatile("" : "+s"(b)); return b; }

constexpr int DM = 1024, NBATCH = 8, SEQ = 4096, DEPTH = 4, CTXL = 256;
constexpr int MC = NBATCH * CTXL;
constexpr int ML = NBATCH * SEQ;
constexpr int MT = MC + ML;
constexpr int INC = 2560, DFF = 2816;
constexpr int NMT = MT / 128;
#ifndef PROBE_MASK
#define PROBE_MASK 0
#endif
#define SCAN_REP 1
#define ATT_REP 1
#define SG_REP 1

struct P {
  const float *x, *c, *ctx, *c_ctx, *n1g, *n2g, *ada_w, *ada_b, *w_in, *conv, *w0, *w_up, *a0, *a_up, *g_up,
      *k_k, *k_a, *r_k, *ln_g, *ln_b, *sgn, *sg_w, *sg_b, *q_g, *k_g, *w_out, *w1, *w2, *fng;
  float* out;
  u16 *wIn, *wOut, *w1t, *w2t, *wUpT, *aUpT, *gUpT, *sgW;
  float *mods, *rope;
  int* cnt;
  float* xc;
  u16 *act, *z, *h, *vTl, *vTc;
  float *y, *bonus, *invn;
  float *rss1, *rss2, *bz, *bh;
  u16* act2;
};

typedef __attribute__((ext_vector_type(2))) __bf16 bf16x2v;
typedef __attribute__((ext_vector_type(2))) float f32x2v;
DEV unsigned pk2(float a, float b) {
  f32x2v v = {a, b};
  bf16x2v r = __builtin_convertvector(v, bf16x2v);
  return *(unsigned*)&r;
}
DEV u16 f2bf(float f) { return (u16)(pk2(f, 0.f) & 0xffffu); }
DEV float bf2f(u16 h) { return __uint_as_float(((unsigned)h) << 16); }
DEV float sigmoidf_(float x) { return __builtin_amdgcn_rcpf(1.f + __expf(-x)); }
DEV float siluf_(float x) { return x * __builtin_amdgcn_rcpf(1.f + __expf(-x)); }
DEV float geluf_(float x) {
  float u = 0.7978845608028654f * (x + 0.044715f * x * x * x);
  return 0.5f * x * (1.f + tanhf(u));
}
DEV int swz(int r, int ch) { return r * 128 + ((ch ^ ((r >> 1) & 7)) << 4); }

template <int CTRL>
DEV float dppf(float v) {
  return __int_as_float(__builtin_amdgcn_update_dpp(0, __float_as_int(v), CTRL, 0xF, 0xF, false));
}
DEV float red16_sum(float v) {
  v += dppf<0xB1>(v);
  v += dppf<0x4E>(v);
  v += dppf<0x141>(v);
  v += dppf<0x140>(v);
  return v;
}
DEV float red16_max(float v) {
  v = fmaxf(v, dppf<0xB1>(v));
  v = fmaxf(v, dppf<0x4E>(v));
  v = fmaxf(v, dppf<0x141>(v));
  v = fmaxf(v, dppf<0x140>(v));
  return v;
}
DEV float wave_sum(float v) {
#pragma unroll
  for (int o = 32; o >= 1; o >>= 1) v += __shfl_xor(v, o);
  return v;
}
DEV f32x4 mfma16(bf16x8 a, bf16x8 b, f32x4 c) { return __builtin_amdgcn_mfma_f32_16x16x32_bf16(a, b, c, 0, 0, 0); }

DEV void tr_tile(const float* __restrict__ src, u16* __restrict__ dst, int K, int N, int kt, int nt, bool il, float* lds) {
  const int tid = tid_l();
  const int k0 = kt * 64, n0 = nt * 64;
  {
    const int c = tid & 63, r0 = tid >> 6;
#pragma unroll
    for (int i = 0; i < 16; ++i) {
      int r = r0 + i * 4;
      lds[r * 65 + c] = src[(size_t)(k0 + r) * N + n0 + c];
    }
  }
  __syncthreads();
  {
    const int ch = tid & 7, nn0 = tid >> 3;
#pragma unroll
    for (int i = 0; i < 2; ++i) {
      const int n = nn0 + i * 32;
      const int gn = n0 + n;
      int np = gn;
      if (il) {
        int j = gn < DFF ? gn : gn - DFF;
        np = (j >> 4) * 32 + (j & 15) + (gn < DFF ? 0 : 16);
      }
      const float* sp = lds + (ch * 8) * 65 + n;
      uint4 o;
      o.x = pk2(sp[0 * 65], sp[1 * 65]);
      o.y = pk2(sp[2 * 65], sp[3 * 65]);
      o.z = pk2(sp[4 * 65], sp[5 * 65]);
      o.w = pk2(sp[6 * 65], sp[7 * 65]);
      *(uint4*)(dst + (size_t)np * K + k0 + ch * 8) = o;
    }
  }
  __syncthreads();
}

DEV void phase0(const P& p, char* smem) {
  float* lds = (float*)smem;
  const int tid = tid_l();
  constexpr int C0 = 2560, C1 = C0 + 1024, C2 = C1 + 5632, C3 = C2 + 2816, C4 = C3 + 48, C5 = C4 + 48, C6 = C5 + 48,
                C7 = C6 + 64, C8 = C7 + 384, C9 = C8 + 1;
  for (int it = bid_l(); it < C9; it += gridDim.x) {
    if (it < C6) {
      const float* src; u16* dst; int K, N, kt, nt; bool il = false;
      if (it < C0) {
        int l = it / 640, r = it % 640;
        src = p.w_in + (size_t)l * 1024 * 2560; dst = p.wIn + (size_t)l * 2560 * 1024; K = 1024; N = 2560; kt = r / 40; nt = r % 40;
      } else if (it < C1) {
        int i2 = it - C0, l = i2 / 256, r = i2 % 256;
        src = p.w_out + (size_t)l * 1024 * 1024; dst = p.wOut + (size_t)l * 1024 * 1024; K = 1024; N = 1024; kt = r / 16; nt = r % 16;
      } else if (it < C2) {
        int i2 = it - C1, l = i2 / 1408, r = i2 % 1408;
        src = p.w1 + (size_t)l * 1024 * 5632; dst = p.w1t + (size_t)l * 5632 * 1024; K = 1024; N = 5632; kt = r / 88; nt = r % 88; il = true;
      } else if (it < C3) {
        int i2 = it - C2, l = i2 / 704, r = i2 % 704;
        src = p.w2 + (size_t)l * 2816 * 1024; dst = p.w2t + (size_t)l * 1024 * 2816; K = 2816; N = 1024; kt = r / 16; nt = r % 16;
      } else if (it < C4) {
        int i2 = it - C3, bb = i2 / 6;
        src = p.w_up + (size_t)bb * 64 * 384; dst = p.wUpT + (size_t)bb * 384 * 64; K = 64; N = 384; kt = 0; nt = i2 % 6;
      } else if (it < C5) {
        int i2 = it - C4, bb = i2 / 6;
        src = p.a_up + (size_t)bb * 64 * 384; dst = p.aUpT + (size_t)bb * 384 * 64; K = 64; N = 384; kt = 0; nt = i2 % 6;
      } else {
        int i2 = it - C5, l = i2 / 12, r = i2 % 12;
        src = p.g_up + (size_t)l * 128 * 384; dst = p.gUpT + (size_t)l * 384 * 128; K = 128; N = 384; kt = r / 6; nt = r % 6;
      }
      tr_tile(src, dst, K, N, kt, nt, il, lds);
    } else if (it < C7) {
      int i2 = it - C6;
      for (int i = 0; i < 16; ++i) {
        int e = i2 * 4096 + i * 256 + tid;
        p.sgW[e] = f2bf(p.sg_w[e]);
      }
    } else if (it < C8) {
      int i2 = it - C7, l = i2 / 96, cb = i2 % 96;
      for (int e = tid; e < 9 * 1024; e += 256) {
        int s = e >> 10, k = e & 1023;
        float v = s < 8 ? p.c[s * 1024 + k] : p.c_ctx[k];
        lds[e] = siluf_(v);
      }
      __syncthreads();
      const int col = tid & 63, kq = tid >> 6;
      const int n = cb * 64 + col;
      float acc[9];
#pragma unroll
      for (int s = 0; s < 9; ++s) acc[s] = 0.f;
      const float* wp = p.ada_w + (size_t)l * 1024 * 6144 + n;
#pragma unroll 4
      for (int k = kq * 256; k < kq * 256 + 256; ++k) {
        float w = wp[(size_t)k * 6144];
#pragma unroll
        for (int s = 0; s < 9; ++s) acc[s] += lds[s * 1024 + k] * w;
      }
      __syncthreads();
      float* red = lds + 9216;
#pragma unroll
      for (int s = 0; s < 9; ++s) red[(kq * 9 + s) * 64 + col] = acc[s];
      __syncthreads();
      for (int e = tid; e < 9 * 64; e += 256) {
        int s = e >> 6, cc = e & 63;
        float v = red[(0 * 9 + s) * 64 + cc] + red[(1 * 9 + s) * 64 + cc] + red[(2 * 9 + s) * 64 + cc] + red[(3 * 9 + s) * 64 + cc];
        int nn = cb * 64 + cc;
        p.mods[((size_t)l * 9 + s) * 6144 + nn] = v + p.ada_b[l * 6144 + nn];
      }
      __syncthreads();
    } else {
      for (int e = tid; e < 1024; e += 256) {
        int pos = e >> 4, i = e & 15;
        float inv = powf(10000.f, -(float)i / 16.f);
        float ang = (float)pos * inv;
        p.rope[e * 2] = cosf(ang);
        p.rope[e * 2 + 1] = sinf(ang);
      }
      if (tid < 64) p.cnt[tid] = 0;
    }
  }
}

DEV void norm_phase(const P& p, int l, const float* __restrict__ g, int shoff, int scoff, int row_lo, bool from_input) {
  const int tid = tid_l();
  const int lane = tid & 63;
  const int gw = bid_l() * 4 + (tid >> 6), nw = gridDim.x * 4;
  const float* lat = from_input ? p.x : p.out;
  const float* cx = from_input ? p.ctx : p.xc;
  for (int r0 = row_lo + gw; r0 < MT; r0 += 4 * nw) {
    float4 v[4][4];
#pragma unroll
    for (int u = 0; u < 4; ++u) {
      const int r = r0 + u * nw;
      if (r < MT) {
        const float* src = r < MC ? cx + (size_t)r * DM : lat + (size_t)(r - MC) * DM;
#pragma unroll
        for (int i = 0; i < 4; ++i) v[u][i] = *(const float4*)(src + i * 256 + lane * 4);
      }
    }
#pragma unroll
    for (int u = 0; u < 4; ++u) {
      const int r = r0 + u * nw;
      if (r < MT) {
        const int s = r < MC ? 8 : (r - MC) >> 12;
        const float* md = p.mods + ((size_t)l * 9 + s) * 6144;
        float ss = 0.f;
#pragma unroll
        for (int i = 0; i < 4; ++i) ss += v[u][i].x * v[u][i].x + v[u][i].y * v[u][i].y + v[u][i].z * v[u][i].z + v[u][i].w * v[u][i].w;
        ss = wave_sum(ss);
        const float rstd = rsqrtf(ss * (1.f / DM) + 1e-6f);
#pragma unroll
        for (int i = 0; i < 4; ++i) {
          const int c = i * 256 + lane * 4;
          float4 gg = *(const float4*)(g + c);
          float4 sh = *(const float4*)(md + shoff + c);
          float4 sc = *(const float4*)(md + scoff + c);
          float o0 = v[u][i].x * rstd * gg.x * (1.f + sc.x) + sh.x;
          float o1 = v[u][i].y * rstd * gg.y * (1.f + sc.y) + sh.y;
          float o2 = v[u][i].z * rstd * gg.z * (1.f + sc.z) + sh.z;
          float o3 = v[u][i].w * rstd * gg.w * (1.f + sc.w) + sh.w;
          uint2 o;
          o.x = pk2(o0, o1);
          o.y = pk2(o2, o3);
          *(uint2*)(p.act + (size_t)r * DM + c) = o;
        }
      }
    }
  }
}

DEV void final_norm(const P& p) {
  const int tid = tid_l();
  const int lane = tid & 63;
  const int gw = bid_l() * 4 + (tid >> 6), nw = gridDim.x * 4;
  for (int r0 = gw; r0 < ML; r0 += 4 * nw) {
    float4 v[4][4];
#pragma unroll
    for (int u = 0; u < 4; ++u) {
      const int r = r0 + u * nw;
      if (r < ML) {
#pragma unroll
        for (int i = 0; i < 4; ++i) v[u][i] = *(const float4*)(p.out + (size_t)r * DM + i * 256 + lane * 4);
      }
    }
#pragma unroll
    for (int u = 0; u < 4; ++u) {
      const int r = r0 + u * nw;
      if (r < ML) {
        const float rstd = rsqrtf(p.rss1[MC + r] * (1.f / DM) + 1e-6f);
#pragma unroll
        for (int i = 0; i < 4; ++i) {
          const int c = i * 256 + lane * 4;
          float4 gg = *(const float4*)(p.fng + c);
          float4 o;
          o.x = v[u][i].x * rstd * gg.x;
          o.y = v[u][i].y * rstd * gg.y;
          o.z = v[u][i].z * rstd * gg.z;
          o.w = v[u][i].w * rstd * gg.w;
          *(float4*)(p.out + (size_t)r * DM + c) = o;
        }
      }
    }
  }
}

DEV void phase0b(const P& p, char* smem) {
  float* lds = (float*)smem;
  const int tid = tid_l(), lane = tid & 63;
  for (int it = bid_l(); it < 512; it += gridDim.x) {
    const bool isz = it < 160;
    const int i2 = isz ? it : it - 160;
    const int l = isz ? i2 / 40 : i2 / 88, cb = isz ? i2 % 40 : i2 % 88;
    const int N = isz ? 2560 : 5632;
    const float* W = isz ? p.w_in + (size_t)l * 1024 * 2560 : p.w1 + (size_t)l * 1024 * 5632;
    for (int e = tid; e < 9 * 1024; e += 256) {
      const int s9 = e >> 10, k = e & 1023;
      lds[e] = p.mods[((size_t)l * 9 + s9) * 6144 + (isz ? 0 : 3072) + k];
    }
    __syncthreads();
    const int col = tid & 63, kq = tid >> 6;
    const int n = cb * 64 + col;
    float acc[9];
#pragma unroll
    for (int s9 = 0; s9 < 9; ++s9) acc[s9] = 0.f;
    const float* wp = W + n;
#pragma unroll 4
    for (int k = kq * 256; k < kq * 256 + 256; ++k) {
      const float w = wp[(size_t)k * N];
#pragma unroll
      for (int s9 = 0; s9 < 9; ++s9) acc[s9] += lds[s9 * 1024 + k] * w;
    }
    __syncthreads();
    float* red = lds + 9216;
#pragma unroll
    for (int s9 = 0; s9 < 9; ++s9) red[(kq * 9 + s9) * 64 + col] = acc[s9];
    __syncthreads();
    for (int e = tid; e < 9 * 64; e += 256) {
      const int s9 = e >> 6, cc = e & 63;
      const float v = red[(0 * 9 + s9) * 64 + cc] + red[(1 * 9 + s9) * 64 + cc] + red[(2 * 9 + s9) * 64 + cc] + red[(3 * 9 + s9) * 64 + cc];
      const int gn = cb * 64 + cc;
      if (isz) p.bz[((size_t)l * 9 + s9) * 2560 + gn] = v;
      else {
        const int j = gn < DFF ? gn : gn - DFF;
        const int np = (j >> 4) * 32 + (j & 15) + (gn < DFF ? 0 : 16);
        p.bh[((size_t)l * 9 + s9) * 5632 + np] = v;
      }
    }
    __syncthreads();
  }
  const int gw = bid_l() * 4 + (tid >> 6), nw = gridDim.x * 4;
  for (int r0 = gw; r0 < MT; r0 += 4 * nw) {
    float4 v[4][4];
#pragma unroll
    for (int u = 0; u < 4; ++u) {
      const int r = r0 + u * nw;
      if (r < MT) {
        const float* src = r < MC ? p.ctx + (size_t)r * DM : p.x + (size_t)(r - MC) * DM;
#pragma unroll
        for (int i = 0; i < 4; ++i) v[u][i] = *(const float4*)(src + i * 256 + lane * 4);
      }
    }
#pragma unroll
    for (int u = 0; u < 4; ++u) {
      const int r = r0 + u * nw;
      if (r < MT) {
        const int s9 = r < MC ? 8 : (r - MC) >> 12;
        const float* md = p.mods + (size_t)s9 * 6144 + 1024;
        float ss = 0.f;
#pragma unroll
        for (int i = 0; i < 4; ++i) ss += v[u][i].x * v[u][i].x + v[u][i].y * v[u][i].y + v[u][i].z * v[u][i].z + v[u][i].w * v[u][i].w;
        ss = wave_sum(ss);
        if (lane == 0) p.rss1[r] = ss;
#pragma unroll
        for (int i = 0; i < 4; ++i) {
          const int c = i * 256 + lane * 4;
          const float4 gg = *(const float4*)(p.n1g + c);
          const float4 sc = *(const float4*)(md + c);
          *(uint2*)(p.act + (size_t)r * DM + c) =
              make_uint2(pk2(v[u][i].x * gg.x * (1.f + sc.x), v[u][i].y * gg.y * (1.f + sc.y)),
                         pk2(v[u][i].z * gg.z * (1.f + sc.z), v[u][i].w * gg.w * (1.f + sc.w)));
        }
      }
    }
  }
}

enum { EPI_Z = 0, EPI_RES = 1, EPI_SWIGLU = 2 };
struct GX { float* rss_acc; u16* aout; const float* gnext; int lmod; int scoff; };

template <int EPI>
DEV void gemm_phase(const P& p, int l, const u16* __restrict__ A, int lda, const u16* __restrict__ Bt, int K, int NT,
                           int mt_lo, int goff, char* smem, GX gx, int dry = 0) {
  const int tid = tid_l(), lane = tid & 63, wid = tid >> 6, wr = wid >> 1, wc = wid & 1, l15 = lane & 15, quad = lane >> 4;
  const int nmt = NMT - mt_lo;
  const int nk = K / 64;
  const int npn = NT >> 2;
  const int npatch = (nmt >> 4) * npn;
  const int tmax = ((npatch + 7) >> 3) * 512;
#define G_MAP(T, OK, M0, N0)                                                                        \
  {                                                                                                 \
    const int xcd_ = (T)&7, sidx_ = (T) >> 3;                                                       \
    const int gp_ = (sidx_ >> 6) * 8 + xcd_;                                                        \
    OK = (T) < tmax && gp_ < npatch;                                                                \
    const int within_ = sidx_ & 63;                                                                 \
    M0 = (mt_lo + (gp_ / npn) * 16 + (within_ & 15)) * 128;                                         \
    N0 = ((gp_ % npn) * 4 + (within_ >> 4)) * 128;                                                  \
  }
  uint4 xa0, xa1, xa2, xa3, xb0, xb1, xb2, xb3, ya0, ya1, ya2, ya3, yb0, yb1, yb2, yb3;
  int t = bid_l();
  bool have;
  int m0, n0;
  G_MAP(t, have, m0, n0);
  const u16* Ag = A + (size_t)(m0 + (tid >> 3)) * lda + (tid & 7) * 8;
  const u16* Bg = Bt + (size_t)(n0 + (tid >> 3)) * K + (tid & 7) * 8;
  bool primed = false;
  while (have) {
    f32x4 acc[4][4];
#pragma unroll
    for (int i = 0; i < 4; ++i)
#pragma unroll
      for (int j = 0; j < 4; ++j) acc[i][j] = f32x4{0.f, 0.f, 0.f, 0.f};
#define G_GL(P, KT)                                                          \
    {                                                                        \
      const int k0_ = (KT)*64;                                               \
      P##a0 = *(const uint4*)(Ag + k0_);                                     \
      P##b0 = *(const uint4*)(Bg + k0_);                                     \
      P##a1 = *(const uint4*)(Ag + (size_t)32 * lda + k0_);                  \
      P##b1 = *(const uint4*)(Bg + (size_t)32 * K + k0_);                    \
      P##a2 = *(const uint4*)(Ag + (size_t)64 * lda + k0_);                  \
      P##b2 = *(const uint4*)(Bg + (size_t)64 * K + k0_);                    \
      P##a3 = *(const uint4*)(Ag + (size_t)96 * lda + k0_);                  \
      P##b3 = *(const uint4*)(Bg + (size_t)96 * K + k0_);                    \
    }
#define G_LS(P, BUF)                                                         \
    {                                                                        \
      char* Aw_ = smem + (BUF)*32768;                                        \
      *(uint4*)(Aw_ + swz((tid >> 3), tid & 7)) = P##a0;                     \
      *(uint4*)(Aw_ + 16384 + swz((tid >> 3), tid & 7)) = P##b0;             \
      *(uint4*)(Aw_ + swz((tid >> 3) + 32, tid & 7)) = P##a1;                \
      *(uint4*)(Aw_ + 16384 + swz((tid >> 3) + 32, tid & 7)) = P##b1;        \
      *(uint4*)(Aw_ + swz((tid >> 3) + 64, tid & 7)) = P##a2;                \
      *(uint4*)(Aw_ + 16384 + swz((tid >> 3) + 64, tid & 7)) = P##b2;        \
      *(uint4*)(Aw_ + swz((tid >> 3) + 96, tid & 7)) = P##a3;                \
      *(uint4*)(Aw_ + 16384 + swz((tid >> 3) + 96, tid & 7)) = P##b3;        \
    }
#define G_COMPUTE(BUF)                                                                                             \
    {                                                                                                              \
      const char* As = smem + (BUF)*32768;                                                                         \
      const char* Bs = As + 16384;                                                                                 \
      _Pragma("unroll") for (int kh = 0; kh < 2; ++kh) {                                                           \
        bf16x8 a[4], b[4];                                                                                         \
        _Pragma("unroll") for (int mi = 0; mi < 4; ++mi)                                                           \
            a[mi] = *(const bf16x8*)(As + swz(wr * 64 + mi * 16 + l15, kh * 4 + quad));                            \
        _Pragma("unroll") for (int ni = 0; ni < 4; ++ni)                                                           \
            b[ni] = *(const bf16x8*)(Bs + swz(wc * 64 + ni * 16 + l15, kh * 4 + quad));                            \
        _Pragma("unroll") for (int mi = 0; mi < 4; ++mi)                                                           \
            _Pragma("unroll") for (int ni = 0; ni < 4; ++ni) acc[mi][ni] = mfma16(b[ni], a[mi], acc[mi][ni]);      \
      }                                                                                                            \
    }
    if (!primed) {
      G_GL(x, 0);
      G_GL(y, 1);
    }
    G_LS(x, 0);
    if (2 < nk) G_GL(x, 2);
    __syncthreads();
    for (int kt = 0; kt < nk; kt += 2) {
      G_COMPUTE(0);
      G_LS(y, 1);
      if (kt + 3 < nk) G_GL(y, kt + 3);
      __syncthreads();
      G_COMPUTE(1);
      if (kt + 2 < nk) G_LS(x, 0);
      if (kt + 4 < nk) G_GL(x, kt + 4);
      __syncthreads();
    }
    const int em0 = m0, en0 = n0;
    t += gridDim.x;
    G_MAP(t, have, m0, n0);
    if (have) {
      Ag = A + (size_t)(m0 + (tid >> 3)) * lda + (tid & 7) * 8;
      Bg = Bt + (size_t)(n0 + (tid >> 3)) * K + (tid & 7) * 8;
      G_GL(x, 0);
      G_GL(y, 1);
      primed = true;
    }
    if (dry) {
      if (acc[0][0][0] == 1.2345e33f) p.bonus[0] = acc[1][1][1] + acc[2][2][2] + acc[3][3][3];
      continue;
    }
    const int cw0 = en0 + wc * 64;
    if constexpr (EPI == EPI_Z || EPI == EPI_SWIGLU) {
      const int sb_ = em0 < MC ? 8 : (em0 - MC) >> 12;
      const float* rssp = EPI == EPI_Z ? p.rss1 : p.rss2;
      const float* bias = EPI == EPI_Z ? p.bz + ((size_t)l * 9 + sb_) * 2560 + cw0 : p.bh + ((size_t)l * 9 + sb_) * 5632 + cw0;
      float rsv[4];
#pragma unroll
      for (int mi = 0; mi < 4; ++mi) rsv[mi] = rsqrtf(rssp[em0 + wr * 64 + mi * 16 + l15] * (1.f / DM) + 1e-6f);
#pragma unroll
      for (int ni = 0; ni < 4; ++ni) {
        const float4 bb = *(const float4*)(bias + ni * 16 + quad * 4);
#pragma unroll
        for (int mi = 0; mi < 4; ++mi) {
          acc[mi][ni][0] = acc[mi][ni][0] * rsv[mi] + bb.x;
          acc[mi][ni][1] = acc[mi][ni][1] * rsv[mi] + bb.y;
          acc[mi][ni][2] = acc[mi][ni][2] * rsv[mi] + bb.z;
          acc[mi][ni][3] = acc[mi][ni][3] * rsv[mi] + bb.w;
        }
      }
    }
    if constexpr (EPI == EPI_Z) {
      if (cw0 < 1920) {
#pragma unroll
        for (int mi = 0; mi < 4; ++mi) {
          const int r = em0 + wr * 64 + mi * 16 + l15;
#pragma unroll
          for (int ni = 0; ni < 4; ++ni)
            *(uint2*)(p.z + (size_t)r * INC + cw0 + ni * 16 + quad * 4) =
                make_uint2(pk2(acc[mi][ni][0], acc[mi][ni][1]), pk2(acc[mi][ni][2], acc[mi][ni][3]));
          __builtin_amdgcn_sched_barrier(0);
        }
      } else {
        const int hh = (cw0 - 1920) >> 6;
        if (hh < 8) {
          const float* gp = (hh < 6 ? p.q_g : p.k_g) + l * 64;
          float4 gv[4];
#pragma unroll
          for (int ni = 0; ni < 4; ++ni) gv[ni] = *(const float4*)(gp + ni * 16 + quad * 4);
          const float qs = hh < 6 ? 0.125f : 1.f;
#pragma unroll
          for (int mi = 0; mi < 4; ++mi) {
            const int r = em0 + wr * 64 + mi * 16 + l15;
            float ss = 0.f;
#pragma unroll
            for (int ni = 0; ni < 4; ++ni)
#pragma unroll
              for (int j = 0; j < 4; ++j) ss += acc[mi][ni][j] * acc[mi][ni][j];
            ss += __shfl_xor(ss, 16);
            ss += __shfl_xor(ss, 32);
            const float rstd = rsqrtf(ss * (1.f / 64.f) + 1e-6f) ;
            float yv[4][4];
#pragma unroll
            for (int ni = 0; ni < 4; ++ni) {
              yv[ni][0] = acc[mi][ni][0] * rstd * gv[ni].x;
              yv[ni][1] = acc[mi][ni][1] * rstd * gv[ni].y;
              yv[ni][2] = acc[mi][ni][2] * rstd * gv[ni].z;
              yv[ni][3] = acc[mi][ni][3] * rstd * gv[ni].w;
            }
            if (r >= MC) {
              const int tt = (r - MC) & 4095;
              const int prow = tt >> 6, pcol = tt & 63;
              const float* rr_ = p.rope + (prow * 16 + quad * 4) * 2;
              const float* rc_ = p.rope + (pcol * 16 + quad * 4) * 2;
              const float4 ra = *(const float4*)rr_, rb = *(const float4*)(rr_ + 4);
              const float4 ca = *(const float4*)rc_, cb = *(const float4*)(rc_ + 4);
              const float cr[4] = {ra.x, ra.z, rb.x, rb.z}, sr[4] = {ra.y, ra.w, rb.y, rb.w};
              const float cc[4] = {ca.x, ca.z, cb.x, cb.z}, sc[4] = {ca.y, ca.w, cb.y, cb.w};
#pragma unroll
              for (int j = 0; j < 4; ++j) {
                const float a0 = yv[0][j] * cr[j] - yv[1][j] * sr[j], a1 = yv[1][j] * cr[j] + yv[0][j] * sr[j];
                const float a2 = yv[2][j] * cc[j] - yv[3][j] * sc[j], a3 = yv[3][j] * cc[j] + yv[2][j] * sc[j];
                yv[0][j] = a0; yv[1][j] = a1; yv[2][j] = a2; yv[3][j] = a3;
              }
            }
#pragma unroll
            for (int ni = 0; ni < 4; ++ni)
              *(uint2*)(p.z + (size_t)r * INC + cw0 + ni * 16 + quad * 4) =
                  make_uint2(pk2(yv[ni][0] * qs, yv[ni][1] * qs), pk2(yv[ni][2] * qs, yv[ni][3] * qs));
            __builtin_amdgcn_sched_barrier(0);
          }
        } else {
          const int kvh = hh - 8;
#pragma unroll
          for (int mi = 0; mi < 4; ++mi) {
            const int r = em0 + wr * 64 + mi * 16 + l15;
            u16* vb;
            int vstride;
            if (r < MC) { vb = p.vTc + ((size_t)(((r >> 8) * 2 + kvh) * 64)) * CTXL + (r & 255); vstride = CTXL; }
            else { const int rr = r - MC; vb = p.vTl + ((size_t)(((rr >> 12) * 2 + kvh) * 64)) * SEQ + (rr & 4095); vstride = SEQ; }
#pragma unroll
            for (int ni = 0; ni < 4; ++ni)
#pragma unroll
              for (int j = 0; j < 4; ++j) vb[(size_t)(ni * 16 + quad * 4 + j) * vstride] = f2bf(acc[mi][ni][j]);
            __builtin_amdgcn_sched_barrier(0);
          }
        }
      }
    } else if constexpr (EPI == EPI_RES) {
      const int s = em0 < MC ? 8 : (em0 - MC) >> 12;
      const float* gate = p.mods + ((size_t)l * 9 + s) * 6144 + goff;
      float4 gv[4], gm[4];
#pragma unroll
      for (int ni = 0; ni < 4; ++ni) {
        gv[ni] = *(const float4*)(gate + cw0 + ni * 16 + quad * 4);
        gm[ni] = make_float4(0.f, 0.f, 0.f, 0.f);
        if (gx.aout) {
          const float4 g4 = *(const float4*)(gx.gnext + cw0 + ni * 16 + quad * 4);
          const float4 s4 = *(const float4*)(p.mods + ((size_t)gx.lmod * 9 + s) * 6144 + gx.scoff + cw0 + ni * 16 + quad * 4);
          gm[ni] = make_float4(g4.x * (1.f + s4.x), g4.y * (1.f + s4.y), g4.z * (1.f + s4.z), g4.w * (1.f + s4.w));
        }
      }
#pragma unroll
      for (int mi = 0; mi < 4; ++mi) {
        const int r = em0 + wr * 64 + mi * 16 + l15;
        const float* src;
        if (l == 0 && goff == 2048) src = r < MC ? p.ctx + (size_t)r * DM : p.x + (size_t)(r - MC) * DM;
        else src = r < MC ? p.xc + (size_t)r * DM : p.out + (size_t)(r - MC) * DM;
        float* dst = r < MC ? p.xc + (size_t)r * DM : p.out + (size_t)(r - MC) * DM;
        float ssq = 0.f;
#pragma unroll
        for (int ni = 0; ni < 4; ++ni) {
          const int c = cw0 + ni * 16 + quad * 4;
          const float4 xv = *(const float4*)(src + c);
          float4 o;
          o.x = xv.x + gv[ni].x * acc[mi][ni][0];
          o.y = xv.y + gv[ni].y * acc[mi][ni][1];
          o.z = xv.z + gv[ni].z * acc[mi][ni][2];
          o.w = xv.w + gv[ni].w * acc[mi][ni][3];
          *(float4*)(dst + c) = o;
          ssq += o.x * o.x + o.y * o.y + o.z * o.z + o.w * o.w;
          if (gx.aout) {
            *(uint2*)(gx.aout + (size_t)r * DM + c) =
                make_uint2(pk2(o.x * gm[ni].x, o.y * gm[ni].y), pk2(o.z * gm[ni].z, o.w * gm[ni].w));
          }
        }
        ssq += __shfl_xor(ssq, 16);
        ssq += __shfl_xor(ssq, 32);
        if (quad == 0) unsafeAtomicAdd(gx.rss_acc + r, ssq);
        __builtin_amdgcn_sched_barrier(0);
      }
    } else {
      const int hc0 = (en0 >> 1) + wc * 32;
#pragma unroll
      for (int mi = 0; mi < 4; ++mi) {
        const int r = em0 + wr * 64 + mi * 16 + l15;
#pragma unroll
        for (int pp = 0; pp < 2; ++pp) {
          float hv[4];
#pragma unroll
          for (int j = 0; j < 4; ++j) hv[j] = siluf_(acc[mi][2 * pp][j]) * acc[mi][2 * pp + 1][j];
          *(uint2*)(p.h + (size_t)r * DFF + hc0 + pp * 16 + quad * 4) = make_uint2(pk2(hv[0], hv[1]), pk2(hv[2], hv[3]));
        }
        __builtin_amdgcn_sched_barrier(0);
      }
    }
  }
}
#undef G_GL
#undef G_LS
#undef G_COMPUTE
#undef G_MAP

template <int LPR>
DEV float red_lpr(float v) {
  v += dppf<0xB1>(v);
  v += dppf<0x4E>(v);
  if (LPR >= 8) v += dppf<0x141>(v);
  if (LPR >= 16) v += dppf<0x140>(v);
  return v;
}

constexpr int SCAN_LPR = 8;
constexpr int SCAN_RPB = 256 / SCAN_LPR;
constexpr int SCAN_NPART = 64 / SCAN_RPB;
constexpr int SCAN_JL = 64 / SCAN_LPR;
constexpr int SCAN_ITEMS = 96 * SCAN_NPART;

DEV float red8_sum(float v) {
  v += dppf<0xB1>(v);
  v += dppf<0x4E>(v);
  v += dppf<0x141>(v);
  return v;
}
DEV float tanh_fast(float x) {
  float e = __expf(2.f * x);
  return 1.f - 2.f * __builtin_amdgcn_rcpf(1.f + e);
}

struct ChunkPos { int len, rowbase, tlo; };
DEV ChunkPos chunk_pos(int c, int d, int b) {
  ChunkPos cp;
  const int s0 = c * 16;
  int pos0;
  if (s0 < 256) { cp.len = 256; pos0 = s0; cp.rowbase = b * 256; }
  else { cp.len = 4096; pos0 = s0 - 256; cp.rowbase = MC + b * 4096; }
  cp.tlo = d ? (cp.len - 16 - pos0) : pos0;
  return cp;
}

constexpr int SC_R = 0, SC_KD = 12288, SC_V = 24576, SC_W = 30720, SC_KA = 38912, SC_NKK = 47104;

DEV void cvt8(const uint4 u, float4& lo, float4& hi) {
  lo.x = __uint_as_float(u.x << 16); lo.y = __uint_as_float(u.x & 0xffff0000u);
  lo.z = __uint_as_float(u.y << 16); lo.w = __uint_as_float(u.y & 0xffff0000u);
  hi.x = __uint_as_float(u.z << 16); hi.y = __uint_as_float(u.z & 0xffff0000u);
  hi.z = __uint_as_float(u.w << 16); hi.w = __uint_as_float(u.w & 0xffff0000u);
}

DEV void scan_item(const P& p, int l, int item, char* smem) {
  const int tid = tid_l(), lane = tid & 63, wid = tid >> 6, l15 = lane & 15, quad = lane >> 4;
  constexpr int LPR = SCAN_LPR, RPB = SCAN_RPB, JL = SCAN_JL, NV = RPB / 8;
  const int scan = item / SCAN_NPART, part = item % SCAN_NPART;
  const int d = scan / 48, b = (scan % 48) / 6, h = scan % 6;
  const int rloc = tid / LPR, jq = tid % LPR;
  const int irow = part * RPB + rloc;
  const int j0 = jq * JL;

  const int c_ts = (tid & 127) >> 3, c_ch = tid & 7;
  const int c_col = (tid < 128 ? 0 : 384) + h * 64 + c_ch * 8;
  const int v_ts = tid / NV, v_ch = tid % NV;
  const int v_col = 768 + h * 64 + part * RPB + v_ch * 8;

  const int n2 = wid * 16 + l15;
  bf16x8 bW[2], bA[2];
  {
    const u16* wb = p.wUpT + ((size_t)(l * 2 + d) * 384 + h * 64 + n2) * 64 + quad * 8;
    const u16* ab = p.aUpT + ((size_t)(l * 2 + d) * 384 + h * 64 + n2) * 64 + quad * 8;
    bW[0] = *(const bf16x8*)(wb);
    bW[1] = *(const bf16x8*)(wb + 32);
    bA[0] = *(const bf16x8*)(ab);
    bA[1] = *(const bf16x8*)(ab + 32);
  }
  const float w0v = p.w0[(size_t)(l * 2 + d) * 384 + h * 64 + n2];
  const float a0v = p.a0[(size_t)(l * 2 + d) * 384 + h * 64 + n2];
  const float kkc = p.k_k[l * 384 + h * 64 + n2], kac = p.k_a[l * 384 + h * 64 + n2], rkc = p.r_k[l * 384 + h * 64 + n2];

  float2v S2[JL / 2];
#pragma unroll
  for (int j = 0; j < JL / 2; ++j) S2[j] = float2v{0.f, 0.f};
  uint4 g_rk, g_v;
  bf16x8 g_wd0, g_wd1, g_ad0, g_ad1;
  float g_inv[4];

#define SC_GLOAD1(CC)                                                                                  \
  {                                                                                                    \
    const ChunkPos cp_ = chunk_pos((CC), d, b);                                                        \
    g_rk = *(const uint4*)(p.z + (size_t)(cp_.rowbase + cp_.tlo + c_ts) * INC + c_col);                \
    if (tid < 16 * NV) g_v = *(const uint4*)(p.z + (size_t)(cp_.rowbase + cp_.tlo + v_ts) * INC + v_col);  \
  }
#define SC_GLOAD2(CC)                                                                                  \
  {                                                                                                    \
    const ChunkPos cp_ = chunk_pos((CC), d, b);                                                        \
    const u16* rp_ = p.z + (size_t)(cp_.rowbase + cp_.tlo + l15) * INC + 1152 + quad * 8;              \
    g_wd0 = *(const bf16x8*)(rp_);                                                                     \
    g_wd1 = *(const bf16x8*)(rp_ + 32);                                                                \
    g_ad0 = *(const bf16x8*)(rp_ + 64);                                                                \
    g_ad1 = *(const bf16x8*)(rp_ + 96);                                                                \
    _Pragma("unroll") for (int j = 0; j < 4; ++j)                                                      \
      g_inv[j] = p.invn[(size_t)(cp_.rowbase + cp_.tlo + quad * 4 + j) * 8 + h];                       \
  }
#define SC_STAGE1(CC)                                                                                  \
  {                                                                                                    \
    const int i3_ = (CC) % 3;                                                                          \
    float4 lo_, hi_;                                                                                   \
    cvt8(g_rk, lo_, hi_);                                                                              \
    float* dst_ = (float*)(smem + (tid < 128 ? SC_R : SC_KD) + i3_ * 4096) + c_ts * 64 + c_ch * 8;     \
    *(float4*)dst_ = lo_;                                                                              \
    *(float4*)(dst_ + 4) = hi_;                                                                        \
    if (tid < 16 * NV) {                                                                               \
      cvt8(g_v, lo_, hi_);                                                                             \
      float* dv_ = (float*)(smem + SC_V + i3_ * 2048) + v_ts * RPB + v_ch * 8;                         \
      *(float4*)dv_ = lo_;                                                                             \
      *(float4*)(dv_ + 4) = hi_;                                                                       \
    }                                                                                                  \
  }
#define SC_STAGE2(CC)                                                                                  \
  {                                                                                                    \
    const int i3_ = (CC) % 3, i2_ = (CC)&1;                                                            \
    const ChunkPos cp_ = chunk_pos((CC), d, b);                                                        \
    f32x4 accW = f32x4{0.f, 0.f, 0.f, 0.f}, accA = f32x4{0.f, 0.f, 0.f, 0.f};                          \
    accW = mfma16(g_wd0, bW[0], accW);                                                                 \
    accW = mfma16(g_wd1, bW[1], accW);                                                                 \
    accA = mfma16(g_ad0, bA[0], accA);                                                                 \
    accA = mfma16(g_ad1, bA[1], accA);                                                                 \
    float bon_[4];                                                                                     \
    _Pragma("unroll") for (int j = 0; j < 4; ++j) {                                                    \
      const int ts = quad * 4 + j;                                                                     \
      float* kdp = (float*)(smem + SC_KD + i3_ * 4096) + ts * 64 + n2;                                 \
      const float kv = *kdp;                                                                           \
      const float rv = *((const float*)(smem + SC_R + i3_ * 4096) + ts * 64 + n2);                     \
      const float sg = sigmoidf_(w0v + accW[j]);                                                       \
      const float wv = __expf(-0.6065306597126334f * sg);                                              \
      const float av = sigmoidf_(a0v + accA[j]);                                                       \
      const float kn = kv * kkc * g_inv[j];                                                            \
      const float kd = kv * (1.f + (av - 1.f) * kac);                                                  \
      *((float*)(smem + SC_W + i2_ * 4096) + ts * 64 + n2) = wv;                                       \
      *((float*)(smem + SC_NKK + i2_ * 4096) + ts * 64 + n2) = -kn;                                    \
      *((float*)(smem + SC_KA + i2_ * 4096) + ts * 64 + n2) = kn * av;                                 \
      *kdp = kd;                                                                                       \
      bon_[j] = rv * kd * rkc;                                                                         \
    }                                                                                                  \
    _Pragma("unroll") for (int j = 0; j < 4; ++j) bon_[j] = red16_sum(bon_[j]);                        \
    if (l15 == 0 && part == 0) {                                                                       \
      _Pragma("unroll") for (int j = 0; j < 4; ++j)                                                    \
        p.bonus[(size_t)(cp_.rowbase + cp_.tlo + quad * 4 + j) * 48 + (d * 6 + h) * 4 + wid] = bon_[j]; \
    }                                                                                                  \
  }

  __builtin_amdgcn_s_setprio(3);
  SC_GLOAD1(0);
  SC_GLOAD2(0);
  SC_STAGE1(0);
  SC_GLOAD1(1);
  __syncthreads();
  SC_STAGE2(0);
  SC_STAGE1(1);
  SC_GLOAD1(2);
  SC_GLOAD2(1);
  __syncthreads();

  for (int c = 0; c < 272; ++c) {
    {
      const int i3 = c % 3, i2 = c & 1;
      const ChunkPos cp = chunk_pos(c, d, b);
      const float* pW = (const float*)(smem + SC_W + i2 * 4096) + j0;
      const float* pN = (const float*)(smem + SC_NKK + i2 * 4096) + j0;
      const float* pA = (const float*)(smem + SC_KA + i2 * 4096) + j0;
      const float* pD = (const float*)(smem + SC_KD + i3 * 4096) + j0;
      const float* pR = (const float*)(smem + SC_R + i3 * 4096) + j0;
      const float* pV = (const float*)(smem + SC_V + i3 * 2048) + rloc;
      float* yp = p.y + ((size_t)d * MT + cp.rowbase + cp.tlo) * 384 + h * 64 + irow;
      float yk0 = 0.f, yk1 = 0.f;
      constexpr int NQ = JL / 4;
      float4 cw[NQ], cn[NQ], ca[NQ], cd[NQ], cr[NQ];
      float cvi;
#define SC_LD(TS, W, N, A, D, R, VI)                                                             \
      _Pragma("unroll") for (int q = 0; q < NQ; ++q) {                                           \
        W[q] = *(const float4*)(pW + (TS)*64 + q * 4); N[q] = *(const float4*)(pN + (TS)*64 + q * 4); \
        A[q] = *(const float4*)(pA + (TS)*64 + q * 4); D[q] = *(const float4*)(pD + (TS)*64 + q * 4); \
        R[q] = *(const float4*)(pR + (TS)*64 + q * 4);                                           \
      }                                                                                          \
      VI = pV[(TS)*RPB];
      {
        const int ts0 = d ? 15 : 0;
        SC_LD(ts0, cw, cn, ca, cd, cr, cvi)
      }
#pragma unroll
      for (int si = 0; si < 16; ++si) {
        float4 xw[NQ], xn[NQ], xa[NQ], xd[NQ], xr[NQ];
        float xvi = 0.f;
        if (si + 1 < 16) {
          const int tsn = d ? 14 - si : si + 1;
          SC_LD(tsn, xw, xn, xa, xd, xr, xvi)
        }
        float2v sa2 = S2[0] * float2v{cn[0].x, cn[0].y};
        sa2 = S2[1] * float2v{cn[0].z, cn[0].w} + sa2;
        if constexpr (NQ == 2) {
          float2v sb2 = S2[2] * float2v{cn[1].x, cn[1].y};
          sb2 = S2[3] * float2v{cn[1].z, cn[1].w} + sb2;
          sa2 = sa2 + sb2;
        }
        const float2v viv = float2v{cvi, cvi};
        float2v u2[JL / 2];
#pragma unroll
        for (int q = 0; q < NQ; ++q) {
          u2[2 * q] = S2[2 * q] * float2v{cw[q].x, cw[q].y} + viv * float2v{cd[q].x, cd[q].y};
          u2[2 * q + 1] = S2[2 * q + 1] * float2v{cw[q].z, cw[q].w} + viv * float2v{cd[q].z, cd[q].w};
        }
        const float sa = LPR == 16 ? red16_sum(sa2.x + sa2.y) : red8_sum(sa2.x + sa2.y);
        const float2v sav = float2v{sa, sa};
#pragma unroll
        for (int q = 0; q < NQ; ++q) {
          S2[2 * q] = sav * float2v{ca[q].x, ca[q].y} + u2[2 * q];
          S2[2 * q + 1] = sav * float2v{ca[q].z, ca[q].w} + u2[2 * q + 1];
        }
        float2v y2 = S2[0] * float2v{cr[0].x, cr[0].y};
        y2 = S2[1] * float2v{cr[0].z, cr[0].w} + y2;
        if constexpr (NQ == 2) {
          float2v yb2 = S2[2] * float2v{cr[1].x, cr[1].y};
          yb2 = S2[3] * float2v{cr[1].z, cr[1].w} + yb2;
          y2 = y2 + yb2;
        }
        const float yv = LPR == 16 ? red16_sum(y2.x + y2.y) : red8_sum(y2.x + y2.y);
        if (si < LPR) yk0 = (jq == si) ? yv : yk0;
        else yk1 = (jq == si - LPR) ? yv : yk1;
        if (si + 1 < 16) {
#pragma unroll
          for (int q = 0; q < NQ; ++q) { cw[q] = xw[q]; cn[q] = xn[q]; ca[q] = xa[q]; cd[q] = xd[q]; cr[q] = xr[q]; }
          cvi = xvi;
        }
      }
#undef SC_LD
      {
        const int tsa = d ? 15 - jq : jq;
        yp[(size_t)tsa * 384] = yk0;
        if constexpr (LPR == 8) {
          const int tsb = d ? 7 - jq : 8 + jq;
          yp[(size_t)tsb * 384] = yk1;
        }
      }
    }
    if (c + 1 < 272) SC_STAGE2(c + 1);
    if (c + 2 < 272) SC_STAGE1(c + 2);
    if (c + 3 < 272) SC_GLOAD1(c + 3);
    if (c + 2 < 272) SC_GLOAD2(c + 2);
    __syncthreads();
  }
  __builtin_amdgcn_s_setprio(0);
#undef SC_GLOAD1
#undef SC_GLOAD2
#undef SC_STAGE1
#undef SC_STAGE2
}

DEV void attn_item(const P& p, int item, char* smem) {
  const int tid = tid_l(), lane = tid & 63, wid = tid >> 6, l15 = lane & 15, quad = lane >> 4;
  bool lat = item < 1536;
  int b, hq, qb;
  if (lat) { b = item / 192; int rem = item % 192; hq = rem / 32; qb = rem % 32; }
  else { int i2 = item - 1536; b = i2 / 12; int rem = i2 % 12; hq = rem / 2; qb = rem % 2; }
  const int kvh = hq / 3;
  const int qrow0 = lat ? MC + b * 4096 + qb * 128 : b * 256 + qb * 128;
  const int nkt = lat ? 68 : 4;
  const float LOG2E = 1.4426950408889634f;

  bf16x8 qf[2][2];
#pragma unroll
  for (int mi = 0; mi < 2; ++mi)
#pragma unroll
    for (int ks = 0; ks < 2; ++ks)
      qf[mi][ks] = *(const bf16x8*)(p.z + (size_t)(qrow0 + wid * 32 + mi * 16 + l15) * INC + 1920 + hq * 64 + ks * 32 + quad * 8);

  f32x4 Ot[2][4];
  float mrow[2], lpart[2];
#pragma unroll
  for (int mi = 0; mi < 2; ++mi) {
#pragma unroll
    for (int nd = 0; nd < 4; ++nd) Ot[mi][nd] = f32x4{0.f, 0.f, 0.f, 0.f};
    mrow[mi] = -1e30f;
    lpart[mi] = 0.f;
  }
  const int lrow = tid >> 3, lch = tid & 7;
  uint4 rk0, rk1, rv0, rv1;
#define ATT_GLOAD(KT)                                                                         \
  {                                                                                           \
    const int kt_ = (KT);                                                                     \
    const u16* kp;                                                                            \
    const u16* vp;                                                                            \
    int vstride;                                                                              \
    if (lat && kt_ < 64) {                                                                    \
      kp = p.z + (size_t)(MC + b * 4096 + kt_ * 64) * INC + 2304 + kvh * 64;                  \
      vp = p.vTl + (size_t)((b * 2 + kvh) * 64) * SEQ + kt_ * 64;                             \
      vstride = SEQ;                                                                          \
    } else {                                                                                  \
      const int kc = lat ? kt_ - 64 : kt_;                                                    \
      kp = p.z + (size_t)(b * 256 + kc * 64) * INC + 2304 + kvh * 64;                         \
      vp = p.vTc + (size_t)((b * 2 + kvh) * 64) * CTXL + kc * 64;                             \
      vstride = CTXL;                                                                         \
    }                                                                                         \
    rk0 = *(const uint4*)(kp + (size_t)(lrow)*INC + lch * 8);                                 \
    rk1 = *(const uint4*)(kp + (size_t)(lrow + 32) * INC + lch * 8);                          \
    rv0 = *(const uint4*)(vp + (size_t)(lrow)*vstride + lch * 8);                             \
    rv1 = *(const uint4*)(vp + (size_t)(lrow + 32) * vstride + lch * 8);                      \
  }
#define ATT_LSTORE(BUF)                                     \
  {                                                         \
    char* Kb_ = smem + (BUF)*16384;                         \
    *(uint4*)(Kb_ + swz(lrow, lch)) = rk0;                  \
    *(uint4*)(Kb_ + swz(lrow + 32, lch)) = rk1;             \
    *(uint4*)(Kb_ + 8192 + swz(lrow, lch)) = rv0;           \
    *(uint4*)(Kb_ + 8192 + swz(lrow + 32, lch)) = rv1;      \
  }
  ATT_GLOAD(0);
  ATT_LSTORE(0);
  __syncthreads();
  for (int kt = 0; kt < nkt; ++kt) {
    const int buf = kt & 1;
    if (kt + 1 < nkt) ATT_GLOAD(kt + 1);
    const char* Kb = smem + buf * 16384;
    const char* Vb = Kb + 8192;
    f32x4 St[2][4];
#pragma unroll
    for (int mi = 0; mi < 2; ++mi)
#pragma unroll
      for (int ni = 0; ni < 4; ++ni) St[mi][ni] = f32x4{0.f, 0.f, 0.f, 0.f};
#pragma unroll
    for (int ks = 0; ks < 2; ++ks) {
      bf16x8 kf[4];
#pragma unroll
      for (int ni = 0; ni < 4; ++ni) kf[ni] = *(const bf16x8*)(Kb + swz(ni * 16 + l15, ks * 4 + quad));
#pragma unroll
      for (int mi = 0; mi < 2; ++mi)
#pragma unroll
        for (int ni = 0; ni < 4; ++ni) St[mi][ni] = mfma16(kf[ni], qf[mi][ks], St[mi][ni]);
    }
    bf16x8 pf[2][2];
#pragma unroll
    for (int mi = 0; mi < 2; ++mi) {
      float mx = St[mi][0][0];
#pragma unroll
      for (int ni = 0; ni < 4; ++ni)
#pragma unroll
        for (int jj = 0; jj < 4; ++jj) mx = fmaxf(mx, St[mi][ni][jj]);
      mx = fmaxf(mx, __shfl_xor(mx, 16));
      mx = fmaxf(mx, __shfl_xor(mx, 32));
      const float mnew = fmaxf(mrow[mi], mx);
      const float alpha = __builtin_amdgcn_exp2f((mrow[mi] - mnew) * LOG2E);
      mrow[mi] = mnew;
      const float mb = mnew * LOG2E;
      float ps = 0.f;
      float pv[4][4];
#pragma unroll
      for (int ni = 0; ni < 4; ++ni)
#pragma unroll
        for (int jj = 0; jj < 4; ++jj) {
          pv[ni][jj] = __builtin_amdgcn_exp2f(St[mi][ni][jj] * LOG2E - mb);
          ps += pv[ni][jj];
        }
      lpart[mi] = lpart[mi] * alpha + ps;
#pragma unroll
      for (int nd = 0; nd < 4; ++nd) {
        Ot[mi][nd][0] *= alpha; Ot[mi][nd][1] *= alpha; Ot[mi][nd][2] *= alpha; Ot[mi][nd][3] *= alpha;
      }
#pragma unroll
      for (int s2 = 0; s2 < 2; ++s2) {
        union { unsigned u[4]; bf16x8 v; } pk;
        pk.u[0] = pk2(pv[2 * s2][0], pv[2 * s2][1]);
        pk.u[1] = pk2(pv[2 * s2][2], pv[2 * s2][3]);
        pk.u[2] = pk2(pv[2 * s2 + 1][0], pv[2 * s2 + 1][1]);
        pk.u[3] = pk2(pv[2 * s2 + 1][2], pv[2 * s2 + 1][3]);
        pf[mi][s2] = pk.v;
      }
    }
#pragma unroll
    for (int s2 = 0; s2 < 2; ++s2) {
      bf16x8 vf[4];
#pragma unroll
      for (int nd = 0; nd < 4; ++nd) {
        const int drow = nd * 16 + l15;
        union { uint2 h[2]; bf16x8 v; } vv;
        vv.h[0] = *(const uint2*)(Vb + swz(drow, 4 * s2 + (quad >> 1)) + (quad & 1) * 8);
        vv.h[1] = *(const uint2*)(Vb + swz(drow, 4 * s2 + 2 + (quad >> 1)) + (quad & 1) * 8);
        vf[nd] = vv.v;
      }
#pragma unroll
      for (int mi = 0; mi < 2; ++mi)
#pragma unroll
        for (int nd = 0; nd < 4; ++nd) Ot[mi][nd] = mfma16(vf[nd], pf[mi][s2], Ot[mi][nd]);
    }
    if (kt + 1 < nkt) ATT_LSTORE(buf ^ 1);
    __syncthreads();
  }
#undef ATT_GLOAD
#undef ATT_LSTORE
#pragma unroll
  for (int mi = 0; mi < 2; ++mi) {
    float lsum = lpart[mi];
    lsum += __shfl_xor(lsum, 16);
    lsum += __shfl_xor(lsum, 32);
    const float inv = 1.f / lsum;
    const int r = qrow0 + wid * 32 + mi * 16 + l15;
#pragma unroll
    for (int nd = 0; nd < 4; ++nd)
      *(uint2*)(p.act + (size_t)r * DM + 640 + hq * 64 + nd * 16 + quad * 4) =
          make_uint2(pk2(Ot[mi][nd][0] * inv, Ot[mi][nd][1] * inv), pk2(Ot[mi][nd][2] * inv, Ot[mi][nd][3] * inv));
  }
}

DEV void sgate_item(const P& p, int l, int ck, int g, char* smem) {
  const int tid = tid_l(), lane = tid & 63, wid = tid >> 6, l15 = lane & 15, quad = lane >> 4;
  const int m0 = ck * 128;
  u16* sVT = (u16*)smem;
  {
    const int q = tid >> 1, half = tid & 1;
    const u16* src = p.z + (size_t)(m0 + q) * INC + 1408 + 256 + g * 64 + half * 32;
    float v[32];
    float ss = 0.f;
#pragma unroll
    for (int cidx = 0; cidx < 4; ++cidx) {
      uint4 u = *(const uint4*)(src + cidx * 8);
      unsigned uu[4] = {u.x, u.y, u.z, u.w};
#pragma unroll
      for (int e = 0; e < 4; ++e) {
        float f0 = geluf_(bf2f((u16)(uu[e] & 0xffff)));
        float f1 = geluf_(bf2f((u16)(uu[e] >> 16)));
        v[cidx * 8 + e * 2] = f0;
        v[cidx * 8 + e * 2 + 1] = f1;
        ss += f0 * f0 + f1 * f1;
      }
    }
    ss += __shfl_xor(ss, 1);
    const float rstd = rsqrtf(ss * (1.f / 64.f) + 1e-6f);
    const float* gn = p.sgn + l * 256 + g * 64 + half * 32;
#pragma unroll
    for (int e = 0; e < 32; ++e) sVT[(half * 32 + e) * 136 + q] = f2bf(v[e] * rstd * gn[e]);
  }
  __syncthreads();
  f32x4 acc[2][4];
#pragma unroll
  for (int mi = 0; mi < 2; ++mi)
#pragma unroll
    for (int ni = 0; ni < 4; ++ni) acc[mi][ni] = f32x4{0.f, 0.f, 0.f, 0.f};
  const u16* Wg = p.sgW + (size_t)(l * 4 + g) * 128 * 128;
#pragma unroll
  for (int ks = 0; ks < 4; ++ks) {
    bf16x8 a[2], bb[4];
#pragma unroll
    for (int mi = 0; mi < 2; ++mi) a[mi] = *(const bf16x8*)(Wg + (size_t)(wid * 32 + mi * 16 + l15) * 128 + ks * 32 + quad * 8);
#pragma unroll
    for (int ni = 0; ni < 4; ++ni) bb[ni] = *(const bf16x8*)(sVT + (ni * 16 + l15) * 136 + ks * 32 + quad * 8);
#pragma unroll
    for (int mi = 0; mi < 2; ++mi)
#pragma unroll
      for (int ni = 0; ni < 4; ++ni) acc[mi][ni] = mfma16(a[mi], bb[ni], acc[mi][ni]);
  }
#pragma unroll
  for (int mi = 0; mi < 2; ++mi)
#pragma unroll
    for (int j = 0; j < 4; ++j) {
      const int pr = wid * 32 + mi * 16 + quad * 4 + j;
      const float bias = p.sg_b[(size_t)(l * 4 + g) * 128 + pr];
#pragma unroll
      for (int ni = 0; ni < 4; ++ni) {
        const int c = ni * 16 + l15;
        float u = geluf_(bf2f(p.z[(size_t)(m0 + pr) * INC + 1408 + g * 64 + c]));
        p.act[(size_t)(m0 + pr) * DM + 384 + g * 64 + c] = f2bf(u * (acc[mi][ni][j] + bias));
      }
    }
  __syncthreads();
}

DEV void mix_phase(const P& p, int l, char* smem, int cidx) {
  __shared__ int s_item;
  const bool last = (l == DEPTH - 1);
  const int n_attn = last ? 1536 : 1632;
  const int ck_lo = last ? 16 : 0;
  const int n_sg = (NMT - ck_lo) * 4;
  const int total = SCAN_ITEMS + n_attn + n_sg;
  const int bid = bid_l();
  bool first = bid < SCAN_ITEMS;
  for (;;) {
    int it;
    if (first) {
      it = bid;
      first = false;
    } else {
      if (tid_l() == 0) s_item = SCAN_ITEMS + atomicAdd(p.cnt + cidx, 1);
      __syncthreads();
      it = s_item;
      __syncthreads();
    }
    if (it >= total) break;
    if (it < SCAN_ITEMS) {
      int nr = SCAN_REP; asm volatile("" : "+s"(nr));
      for (int rr = 0; rr < nr; ++rr) scan_item(p, l, it, smem);
    } else if (it < SCAN_ITEMS + n_attn) {
      int nr = ATT_REP; asm volatile("" : "+s"(nr));
      for (int rr = 0; rr < nr; ++rr) { attn_item(p, it - SCAN_ITEMS, smem); __syncthreads(); }
    } else {
      int i2 = it - SCAN_ITEMS - n_attn;
      int nr = SG_REP; asm volatile("" : "+s"(nr));
      for (int rr = 0; rr < nr; ++rr) sgate_item(p, l, ck_lo + (i2 >> 2), i2 & 3, smem);
    }
  }
}

DEV void apost_phase(const P& p, int l, int mt_lo, char* smem) {
  const int tid = tid_l(), lane = tid & 63, wid = tid >> 6, l15 = lane & 15, quad = lane >> 4;
  for (int i = bid_l() * 256 + tid; i < MT; i += gridDim.x * 256) { p.rss1[i] = 0.f; p.rss2[i] = 0.f; }
  const int nit = (NMT - mt_lo) * 6;
  for (int it = bid_l(); it < nit; it += gridDim.x) {
    const int mt = mt_lo + it / 6;
    const int hh = it % 6;
    const int m0 = mt * 128;
    bf16x8 a[2][4];
#pragma unroll
    for (int mi = 0; mi < 2; ++mi)
#pragma unroll
      for (int ks = 0; ks < 4; ++ks)
        a[mi][ks] = *(const bf16x8*)(p.z + (size_t)(m0 + wid * 32 + mi * 16 + l15) * INC + 1280 + ks * 32 + quad * 8);
    {
      f32x4 acc[2][4];
#pragma unroll
      for (int mi = 0; mi < 2; ++mi)
#pragma unroll
        for (int ni = 0; ni < 4; ++ni) acc[mi][ni] = f32x4{0.f, 0.f, 0.f, 0.f};
#pragma unroll
      for (int ks = 0; ks < 4; ++ks) {
        bf16x8 bb[4];
#pragma unroll
        for (int ni = 0; ni < 4; ++ni)
          bb[ni] = *(const bf16x8*)(p.gUpT + ((size_t)l * 384 + hh * 64 + ni * 16 + l15) * 128 + ks * 32 + quad * 8);
#pragma unroll
        for (int mi = 0; mi < 2; ++mi)
#pragma unroll
          for (int ni = 0; ni < 4; ++ni) acc[mi][ni] = mfma16(bb[ni], a[mi][ks], acc[mi][ni]);
      }
      float4 lg[4], lb[4];
#pragma unroll
      for (int ni = 0; ni < 4; ++ni) {
        lg[ni] = *(const float4*)(p.ln_g + l * 384 + hh * 64 + ni * 16 + quad * 4);
        lb[ni] = *(const float4*)(p.ln_b + l * 384 + hh * 64 + ni * 16 + quad * 4);
      }
#pragma unroll
      for (int mi = 0; mi < 2; ++mi) {
        const int r = m0 + wid * 32 + mi * 16 + l15;
        float4 ys[4];
        uint2 vraw[4];
        float sm = 0.f;
#pragma unroll
        for (int ni = 0; ni < 4; ++ni) {
          const int c = hh * 64 + ni * 16 + quad * 4;
          const float4 y0 = *(const float4*)(p.y + (size_t)r * 384 + c);
          const float4 y1 = *(const float4*)(p.y + ((size_t)MT + r) * 384 + c);
          ys[ni] = make_float4(y0.x + y1.x, y0.y + y1.y, y0.z + y1.z, y0.w + y1.w);
          vraw[ni] = *(const uint2*)(p.z + (size_t)r * INC + 768 + c);
          sm += (ys[ni].x + ys[ni].y) + (ys[ni].z + ys[ni].w);
        }
        const float4 bq0 = *(const float4*)(p.bonus + (size_t)r * 48 + hh * 4);
        const float4 bq1 = *(const float4*)(p.bonus + (size_t)r * 48 + (6 + hh) * 4);
        const float bon = (bq0.x + bq0.y) + (bq0.z + bq0.w) + (bq1.x + bq1.y) + (bq1.z + bq1.w);
        sm += __shfl_xor(sm, 16);
        sm += __shfl_xor(sm, 32);
        const float mean = sm * (1.f / 64.f);
        float vs = 0.f;
#pragma unroll
        for (int ni = 0; ni < 4; ++ni) {
          ys[ni].x -= mean; ys[ni].y -= mean; ys[ni].z -= mean; ys[ni].w -= mean;
          vs += ys[ni].x * ys[ni].x + ys[ni].y * ys[ni].y + ys[ni].z * ys[ni].z + ys[ni].w * ys[ni].w;
        }
        vs += __shfl_xor(vs, 16);
        vs += __shfl_xor(vs, 32);
        const float rstd = rsqrtf(vs * (1.f / 64.f) + 64e-5f);
#pragma unroll
        for (int ni = 0; ni < 4; ++ni) {
          const int c = hh * 64 + ni * 16 + quad * 4;
          const float v0 = __uint_as_float(vraw[ni].x << 16), v1 = __uint_as_float(vraw[ni].x & 0xffff0000u);
          const float v2 = __uint_as_float(vraw[ni].y << 16), v3 = __uint_as_float(vraw[ni].y & 0xffff0000u);
          const float o0 = (ys[ni].x * rstd * lg[ni].x + lb[ni].x + bon * v0) * acc[mi][ni][0];
          const float o1 = (ys[ni].y * rstd * lg[ni].y + lb[ni].y + bon * v1) * acc[mi][ni][1];
          const float o2 = (ys[ni].z * rstd * lg[ni].z + lb[ni].z + bon * v2) * acc[mi][ni][2];
          const float o3 = (ys[ni].w * rstd * lg[ni].w + lb[ni].w + bon * v3) * acc[mi][ni][3];
          *(uint2*)(p.act + (size_t)r * DM + c) = make_uint2(pk2(o0, o1), pk2(o2, o3));
        }
        __builtin_amdgcn_sched_barrier(0);
      }
    }
  }
}

DEV uint2 ld8(const u16* q) { return *(const uint2*)q; }
DEV void up4(const uint2 u, float (&f)[4]) {
  f[0] = __uint_as_float(u.x << 16); f[1] = __uint_as_float(u.x & 0xffff0000u);
  f[2] = __uint_as_float(u.y << 16); f[3] = __uint_as_float(u.y & 0xffff0000u);
}
DEV void prep_phase(const P& p, int l, cg::grid_group& grid) {
  const int tid = tid_l(), lane = tid & 63, l15 = lane & 15;
  const int nb = gridDim.x, bid = bid_l();
  constexpr int NR = 8;
  const int rpb = (((MT + nb - 1) / nb) + NR - 1) & ~(NR - 1);
  const int ra = bid * rpb;
  const int rb = min(ra + rpb, MT);
  const bool active = ra < MT;
  const bool has1 = tid < 96;
  const int col0 = tid * 4, col1 = 1024 + tid * 4;
  uint2 hp0 = make_uint2(0, 0), hn0 = hp0, hp1 = hp0, hn1 = hp0;
  if (active) {
    if (ra > 0) { hp0 = ld8(p.z + (size_t)(ra - 1) * INC + col0); if (has1) hp1 = ld8(p.z + (size_t)(ra - 1) * INC + col1); }
    if (rb < MT) { hn0 = ld8(p.z + (size_t)rb * INC + col0); if (has1) hn1 = ld8(p.z + (size_t)rb * INC + col1); }
  }
  grid.sync();
  if (!active) return;
  const float* cw = p.conv + (size_t)l * 3 * 1408;
#pragma unroll 1
  for (int pass = 0; pass < 2; ++pass) {
    if (pass == 1 && !has1) break;
    const int col = pass ? col1 : col0;
    const int typ = col < 1152 ? 0 : (col < 1216 ? 1 : (col < 1280 ? 0 : 2));
    const bool isk = col >= 384 && col < 768;
    float c0[4], c1[4], c2[4], kk4[4];
#pragma unroll
    for (int e = 0; e < 4; ++e) {
      c0[e] = cw[col + e]; c1[e] = cw[1408 + col + e]; c2[e] = cw[2816 + col + e];
      kk4[e] = isk ? p.k_k[l * 384 + (col - 384) + e] : 0.f;
    }
    const int hh = isk ? (col - 384) >> 6 : 0;
    u16* zc = p.z + col;
    uint2 prev = pass ? hp1 : hp0;
    const uint2 halo_n = pass ? hn1 : hn0;
    uint2 cur = ld8(zc + (size_t)ra * INC);
    for (int r = ra; r < rb; r += NR) {
      uint2 w[NR + 2];
      w[0] = prev;
      w[1] = cur;
#pragma unroll
      for (int q = 0; q < NR; ++q) {
        const int rr = r + 1 + q;
        w[q + 2] = rr < rb ? ld8(zc + (size_t)rr * INC) : halo_n;
      }
#pragma unroll
      for (int q = 0; q < NR; ++q) {
        const int rr = r + q;
        const uint2 xp = w[q], xc = w[q + 1], xn = w[q + 2];
        const int tt = rr < MC ? (rr & 255) : ((rr - MC) & 4095);
        const int len = rr < MC ? 256 : 4096;
        const float mp = tt > 0 ? 1.f : 0.f, mn = tt < len - 1 ? 1.f : 0.f;
        float fp[4], fc[4], fn[4], o[4];
        up4(xp, fp); up4(xc, fc); up4(xn, fn);
#pragma unroll
        for (int e = 0; e < 4; ++e) {
          float v = fc[e] * c1[e] + mp * (fp[e] * c0[e]) + mn * (fn[e] * c2[e]);
          if (typ == 1) v = tanh_fast(v);
          else if (typ == 2) v = sigmoidf_(v);
          o[e] = v;
        }
        if (isk) {
          float q0 = o[0] * kk4[0], q1 = o[1] * kk4[1], q2 = o[2] * kk4[2], q3 = o[3] * kk4[3];
          float ss = red16_sum(q0 * q0 + q1 * q1 + q2 * q2 + q3 * q3);
          if (l15 == 0 && rr < rb) p.invn[(size_t)rr * 8 + hh] = 1.f / fmaxf(sqrtf(ss), 1e-12f);
        }
        if (rr < rb) *(uint2*)(zc + (size_t)rr * INC) = make_uint2(pk2(o[0], o[1]), pk2(o[2], o[3]));
      }
      prev = w[NR];
      cur = w[NR + 1];
    }
  }
}

__global__ void __launch_bounds__(256, 2) fwd_megakernel(P p, int ph_lo, int ph_hi) {
  __shared__ __attribute__((aligned(16))) char smem[65536 - 64];
  cg::grid_group grid = cg::this_grid();
  for (int ph = ph_lo; ph < ph_hi; ++ph) {
    if (ph > ph_lo) grid.sync();
    if (ph == 0) { phase0(p, smem); continue; }
    if (ph == 1) { phase0b(p, smem); continue; }
    if (ph == 2 + 6 * DEPTH) { final_norm(p); continue; }
    const int l = (ph - 2) / 6, sub = (ph - 2) % 6;
    const bool last = (l == DEPTH - 1);
    const int mt_lo = last ? 16 : 0;
    GX g0{};
    g0.rss_acc = nullptr; g0.aout = nullptr; g0.gnext = nullptr; g0.lmod = 0; g0.scoff = 0;
    if (sub == 0) {
      gemm_phase<EPI_Z>(p, l, p.act, DM, p.wIn + (size_t)l * 2560 * 1024, 1024, 20, 0, 0, smem, g0, 0);
    } else if (sub == 1) {
      prep_phase(p, l, grid);
      grid.sync();
      mix_phase(p, l, smem, l);
    } else if (sub == 2) {
      apost_phase(p, l, mt_lo, smem);
    } else if (sub == 3 || sub == 5) {
      const bool g4 = sub == 5;
      GX gx{};
      gx.rss_acc = g4 ? p.rss1 : p.rss2;
      gx.aout = g4 ? (last ? nullptr : p.act) : p.act2;
      gx.gnext = g4 ? p.n1g + (last ? 0 : (l + 1) * DM) : p.n2g + l * DM;
      gx.lmod = g4 ? (last ? l : l + 1) : l;
      gx.scoff = g4 ? 1024 : 4096;
      gemm_phase<EPI_RES>(p, l, g4 ? p.h : p.act, g4 ? DFF : DM,
                          g4 ? p.w2t + (size_t)l * 1024 * 2816 : p.wOut + (size_t)l * 1024 * 1024, g4 ? 2816 : 1024, 8, mt_lo,
                          g4 ? 5120 : 2048, smem, gx, 0);
    } else {
      gemm_phase<EPI_SWIGLU>(p, l, p.act2, DM, p.w1t + (size_t)l * 5632 * 1024, 1024, 44, mt_lo, 0, smem, g0, 0);
    }
  }
}

extern "C" void kernel_launch(void* const* d_in, const int* in_sizes, int n_in, void* d_out, int out_size, void* d_ws,
                              size_t ws_size, hipStream_t stream) {
  static int grid_blocks = 0;
  if (!grid_blocks) {
    int dev = 0, cus = 0, per_cu = 0;
    hipGetDevice(&dev);
    hipDeviceGetAttribute(&cus, hipDeviceAttributeMultiprocessorCount, dev);
    hipOccupancyMaxActiveBlocksPerMultiprocessor(&per_cu, fwd_megakernel, 256, 0);
    if (per_cu > 2) per_cu = 2;
    if (per_cu < 1) per_cu = 1;
    grid_blocks = cus * per_cu;
  }
  P p{};
  const float* const* in = (const float* const*)d_in;
  p.x = in[0]; p.c = in[1]; p.ctx = in[2]; p.c_ctx = in[3]; p.n1g = in[4]; p.n2g = in[5]; p.ada_w = in[6]; p.ada_b = in[7];
  p.w_in = in[8]; p.conv = in[9]; p.w0 = in[10]; p.w_up = in[11]; p.a0 = in[12]; p.a_up = in[13]; p.g_up = in[14];
  p.k_k = in[15]; p.k_a = in[16]; p.r_k = in[17]; p.ln_g = in[18]; p.ln_b = in[19]; p.sgn = in[20]; p.sg_w = in[21];
  p.sg_b = in[22]; p.q_g = in[23]; p.k_g = in[24]; p.w_out = in[25]; p.w1 = in[26]; p.w2 = in[27]; p.fng = in[28];
  p.out = (float*)d_out;
  char* ws = (char*)d_ws;
  size_t off = 0;
  auto take = [&](size_t bytes) { char* r = ws + off; off += (bytes + 255) & ~(size_t)255; return r; };
  p.wIn = (u16*)take((size_t)4 * 2560 * 1024 * 2);
  p.wOut = (u16*)take((size_t)4 * 1024 * 1024 * 2);
  p.w1t = (u16*)take((size_t)4 * 5632 * 1024 * 2);
  p.w2t = (u16*)take((size_t)4 * 1024 * 2816 * 2);
  p.wUpT = (u16*)take((size_t)8 * 384 * 64 * 2);
  p.aUpT = (u16*)take((size_t)8 * 384 * 64 * 2);
  p.gUpT = (u16*)take((size_t)4 * 384 * 128 * 2);
  p.sgW = (u16*)take((size_t)16 * 128 * 128 * 2);
  p.mods = (float*)take((size_t)4 * 9 * 6144 * 4);
  p.rope = (float*)take(2048 * 4);
  p.cnt = (int*)take(256);
  p.xc = (float*)take((size_t)MC * DM * 4);
  p.act = (u16*)take((size_t)MT * DM * 2);
  p.z = (u16*)take((size_t)MT * DFF * 2);
  p.h = p.z;
  p.vTl = (u16*)take((size_t)16 * 64 * SEQ * 2);
  p.vTc = (u16*)take((size_t)16 * 64 * CTXL * 2);
  p.y = (float*)take((size_t)2 * MT * 384 * 4);
  p.bonus = (float*)take((size_t)MT * 48 * 4);
  p.invn = (float*)take((size_t)MT * 8 * 4);
  p.rss1 = (float*)take((size_t)MT * 4);
  p.rss2 = (float*)take((size_t)MT * 4);
  p.bz = (float*)take((size_t)4 * 9 * 2560 * 4);
  p.bh = (float*)take((size_t)4 * 9 * 5632 * 4);
  p.act2 = (u16*)p.y;
  if (off > ws_size) { fprintf(stderr, "workspace too small: need %zu have %zu\n", off, ws_size); return; }
  int ph_lo = 0, ph_hi = 3 + 6 * DEPTH;
  void* args[] = {&p, &ph_lo, &ph_hi};
  hipError_t e = hipLaunchCooperativeKernel((void*)fwd_megakernel, dim3(grid_blocks), dim3(256), args, 0, stream);
  if (e != hipSuccess) fprintf(stderr, "cooperative launch failed: %s (grid %d)\n", hipGetErrorString(e), grid_blocks);
}
```

```cpp
#include <hip/hip_runtime.h>
#include <hip/hip_bf16.h>
#include <hip/hip_cooperative_groups.h>
#include <cstdio>
namespace cg = cooperative_groups;

typedef __attribute__((ext_vector_type(8))) short bf16x8;
typedef __attribute__((ext_vector_type(4))) float f32x4;
typedef unsigned short u16;
typedef __attribute__((ext_vector_type(2))) float float2v;

#define DEV __device__ __forceinline__
DEV int tid_l() { int t = threadIdx.x; asm volatile("" : "+v"(t)); return t; }
DEV int bid_l() { int b = blockIdx.x; asm volatile("" : "+s"(b)); return b; }

constexpr int DM = 1024, NBATCH = 8, SEQ = 4096, DEPTH = 4, CTXL = 256;
constexpr int MC = NBATCH * CTXL;
constexpr int ML = NBATCH * SEQ;
constexpr int MT = MC + ML;
constexpr int INC = 2560, DFF = 2816;
constexpr int NMT = MT / 128;
#ifndef PROBE_MASK
#define PROBE_MASK 0
#endif
#define SCAN_REP 1
#define ATT_REP 1
#define SG_REP 1

struct P {
  const float *x, *c, *ctx, *c_ctx, *n1g, *n2g, *ada_w, *ada_b, *w_in, *conv, *w0, *w_up, *a0, *a_up, *g_up,
      *k_k, *k_a, *r_k, *ln_g, *ln_b, *sgn, *sg_w, *sg_b, *q_g, *k_g, *w_out, *w1, *w2, *fng;
  float* out;
  u16 *wIn, *wOut, *w1t, *w2t, *wUpT, *aUpT, *gUpT, *sgW;
  float *mods, *rope;
  int* cnt;
  float* xc;
  u16 *act, *z, *h, *vTl, *vTc;
  float *y, *bonus, *invn;
  float *rss1, *rss2, *bz, *bh;
  u16* act2;
};

typedef __attribute__((ext_vector_type(2))) __bf16 bf16x2v;
typedef __attribute__((ext_vector_type(2))) float f32x2v;
DEV unsigned pk2(float a, float b) {
  f32x2v v = {a, b};
  bf16x2v r = __builtin_convertvector(v, bf16x2v);
  return *(unsigned*)&r;
}
DEV u16 f2bf(float f) { return (u16)(pk2(f, 0.f) & 0xffffu); }
DEV float bf2f(u16 h) { return __uint_as_float(((unsigned)h) << 16); }
DEV float sigmoidf_(float x) { return __builtin_amdgcn_rcpf(1.f + __expf(-x)); }
DEV float siluf_(float x) { return x * __builtin_amdgcn_rcpf(1.f + __expf(-x)); }
DEV float geluf_(float x) {
  float u = 0.7978845608028654f * (x + 0.044715f * x * x * x);
  return 0.5f * x * (1.f + tanhf(u));
}
DEV int swz(int r, int ch) { return r * 128 + ((ch ^ ((r >> 1) & 7)) << 4); }

template <int CTRL>
DEV float dppf(float v) {
  return __int_as_float(__builtin_amdgcn_update_dpp(0, __float_as_int(v), CTRL, 0xF, 0xF, false));
}
DEV float red16_sum(float v) {
  v += dppf<0xB1>(v);
  v += dppf<0x4E>(v);
  v += dppf<0x141>(v);
  v += dppf<0x140>(v);
  return v;
}
DEV float red16_max(float v) {
  v = fmaxf(v, dppf<0xB1>(v));
  v = fmaxf(v, dppf<0x4E>(v));
  v = fmaxf(v, dppf<0x141>(v));
  v = fmaxf(v, dppf<0x140>(v));
  return v;
}
DEV float wave_sum(float v) {
#pragma unroll
  for (int o = 32; o >= 1; o >>= 1) v += __shfl_xor(v, o);
  return v;
}
DEV f32x4 mfma16(bf16x8 a, bf16x8 b, f32x4 c) { return __builtin_amdgcn_mfma_f32_16x16x32_bf16(a, b, c, 0, 0, 0); }


DEV void gbar(unsigned* cnt, unsigned& epoch) {
  asm volatile("s_waitcnt vmcnt(0) lgkmcnt(0)" ::: "memory");
  __syncthreads();
  epoch += gridDim.x;
  if (threadIdx.x == 0) {
    __builtin_amdgcn_fence(__ATOMIC_RELEASE, "agent");
    asm volatile("s_waitcnt vmcnt(0)" ::: "memory");
    __hip_atomic_fetch_add(cnt, 1u, __ATOMIC_RELAXED, __HIP_MEMORY_SCOPE_AGENT);
    unsigned sp = 0;
    while (__hip_atomic_load(cnt, __ATOMIC_RELAXED, __HIP_MEMORY_SCOPE_AGENT) < epoch) {
      __builtin_amdgcn_s_sleep(1);
      if (++sp > (1u << 22)) break;
    }
    __builtin_amdgcn_fence(__ATOMIC_ACQUIRE, "agent");
    asm volatile("s_waitcnt vmcnt(0)" ::: "memory");
  }
  __syncthreads();
}

DEV void tr_tile(const float* __restrict__ src, u16* __restrict__ dst, int K, int N, int kt, int nt, bool il, float* lds) {
  const int tid = tid_l();
  const int k0 = kt * 64, n0 = nt * 64;
  {
    const int c = tid & 63, r0 = tid >> 6;
#pragma unroll
    for (int i = 0; i < 16; ++i) {
      int r = r0 + i * 4;
      lds[r * 65 + c] = src[(size_t)(k0 + r) * N + n0 + c];
    }
  }
  __syncthreads();
  {
    const int ch = tid & 7, nn0 = tid >> 3;
#pragma unroll
    for (int i = 0; i < 2; ++i) {
      const int n = nn0 + i * 32;
      const int gn = n0 + n;
      int np = gn;
      if (il) {
        int j = gn < DFF ? gn : gn - DFF;
        np = (j >> 4) * 32 + (j & 15) + (gn < DFF ? 0 : 16);
      }
      const float* sp = lds + (ch * 8) * 65 + n;
      uint4 o;
      o.x = pk2(sp[0 * 65], sp[1 * 65]);
      o.y = pk2(sp[2 * 65], sp[3 * 65]);
      o.z = pk2(sp[4 * 65], sp[5 * 65]);
      o.w = pk2(sp[6 * 65], sp[7 * 65]);
      *(uint4*)(dst + (size_t)np * K + k0 + ch * 8) = o;
    }
  }
  __syncthreads();
}

DEV void phase0(const P& p, char* smem) {
  float* lds = (float*)smem;
  const int tid = tid_l();
  constexpr int C0 = 2560, C1 = C0 + 1024, C2 = C1 + 5632, C3 = C2 + 2816, C4 = C3 + 48, C5 = C4 + 48, C6 = C5 + 48,
                C7 = C6 + 64, C8 = C7 + 384, C9 = C8 + 1;
  for (int it = bid_l(); it < C9; it += gridDim.x) {
    if (it < C6) {
      const float* src; u16* dst; int K, N, kt, nt; bool il = false;
      if (it < C0) {
        int l = it / 640, r = it % 640;
        src = p.w_in + (size_t)l * 1024 * 2560; dst = p.wIn + (size_t)l * 2560 * 1024; K = 1024; N = 2560; kt = r / 40; nt = r % 40;
      } else if (it < C1) {
        int i2 = it - C0, l = i2 / 256, r = i2 % 256;
        src = p.w_out + (size_t)l * 1024 * 1024; dst = p.wOut + (size_t)l * 1024 * 1024; K = 1024; N = 1024; kt = r / 16; nt = r % 16;
      } else if (it < C2) {
        int i2 = it - C1, l = i2 / 1408, r = i2 % 1408;
        src = p.w1 + (size_t)l * 1024 * 5632; dst = p.w1t + (size_t)l * 5632 * 1024; K = 1024; N = 5632; kt = r / 88; nt = r % 88; il = true;
      } else if (it < C3) {
        int i2 = it - C2, l = i2 / 704, r = i2 % 704;
        src = p.w2 + (size_t)l * 2816 * 1024; dst = p.w2t + (size_t)l * 1024 * 2816; K = 2816; N = 1024; kt = r / 16; nt = r % 16;
      } else if (it < C4) {
        int i2 = it - C3, bb = i2 / 6;
        src = p.w_up + (size_t)bb * 64 * 384; dst = p.wUpT + (size_t)bb * 384 * 64; K = 64; N = 384; kt = 0; nt = i2 % 6;
      } else if (it < C5) {
        int i2 = it - C4, bb = i2 / 6;
        src = p.a_up + (size_t)bb * 64 * 384; dst = p.aUpT + (size_t)bb * 384 * 64; K = 64; N = 384; kt = 0; nt = i2 % 6;
      } else {
        int i2 = it - C5, l = i2 / 12, r = i2 % 12;
        src = p.g_up + (size_t)l * 128 * 384; dst = p.gUpT + (size_t)l * 384 * 128; K = 128; N = 384; kt = r / 6; nt = r % 6;
      }
      tr_tile(src, dst, K, N, kt, nt, il, lds);
    } else if (it < C7) {
      int i2 = it - C6;
      for (int i = 0; i < 16; ++i) {
        int e = i2 * 4096 + i * 256 + tid;
        p.sgW[e] = f2bf(p.sg_w[e]);
      }
    } else if (it < C8) {
      int i2 = it - C7, l = i2 / 96, cb = i2 % 96;
      for (int e = tid; e < 9 * 1024; e += 256) {
        int s = e >> 10, k = e & 1023;
        float v = s < 8 ? p.c[s * 1024 + k] : p.c_ctx[k];
        lds[e] = siluf_(v);
      }
      __syncthreads();
      const int col = tid & 63, kq = tid >> 6;
      const int n = cb * 64 + col;
      float acc[9];
#pragma unroll
      for (int s = 0; s < 9; ++s) acc[s] = 0.f;
      const float* wp = p.ada_w + (size_t)l * 1024 * 6144 + n;
#pragma unroll 4
      for (int k = kq * 256; k < kq * 256 + 256; ++k) {
        float w = wp[(size_t)k * 6144];
#pragma unroll
        for (int s = 0; s < 9; ++s) acc[s] += lds[s * 1024 + k] * w;
      }
      __syncthreads();
      float* red = lds + 9216;
#pragma unroll
      for (int s = 0; s < 9; ++s) red[(kq * 9 + s) * 64 + col] = acc[s];
      __syncthreads();
      for (int e = tid; e < 9 * 64; e += 256) {
        int s = e >> 6, cc = e & 63;
        float v = red[(0 * 9 + s) * 64 + cc] + red[(1 * 9 + s) * 64 + cc] + red[(2 * 9 + s) * 64 + cc] + red[(3 * 9 + s) * 64 + cc];
        int nn = cb * 64 + cc;
        p.mods[((size_t)l * 9 + s) * 6144 + nn] = v + p.ada_b[l * 6144 + nn];
      }
      __syncthreads();
    } else {
      for (int e = tid; e < 1024; e += 256) {
        int pos = e >> 4, i = e & 15;
        float inv = powf(10000.f, -(float)i / 16.f);
        float ang = (float)pos * inv;
        p.rope[e * 2] = cosf(ang);
        p.rope[e * 2 + 1] = sinf(ang);
      }
      if (tid < 64) p.cnt[tid] = 0;
    }
  }
}

DEV void norm_phase(const P& p, int l, const float* __restrict__ g, int shoff, int scoff, int row_lo, bool from_input) {
  const int tid = tid_l();
  const int lane = tid & 63;
  const int gw = bid_l() * 4 + (tid >> 6), nw = gridDim.x * 4;
  const float* lat = from_input ? p.x : p.out;
  const float* cx = from_input ? p.ctx : p.xc;
  for (int r0 = row_lo + gw; r0 < MT; r0 += 4 * nw) {
    float4 v[4][4];
#pragma unroll
    for (int u = 0; u < 4; ++u) {
      const int r = r0 + u * nw;
      if (r < MT) {
        const float* src = r < MC ? cx + (size_t)r * DM : lat + (size_t)(r - MC) * DM;
#pragma unroll
        for (int i = 0; i < 4; ++i) v[u][i] = *(const float4*)(src + i * 256 + lane * 4);
      }
    }
#pragma unroll
    for (int u = 0; u < 4; ++u) {
      const int r = r0 + u * nw;
      if (r < MT) {
        const int s = r < MC ? 8 : (r - MC) >> 12;
        const float* md = p.mods + ((size_t)l * 9 + s) * 6144;
        float ss = 0.f;
#pragma unroll
        for (int i = 0; i < 4; ++i) ss += v[u][i].x * v[u][i].x + v[u][i].y * v[u][i].y + v[u][i].z * v[u][i].z + v[u][i].w * v[u][i].w;
        ss = wave_sum(ss);
        const float rstd = rsqrtf(ss * (1.f / DM) + 1e-6f);
#pragma unroll
        for (int i = 0; i < 4; ++i) {
          const int c = i * 256 + lane * 4;
          float4 gg = *(const float4*)(g + c);
          float4 sh = *(const float4*)(md + shoff + c);
          float4 sc = *(const float4*)(md + scoff + c);
          float o0 = v[u][i].x * rstd * gg.x * (1.f + sc.x) + sh.x;
          float o1 = v[u][i].y * rstd * gg.y * (1.f + sc.y) + sh.y;
          float o2 = v[u][i].z * rstd * gg.z * (1.f + sc.z) + sh.z;
          float o3 = v[u][i].w * rstd * gg.w * (1.f + sc.w) + sh.w;
          uint2 o;
          o.x = pk2(o0, o1);
          o.y = pk2(o2, o3);
          *(uint2*)(p.act + (size_t)r * DM + c) = o;
        }
      }
    }
  }
}

DEV void final_norm(const P& p) {
  const int tid = tid_l();
  const int lane = tid & 63;
  const int gw = bid_l() * 4 + (tid >> 6), nw = gridDim.x * 4;
  for (int r0 = gw; r0 < ML; r0 += 4 * nw) {
    float4 v[4][4];
#pragma unroll
    for (int u = 0; u < 4; ++u) {
      const int r = r0 + u * nw;
      if (r < ML) {
#pragma unroll
        for (int i = 0; i < 4; ++i) v[u][i] = *(const float4*)(p.out + (size_t)r * DM + i * 256 + lane * 4);
      }
    }
#pragma unroll
    for (int u = 0; u < 4; ++u) {
      const int r = r0 + u * nw;
      if (r < ML) {
        const float rstd = rsqrtf(p.rss1[MC + r] * (1.f / DM) + 1e-6f);
#pragma unroll
        for (int i = 0; i < 4; ++i) {
          const int c = i * 256 + lane * 4;
          float4 gg = *(const float4*)(p.fng + c);
          float4 o;
          o.x = v[u][i].x * rstd * gg.x;
          o.y = v[u][i].y * rstd * gg.y;
          o.z = v[u][i].z * rstd * gg.z;
          o.w = v[u][i].w * rstd * gg.w;
          *(float4*)(p.out + (size_t)r * DM + c) = o;
        }
      }
    }
  }
}

DEV void phase0b(const P& p, char* smem) {
  float* lds = (float*)smem;
  const int tid = tid_l(), lane = tid & 63;
  for (int it = bid_l(); it < 512; it += gridDim.x) {
    const bool isz = it < 160;
    const int i2 = isz ? it : it - 160;
    const int l = isz ? i2 / 40 : i2 / 88, cb = isz ? i2 % 40 : i2 % 88;
    const int N = isz ? 2560 : 5632;
    const float* W = isz ? p.w_in + (size_t)l * 1024 * 2560 : p.w1 + (size_t)l * 1024 * 5632;
    for (int e = tid; e < 9 * 1024; e += 256) {
      const int s9 = e >> 10, k = e & 1023;
      lds[e] = p.mods[((size_t)l * 9 + s9) * 6144 + (isz ? 0 : 3072) + k];
    }
    __syncthreads();
    const int col = tid & 63, kq = tid >> 6;
    const int n = cb * 64 + col;
    float acc[9];
#pragma unroll
    for (int s9 = 0; s9 < 9; ++s9) acc[s9] = 0.f;
    const float* wp = W + n;
#pragma unroll 4
    for (int k = kq * 256; k < kq * 256 + 256; ++k) {
      const float w = wp[(size_t)k * N];
#pragma unroll
      for (int s9 = 0; s9 < 9; ++s9) acc[s9] += lds[s9 * 1024 + k] * w;
    }
    __syncthreads();
    float* red = lds + 9216;
#pragma unroll
    for (int s9 = 0; s9 < 9; ++s9) red[(kq * 9 + s9) * 64 + col] = acc[s9];
    __syncthreads();
    for (int e = tid; e < 9 * 64; e += 256) {
      const int s9 = e >> 6, cc = e & 63;
      const float v = red[(0 * 9 + s9) * 64 + cc] + red[(1 * 9 + s9) * 64 + cc] + red[(2 * 9 + s9) * 64 + cc] + red[(3 * 9 + s9) * 64 + cc];
      const int gn = cb * 64 + cc;
      if (isz) p.bz[((size_t)l * 9 + s9) * 2560 + gn] = v;
      else {
        const int j = gn < DFF ? gn : gn - DFF;
        const int np = (j >> 4) * 32 + (j & 15) + (gn < DFF ? 0 : 16);
        p.bh[((size_t)l * 9 + s9) * 5632 + np] = v;
      }
    }
    __syncthreads();
  }
  const int gw = bid_l() * 4 + (tid >> 6), nw = gridDim.x * 4;
  for (int r0 = gw; r0 < MT; r0 += 4 * nw) {
    float4 v[4][4];
#pragma unroll
    for (int u = 0; u < 4; ++u) {
      const int r = r0 + u * nw;
      if (r < MT) {
        const float* src = r < MC ? p.ctx + (size_t)r * DM : p.x + (size_t)(r - MC) * DM;
#pragma unroll
        for (int i = 0; i < 4; ++i) v[u][i] = *(const float4*)(src + i * 256 + lane * 4);
      }
    }
#pragma unroll
    for (int u = 0; u < 4; ++u) {
      const int r = r0 + u * nw;
      if (r < MT) {
        const int s9 = r < MC ? 8 : (r - MC) >> 12;
        const float* md = p.mods + (size_t)s9 * 6144 + 1024;
        float ss = 0.f;
#pragma unroll
        for (int i = 0; i < 4; ++i) ss += v[u][i].x * v[u][i].x + v[u][i].y * v[u][i].y + v[u][i].z * v[u][i].z + v[u][i].w * v[u][i].w;
        ss = wave_sum(ss);
        if (lane == 0) p.rss1[r] = ss;
#pragma unroll
        for (int i = 0; i < 4; ++i) {
          const int c = i * 256 + lane * 4;
          const float4 gg = *(const float4*)(p.n1g + c);
          const float4 sc = *(const float4*)(md + c);
          *(uint2*)(p.act + (size_t)r * DM + c) =
              make_uint2(pk2(v[u][i].x * gg.x * (1.f + sc.x), v[u][i].y * gg.y * (1.f + sc.y)),
                         pk2(v[u][i].z * gg.z * (1.f + sc.z), v[u][i].w * gg.w * (1.f + sc.w)));
        }
      }
    }
  }
}

enum { EPI_Z = 0, EPI_RES = 1, EPI_SWIGLU = 2 };
struct GX { float* rss_acc; u16* aout; const float* gnext; int lmod; int scoff; };

template <int EPI>
DEV void gemm_phase(const P& p, int l, const u16* __restrict__ A, int lda, const u16* __restrict__ Bt, int K, int NT,
                           int mt_lo, int goff, char* smem, GX gx, int dry = 0) {
  const int tid = tid_l(), lane = tid & 63, wid = tid >> 6, wr = wid >> 1, wc = wid & 1, l15 = lane & 15, quad = lane >> 4;
  const int nmt = NMT - mt_lo;
  const int nk = K / 64;
  const int npn = NT >> 2;
  const int npatch = (nmt >> 4) * npn;
  const int tmax = ((npatch + 7) >> 3) * 512;
#define G_MAP(T, OK, M0, N0)                                                                        \
  {                                                                                                 \
    const int xcd_ = (T)&7, sidx_ = (T) >> 3;                                                       \
    const int gp_ = (sidx_ >> 6) * 8 + xcd_;                                                        \
    OK = (T) < tmax && gp_ < npatch;                                                                \
    const int within_ = sidx_ & 63;                                                                 \
    M0 = (mt_lo + (gp_ / npn) * 16 + (within_ & 15)) * 128;                                         \
    N0 = ((gp_ % npn) * 4 + (within_ >> 4)) * 128;                                                  \
  }
  uint4 xa0, xa1, xa2, xa3, xb0, xb1, xb2, xb3, ya0, ya1, ya2, ya3, yb0, yb1, yb2, yb3;
  int t = bid_l();
  bool have;
  int m0, n0;
  G_MAP(t, have, m0, n0);
  const u16* Ag = A + (size_t)(m0 + (tid >> 3)) * lda + (tid & 7) * 8;
  const u16* Bg = Bt + (size_t)(n0 + (tid >> 3)) * K + (tid & 7) * 8;
  bool primed = false;
  while (have) {
    f32x4 acc[4][4];
#pragma unroll
    for (int i = 0; i < 4; ++i)
#pragma unroll
      for (int j = 0; j < 4; ++j) acc[i][j] = f32x4{0.f, 0.f, 0.f, 0.f};
#define G_GL(P, KT)                                                          \
    {                                                                        \
      const int k0_ = (KT)*64;                                               \
      P##a0 = *(const uint4*)(Ag + k0_);                                     \
      P##b0 = *(const uint4*)(Bg + k0_);                                     \
      P##a1 = *(const uint4*)(Ag + (size_t)32 * lda + k0_);                  \
      P##b1 = *(const uint4*)(Bg + (size_t)32 * K + k0_);                    \
      P##a2 = *(const uint4*)(Ag + (size_t)64 * lda + k0_);                  \
      P##b2 = *(const uint4*)(Bg + (size_t)64 * K + k0_);                    \
      P##a3 = *(const uint4*)(Ag + (size_t)96 * lda + k0_);                  \
      P##b3 = *(const uint4*)(Bg + (size_t)96 * K + k0_);                    \
    }
#define G_LS(P, BUF)                                                         \
    {                                                                        \
      char* Aw_ = smem + (BUF)*32768;                                        \
      *(uint4*)(Aw_ + swz((tid >> 3), tid & 7)) = P##a0;                     \
      *(uint4*)(Aw_ + 16384 + swz((tid >> 3), tid & 7)) = P##b0;             \
      *(uint4*)(Aw_ + swz((tid >> 3) + 32, tid & 7)) = P##a1;                \
      *(uint4*)(Aw_ + 16384 + swz((tid >> 3) + 32, tid & 7)) = P##b1;        \
      *(uint4*)(Aw_ + swz((tid >> 3) + 64, tid & 7)) = P##a2;                \
      *(uint4*)(Aw_ + 16384 + swz((tid >> 3) + 64, tid & 7)) = P##b2;        \
      *(uint4*)(Aw_ + swz((tid >> 3) + 96, tid & 7)) = P##a3;                \
      *(uint4*)(Aw_ + 16384 + swz((tid >> 3) + 96, tid & 7)) = P##b3;        \
    }
#define G_COMPUTE(BUF)                                                                                             \
    {                                                                                                              \
      const char* As = smem + (BUF)*32768;                                                                         \
      const char* Bs = As + 16384;                                                                                 \
      _Pragma("unroll") for (int kh = 0; kh < 2; ++kh) {                                                           \
        bf16x8 a[4], b[4];                                                                                         \
        _Pragma("unroll") for (int mi = 0; mi < 4; ++mi)                                                           \
            a[mi] = *(const bf16x8*)(As + swz(wr * 64 + mi * 16 + l15, kh * 4 + quad));                            \
        _Pragma("unroll") for (int ni = 0; ni < 4; ++ni)                                                           \
            b[ni] = *(const bf16x8*)(Bs + swz(wc * 64 + ni * 16 + l15, kh * 4 + quad));                            \
        _Pragma("unroll") for (int mi = 0; mi < 4; ++mi)                                                           \
            _Pragma("unroll") for (int ni = 0; ni < 4; ++ni) acc[mi][ni] = mfma16(b[ni], a[mi], acc[mi][ni]);      \
      }                                                                                                            \
    }
    if (!primed) {
      G_GL(x, 0);
      G_GL(y, 1);
    }
    G_LS(x, 0);
    if (2 < nk) G_GL(x, 2);
    __syncthreads();
    for (int kt = 0; kt < nk; kt += 2) {
      G_COMPUTE(0);
      G_LS(y, 1);
      if (kt + 3 < nk) G_GL(y, kt + 3);
      __syncthreads();
      G_COMPUTE(1);
      if (kt + 2 < nk) G_LS(x, 0);
      if (kt + 4 < nk) G_GL(x, kt + 4);
      __syncthreads();
    }
    const int em0 = m0, en0 = n0;
    t += gridDim.x;
    G_MAP(t, have, m0, n0);
    if (have) {
      Ag = A + (size_t)(m0 + (tid >> 3)) * lda + (tid & 7) * 8;
      Bg = Bt + (size_t)(n0 + (tid >> 3)) * K + (tid & 7) * 8;
      G_GL(x, 0);
      G_GL(y, 1);
      primed = true;
    }
    if (dry) {
      if (acc[0][0][0] == 1.2345e33f) p.bonus[0] = acc[1][1][1] + acc[2][2][2] + acc[3][3][3];
      continue;
    }
    const int cw0 = en0 + wc * 64;
    if constexpr (EPI == EPI_Z || EPI == EPI_SWIGLU) {
      const int sb_ = em0 < MC ? 8 : (em0 - MC) >> 12;
      const float* rssp = EPI == EPI_Z ? p.rss1 : p.rss2;
      const float* bias = EPI == EPI_Z ? p.bz + ((size_t)l * 9 + sb_) * 2560 + cw0 : p.bh + ((size_t)l * 9 + sb_) * 5632 + cw0;
      float rsv[4];
#pragma unroll
      for (int mi = 0; mi < 4; ++mi) rsv[mi] = rsqrtf(rssp[em0 + wr * 64 + mi * 16 + l15] * (1.f / DM) + 1e-6f);
#pragma unroll
      for (int ni = 0; ni < 4; ++ni) {
        const float4 bb = *(const float4*)(bias + ni * 16 + quad * 4);
#pragma unroll
        for (int mi = 0; mi < 4; ++mi) {
          acc[mi][ni][0] = acc[mi][ni][0] * rsv[mi] + bb.x;
          acc[mi][ni][1] = acc[mi][ni][1] * rsv[mi] + bb.y;
          acc[mi][ni][2] = acc[mi][ni][2] * rsv[mi] + bb.z;
          acc[mi][ni][3] = acc[mi][ni][3] * rsv[mi] + bb.w;
        }
      }
    }
    if constexpr (EPI == EPI_Z) {
      if (cw0 < 1920) {
#pragma unroll
        for (int mi = 0; mi < 4; ++mi) {
          const int r = em0 + wr * 64 + mi * 16 + l15;
#pragma unroll
          for (int ni = 0; ni < 4; ++ni)
            *(uint2*)(p.z + (size_t)r * INC + cw0 + ni * 16 + quad * 4) =
                make_uint2(pk2(acc[mi][ni][0], acc[mi][ni][1]), pk2(acc[mi][ni][2], acc[mi][ni][3]));
          __builtin_amdgcn_sched_barrier(0);
        }
      } else {
        const int hh = (cw0 - 1920) >> 6;
        if (hh < 8) {
          const float* gp = (hh < 6 ? p.q_g : p.k_g) + l * 64;
          float4 gv[4];
#pragma unroll
          for (int ni = 0; ni < 4; ++ni) gv[ni] = *(const float4*)(gp + ni * 16 + quad * 4);
          const float qs = hh < 6 ? 0.125f : 1.f;
#pragma unroll
          for (int mi = 0; mi < 4; ++mi) {
            const int r = em0 + wr * 64 + mi * 16 + l15;
            float ss = 0.f;
#pragma unroll
            for (int ni = 0; ni < 4; ++ni)
#pragma unroll
              for (int j = 0; j < 4; ++j) ss += acc[mi][ni][j] * acc[mi][ni][j];
            ss += __shfl_xor(ss, 16);
            ss += __shfl_xor(ss, 32);
            const float rstd = rsqrtf(ss * (1.f / 64.f) + 1e-6f) ;
            float yv[4][4];
#pragma unroll
            for (int ni = 0; ni < 4; ++ni) {
              yv[ni][0] = acc[mi][ni][0] * rstd * gv[ni].x;
              yv[ni][1] = acc[mi][ni][1] * rstd * gv[ni].y;
              yv[ni][2] = acc[mi][ni][2] * rstd * gv[ni].z;
              yv[ni][3] = acc[mi][ni][3] * rstd * gv[ni].w;
            }
            if (r >= MC) {
              const int tt = (r - MC) & 4095;
              const int prow = tt >> 6, pcol = tt & 63;
              const float* rr_ = p.rope + (prow * 16 + quad * 4) * 2;
              const float* rc_ = p.rope + (pcol * 16 + quad * 4) * 2;
              const float4 ra = *(const float4*)rr_, rb = *(const float4*)(rr_ + 4);
              const float4 ca = *(const float4*)rc_, cb = *(const float4*)(rc_ + 4);
              const float cr[4] = {ra.x, ra.z, rb.x, rb.z}, sr[4] = {ra.y, ra.w, rb.y, rb.w};
              const float cc[4] = {ca.x, ca.z, cb.x, cb.z}, sc[4] = {ca.y, ca.w, cb.y, cb.w};
#pragma unroll
              for (int j = 0; j < 4; ++j) {
                const float a0 = yv[0][j] * cr[j] - yv[1][j] * sr[j], a1 = yv[1][j] * cr[j] + yv[0][j] * sr[j];
                const float a2 = yv[2][j] * cc[j] - yv[3][j] * sc[j], a3 = yv[3][j] * cc[j] + yv[2][j] * sc[j];
                yv[0][j] = a0; yv[1][j] = a1; yv[2][j] = a2; yv[3][j] = a3;
              }
            }
#pragma unroll
            for (int ni = 0; ni < 4; ++ni)
              *(uint2*)(p.z + (size_t)r * INC + cw0 + ni * 16 + quad * 4) =
                  make_uint2(pk2(yv[ni][0] * qs, yv[ni][1] * qs), pk2(yv[ni][2] * qs, yv[ni][3] * qs));
            __builtin_amdgcn_sched_barrier(0);
          }
        } else {
          const int kvh = hh - 8;
#pragma unroll
          for (int mi = 0; mi < 4; ++mi) {
            const int r = em0 + wr * 64 + mi * 16 + l15;
            u16* vb;
            int vstride;
            if (r < MC) { vb = p.vTc + ((size_t)(((r >> 8) * 2 + kvh) * 64)) * CTXL + (r & 255); vstride = CTXL; }
            else { const int rr = r - MC; vb = p.vTl + ((size_t)(((rr >> 12) * 2 + kvh) * 64)) * SEQ + (rr & 4095); vstride = SEQ; }
#pragma unroll
            for (int ni = 0; ni < 4; ++ni)
#pragma unroll
              for (int j = 0; j < 4; ++j) vb[(size_t)(ni * 16 + quad * 4 + j) * vstride] = f2bf(acc[mi][ni][j]);
            __builtin_amdgcn_sched_barrier(0);
          }
        }
      }
    } else if constexpr (EPI == EPI_RES) {
      const int s = em0 < MC ? 8 : (em0 - MC) >> 12;
      const float* gate = p.mods + ((size_t)l * 9 + s) * 6144 + goff;
      float4 gv[4], gm[4];
#pragma unroll
      for (int ni = 0; ni < 4; ++ni) {
        gv[ni] = *(const float4*)(gate + cw0 + ni * 16 + quad * 4);
        gm[ni] = make_float4(0.f, 0.f, 0.f, 0.f);
        if (gx.aout) {
          const float4 g4 = *(const float4*)(gx.gnext + cw0 + ni * 16 + quad * 4);
          const float4 s4 = *(const float4*)(p.mods + ((size_t)gx.lmod * 9 + s) * 6144 + gx.scoff + cw0 + ni * 16 + quad * 4);
          gm[ni] = make_float4(g4.x * (1.f + s4.x), g4.y * (1.f + s4.y), g4.z * (1.f + s4.z), g4.w * (1.f + s4.w));
        }
      }
#pragma unroll
      for (int mi = 0; mi < 4; ++mi) {
        const int r = em0 + wr * 64 + mi * 16 + l15;
        const float* src;
        if (l == 0 && goff == 2048) src = r < MC ? p.ctx + (size_t)r * DM : p.x + (size_t)(r - MC) * DM;
        else src = r < MC ? p.xc + (size_t)r * DM : p.out + (size_t)(r - MC) * DM;
        float* dst = r < MC ? p.xc + (size_t)r * DM : p.out + (size_t)(r - MC) * DM;
        float ssq = 0.f;
#pragma unroll
        for (int ni = 0; ni < 4; ++ni) {
          const int c = cw0 + ni * 16 + quad * 4;
          const float4 xv = *(const float4*)(src + c);
          float4 o;
          o.x = xv.x + gv[ni].x * acc[mi][ni][0];
          o.y = xv.y + gv[ni].y * acc[mi][ni][1];
          o.z = xv.z + gv[ni].z * acc[mi][ni][2];
          o.w = xv.w + gv[ni].w * acc[mi][ni][3];
          *(float4*)(dst + c) = o;
          ssq += o.x * o.x + o.y * o.y + o.z * o.z + o.w * o.w;
          if (gx.aout) {
            *(uint2*)(gx.aout + (size_t)r * DM + c) =
                make_uint2(pk2(o.x * gm[ni].x, o.y * gm[ni].y), pk2(o.z * gm[ni].z, o.w * gm[ni].w));
          }
        }
        ssq += __shfl_xor(ssq, 16);
        ssq += __shfl_xor(ssq, 32);
        if (quad == 0) unsafeAtomicAdd(gx.rss_acc + r, ssq);
        __builtin_amdgcn_sched_barrier(0);
      }
    } else {
      const int hc0 = (en0 >> 1) + wc * 32;
#pragma unroll
      for (int mi = 0; mi < 4; ++mi) {
        const int r = em0 + wr * 64 + mi * 16 + l15;
#pragma unroll
        for (int pp = 0; pp < 2; ++pp) {
          float hv[4];
#pragma unroll
          for (int j = 0; j < 4; ++j) hv[j] = siluf_(acc[mi][2 * pp][j]) * acc[mi][2 * pp + 1][j];
          *(uint2*)(p.h + (size_t)r * DFF + hc0 + pp * 16 + quad * 4) = make_uint2(pk2(hv[0], hv[1]), pk2(hv[2], hv[3]));
        }
        __builtin_amdgcn_sched_barrier(0);
      }
    }
  }
}
#undef G_GL
#undef G_LS
#undef G_COMPUTE
#undef G_MAP

template <int LPR>
DEV float red_lpr(float v) {
  v += dppf<0xB1>(v);
  v += dppf<0x4E>(v);
  if (LPR >= 8) v += dppf<0x141>(v);
  if (LPR >= 16) v += dppf<0x140>(v);
  return v;
}

constexpr int SCAN_LPR = 8;
constexpr int SCAN_RPB = 256 / SCAN_LPR;
constexpr int SCAN_NPART = 64 / SCAN_RPB;
constexpr int SCAN_JL = 64 / SCAN_LPR;
constexpr int SCAN_ITEMS = 96 * SCAN_NPART;

DEV float red8_sum(float v) {
  v += dppf<0xB1>(v);
  v += dppf<0x4E>(v);
  v += dppf<0x141>(v);
  return v;
}
DEV float tanh_fast(float x) {
  float e = __expf(2.f * x);
  return 1.f - 2.f * __builtin_amdgcn_rcpf(1.f + e);
}

struct ChunkPos { int len, rowbase, tlo; };
DEV ChunkPos chunk_pos(int c, int d, int b) {
  ChunkPos cp;
  const int s0 = c * 16;
  int pos0;
  if (s0 < 256) { cp.len = 256; pos0 = s0; cp.rowbase = b * 256; }
  else { cp.len = 4096; pos0 = s0 - 256; cp.rowbase = MC + b * 4096; }
  cp.tlo = d ? (cp.len - 16 - pos0) : pos0;
  return cp;
}

constexpr int SC_R = 0, SC_KD = 12288, SC_V = 24576, SC_W = 30720, SC_KA = 38912, SC_NKK = 47104;

DEV void cvt8(const uint4 u, float4& lo, float4& hi) {
  lo.x = __uint_as_float(u.x << 16); lo.y = __uint_as_float(u.x & 0xffff0000u);
  lo.z = __uint_as_float(u.y << 16); lo.w = __uint_as_float(u.y & 0xffff0000u);
  hi.x = __uint_as_float(u.z << 16); hi.y = __uint_as_float(u.z & 0xffff0000u);
  hi.z = __uint_as_float(u.w << 16); hi.w = __uint_as_float(u.w & 0xffff0000u);
}

DEV void scan_item(const P& p, int l, int item, char* smem) {
  const int tid = tid_l(), lane = tid & 63, wid = tid >> 6, l15 = lane & 15, quad = lane >> 4;
  constexpr int LPR = SCAN_LPR, RPB = SCAN_RPB, JL = SCAN_JL, NV = RPB / 8;
  const int scan = item / SCAN_NPART, part = item % SCAN_NPART;
  const int d = scan / 48, b = (scan % 48) / 6, h = scan % 6;
  const int rloc = tid / LPR, jq = tid % LPR;
  const int irow = part * RPB + rloc;
  const int j0 = jq * JL;

  const int c_ts = (tid & 127) >> 3, c_ch = tid & 7;
  const int c_col = (tid < 128 ? 0 : 384) + h * 64 + c_ch * 8;
  const int v_ts = tid / NV, v_ch = tid % NV;
  const int v_col = 768 + h * 64 + part * RPB + v_ch * 8;

  const int n2 = wid * 16 + l15;
  bf16x8 bW[2], bA[2];
  {
    const u16* wb = p.wUpT + ((size_t)(l * 2 + d) * 384 + h * 64 + n2) * 64 + quad * 8;
    const u16* ab = p.aUpT + ((size_t)(l * 2 + d) * 384 + h * 64 + n2) * 64 + quad * 8;
    bW[0] = *(const bf16x8*)(wb);
    bW[1] = *(const bf16x8*)(wb + 32);
    bA[0] = *(const bf16x8*)(ab);
    bA[1] = *(const bf16x8*)(ab + 32);
  }
  const float w0v = p.w0[(size_t)(l * 2 + d) * 384 + h * 64 + n2];
  const float a0v = p.a0[(size_t)(l * 2 + d) * 384 + h * 64 + n2];
  const float kkc = p.k_k[l * 384 + h * 64 + n2], kac = p.k_a[l * 384 + h * 64 + n2], rkc = p.r_k[l * 384 + h * 64 + n2];

  float2v S2[JL / 2];
#pragma unroll
  for (int j = 0; j < JL / 2; ++j) S2[j] = float2v{0.f, 0.f};
  uint4 g_rk, g_v;
  bf16x8 g_wd0, g_wd1, g_ad0, g_ad1;
  float g_inv[4];

#define SC_GLOAD1(CC)                                                                                  \
  {                                                                                                    \
    const ChunkPos cp_ = chunk_pos((CC), d, b);                                                        \
    g_rk = *(const uint4*)(p.z + (size_t)(cp_.rowbase + cp_.tlo + c_ts) * INC + c_col);                \
    if (tid < 16 * NV) g_v = *(const uint4*)(p.z + (size_t)(cp_.rowbase + cp_.tlo + v_ts) * INC + v_col);  \
  }
#define SC_GLOAD2(CC)                                                                                  \
  {                                                                                                    \
    const ChunkPos cp_ = chunk_pos((CC), d, b);                                                        \
    const u16* rp_ = p.z + (size_t)(cp_.rowbase + cp_.tlo + l15) * INC + 1152 + quad * 8;              \
    g_wd0 = *(const bf16x8*)(rp_);                                                                     \
    g_wd1 = *(const bf16x8*)(rp_ + 32);                                                                \
    g_ad0 = *(const bf16x8*)(rp_ + 64);                                                                \
    g_ad1 = *(const bf16x8*)(rp_ + 96);                                                                \
    _Pragma("unroll") for (int j = 0; j < 4; ++j)                                                      \
      g_inv[j] = p.invn[(size_t)(cp_.rowbase + cp_.tlo + quad * 4 + j) * 8 + h];                       \
  }
#define SC_STAGE1(CC)                                                                                  \
  {                                                                                                    \
    const int i3_ = (CC) % 3;                                                                          \
    float4 lo_, hi_;                                                                                   \
    cvt8(g_rk, lo_, hi_);                                                                              \
    float* dst_ = (float*)(smem + (tid < 128 ? SC_R : SC_KD) + i3_ * 4096) + c_ts * 64 + c_ch * 8;     \
    *(float4*)dst_ = lo_;                                                                              \
    *(float4*)(dst_ + 4) = hi_;                                                                        \
    if (tid < 16 * NV) {                                                                               \
      cvt8(g_v, lo_, hi_);                                                                             \
      float* dv_ = (float*)(smem + SC_V + i3_ * 2048) + v_ts * RPB + v_ch * 8;                         \
      *(float4*)dv_ = lo_;                                                                             \
      *(float4*)(dv_ + 4) = hi_;                                                                       \
    }                                                                                                  \
  }
#define SC_STAGE2(CC)                                                                                  \
  {                                                                                                    \
    const int i3_ = (CC) % 3, i2_ = (CC)&1;                                                            \
    const ChunkPos cp_ = chunk_pos((CC), d, b);                                                        \
    f32x4 accW = f32x4{0.f, 0.f, 0.f, 0.f}, accA = f32x4{0.f, 0.f, 0.f, 0.f};                          \
    accW = mfma16(g_wd0, bW[0], accW);                                                                 \
    accW = mfma16(g_wd1, bW[1], accW);                                                                 \
    accA = mfma16(g_ad0, bA[0], accA);                                                                 \
    accA = mfma16(g_ad1, bA[1], accA);                                                                 \
    float bon_[4];                                                                                     \
    _Pragma("unroll") for (int j = 0; j < 4; ++j) {                                                    \
      const int ts = quad * 4 + j;                                                                     \
      float* kdp = (float*)(smem + SC_KD + i3_ * 4096) + ts * 64 + n2;                                 \
      const float kv = *kdp;                                                                           \
      const float rv = *((const float*)(smem + SC_R + i3_ * 4096) + ts * 64 + n2);                     \
      const float sg = sigmoidf_(w0v + accW[j]);                                                       \
      const float wv = __expf(-0.6065306597126334f * sg);                                              \
      const float av = sigmoidf_(a0v + accA[j]);                                                       \
      const float kn = kv * kkc * g_inv[j];                                                            \
      const float kd = kv * (1.f + (av - 1.f) * kac);                                                  \
      *((float*)(smem + SC_W + i2_ * 4096) + ts * 64 + n2) = wv;                                       \
      *((float*)(smem + SC_NKK + i2_ * 4096) + ts * 64 + n2) = -kn;                                    \
      *((float*)(smem + SC_KA + i2_ * 4096) + ts * 64 + n2) = kn * av;                                 \
      *kdp = kd;                                                                                       \
      bon_[j] = rv * kd * rkc;                                                                         \
    }                                                                                                  \
    _Pragma("unroll") for (int j = 0; j < 4; ++j) bon_[j] = red16_sum(bon_[j]);                        \
    if (l15 == 0 && part == 0) {                                                                       \
      _Pragma("unroll") for (int j = 0; j < 4; ++j)                                                    \
        p.bonus[(size_t)(cp_.rowbase + cp_.tlo + quad * 4 + j) * 48 + (d * 6 + h) * 4 + wid] = bon_[j]; \
    }                                                                                                  \
  }

  __builtin_amdgcn_s_setprio(3);
  SC_GLOAD1(0);
  SC_GLOAD2(0);
  SC_STAGE1(0);
  SC_GLOAD1(1);
  __syncthreads();
  SC_STAGE2(0);
  SC_STAGE1(1);
  SC_GLOAD1(2);
  SC_GLOAD2(1);
  __syncthreads();

  for (int c = 0; c < 272; ++c) {
    {
      const int i3 = c % 3, i2 = c & 1;
      const ChunkPos cp = chunk_pos(c, d, b);
      const float* pW = (const float*)(smem + SC_W + i2 * 4096) + j0;
      const float* pN = (const float*)(smem + SC_NKK + i2 * 4096) + j0;
      const float* pA = (const float*)(smem + SC_KA + i2 * 4096) + j0;
      const float* pD = (const float*)(smem + SC_KD + i3 * 4096) + j0;
      const float* pR = (const float*)(smem + SC_R + i3 * 4096) + j0;
      const float* pV = (const float*)(smem + SC_V + i3 * 2048) + rloc;
      float* yp = p.y + ((size_t)d * MT + cp.rowbase + cp.tlo) * 384 + h * 64 + irow;
      float yk0 = 0.f, yk1 = 0.f;
      constexpr int NQ = JL / 4;
      float4 cw[NQ], cn[NQ], ca[NQ], cd[NQ], cr[NQ];
      float cvi;
#define SC_LD(TS, W, N, A, D, R, VI)                                                             \
      _Pragma("unroll") for (int q = 0; q < NQ; ++q) {                                           \
        W[q] = *(const float4*)(pW + (TS)*64 + q * 4); N[q] = *(const float4*)(pN + (TS)*64 + q * 4); \
        A[q] = *(const float4*)(pA + (TS)*64 + q * 4); D[q] = *(const float4*)(pD + (TS)*64 + q * 4); \
        R[q] = *(const float4*)(pR + (TS)*64 + q * 4);                                           \
      }                                                                                          \
      VI = pV[(TS)*RPB];
      {
        const int ts0 = d ? 15 : 0;
        SC_LD(ts0, cw, cn, ca, cd, cr, cvi)
      }
#pragma unroll
      for (int si = 0; si < 16; ++si) {
        float4 xw[NQ], xn[NQ], xa[NQ], xd[NQ], xr[NQ];
        float xvi = 0.f;
        if (si + 1 < 16) {
          const int tsn = d ? 14 - si : si + 1;
          SC_LD(tsn, xw, xn, xa, xd, xr, xvi)
        }
        float2v sa2 = S2[0] * float2v{cn[0].x, cn[0].y};
        sa2 = S2[1] * float2v{cn[0].z, cn[0].w} + sa2;
        if constexpr (NQ == 2) {
          float2v sb2 = S2[2] * float2v{cn[1].x, cn[1].y};
          sb2 = S2[3] * float2v{cn[1].z, cn[1].w} + sb2;
          sa2 = sa2 + sb2;
        }
        const float2v viv = float2v{cvi, cvi};
        float2v u2[JL / 2];
#pragma unroll
        for (int q = 0; q < NQ; ++q) {
          u2[2 * q] = S2[2 * q] * float2v{cw[q].x, cw[q].y} + viv * float2v{cd[q].x, cd[q].y};
          u2[2 * q + 1] = S2[2 * q + 1] * float2v{cw[q].z, cw[q].w} + viv * float2v{cd[q].z, cd[q].w};
        }
        const float sa = LPR == 16 ? red16_sum(sa2.x + sa2.y) : red8_sum(sa2.x + sa2.y);
        const float2v sav = float2v{sa, sa};
#pragma unroll
        for (int q = 0; q < NQ; ++q) {
          S2[2 * q] = sav * float2v{ca[q].x, ca[q].y} + u2[2 * q];
          S2[2 * q + 1] = sav * float2v{ca[q].z, ca[q].w} + u2[2 * q + 1];
        }
        float2v y2 = S2[0] * float2v{cr[0].x, cr[0].y};
        y2 = S2[1] * float2v{cr[0].z, cr[0].w} + y2;
        if constexpr (NQ == 2) {
          float2v yb2 = S2[2] * float2v{cr[1].x, cr[1].y};
          yb2 = S2[3] * float2v{cr[1].z, cr[1].w} + yb2;
          y2 = y2 + yb2;
        }
        const float yv = LPR == 16 ? red16_sum(y2.x + y2.y) : red8_sum(y2.x + y2.y);
        if (si < LPR) yk0 = (jq == si) ? yv : yk0;
        else yk1 = (jq == si - LPR) ? yv : yk1;
        if (si + 1 < 16) {
#pragma unroll
          for (int q = 0; q < NQ; ++q) { cw[q] = xw[q]; cn[q] = xn[q]; ca[q] = xa[q]; cd[q] = xd[q]; cr[q] = xr[q]; }
          cvi = xvi;
        }
      }
#undef SC_LD
      {
        const int tsa = d ? 15 - jq : jq;
        yp[(size_t)tsa * 384] = yk0;
        if constexpr (LPR == 8) {
          const int tsb = d ? 7 - jq : 8 + jq;
          yp[(size_t)tsb * 384] = yk1;
        }
      }
    }
    if (c + 1 < 272) SC_STAGE2(c + 1);
    if (c + 2 < 272) SC_STAGE1(c + 2);
    if (c + 3 < 272) SC_GLOAD1(c + 3);
    if (c + 2 < 272) SC_GLOAD2(c + 2);
    __syncthreads();
  }
  __builtin_amdgcn_s_setprio(0);
#undef SC_GLOAD1
#undef SC_GLOAD2
#undef SC_STAGE1
#undef SC_STAGE2
}

DEV void attn_item(const P& p, int item, char* smem) {
  const int tid = tid_l(), lane = tid & 63, wid = tid >> 6, l15 = lane & 15, quad = lane >> 4;
  bool lat = item < 1536;
  int b, hq, qb;
  if (lat) { b = item / 192; int rem = item % 192; hq = rem / 32; qb = rem % 32; }
  else { int i2 = item - 1536; b = i2 / 12; int rem = i2 % 12; hq = rem / 2; qb = rem % 2; }
  const int kvh = hq / 3;
  const int qrow0 = lat ? MC + b * 4096 + qb * 128 : b * 256 + qb * 128;
  const int nkt = lat ? 68 : 4;
  const float LOG2E = 1.4426950408889634f;

  bf16x8 qf[2][2];
#pragma unroll
  for (int mi = 0; mi < 2; ++mi)
#pragma unroll
    for (int ks = 0; ks < 2; ++ks)
      qf[mi][ks] = *(const bf16x8*)(p.z + (size_t)(qrow0 + wid * 32 + mi * 16 + l15) * INC + 1920 + hq * 64 + ks * 32 + quad * 8);

  f32x4 Ot[2][4];
  float mrow[2], lpart[2];
#pragma unroll
  for (int mi = 0; mi < 2; ++mi) {
#pragma unroll
    for (int nd = 0; nd < 4; ++nd) Ot[mi][nd] = f32x4{0.f, 0.f, 0.f, 0.f};
    mrow[mi] = -1e30f;
    lpart[mi] = 0.f;
  }
  const int lrow = tid >> 3, lch = tid & 7;
  uint4 rk0, rk1, rv0, rv1;
#define ATT_GLOAD(KT)                                                                         \
  {                                                                                           \
    const int kt_ = (KT);                                                                     \
    const u16* kp;                                                                            \
    const u16* vp;                                                                            \
    int vstride;                                                                              \
    if (lat && kt_ < 64) {                                                                    \
      kp = p.z + (size_t)(MC + b * 4096 + kt_ * 64) * INC + 2304 + kvh * 64;                  \
      vp = p.vTl + (size_t)((b * 2 + kvh) * 64) * SEQ + kt_ * 64;                             \
      vstride = SEQ;                                                                          \
    } else {                                                                                  \
      const int kc = lat ? kt_ - 64 : kt_;                                                    \
      kp = p.z + (size_t)(b * 256 + kc * 64) * INC + 2304 + kvh * 64;                         \
      vp = p.vTc + (size_t)((b * 2 + kvh) * 64) * CTXL + kc * 64;                             \
      vstride = CTXL;                                                                         \
    }                                                                                         \
    rk0 = *(const uint4*)(kp + (size_t)(lrow)*INC + lch * 8);                                 \
    rk1 = *(const uint4*)(kp + (size_t)(lrow + 32) * INC + lch * 8);                          \
    rv0 = *(const uint4*)(vp + (size_t)(lrow)*vstride + lch * 8);                             \
    rv1 = *(const uint4*)(vp + (size_t)(lrow + 32) * vstride + lch * 8);                      \
  }
#define ATT_LSTORE(BUF)                                     \
  {                                                         \
    char* Kb_ = smem + (BUF)*16384;                         \
    *(uint4*)(Kb_ + swz(lrow, lch)) = rk0;                  \
    *(uint4*)(Kb_ + swz(lrow + 32, lch)) = rk1;             \
    *(uint4*)(Kb_ + 8192 + swz(lrow, lch)) = rv0;           \
    *(uint4*)(Kb_ + 8192 + swz(lrow + 32, lch)) = rv1;      \
  }
  ATT_GLOAD(0);
  ATT_LSTORE(0);
  __syncthreads();
  for (int kt = 0; kt < nkt; ++kt) {
    const int buf = kt & 1;
    if (kt + 1 < nkt) ATT_GLOAD(kt + 1);
    const char* Kb = smem + buf * 16384;
    const char* Vb = Kb + 8192;
    f32x4 St[2][4];
#pragma unroll
    for (int mi = 0; mi < 2; ++mi)
#pragma unroll
      for (int ni = 0; ni < 4; ++ni) St[mi][ni] = f32x4{0.f, 0.f, 0.f, 0.f};
#pragma unroll
    for (int ks = 0; ks < 2; ++ks) {
      bf16x8 kf[4];
#pragma unroll
      for (int ni = 0; ni < 4; ++ni) kf[ni] = *(const bf16x8*)(Kb + swz(ni * 16 + l15, ks * 4 + quad));
#pragma unroll
      for (int mi = 0; mi < 2; ++mi)
#pragma unroll
        for (int ni = 0; ni < 4; ++ni) St[mi][ni] = mfma16(kf[ni], qf[mi][ks], St[mi][ni]);
    }
    bf16x8 pf[2][2];
#pragma unroll
    for (int mi = 0; mi < 2; ++mi) {
      float mx = St[mi][0][0];
#pragma unroll
      for (int ni = 0; ni < 4; ++ni)
#pragma unroll
        for (int jj = 0; jj < 4; ++jj) mx = fmaxf(mx, St[mi][ni][jj]);
      mx = fmaxf(mx, __shfl_xor(mx, 16));
      mx = fmaxf(mx, __shfl_xor(mx, 32));
      const float mnew = fmaxf(mrow[mi], mx);
      const float alpha = __builtin_amdgcn_exp2f((mrow[mi] - mnew) * LOG2E);
      mrow[mi] = mnew;
      const float mb = mnew * LOG2E;
      float ps = 0.f;
      float pv[4][4];
#pragma unroll
      for (int ni = 0; ni < 4; ++ni)
#pragma unroll
        for (int jj = 0; jj < 4; ++jj) {
          pv[ni][jj] = __builtin_amdgcn_exp2f(St[mi][ni][jj] * LOG2E - mb);
          ps += pv[ni][jj];
        }
      lpart[mi] = lpart[mi] * alpha + ps;
#pragma unroll
      for (int nd = 0; nd < 4; ++nd) {
        Ot[mi][nd][0] *= alpha; Ot[mi][nd][1] *= alpha; Ot[mi][nd][2] *= alpha; Ot[mi][nd][3] *= alpha;
      }
#pragma unroll
      for (int s2 = 0; s2 < 2; ++s2) {
        union { unsigned u[4]; bf16x8 v; } pk;
        pk.u[0] = pk2(pv[2 * s2][0], pv[2 * s2][1]);
        pk.u[1] = pk2(pv[2 * s2][2], pv[2 * s2][3]);
        pk.u[2] = pk2(pv[2 * s2 + 1][0], pv[2 * s2 + 1][1]);
        pk.u[3] = pk2(pv[2 * s2 + 1][2], pv[2 * s2 + 1][3]);
        pf[mi][s2] = pk.v;
      }
    }
#pragma unroll
    for (int s2 = 0; s2 < 2; ++s2) {
      bf16x8 vf[4];
#pragma unroll
      for (int nd = 0; nd < 4; ++nd) {
        const int drow = nd * 16 + l15;
        union { uint2 h[2]; bf16x8 v; } vv;
        vv.h[0] = *(const uint2*)(Vb + swz(drow, 4 * s2 + (quad >> 1)) + (quad & 1) * 8);
        vv.h[1] = *(const uint2*)(Vb + swz(drow, 4 * s2 + 2 + (quad >> 1)) + (quad & 1) * 8);
        vf[nd] = vv.v;
      }
#pragma unroll
      for (int mi = 0; mi < 2; ++mi)
#pragma unroll
        for (int nd = 0; nd < 4; ++nd) Ot[mi][nd] = mfma16(vf[nd], pf[mi][s2], Ot[mi][nd]);
    }
    if (kt + 1 < nkt) ATT_LSTORE(buf ^ 1);
    __syncthreads();
  }
#undef ATT_GLOAD
#undef ATT_LSTORE
#pragma unroll
  for (int mi = 0; mi < 2; ++mi) {
    float lsum = lpart[mi];
    lsum += __shfl_xor(lsum, 16);
    lsum += __shfl_xor(lsum, 32);
    const float inv = 1.f / lsum;
    const int r = qrow0 + wid * 32 + mi * 16 + l15;
#pragma unroll
    for (int nd = 0; nd < 4; ++nd)
      *(uint2*)(p.act + (size_t)r * DM + 640 + hq * 64 + nd * 16 + quad * 4) =
          make_uint2(pk2(Ot[mi][nd][0] * inv, Ot[mi][nd][1] * inv), pk2(Ot[mi][nd][2] * inv, Ot[mi][nd][3] * inv));
  }
}

DEV void sgate_item(const P& p, int l, int ck, int g, char* smem) {
  const int tid = tid_l(), lane = tid & 63, wid = tid >> 6, l15 = lane & 15, quad = lane >> 4;
  const int m0 = ck * 128;
  u16* sVT = (u16*)smem;
  {
    const int q = tid >> 1, half = tid & 1;
    const u16* src = p.z + (size_t)(m0 + q) * INC + 1408 + 256 + g * 64 + half * 32;
    float v[32];
    float ss = 0.f;
#pragma unroll
    for (int cidx = 0; cidx < 4; ++cidx) {
      uint4 u = *(const uint4*)(src + cidx * 8);
      unsigned uu[4] = {u.x, u.y, u.z, u.w};
#pragma unroll
      for (int e = 0; e < 4; ++e) {
        float f0 = geluf_(bf2f((u16)(uu[e] & 0xffff)));
        float f1 = geluf_(bf2f((u16)(uu[e] >> 16)));
        v[cidx * 8 + e * 2] = f0;
        v[cidx * 8 + e * 2 + 1] = f1;
        ss += f0 * f0 + f1 * f1;
      }
    }
    ss += __shfl_xor(ss, 1);
    const float rstd = rsqrtf(ss * (1.f / 64.f) + 1e-6f);
    const float* gn = p.sgn + l * 256 + g * 64 + half * 32;
#pragma unroll
    for (int e = 0; e < 32; ++e) sVT[(half * 32 + e) * 136 + q] = f2bf(v[e] * rstd * gn[e]);
  }
  __syncthreads();
  f32x4 acc[2][4];
#pragma unroll
  for (int mi = 0; mi < 2; ++mi)
#pragma unroll
    for (int ni = 0; ni < 4; ++ni) acc[mi][ni] = f32x4{0.f, 0.f, 0.f, 0.f};
  const u16* Wg = p.sgW + (size_t)(l * 4 + g) * 128 * 128;
#pragma unroll
  for (int ks = 0; ks < 4; ++ks) {
    bf16x8 a[2], bb[4];
#pragma unroll
    for (int mi = 0; mi < 2; ++mi) a[mi] = *(const bf16x8*)(Wg + (size_t)(wid * 32 + mi * 16 + l15) * 128 + ks * 32 + quad * 8);
#pragma unroll
    for (int ni = 0; ni < 4; ++ni) bb[ni] = *(const bf16x8*)(sVT + (ni * 16 + l15) * 136 + ks * 32 + quad * 8);
#pragma unroll
    for (int mi = 0; mi < 2; ++mi)
#pragma unroll
      for (int ni = 0; ni < 4; ++ni) acc[mi][ni] = mfma16(a[mi], bb[ni], acc[mi][ni]);
  }
#pragma unroll
  for (int mi = 0; mi < 2; ++mi)
#pragma unroll
    for (int j = 0; j < 4; ++j) {
      const int pr = wid * 32 + mi * 16 + quad * 4 + j;
      const float bias = p.sg_b[(size_t)(l * 4 + g) * 128 + pr];
#pragma unroll
      for (int ni = 0; ni < 4; ++ni) {
        const int c = ni * 16 + l15;
        float u = geluf_(bf2f(p.z[(size_t)(m0 + pr) * INC + 1408 + g * 64 + c]));
        p.act[(size_t)(m0 + pr) * DM + 384 + g * 64 + c] = f2bf(u * (acc[mi][ni][j] + bias));
      }
    }
  __syncthreads();
}

DEV void mix_phase(const P& p, int l, char* smem, int cidx) {
  __shared__ int s_item;
  const bool last = (l == DEPTH - 1);
  const int n_attn = last ? 1536 : 1632;
  const int ck_lo = last ? 16 : 0;
  const int n_sg = (NMT - ck_lo) * 4;
  const int total = SCAN_ITEMS + n_attn + n_sg;
  const int bid = bid_l();
  bool first = bid < SCAN_ITEMS;
  for (;;) {
    int it;
    if (first) {
      it = bid;
      first = false;
    } else {
      if (tid_l() == 0) s_item = SCAN_ITEMS + atomicAdd(p.cnt + cidx, 1);
      __syncthreads();
      it = s_item;
      __syncthreads();
    }
    if (it >= total) break;
    if (it < SCAN_ITEMS) {
      int nr = SCAN_REP; asm volatile("" : "+s"(nr));
      for (int rr = 0; rr < nr; ++rr) scan_item(p, l, it, smem);
    } else if (it < SCAN_ITEMS + n_attn) {
      int nr = ATT_REP; asm volatile("" : "+s"(nr));
      for (int rr = 0; rr < nr; ++rr) { attn_item(p, it - SCAN_ITEMS, smem); __syncthreads(); }
    } else {
      int i2 = it - SCAN_ITEMS - n_attn;
      int nr = SG_REP; asm volatile("" : "+s"(nr));
      for (int rr = 0; rr < nr; ++rr) sgate_item(p, l, ck_lo + (i2 >> 2), i2 & 3, smem);
    }
  }
}

DEV void apost_phase(const P& p, int l, int mt_lo, char* smem) {
  const int tid = tid_l(), lane = tid & 63, wid = tid >> 6, l15 = lane & 15, quad = lane >> 4;
  for (int i = bid_l() * 256 + tid; i < MT; i += gridDim.x * 256) { p.rss1[i] = 0.f; p.rss2[i] = 0.f; }
  const int nit = (NMT - mt_lo) * 6;
  for (int it = bid_l(); it < nit; it += gridDim.x) {
    const int mt = mt_lo + it / 6;
    const int hh = it % 6;
    const int m0 = mt * 128;
    bf16x8 a[2][4];
#pragma unroll
    for (int mi = 0; mi < 2; ++mi)
#pragma unroll
      for (int ks = 0; ks < 4; ++ks)
        a[mi][ks] = *(const bf16x8*)(p.z + (size_t)(m0 + wid * 32 + mi * 16 + l15) * INC + 1280 + ks * 32 + quad * 8);
    {
      f32x4 acc[2][4];
#pragma unroll
      for (int mi = 0; mi < 2; ++mi)
#pragma unroll
        for (int ni = 0; ni < 4; ++ni) acc[mi][ni] = f32x4{0.f, 0.f, 0.f, 0.f};
#pragma unroll
      for (int ks = 0; ks < 4; ++ks) {
        bf16x8 bb[4];
#pragma unroll
        for (int ni = 0; ni < 4; ++ni)
          bb[ni] = *(const bf16x8*)(p.gUpT + ((size_t)l * 384 + hh * 64 + ni * 16 + l15) * 128 + ks * 32 + quad * 8);
#pragma unroll
        for (int mi = 0; mi < 2; ++mi)
#pragma unroll
          for (int ni = 0; ni < 4; ++ni) acc[mi][ni] = mfma16(bb[ni], a[mi][ks], acc[mi][ni]);
      }
      float4 lg[4], lb[4];
#pragma unroll
      for (int ni = 0; ni < 4; ++ni) {
        lg[ni] = *(const float4*)(p.ln_g + l * 384 + hh * 64 + ni * 16 + quad * 4);
        lb[ni] = *(const float4*)(p.ln_b + l * 384 + hh * 64 + ni * 16 + quad * 4);
      }
#pragma unroll
      for (int mi = 0; mi < 2; ++mi) {
        const int r = m0 + wid * 32 + mi * 16 + l15;
        float4 ys[4];
        uint2 vraw[4];
        float sm = 0.f;
#pragma unroll
        for (int ni = 0; ni < 4; ++ni) {
          const int c = hh * 64 + ni * 16 + quad * 4;
          const float4 y0 = *(const float4*)(p.y + (size_t)r * 384 + c);
          const float4 y1 = *(const float4*)(p.y + ((size_t)MT + r) * 384 + c);
          ys[ni] = make_float4(y0.x + y1.x, y0.y + y1.y, y0.z + y1.z, y0.w + y1.w);
          vraw[ni] = *(const uint2*)(p.z + (size_t)r * INC + 768 + c);
          sm += (ys[ni].x + ys[ni].y) + (ys[ni].z + ys[ni].w);
        }
        const float4 bq0 = *(const float4*)(p.bonus + (size_t)r * 48 + hh * 4);
        const float4 bq1 = *(const float4*)(p.bonus + (size_t)r * 48 + (6 + hh) * 4);
        const float bon = (bq0.x + bq0.y) + (bq0.z + bq0.w) + (bq1.x + bq1.y) + (bq1.z + bq1.w);
        sm += __shfl_xor(sm, 16);
        sm += __shfl_xor(sm, 32);
        const float mean = sm * (1.f / 64.f);
        float vs = 0.f;
#pragma unroll
        for (int ni = 0; ni < 4; ++ni) {
          ys[ni].x -= mean; ys[ni].y -= mean; ys[ni].z -= mean; ys[ni].w -= mean;
          vs += ys[ni].x * ys[ni].x + ys[ni].y * ys[ni].y + ys[ni].z * ys[ni].z + ys[ni].w * ys[ni].w;
        }
        vs += __shfl_xor(vs, 16);
        vs += __shfl_xor(vs, 32);
        const float rstd = rsqrtf(vs * (1.f / 64.f) + 64e-5f);
#pragma unroll
        for (int ni = 0; ni < 4; ++ni) {
          const int c = hh * 64 + ni * 16 + quad * 4;
          const float v0 = __uint_as_float(vraw[ni].x << 16), v1 = __uint_as_float(vraw[ni].x & 0xffff0000u);
          const float v2 = __uint_as_float(vraw[ni].y << 16), v3 = __uint_as_float(vraw[ni].y & 0xffff0000u);
          const float o0 = (ys[ni].x * rstd * lg[ni].x + lb[ni].x + bon * v0) * acc[mi][ni][0];
          const float o1 = (ys[ni].y * rstd * lg[ni].y + lb[ni].y + bon * v1) * acc[mi][ni][1];
          const float o2 = (ys[ni].z * rstd * lg[ni].z + lb[ni].z + bon * v2) * acc[mi][ni][2];
          const float o3 = (ys[ni].w * rstd * lg[ni].w + lb[ni].w + bon * v3) * acc[mi][ni][3];
          *(uint2*)(p.act + (size_t)r * DM + c) = make_uint2(pk2(o0, o1), pk2(o2, o3));
        }
        __builtin_amdgcn_sched_barrier(0);
      }
    }
  }
}

DEV uint2 ld8(const u16* q) { return *(const uint2*)q; }
DEV void up4(const uint2 u, float (&f)[4]) {
  f[0] = __uint_as_float(u.x << 16); f[1] = __uint_as_float(u.x & 0xffff0000u);
  f[2] = __uint_as_float(u.y << 16); f[3] = __uint_as_float(u.y & 0xffff0000u);
}
DEV void prep_phase(const P& p, int l, unsigned* bcnt, unsigned& epoch) {
  const int tid = tid_l(), lane = tid & 63, l15 = lane & 15;
  const int nb = gridDim.x, bid = bid_l();
  constexpr int NR = 8;
  const int rpb = (((MT + nb - 1) / nb) + NR - 1) & ~(NR - 1);
  const int ra = bid * rpb;
  const int rb = min(ra + rpb, MT);
  const bool active = ra < MT;
  const bool has1 = tid < 96;
  const int col0 = tid * 4, col1 = 1024 + tid * 4;
  uint2 hp0 = make_uint2(0, 0), hn0 = hp0, hp1 = hp0, hn1 = hp0;
  if (active) {
    if (ra > 0) { hp0 = ld8(p.z + (size_t)(ra - 1) * INC + col0); if (has1) hp1 = ld8(p.z + (size_t)(ra - 1) * INC + col1); }
    if (rb < MT) { hn0 = ld8(p.z + (size_t)rb * INC + col0); if (has1) hn1 = ld8(p.z + (size_t)rb * INC + col1); }
  }
  gbar(bcnt, epoch);
  if (!active) return;
  const float* cw = p.conv + (size_t)l * 3 * 1408;
#pragma unroll 1
  for (int pass = 0; pass < 2; ++pass) {
    if (pass == 1 && !has1) break;
    const int col = pass ? col1 : col0;
    const int typ = col < 1152 ? 0 : (col < 1216 ? 1 : (col < 1280 ? 0 : 2));
    const bool isk = col >= 384 && col < 768;
    float c0[4], c1[4], c2[4], kk4[4];
#pragma unroll
    for (int e = 0; e < 4; ++e) {
      c0[e] = cw[col + e]; c1[e] = cw[1408 + col + e]; c2[e] = cw[2816 + col + e];
      kk4[e] = isk ? p.k_k[l * 384 + (col - 384) + e] : 0.f;
    }
    const int hh = isk ? (col - 384) >> 6 : 0;
    u16* zc = p.z + col;
    uint2 prev = pass ? hp1 : hp0;
    const uint2 halo_n = pass ? hn1 : hn0;
    uint2 cur = ld8(zc + (size_t)ra * INC);
    for (int r = ra; r < rb; r += NR) {
      uint2 w[NR + 2];
      w[0] = prev;
      w[1] = cur;
#pragma unroll
      for (int q = 0; q < NR; ++q) {
        const int rr = r + 1 + q;
        w[q + 2] = rr < rb ? ld8(zc + (size_t)rr * INC) : halo_n;
      }
#pragma unroll
      for (int q = 0; q < NR; ++q) {
        const int rr = r + q;
        const uint2 xp = w[q], xc = w[q + 1], xn = w[q + 2];
        const int tt = rr < MC ? (rr & 255) : ((rr - MC) & 4095);
        const int len = rr < MC ? 256 : 4096;
        const float mp = tt > 0 ? 1.f : 0.f, mn = tt < len - 1 ? 1.f : 0.f;
        float fp[4], fc[4], fn[4], o[4];
        up4(xp, fp); up4(xc, fc); up4(xn, fn);
#pragma unroll
        for (int e = 0; e < 4; ++e) {
          float v = fc[e] * c1[e] + mp * (fp[e] * c0[e]) + mn * (fn[e] * c2[e]);
          if (typ == 1) v = tanh_fast(v);
          else if (typ == 2) v = sigmoidf_(v);
          o[e] = v;
        }
        if (isk) {
          float q0 = o[0] * kk4[0], q1 = o[1] * kk4[1], q2 = o[2] * kk4[2], q3 = o[3] * kk4[3];
          float ss = red16_sum(q0 * q0 + q1 * q1 + q2 * q2 + q3 * q3);
          if (l15 == 0 && rr < rb) p.invn[(size_t)rr * 8 + hh] = 1.f / fmaxf(sqrtf(ss), 1e-12f);
        }
        if (rr < rb) *(uint2*)(zc + (size_t)rr * INC) = make_uint2(pk2(o[0], o[1]), pk2(o[2], o[3]));
      }
      prev = w[NR];
      cur = w[NR + 1];
    }
  }
}

__global__ void __launch_bounds__(256, 2) fwd_megakernel(P p, int ph_lo, int ph_hi) {
  __shared__ __attribute__((aligned(16))) char smem[65536 - 64];
  cg::grid_group grid = cg::this_grid();
  unsigned* bcnt = (unsigned*)(p.cnt + 32);
  unsigned epoch = 0;
  for (int ph = ph_lo; ph < ph_hi; ++ph) {
    if (ph > ph_lo) {
      if (ph == ph_lo + 1) grid.sync();
      else gbar(bcnt, epoch);
    }
    if (ph == 0) { phase0(p, smem); continue; }
    if (ph == 1) { phase0b(p, smem); continue; }
    if (ph == 2 + 6 * DEPTH) { final_norm(p); continue; }
    const int l = (ph - 2) / 6, sub = (ph - 2) % 6;
    const bool last = (l == DEPTH - 1);
    const int mt_lo = last ? 16 : 0;
    GX g0{};
    g0.rss_acc = nullptr; g0.aout = nullptr; g0.gnext = nullptr; g0.lmod = 0; g0.scoff = 0;
    if (sub == 0) {
      gemm_phase<EPI_Z>(p, l, p.act, DM, p.wIn + (size_t)l * 2560 * 1024, 1024, 20, 0, 0, smem, g0, 0);
    } else if (sub == 1) {
      prep_phase(p, l, bcnt, epoch);
      gbar(bcnt, epoch);
      mix_phase(p, l, smem, l);
    } else if (sub == 2) {
      apost_phase(p, l, mt_lo, smem);
    } else if (sub == 3 || sub == 5) {
      const bool g4 = sub == 5;
      GX gx{};
      gx.rss_acc = g4 ? p.rss1 : p.rss2;
      gx.aout = g4 ? (last ? nullptr : p.act) : p.act2;
      gx.gnext = g4 ? p.n1g + (last ? 0 : (l + 1) * DM) : p.n2g + l * DM;
      gx.lmod = g4 ? (last ? l : l + 1) : l;
      gx.scoff = g4 ? 1024 : 4096;
      gemm_phase<EPI_RES>(p, l, g4 ? p.h : p.act, g4 ? DFF : DM,
                          g4 ? p.w2t + (size_t)l * 1024 * 2816 : p.wOut + (size_t)l * 1024 * 1024, g4 ? 2816 : 1024, 8, mt_lo,
                          g4 ? 5120 : 2048, smem, gx, 0);
    } else {
      gemm_phase<EPI_SWIGLU>(p, l, p.act2, DM, p.w1t + (size_t)l * 5632 * 1024, 1024, 44, mt_lo, 0, smem, g0, 0);
    }
  }
}

extern "C" void kernel_launch(void* const* d_in, const int* in_sizes, int n_in, void* d_out, int out_size, void* d_ws,
                              size_t ws_size, hipStream_t stream) {
  static int grid_blocks = 0;
  if (!grid_blocks) {
    int dev = 0, cus = 0, per_cu = 0;
    hipGetDevice(&dev);
    hipDeviceGetAttribute(&cus, hipDeviceAttributeMultiprocessorCount, dev);
    hipOccupancyMaxActiveBlocksPerMultiprocessor(&per_cu, fwd_megakernel, 256, 0);
    if (per_cu > 2) per_cu = 2;
    if (per_cu < 1) per_cu = 1;
    grid_blocks = cus * per_cu;
  }
  P p{};
  const float* const* in = (const float* const*)d_in;
  p.x = in[0]; p.c = in[1]; p.ctx = in[2]; p.c_ctx = in[3]; p.n1g = in[4]; p.n2g = in[5]; p.ada_w = in[6]; p.ada_b = in[7];
  p.w_in = in[8]; p.conv = in[9]; p.w0 = in[10]; p.w_up = in[11]; p.a0 = in[12]; p.a_up = in[13]; p.g_up = in[14];
  p.k_k = in[15]; p.k_a = in[16]; p.r_k = in[17]; p.ln_g = in[18]; p.ln_b = in[19]; p.sgn = in[20]; p.sg_w = in[21];
  p.sg_b = in[22]; p.q_g = in[23]; p.k_g = in[24]; p.w_out = in[25]; p.w1 = in[26]; p.w2 = in[27]; p.fng = in[28];
  p.out = (float*)d_out;
  char* ws = (char*)d_ws;
  size_t off = 0;
  auto take = [&](size_t bytes) { char* r = ws + off; off += (bytes + 255) & ~(size_t)255; return r; };
  p.wIn = (u16*)take((size_t)4 * 2560 * 1024 * 2);
  p.wOut = (u16*)take((size_t)4 * 1024 * 1024 * 2);
  p.w1t = (u16*)take((size_t)4 * 5632 * 1024 * 2);
  p.w2t = (u16*)take((size_t)4 * 1024 * 2816 * 2);
  p.wUpT = (u16*)take((size_t)8 * 384 * 64 * 2);
  p.aUpT = (u16*)take((size_t)8 * 384 * 64 * 2);
  p.gUpT = (u16*)take((size_t)4 * 384 * 128 * 2);
  p.sgW = (u16*)take((size_t)16 * 128 * 128 * 2);
  p.mods = (float*)take((size_t)4 * 9 * 6144 * 4);
  p.rope = (float*)take(2048 * 4);
  p.cnt = (int*)take(256);
  p.xc = (float*)take((size_t)MC * DM * 4);
  p.act = (u16*)take((size_t)MT * DM * 2);
  p.z = (u16*)take((size_t)MT * DFF * 2);
  p.h = p.z;
  p.vTl = (u16*)take((size_t)16 * 64 * SEQ * 2);
  p.vTc = (u16*)take((size_t)16 * 64 * CTXL * 2);
  p.y = (float*)take((size_t)2 * MT * 384 * 4);
  p.bonus = (float*)take((size_t)MT * 48 * 4);
  p.invn = (float*)take((size_t)MT * 8 * 4);
  p.rss1 = (float*)take((size_t)MT * 4);
  p.rss2 = (float*)take((size_t)MT * 4);
  p.bz = (float*)take((size_t)4 * 9 * 2560 * 4);
  p.bh = (float*)take((size_t)4 * 9 * 5632 * 4);
  p.act2 = (u16*)p.y;
  if (off > ws_size) { fprintf(stderr, "workspace too small: need %zu have %zu\n", off, ws_size); return; }
  int ph_lo = 0, ph_hi = 3 + 6 * DEPTH;
  void* args[] = {&p, &ph_lo, &ph_hi};
  hipError_t e = hipLaunchCooperativeKernel((void*)fwd_megakernel, dim3(grid_blocks), dim3(256), args, 0, stream);
  if (e != hipSuccess) fprintf(stderr, "cooperative launch failed: %s (grid %d)\n", hipGetErrorString(e), grid_blocks);
}
```

```cpp
#include <hip/hip_runtime.h>
#include <hip/hip_bf16.h>
#include <hip/hip_cooperative_groups.h>
#include <cstdio>
namespace cg = cooperative_groups;

typedef __attribute__((ext_vector_type(8))) short bf16x8;
typedef __attribute__((ext_vector_type(4))) float f32x4;
typedef unsigned short u16;
typedef __attribute__((ext_vector_type(2))) float float2v;

#define DEV __device__ __forceinline__
DEV int tid_l() { int t = threadIdx.x; asm volatile("" : "+v"(t)); return t; }
DEV int bid_l() { int b = blockIdx.x; asm volatile("" : "+s"(b)); return b; }

constexpr int DM = 1024, NBATCH = 8, SEQ = 4096, DEPTH = 4, CTXL = 256;
constexpr int MC = NBATCH * CTXL;
constexpr int ML = NBATCH * SEQ;
constexpr int MT = MC + ML;
constexpr int INC = 2560, DFF = 2816;
constexpr int NMT = MT / 128;
#ifndef PROBE_MASK
#define PROBE_MASK 0
#endif
#define SCAN_REP 1
#define ATT_REP 1
#define SG_REP 1

struct P {
  const float *x, *c, *ctx, *c_ctx, *n1g, *n2g, *ada_w, *ada_b, *w_in, *conv, *w0, *w_up, *a0, *a_up, *g_up,
      *k_k, *k_a, *r_k, *ln_g, *ln_b, *sgn, *sg_w, *sg_b, *q_g, *k_g, *w_out, *w1, *w2, *fng;
  float* out;
  u16 *wIn, *wOut, *w1t, *w2t, *wUpT, *aUpT, *gUpT, *sgW;
  float *mods, *rope;
  int* cnt;
  unsigned* xbar;
  float* xc;
  u16 *act, *z, *h, *vTl, *vTc;
  float *y, *bonus, *invn;
  float *rss1, *rss2, *bz, *bh;
  u16* act2;
};

typedef __attribute__((ext_vector_type(2))) __bf16 bf16x2v;
typedef __attribute__((ext_vector_type(2))) float f32x2v;
DEV unsigned pk2(float a, float b) {
  f32x2v v = {a, b};
  bf16x2v r = __builtin_convertvector(v, bf16x2v);
  return *(unsigned*)&r;
}
DEV u16 f2bf(float f) { return (u16)(pk2(f, 0.f) & 0xffffu); }
DEV float bf2f(u16 h) { return __uint_as_float(((unsigned)h) << 16); }
DEV float sigmoidf_(float x) { return __builtin_amdgcn_rcpf(1.f + __expf(-x)); }
DEV float siluf_(float x) { return x * __builtin_amdgcn_rcpf(1.f + __expf(-x)); }
DEV float geluf_(float x) {
  float u = 0.7978845608028654f * (x + 0.044715f * x * x * x);
  return 0.5f * x * (1.f + tanhf(u));
}
DEV int swz(int r, int ch) { return r * 128 + ((ch ^ ((r >> 1) & 7)) << 4); }

template <int CTRL>
DEV float dppf(float v) {
  return __int_as_float(__builtin_amdgcn_update_dpp(0, __float_as_int(v), CTRL, 0xF, 0xF, false));
}
DEV float red16_sum(float v) {
  v += dppf<0xB1>(v);
  v += dppf<0x4E>(v);
  v += dppf<0x141>(v);
  v += dppf<0x140>(v);
  return v;
}
DEV float red16_max(float v) {
  v = fmaxf(v, dppf<0xB1>(v));
  v = fmaxf(v, dppf<0x4E>(v));
  v = fmaxf(v, dppf<0x141>(v));
  v = fmaxf(v, dppf<0x140>(v));
  return v;
}
DEV float wave_sum(float v) {
#pragma unroll
  for (int o = 32; o >= 1; o >>= 1) v += __shfl_xor(v, o);
  return v;
}
DEV f32x4 mfma16(bf16x8 a, bf16x8 b, f32x4 c) { return __builtin_amdgcn_mfma_f32_16x16x32_bf16(a, b, c, 0, 0, 0); }


#define XB_TMO      128
#define XB_XCNT(j)  (256  + 64 * (j))
#define XB_XSUB(j)  (1280 + 64 * (j))
#define XB_XGEN(j)  (2304 + 64 * (j))
#define XB_TOP      3328
#define XB_TOPGEN   3392
#define XCD_BAR_WORDS 3456
#define XB_SPIN_CAP (1u << 20)
DEV unsigned xb_ld(unsigned* q) { return __hip_atomic_load(q, __ATOMIC_RELAXED, __HIP_MEMORY_SCOPE_AGENT); }
DEV unsigned xb_add(unsigned* q, unsigned v) { return __hip_atomic_fetch_add(q, v, __ATOMIC_RELAXED, __HIP_MEMORY_SCOPE_AGENT); }
DEV unsigned xb_xcc_id() { return (unsigned)__builtin_amdgcn_s_getreg((3 << 11) | 20) & 0xFu; }
#define XB_SPIN(cond, bar) do { unsigned _sp = 0; while (cond) { __builtin_amdgcn_s_sleep(1); \
    if ((++_sp & 255u) == 0u) { if (xb_ld(&(bar)[XB_TMO])) break; if (_sp > XB_SPIN_CAP) { atomicAdd(&(bar)[XB_TMO], 1u); break; } } } } while (0)
struct XcdBarrier { unsigned* bar; unsigned x; unsigned nloc, nx; };
DEV XcdBarrier xcd_barrier_post(unsigned* bar) {
  XcdBarrier b; b.bar = bar; b.x = xb_xcc_id(); b.nloc = 0u; b.nx = 0u;
  if (threadIdx.x == 0) (void)xb_add(&bar[XB_XCNT(b.x)], 1u);
  return b;
}
DEV void xcd_barrier_complete(unsigned* bar, unsigned x, unsigned& nloc, unsigned& nx) {
  const unsigned G = gridDim.x * gridDim.y * gridDim.z;
  unsigned sum, cnt, mine, sp = 0u;
  for (;;) {
    sum = 0u; cnt = 0u; mine = 0u;
#pragma unroll
    for (unsigned j = 0; j < 16; ++j) { const unsigned c = xb_ld(&bar[XB_XCNT(j)]); sum += c; cnt += (c > 0u) ? 1u : 0u; mine = (j == x) ? c : mine; }
    if (sum == G) break;
    __builtin_amdgcn_s_sleep(1);
    if ((++sp & 255u) == 0u) { if (xb_ld(&bar[XB_TMO])) break; if (sp > XB_SPIN_CAP) { atomicAdd(&bar[XB_TMO], 1u); break; } }
  }
  nloc = mine > 0u ? mine : 1u; nx = cnt > 0u ? cnt : 1u;
}
DEV void xcd_barrier(XcdBarrier& b) {
  asm volatile("s_waitcnt vmcnt(0)" ::: "memory");
  __syncthreads();
  if (threadIdx.x == 0) {
    unsigned* bar = b.bar;
    __builtin_amdgcn_s_waitcnt(0);
    if (b.nloc == 0u) xcd_barrier_complete(bar, b.x, b.nloc, b.nx);
    const unsigned nloc = b.nloc, nx = b.nx;
    const unsigned old = xb_add(&bar[XB_XSUB(b.x)], 1u);
    const unsigned gen = old / nloc;
    if (old + 1u == (gen + 1u) * nloc) {
      __builtin_amdgcn_fence(__ATOMIC_RELEASE, "agent");
      asm volatile("s_waitcnt vmcnt(0)" ::: "memory");
      const unsigned og = xb_add(&bar[XB_TOP], 1u);
      const unsigned tg = og / nx;
      if (og + 1u == (tg + 1u) * nx) xb_add(&bar[XB_TOPGEN], 1u);
      else XB_SPIN(xb_ld(&bar[XB_TOPGEN]) == tg, bar);
      __builtin_amdgcn_fence(__ATOMIC_ACQUIRE, "agent");
      xb_add(&bar[XB_XGEN(b.x)], 1u);
      asm volatile("s_waitcnt vmcnt(0)" ::: "memory");
    } else {
      XB_SPIN(xb_ld(&bar[XB_XGEN(b.x)]) == gen, bar);
      __builtin_amdgcn_fence(__ATOMIC_ACQUIRE, "agent");
      asm volatile("s_waitcnt vmcnt(0)" ::: "memory");
    }
  }
  __syncthreads();
}

DEV void tr_tile(const float* __restrict__ src, u16* __restrict__ dst, int K, int N, int kt, int nt, bool il, float* lds) {
  const int tid = tid_l();
  const int k0 = kt * 64, n0 = nt * 64;
  {
    const int c = tid & 63, r0 = tid >> 6;
#pragma unroll
    for (int i = 0; i < 16; ++i) {
      int r = r0 + i * 4;
      lds[r * 65 + c] = src[(size_t)(k0 + r) * N + n0 + c];
    }
  }
  __syncthreads();
  {
    const int ch = tid & 7, nn0 = tid >> 3;
#pragma unroll
    for (int i = 0; i < 2; ++i) {
      const int n = nn0 + i * 32;
      const int gn = n0 + n;
      int np = gn;
      if (il) {
        int j = gn < DFF ? gn : gn - DFF;
        np = (j >> 4) * 32 + (j & 15) + (gn < DFF ? 0 : 16);
      }
      const float* sp = lds + (ch * 8) * 65 + n;
      uint4 o;
      o.x = pk2(sp[0 * 65], sp[1 * 65]);
      o.y = pk2(sp[2 * 65], sp[3 * 65]);
      o.z = pk2(sp[4 * 65], sp[5 * 65]);
      o.w = pk2(sp[6 * 65], sp[7 * 65]);
      *(uint4*)(dst + (size_t)np * K + k0 + ch * 8) = o;
    }
  }
  __syncthreads();
}

DEV void phase0(const P& p, char* smem) {
  float* lds = (float*)smem;
  const int tid = tid_l();
  constexpr int C0 = 2560, C1 = C0 + 1024, C2 = C1 + 5632, C3 = C2 + 2816, C4 = C3 + 48, C5 = C4 + 48, C6 = C5 + 48,
                C7 = C6 + 64, C8 = C7 + 384, C9 = C8 + 1;
  for (int it = bid_l(); it < C9; it += gridDim.x) {
    if (it < C6) {
      const float* src; u16* dst; int K, N, kt, nt; bool il = false;
      if (it < C0) {
        int l = it / 640, r = it % 640;
        src = p.w_in + (size_t)l * 1024 * 2560; dst = p.wIn + (size_t)l * 2560 * 1024; K = 1024; N = 2560; kt = r / 40; nt = r % 40;
      } else if (it < C1) {
        int i2 = it - C0, l = i2 / 256, r = i2 % 256;
        src = p.w_out + (size_t)l * 1024 * 1024; dst = p.wOut + (size_t)l * 1024 * 1024; K = 1024; N = 1024; kt = r / 16; nt = r % 16;
      } else if (it < C2) {
        int i2 = it - C1, l = i2 / 1408, r = i2 % 1408;
        src = p.w1 + (size_t)l * 1024 * 5632; dst = p.w1t + (size_t)l * 5632 * 1024; K = 1024; N = 5632; kt = r / 88; nt = r % 88; il = true;
      } else if (it < C3) {
        int i2 = it - C2, l = i2 / 704, r = i2 % 704;
        src = p.w2 + (size_t)l * 2816 * 1024; dst = p.w2t + (size_t)l * 1024 * 2816; K = 2816; N = 1024; kt = r / 16; nt = r % 16;
      } else if (it < C4) {
        int i2 = it - C3, bb = i2 / 6;
        src = p.w_up + (size_t)bb * 64 * 384; dst = p.wUpT + (size_t)bb * 384 * 64; K = 64; N = 384; kt = 0; nt = i2 % 6;
      } else if (it < C5) {
        int i2 = it - C4, bb = i2 / 6;
        src = p.a_up + (size_t)bb * 64 * 384; dst = p.aUpT + (size_t)bb * 384 * 64; K = 64; N = 384; kt = 0; nt = i2 % 6;
      } else {
        int i2 = it - C5, l = i2 / 12, r = i2 % 12;
        src = p.g_up + (size_t)l * 128 * 384; dst = p.gUpT + (size_t)l * 384 * 128; K = 128; N = 384; kt = r / 6; nt = r % 6;
      }
      tr_tile(src, dst, K, N, kt, nt, il, lds);
    } else if (it < C7) {
      int i2 = it - C6;
      for (int i = 0; i < 16; ++i) {
        int e = i2 * 4096 + i * 256 + tid;
        p.sgW[e] = f2bf(p.sg_w[e]);
      }
    } else if (it < C8) {
      int i2 = it - C7, l = i2 / 96, cb = i2 % 96;
      for (int e = tid; e < 9 * 1024; e += 256) {
        int s = e >> 10, k = e & 1023;
        float v = s < 8 ? p.c[s * 1024 + k] : p.c_ctx[k];
        lds[e] = siluf_(v);
      }
      __syncthreads();
      const int col = tid & 63, kq = tid >> 6;
      const int n = cb * 64 + col;
      float acc[9];
#pragma unroll
      for (int s = 0; s < 9; ++s) acc[s] = 0.f;
      const float* wp = p.ada_w + (size_t)l * 1024 * 6144 + n;
#pragma unroll 4
      for (int k = kq * 256; k < kq * 256 + 256; ++k) {
        float w = wp[(size_t)k * 6144];
#pragma unroll
        for (int s = 0; s < 9; ++s) acc[s] += lds[s * 1024 + k] * w;
      }
      __syncthreads();
      float* red = lds + 9216;
#pragma unroll
      for (int s = 0; s < 9; ++s) red[(kq * 9 + s) * 64 + col] = acc[s];
      __syncthreads();
      for (int e = tid; e < 9 * 64; e += 256) {
        int s = e >> 6, cc = e & 63;
        float v = red[(0 * 9 + s) * 64 + cc] + red[(1 * 9 + s) * 64 + cc] + red[(2 * 9 + s) * 64 + cc] + red[(3 * 9 + s) * 64 + cc];
        int nn = cb * 64 + cc;
        p.mods[((size_t)l * 9 + s) * 6144 + nn] = v + p.ada_b[l * 6144 + nn];
      }
      __syncthreads();
    } else {
      for (int e = tid; e < 1024; e += 256) {
        int pos = e >> 4, i = e & 15;
        float inv = powf(10000.f, -(float)i / 16.f);
        float ang = (float)pos * inv;
        p.rope[e * 2] = cosf(ang);
        p.rope[e * 2 + 1] = sinf(ang);
      }
      if (tid < 64) p.cnt[tid] = 0;
      for (int e = tid; e < XCD_BAR_WORDS; e += 256) p.xbar[e] = 0u;
    }
  }
}

DEV void norm_phase(const P& p, int l, const float* __restrict__ g, int shoff, int scoff, int row_lo, bool from_input) {
  const int tid = tid_l();
  const int lane = tid & 63;
  const int gw = bid_l() * 4 + (tid >> 6), nw = gridDim.x * 4;
  const float* lat = from_input ? p.x : p.out;
  const float* cx = from_input ? p.ctx : p.xc;
  for (int r0 = row_lo + gw; r0 < MT; r0 += 4 * nw) {
    float4 v[4][4];
#pragma unroll
    for (int u = 0; u < 4; ++u) {
      const int r = r0 + u * nw;
      if (r < MT) {
        const float* src = r < MC ? cx + (size_t)r * DM : lat + (size_t)(r - MC) * DM;
#pragma unroll
        for (int i = 0; i < 4; ++i) v[u][i] = *(const float4*)(src + i * 256 + lane * 4);
      }
    }
#pragma unroll
    for (int u = 0; u < 4; ++u) {
      const int r = r0 + u * nw;
      if (r < MT) {
        const int s = r < MC ? 8 : (r - MC) >> 12;
        const float* md = p.mods + ((size_t)l * 9 + s) * 6144;
        float ss = 0.f;
#pragma unroll
        for (int i = 0; i < 4; ++i) ss += v[u][i].x * v[u][i].x + v[u][i].y * v[u][i].y + v[u][i].z * v[u][i].z + v[u][i].w * v[u][i].w;
        ss = wave_sum(ss);
        const float rstd = rsqrtf(ss * (1.f / DM) + 1e-6f);
#pragma unroll
        for (int i = 0; i < 4; ++i) {
          const int c = i * 256 + lane * 4;
          float4 gg = *(const float4*)(g + c);
          float4 sh = *(const float4*)(md + shoff + c);
          float4 sc = *(const float4*)(md + scoff + c);
          float o0 = v[u][i].x * rstd * gg.x * (1.f + sc.x) + sh.x;
          float o1 = v[u][i].y * rstd * gg.y * (1.f + sc.y) + sh.y;
          float o2 = v[u][i].z * rstd * gg.z * (1.f + sc.z) + sh.z;
          float o3 = v[u][i].w * rstd * gg.w * (1.f + sc.w) + sh.w;
          uint2 o;
          o.x = pk2(o0, o1);
          o.y = pk2(o2, o3);
          *(uint2*)(p.act + (size_t)r * DM + c) = o;
        }
      }
    }
  }
}

DEV void final_norm(const P& p) {
  const int tid = tid_l();
  const int lane = tid & 63;
  const int gw = bid_l() * 4 + (tid >> 6), nw = gridDim.x * 4;
  for (int r0 = gw; r0 < ML; r0 += 4 * nw) {
    float4 v[4][4];
#pragma unroll
    for (int u = 0; u < 4; ++u) {
      const int r = r0 + u * nw;
      if (r < ML) {
#pragma unroll
        for (int i = 0; i < 4; ++i) v[u][i] = *(const float4*)(p.out + (size_t)r * DM + i * 256 + lane * 4);
      }
    }
#pragma unroll
    for (int u = 0; u < 4; ++u) {
      const int r = r0 + u * nw;
      if (r < ML) {
        const float rstd = rsqrtf(p.rss1[MC + r] * (1.f / DM) + 1e-6f);
#pragma unroll
        for (int i = 0; i < 4; ++i) {
          const int c = i * 256 + lane * 4;
          float4 gg = *(const float4*)(p.fng + c);
          float4 o;
          o.x = v[u][i].x * rstd * gg.x;
          o.y = v[u][i].y * rstd * gg.y;
          o.z = v[u][i].z * rstd * gg.z;
          o.w = v[u][i].w * rstd * gg.w;
          *(float4*)(p.out + (size_t)r * DM + c) = o;
        }
      }
    }
  }
}

DEV void phase0b(const P& p, char* smem) {
  float* lds = (float*)smem;
  const int tid = tid_l(), lane = tid & 63;
  for (int it = bid_l(); it < 512; it += gridDim.x) {
    const bool isz = it < 160;
    const int i2 = isz ? it : it - 160;
    const int l = isz ? i2 / 40 : i2 / 88, cb = isz ? i2 % 40 : i2 % 88;
    const int N = isz ? 2560 : 5632;
    const float* W = isz ? p.w_in + (size_t)l * 1024 * 2560 : p.w1 + (size_t)l * 1024 * 5632;
    for (int e = tid; e < 9 * 1024; e += 256) {
      const int s9 = e >> 10, k = e & 1023;
      lds[e] = p.mods[((size_t)l * 9 + s9) * 6144 + (isz ? 0 : 3072) + k];
    }
    __syncthreads();
    const int col = tid & 63, kq = tid >> 6;
    const int n = cb * 64 + col;
    float acc[9];
#pragma unroll
    for (int s9 = 0; s9 < 9; ++s9) acc[s9] = 0.f;
    const float* wp = W + n;
#pragma unroll 4
    for (int k = kq * 256; k < kq * 256 + 256; ++k) {
      const float w = wp[(size_t)k * N];
#pragma unroll
      for (int s9 = 0; s9 < 9; ++s9) acc[s9] += lds[s9 * 1024 + k] * w;
    }
    __syncthreads();
    float* red = lds + 9216;
#pragma unroll
    for (int s9 = 0; s9 < 9; ++s9) red[(kq * 9 + s9) * 64 + col] = acc[s9];
    __syncthreads();
    for (int e = tid; e < 9 * 64; e += 256) {
      const int s9 = e >> 6, cc = e & 63;
      const float v = red[(0 * 9 + s9) * 64 + cc] + red[(1 * 9 + s9) * 64 + cc] + red[(2 * 9 + s9) * 64 + cc] + red[(3 * 9 + s9) * 64 + cc];
      const int gn = cb * 64 + cc;
      if (isz) p.bz[((size_t)l * 9 + s9) * 2560 + gn] = v;
      else {
        const int j = gn < DFF ? gn : gn - DFF;
        const int np = (j >> 4) * 32 + (j & 15) + (gn < DFF ? 0 : 16);
        p.bh[((size_t)l * 9 + s9) * 5632 + np] = v;
      }
    }
    __syncthreads();
  }
  const int gw = bid_l() * 4 + (tid >> 6), nw = gridDim.x * 4;
  for (int r0 = gw; r0 < MT; r0 += 4 * nw) {
    float4 v[4][4];
#pragma unroll
    for (int u = 0; u < 4; ++u) {
      const int r = r0 + u * nw;
      if (r < MT) {
        const float* src = r < MC ? p.ctx + (size_t)r * DM : p.x + (size_t)(r - MC) * DM;
#pragma unroll
        for (int i = 0; i < 4; ++i) v[u][i] = *(const float4*)(src + i * 256 + lane * 4);
      }
    }
#pragma unroll
    for (int u = 0; u < 4; ++u) {
      const int r = r0 + u * nw;
      if (r < MT) {
        const int s9 = r < MC ? 8 : (r - MC) >> 12;
        const float* md = p.mods + (size_t)s9 * 6144 + 1024;
        float ss = 0.f;
#pragma unroll
        for (int i = 0; i < 4; ++i) ss += v[u][i].x * v[u][i].x + v[u][i].y * v[u][i].y + v[u][i].z * v[u][i].z + v[u][i].w * v[u][i].w;
        ss = wave_sum(ss);
        if (lane == 0) p.rss1[r] = ss;
#pragma unroll
        for (int i = 0; i < 4; ++i) {
          const int c = i * 256 + lane * 4;
          const float4 gg = *(const float4*)(p.n1g + c);
          const float4 sc = *(const float4*)(md + c);
          *(uint2*)(p.act + (size_t)r * DM + c) =
              make_uint2(pk2(v[u][i].x * gg.x * (1.f + sc.x), v[u][i].y * gg.y * (1.f + sc.y)),
                         pk2(v[u][i].z * gg.z * (1.f + sc.z), v[u][i].w * gg.w * (1.f + sc.w)));
        }
      }
    }
  }
}

enum { EPI_Z = 0, EPI_RES = 1, EPI_SWIGLU = 2 };
struct GX { float* rss_acc; u16* aout; const float* gnext; int lmod; int scoff; };

template <int EPI>
DEV void gemm_phase(const P& p, int l, const u16* __restrict__ A, int lda, const u16* __restrict__ Bt, int K, int NT,
                           int mt_lo, int goff, char* smem, GX gx, int dry = 0) {
  const int tid = tid_l(), lane = tid & 63, wid = tid >> 6, wr = wid >> 1, wc = wid & 1, l15 = lane & 15, quad = lane >> 4;
  const int nmt = NMT - mt_lo;
  const int nk = K / 64;
  const int npn = NT >> 2;
  const int npatch = (nmt >> 4) * npn;
  const int tmax = ((npatch + 7) >> 3) * 512;
#define G_MAP(T, OK, M0, N0)                                                                        \
  {                                                                                                 \
    const int xcd_ = (T)&7, sidx_ = (T) >> 3;                                                       \
    const int gp_ = (sidx_ >> 6) * 8 + xcd_;                                                        \
    OK = (T) < tmax && gp_ < npatch;                                                                \
    const int within_ = sidx_ & 63;                                                                 \
    M0 = (mt_lo + (gp_ / npn) * 16 + (within_ & 15)) * 128;                                         \
    N0 = ((gp_ % npn) * 4 + (within_ >> 4)) * 128;                                                  \
  }
  uint4 xa0, xa1, xa2, xa3, xb0, xb1, xb2, xb3, ya0, ya1, ya2, ya3, yb0, yb1, yb2, yb3;
  int t = bid_l();
  bool have;
  int m0, n0;
  G_MAP(t, have, m0, n0);
  const u16* Ag = A + (size_t)(m0 + (tid >> 3)) * lda + (tid & 7) * 8;
  const u16* Bg = Bt + (size_t)(n0 + (tid >> 3)) * K + (tid & 7) * 8;
  bool primed = false;
  while (have) {
    f32x4 acc[4][4];
#pragma unroll
    for (int i = 0; i < 4; ++i)
#pragma unroll
      for (int j = 0; j < 4; ++j) acc[i][j] = f32x4{0.f, 0.f, 0.f, 0.f};
#define G_GL(P, KT)                                                          \
    {                                                                        \
      const int k0_ = (KT)*64;                                               \
      P##a0 = *(const uint4*)(Ag + k0_);                                     \
      P##b0 = *(const uint4*)(Bg + k0_);                                     \
      P##a1 = *(const uint4*)(Ag + (size_t)32 * lda + k0_);                  \
      P##b1 = *(const uint4*)(Bg + (size_t)32 * K + k0_);                    \
      P##a2 = *(const uint4*)(Ag + (size_t)64 * lda + k0_);                  \
      P##b2 = *(const uint4*)(Bg + (size_t)64 * K + k0_);                    \
      P##a3 = *(const uint4*)(Ag + (size_t)96 * lda + k0_);                  \
      P##b3 = *(const uint4*)(Bg + (size_t)96 * K + k0_);                    \
    }
#define G_LS(P, BUF)                                                         \
    {                                                                        \
      char* Aw_ = smem + (BUF)*32768;                                        \
      *(uint4*)(Aw_ + swz((tid >> 3), tid & 7)) = P##a0;                     \
      *(uint4*)(Aw_ + 16384 + swz((tid >> 3), tid & 7)) = P##b0;             \
      *(uint4*)(Aw_ + swz((tid >> 3) + 32, tid & 7)) = P##a1;                \
      *(uint4*)(Aw_ + 16384 + swz((tid >> 3) + 32, tid & 7)) = P##b1;        \
      *(uint4*)(Aw_ + swz((tid >> 3) + 64, tid & 7)) = P##a2;                \
      *(uint4*)(Aw_ + 16384 + swz((tid >> 3) + 64, tid & 7)) = P##b2;        \
      *(uint4*)(Aw_ + swz((tid >> 3) + 96, tid & 7)) = P##a3;                \
      *(uint4*)(Aw_ + 16384 + swz((tid >> 3) + 96, tid & 7)) = P##b3;        \
    }
#define G_COMPUTE(BUF)                                                                                             \
    {                                                                                                              \
      const char* As = smem + (BUF)*32768;                                                                         \
      const char* Bs = As + 16384;                                                                                 \
      _Pragma("unroll") for (int kh = 0; kh < 2; ++kh) {                                                           \
        bf16x8 a[4], b[4];                                                                                         \
        _Pragma("unroll") for (int mi = 0; mi < 4; ++mi)                                                           \
            a[mi] = *(const bf16x8*)(As + swz(wr * 64 + mi * 16 + l15, kh * 4 + quad));                            \
        _Pragma("unroll") for (int ni = 0; ni < 4; ++ni)                                                           \
            b[ni] = *(const bf16x8*)(Bs + swz(wc * 64 + ni * 16 + l15, kh * 4 + quad));                            \
        _Pragma("unroll") for (int mi = 0; mi < 4; ++mi)                                                           \
            _Pragma("unroll") for (int ni = 0; ni < 4; ++ni) acc[mi][ni] = mfma16(b[ni], a[mi], acc[mi][ni]);      \
      }                                                                                                            \
    }
    if (!primed) {
      G_GL(x, 0);
      G_GL(y, 1);
    }
    G_LS(x, 0);
    if (2 < nk) G_GL(x, 2);
    __syncthreads();
    for (int kt = 0; kt < nk; kt += 2) {
      G_COMPUTE(0);
      G_LS(y, 1);
      if (kt + 3 < nk) G_GL(y, kt + 3);
      __syncthreads();
      G_COMPUTE(1);
      if (kt + 2 < nk) G_LS(x, 0);
      if (kt + 4 < nk) G_GL(x, kt + 4);
      __syncthreads();
    }
    const int em0 = m0, en0 = n0;
    t += gridDim.x;
    G_MAP(t, have, m0, n0);
    if (have) {
      Ag = A + (size_t)(m0 + (tid >> 3)) * lda + (tid & 7) * 8;
      Bg = Bt + (size_t)(n0 + (tid >> 3)) * K + (tid & 7) * 8;
      G_GL(x, 0);
      G_GL(y, 1);
      primed = true;
    }
    if (dry) {
      if (acc[0][0][0] == 1.2345e33f) p.bonus[0] = acc[1][1][1] + acc[2][2][2] + acc[3][3][3];
      continue;
    }
    const int cw0 = en0 + wc * 64;
    if constexpr (EPI == EPI_Z || EPI == EPI_SWIGLU) {
      const int sb_ = em0 < MC ? 8 : (em0 - MC) >> 12;
      const float* rssp = EPI == EPI_Z ? p.rss1 : p.rss2;
      const float* bias = EPI == EPI_Z ? p.bz + ((size_t)l * 9 + sb_) * 2560 + cw0 : p.bh + ((size_t)l * 9 + sb_) * 5632 + cw0;
      float rsv[4];
#pragma unroll
      for (int mi = 0; mi < 4; ++mi) rsv[mi] = rsqrtf(rssp[em0 + wr * 64 + mi * 16 + l15] * (1.f / DM) + 1e-6f);
#pragma unroll
      for (int ni = 0; ni < 4; ++ni) {
        const float4 bb = *(const float4*)(bias + ni * 16 + quad * 4);
#pragma unroll
        for (int mi = 0; mi < 4; ++mi) {
          acc[mi][ni][0] = acc[mi][ni][0] * rsv[mi] + bb.x;
          acc[mi][ni][1] = acc[mi][ni][1] * rsv[mi] + bb.y;
          acc[mi][ni][2] = acc[mi][ni][2] * rsv[mi] + bb.z;
          acc[mi][ni][3] = acc[mi][ni][3] * rsv[mi] + bb.w;
        }
      }
    }
    if constexpr (EPI == EPI_Z) {
      if (cw0 < 1920) {
#pragma unroll
        for (int mi = 0; mi < 4; ++mi) {
          const int r = em0 + wr * 64 + mi * 16 + l15;
#pragma unroll
          for (int ni = 0; ni < 4; ++ni)
            *(uint2*)(p.z + (size_t)r * INC + cw0 + ni * 16 + quad * 4) =
                make_uint2(pk2(acc[mi][ni][0], acc[mi][ni][1]), pk2(acc[mi][ni][2], acc[mi][ni][3]));
          __builtin_amdgcn_sched_barrier(0);
        }
      } else {
        const int hh = (cw0 - 1920) >> 6;
        if (hh < 8) {
          const float* gp = (hh < 6 ? p.q_g : p.k_g) + l * 64;
          float4 gv[4];
#pragma unroll
          for (int ni = 0; ni < 4; ++ni) gv[ni] = *(const float4*)(gp + ni * 16 + quad * 4);
          const float qs = hh < 6 ? 0.125f : 1.f;
#pragma unroll
          for (int mi = 0; mi < 4; ++mi) {
            const int r = em0 + wr * 64 + mi * 16 + l15;
            float ss = 0.f;
#pragma unroll
            for (int ni = 0; ni < 4; ++ni)
#pragma unroll
              for (int j = 0; j < 4; ++j) ss += acc[mi][ni][j] * acc[mi][ni][j];
            ss += __shfl_xor(ss, 16);
            ss += __shfl_xor(ss, 32);
            const float rstd = rsqrtf(ss * (1.f / 64.f) + 1e-6f) ;
            float yv[4][4];
#pragma unroll
            for (int ni = 0; ni < 4; ++ni) {
              yv[ni][0] = acc[mi][ni][0] * rstd * gv[ni].x;
              yv[ni][1] = acc[mi][ni][1] * rstd * gv[ni].y;
              yv[ni][2] = acc[mi][ni][2] * rstd * gv[ni].z;
              yv[ni][3] = acc[mi][ni][3] * rstd * gv[ni].w;
            }
            if (r >= MC) {
              const int tt = (r - MC) & 4095;
              const int prow = tt >> 6, pcol = tt & 63;
              const float* rr_ = p.rope + (prow * 16 + quad * 4) * 2;
              const float* rc_ = p.rope + (pcol * 16 + quad * 4) * 2;
              const float4 ra = *(const float4*)rr_, rb = *(const float4*)(rr_ + 4);
              const float4 ca = *(const float4*)rc_, cb = *(const float4*)(rc_ + 4);
              const float cr[4] = {ra.x, ra.z, rb.x, rb.z}, sr[4] = {ra.y, ra.w, rb.y, rb.w};
              const float cc[4] = {ca.x, ca.z, cb.x, cb.z}, sc[4] = {ca.y, ca.w, cb.y, cb.w};
#pragma unroll
              for (int j = 0; j < 4; ++j) {
                const float a0 = yv[0][j] * cr[j] - yv[1][j] * sr[j], a1 = yv[1][j] * cr[j] + yv[0][j] * sr[j];
                const float a2 = yv[2][j] * cc[j] - yv[3][j] * sc[j], a3 = yv[3][j] * cc[j] + yv[2][j] * sc[j];
                yv[0][j] = a0; yv[1][j] = a1; yv[2][j] = a2; yv[3][j] = a3;
              }
            }
#pragma unroll
            for (int ni = 0; ni < 4; ++ni)
              *(uint2*)(p.z + (size_t)r * INC + cw0 + ni * 16 + quad * 4) =
                  make_uint2(pk2(yv[ni][0] * qs, yv[ni][1] * qs), pk2(yv[ni][2] * qs, yv[ni][3] * qs));
            __builtin_amdgcn_sched_barrier(0);
          }
        } else {
          const int kvh = hh - 8;
#pragma unroll
          for (int mi = 0; mi < 4; ++mi) {
            const int r = em0 + wr * 64 + mi * 16 + l15;
            u16* vb;
            int vstride;
            if (r < MC) { vb = p.vTc + ((size_t)(((r >> 8) * 2 + kvh) * 64)) * CTXL + (r & 255); vstride = CTXL; }
            else { const int rr = r - MC; vb = p.vTl + ((size_t)(((rr >> 12) * 2 + kvh) * 64)) * SEQ + (rr & 4095); vstride = SEQ; }
#pragma unroll
            for (int ni = 0; ni < 4; ++ni)
#pragma unroll
              for (int j = 0; j < 4; ++j) vb[(size_t)(ni * 16 + quad * 4 + j) * vstride] = f2bf(acc[mi][ni][j]);
            __builtin_amdgcn_sched_barrier(0);
          }
        }
      }
    } else if constexpr (EPI == EPI_RES) {
      const int s = em0 < MC ? 8 : (em0 - MC) >> 12;
      const float* gate = p.mods + ((size_t)l * 9 + s) * 6144 + goff;
      float4 gv[4], gm[4];
#pragma unroll
      for (int ni = 0; ni < 4; ++ni) {
        gv[ni] = *(const float4*)(gate + cw0 + ni * 16 + quad * 4);
        gm[ni] = make_float4(0.f, 0.f, 0.f, 0.f);
        if (gx.aout) {
          const float4 g4 = *(const float4*)(gx.gnext + cw0 + ni * 16 + quad * 4);
          const float4 s4 = *(const float4*)(p.mods + ((size_t)gx.lmod * 9 + s) * 6144 + gx.scoff + cw0 + ni * 16 + quad * 4);
          gm[ni] = make_float4(g4.x * (1.f + s4.x), g4.y * (1.f + s4.y), g4.z * (1.f + s4.z), g4.w * (1.f + s4.w));
        }
      }
#pragma unroll
      for (int mi = 0; mi < 4; ++mi) {
        const int r = em0 + wr * 64 + mi * 16 + l15;
        const float* src;
        if (l == 0 && goff == 2048) src = r < MC ? p.ctx + (size_t)r * DM : p.x + (size_t)(r - MC) * DM;
        else src = r < MC ? p.xc + (size_t)r * DM : p.out + (size_t)(r - MC) * DM;
        float* dst = r < MC ? p.xc + (size_t)r * DM : p.out + (size_t)(r - MC) * DM;
        float ssq = 0.f;
#pragma unroll
        for (int ni = 0; ni < 4; ++ni) {
          const int c = cw0 + ni * 16 + quad * 4;
          const float4 xv = *(const float4*)(src + c);
          float4 o;
          o.x = xv.x + gv[ni].x * acc[mi][ni][0];
          o.y = xv.y + gv[ni].y * acc[mi][ni][1];
          o.z = xv.z + gv[ni].z * acc[mi][ni][2];
          o.w = xv.w + gv[ni].w * acc[mi][ni][3];
          *(float4*)(dst + c) = o;
          ssq += o.x * o.x + o.y * o.y + o.z * o.z + o.w * o.w;
          if (gx.aout) {
            *(uint2*)(gx.aout + (size_t)r * DM + c) =
                make_uint2(pk2(o.x * gm[ni].x, o.y * gm[ni].y), pk2(o.z * gm[ni].z, o.w * gm[ni].w));
          }
        }
        ssq += __shfl_xor(ssq, 16);
        ssq += __shfl_xor(ssq, 32);
        if (quad == 0) {
          const float old_ = unsafeAtomicAdd(gx.rss_acc + r, ssq);
          asm volatile("" ::"v"(old_));
        }
        __builtin_amdgcn_sched_barrier(0);
      }
    } else {
      const int hc0 = (en0 >> 1) + wc * 32;
#pragma unroll
      for (int mi = 0; mi < 4; ++mi) {
        const int r = em0 + wr * 64 + mi * 16 + l15;
#pragma unroll
        for (int pp = 0; pp < 2; ++pp) {
          float hv[4];
#pragma unroll
          for (int j = 0; j < 4; ++j) hv[j] = siluf_(acc[mi][2 * pp][j]) * acc[mi][2 * pp + 1][j];
          *(uint2*)(p.h + (size_t)r * DFF + hc0 + pp * 16 + quad * 4) = make_uint2(pk2(hv[0], hv[1]), pk2(hv[2], hv[3]));
        }
        __builtin_amdgcn_sched_barrier(0);
      }
    }
  }
}
#undef G_GL
#undef G_LS
#undef G_COMPUTE
#undef G_MAP

template <int LPR>
DEV float red_lpr(float v) {
  v += dppf<0xB1>(v);
  v += dppf<0x4E>(v);
  if (LPR >= 8) v += dppf<0x141>(v);
  if (LPR >= 16) v += dppf<0x140>(v);
  return v;
}

constexpr int SCAN_LPR = 8;
constexpr int SCAN_RPB = 256 / SCAN_LPR;
constexpr int SCAN_NPART = 64 / SCAN_RPB;
constexpr int SCAN_JL = 64 / SCAN_LPR;
constexpr int SCAN_ITEMS = 96 * SCAN_NPART;

DEV float red8_sum(float v) {
  v += dppf<0xB1>(v);
  v += dppf<0x4E>(v);
  v += dppf<0x141>(v);
  return v;
}
DEV float tanh_fast(float x) {
  float e = __expf(2.f * x);
  return 1.f - 2.f * __builtin_amdgcn_rcpf(1.f + e);
}

struct ChunkPos { int len, rowbase, tlo; };
DEV ChunkPos chunk_pos(int c, int d, int b) {
  ChunkPos cp;
  const int s0 = c * 16;
  int pos0;
  if (s0 < 256) { cp.len = 256; pos0 = s0; cp.rowbase = b * 256; }
  else { cp.len = 4096; pos0 = s0 - 256; cp.rowbase = MC + b * 4096; }
  cp.tlo = d ? (cp.len - 16 - pos0) : pos0;
  return cp;
}

constexpr int SC_R = 0, SC_KD = 12288, SC_V = 24576, SC_W = 30720, SC_KA = 38912, SC_NKK = 47104;

DEV void cvt8(const uint4 u, float4& lo, float4& hi) {
  lo.x = __uint_as_float(u.x << 16); lo.y = __uint_as_float(u.x & 0xffff0000u);
  lo.z = __uint_as_float(u.y << 16); lo.w = __uint_as_float(u.y & 0xffff0000u);
  hi.x = __uint_as_float(u.z << 16); hi.y = __uint_as_float(u.z & 0xffff0000u);
  hi.z = __uint_as_float(u.w << 16); hi.w = __uint_as_float(u.w & 0xffff0000u);
}

DEV void scan_item(const P& p, int l, int item, char* smem) {
  const int tid = tid_l(), lane = tid & 63, wid = tid >> 6, l15 = lane & 15, quad = lane >> 4;
  constexpr int LPR = SCAN_LPR, RPB = SCAN_RPB, JL = SCAN_JL, NV = RPB / 8;
  const int scan = item / SCAN_NPART, part = item % SCAN_NPART;
  const int d = scan / 48, b = (scan % 48) / 6, h = scan % 6;
  const int rloc = tid / LPR, jq = tid % LPR;
  const int irow = part * RPB + rloc;
  const int j0 = jq * JL;

  const int c_ts = (tid & 127) >> 3, c_ch = tid & 7;
  const int c_col = (tid < 128 ? 0 : 384) + h * 64 + c_ch * 8;
  const int v_ts = tid / NV, v_ch = tid % NV;
  const int v_col = 768 + h * 64 + part * RPB + v_ch * 8;

  const int n2 = wid * 16 + l15;
  bf16x8 bW[2], bA[2];
  {
    const u16* wb = p.wUpT + ((size_t)(l * 2 + d) * 384 + h * 64 + n2) * 64 + quad * 8;
    const u16* ab = p.aUpT + ((size_t)(l * 2 + d) * 384 + h * 64 + n2) * 64 + quad * 8;
    bW[0] = *(const bf16x8*)(wb);
    bW[1] = *(const bf16x8*)(wb + 32);
    bA[0] = *(const bf16x8*)(ab);
    bA[1] = *(const bf16x8*)(ab + 32);
  }
  const float w0v = p.w0[(size_t)(l * 2 + d) * 384 + h * 64 + n2];
  const float a0v = p.a0[(size_t)(l * 2 + d) * 384 + h * 64 + n2];
  const float kkc = p.k_k[l * 384 + h * 64 + n2], kac = p.k_a[l * 384 + h * 64 + n2], rkc = p.r_k[l * 384 + h * 64 + n2];

  float2v S2[JL / 2];
#pragma unroll
  for (int j = 0; j < JL / 2; ++j) S2[j] = float2v{0.f, 0.f};
  uint4 g_rk, g_v;
  bf16x8 g_wd0, g_wd1, g_ad0, g_ad1;
  float g_inv[4];

#define SC_GLOAD1(CC)                                                                                  \
  {                                                                                                    \
    const ChunkPos cp_ = chunk_pos((CC), d, b);                                                        \
    g_rk = *(const uint4*)(p.z + (size_t)(cp_.rowbase + cp_.tlo + c_ts) * INC + c_col);                \
    if (tid < 16 * NV) g_v = *(const uint4*)(p.z + (size_t)(cp_.rowbase + cp_.tlo + v_ts) * INC + v_col);  \
  }
#define SC_GLOAD2(CC)                                                                                  \
  {                                                                                                    \
    const ChunkPos cp_ = chunk_pos((CC), d, b);                                                        \
    const u16* rp_ = p.z + (size_t)(cp_.rowbase + cp_.tlo + l15) * INC + 1152 + quad * 8;              \
    g_wd0 = *(const bf16x8*)(rp_);                                                                     \
    g_wd1 = *(const bf16x8*)(rp_ + 32);                                                                \
    g_ad0 = *(const bf16x8*)(rp_ + 64);                                                                \
    g_ad1 = *(const bf16x8*)(rp_ + 96);                                                                \
    _Pragma("unroll") for (int j = 0; j < 4; ++j)                                                      \
      g_inv[j] = p.invn[(size_t)(cp_.rowbase + cp_.tlo + quad * 4 + j) * 8 + h];                       \
  }
#define SC_STAGE1(CC)                                                                                  \
  {                                                                                                    \
    const int i3_ = (CC) % 3;                                                                          \
    float4 lo_, hi_;                                                                                   \
    cvt8(g_rk, lo_, hi_);                                                                              \
    float* dst_ = (float*)(smem + (tid < 128 ? SC_R : SC_KD) + i3_ * 4096) + c_ts * 64 + c_ch * 8;     \
    *(float4*)dst_ = lo_;                                                                              \
    *(float4*)(dst_ + 4) = hi_;                                                                        \
    if (tid < 16 * NV) {                                                                               \
      cvt8(g_v, lo_, hi_);                                                                             \
      float* dv_ = (float*)(smem + SC_V + i3_ * 2048) + v_ts * RPB + v_ch * 8;                         \
      *(float4*)dv_ = lo_;                                                                             \
      *(float4*)(dv_ + 4) = hi_;                                                                       \
    }                                                                                                  \
  }
#define SC_STAGE2(CC)                                                                                  \
  {                                                                                                    \
    const int i3_ = (CC) % 3, i2_ = (CC)&1;                                                            \
    const ChunkPos cp_ = chunk_pos((CC), d, b);                                                        \
    f32x4 accW = f32x4{0.f, 0.f, 0.f, 0.f}, accA = f32x4{0.f, 0.f, 0.f, 0.f};                          \
    accW = mfma16(g_wd0, bW[0], accW);                                                                 \
    accW = mfma16(g_wd1, bW[1], accW);                                                                 \
    accA = mfma16(g_ad0, bA[0], accA);                                                                 \
    accA = mfma16(g_ad1, bA[1], accA);                                                                 \
    float bon_[4];                                                                                     \
    _Pragma("unroll") for (int j = 0; j < 4; ++j) {                                                    \
      const int ts = quad * 4 + j;                                                                     \
      float* kdp = (float*)(smem + SC_KD + i3_ * 4096) + ts * 64 + n2;                                 \
      const float kv = *kdp;                                                                           \
      const float rv = *((const float*)(smem + SC_R + i3_ * 4096) + ts * 64 + n2);                     \
      const float sg = sigmoidf_(w0v + accW[j]);                                                       \
      const float wv = __expf(-0.6065306597126334f * sg);                                              \
      const float av = sigmoidf_(a0v + accA[j]);                                                       \
      const float kn = kv * kkc * g_inv[j];                                                            \
      const float kd = kv * (1.f + (av - 1.f) * kac);                                                  \
      *((float*)(smem + SC_W + i2_ * 4096) + ts * 64 + n2) = wv;                                       \
      *((float*)(smem + SC_NKK + i2_ * 4096) + ts * 64 + n2) = -kn;                                    \
      *((float*)(smem + SC_KA + i2_ * 4096) + ts * 64 + n2) = kn * av;                                 \
      *kdp = kd;                                                                                       \
      bon_[j] = rv * kd * rkc;                                                                         \
    }                                                                                                  \
    _Pragma("unroll") for (int j = 0; j < 4; ++j) bon_[j] = red16_sum(bon_[j]);                        \
    if (l15 == 0 && part == 0) {                                                                       \
      _Pragma("unroll") for (int j = 0; j < 4; ++j)                                                    \
        p.bonus[(size_t)(cp_.rowbase + cp_.tlo + quad * 4 + j) * 48 + (d * 6 + h) * 4 + wid] = bon_[j]; \
    }                                                                                                  \
  }

  __builtin_amdgcn_s_setprio(3);
  SC_GLOAD1(0);
  SC_GLOAD2(0);
  SC_STAGE1(0);
  SC_GLOAD1(1);
  __syncthreads();
  SC_STAGE2(0);
  SC_STAGE1(1);
  SC_GLOAD1(2);
  SC_GLOAD2(1);
  __syncthreads();

  for (int c = 0; c < 272; ++c) {
    {
      const int i3 = c % 3, i2 = c & 1;
      const ChunkPos cp = chunk_pos(c, d, b);
      const float* pW = (const float*)(smem + SC_W + i2 * 4096) + j0;
      const float* pN = (const float*)(smem + SC_NKK + i2 * 4096) + j0;
      const float* pA = (const float*)(smem + SC_KA + i2 * 4096) + j0;
      const float* pD = (const float*)(smem + SC_KD + i3 * 4096) + j0;
      const float* pR = (const float*)(smem + SC_R + i3 * 4096) + j0;
      const float* pV = (const float*)(smem + SC_V + i3 * 2048) + rloc;
      float* yp = p.y + ((size_t)d * MT + cp.rowbase + cp.tlo) * 384 + h * 64 + irow;
      float yk0 = 0.f, yk1 = 0.f;
      constexpr int NQ = JL / 4;
      float4 cw[NQ], cn[NQ], ca[NQ], cd[NQ], cr[NQ];
      float cvi;
#define SC_LD(TS, W, N, A, D, R, VI)                                                             \
      _Pragma("unroll") for (int q = 0; q < NQ; ++q) {                                           \
        W[q] = *(const float4*)(pW + (TS)*64 + q * 4); N[q] = *(const float4*)(pN + (TS)*64 + q * 4); \
        A[q] = *(const float4*)(pA + (TS)*64 + q * 4); D[q] = *(const float4*)(pD + (TS)*64 + q * 4); \
        R[q] = *(const float4*)(pR + (TS)*64 + q * 4);                                           \
      }                                                                                          \
      VI = pV[(TS)*RPB];
      {
        const int ts0 = d ? 15 : 0;
        SC_LD(ts0, cw, cn, ca, cd, cr, cvi)
      }
#pragma unroll
      for (int si = 0; si < 16; ++si) {
        float4 xw[NQ], xn[NQ], xa[NQ], xd[NQ], xr[NQ];
        float xvi = 0.f;
        if (si + 1 < 16) {
          const int tsn = d ? 14 - si : si + 1;
          SC_LD(tsn, xw, xn, xa, xd, xr, xvi)
        }
        float2v sa2 = S2[0] * float2v{cn[0].x, cn[0].y};
        sa2 = S2[1] * float2v{cn[0].z, cn[0].w} + sa2;
        if constexpr (NQ == 2) {
          float2v sb2 = S2[2] * float2v{cn[1].x, cn[1].y};
          sb2 = S2[3] * float2v{cn[1].z, cn[1].w} + sb2;
          sa2 = sa2 + sb2;
        }
        const float2v viv = float2v{cvi, cvi};
        float2v u2[JL / 2];
#pragma unroll
        for (int q = 0; q < NQ; ++q) {
          u2[2 * q] = S2[2 * q] * float2v{cw[q].x, cw[q].y} + viv * float2v{cd[q].x, cd[q].y};
          u2[2 * q + 1] = S2[2 * q + 1] * float2v{cw[q].z, cw[q].w} + viv * float2v{cd[q].z, cd[q].w};
        }
        const float sa = LPR == 16 ? red16_sum(sa2.x + sa2.y) : red8_sum(sa2.x + sa2.y);
        const float2v sav = float2v{sa, sa};
#pragma unroll
        for (int q = 0; q < NQ; ++q) {
          S2[2 * q] = sav * float2v{ca[q].x, ca[q].y} + u2[2 * q];
          S2[2 * q + 1] = sav * float2v{ca[q].z, ca[q].w} + u2[2 * q + 1];
        }
        float2v y2 = S2[0] * float2v{cr[0].x, cr[0].y};
        y2 = S2[1] * float2v{cr[0].z, cr[0].w} + y2;
        if constexpr (NQ == 2) {
          float2v yb2 = S2[2] * float2v{cr[1].x, cr[1].y};
          yb2 = S2[3] * float2v{cr[1].z, cr[1].w} + yb2;
          y2 = y2 + yb2;
        }
        const float yv = LPR == 16 ? red16_sum(y2.x + y2.y) : red8_sum(y2.x + y2.y);
        if (si < LPR) yk0 = (jq == si) ? yv : yk0;
        else yk1 = (jq == si - LPR) ? yv : yk1;
        if (si + 1 < 16) {
#pragma unroll
          for (int q = 0; q < NQ; ++q) { cw[q] = xw[q]; cn[q] = xn[q]; ca[q] = xa[q]; cd[q] = xd[q]; cr[q] = xr[q]; }
          cvi = xvi;
        }
      }
#undef SC_LD
      {
        const int tsa = d ? 15 - jq : jq;
        yp[(size_t)tsa * 384] = yk0;
        if constexpr (LPR == 8) {
          const int tsb = d ? 7 - jq : 8 + jq;
          yp[(size_t)tsb * 384] = yk1;
        }
      }
    }
    if (c + 1 < 272) SC_STAGE2(c + 1);
    if (c + 2 < 272) SC_STAGE1(c + 2);
    if (c + 3 < 272) SC_GLOAD1(c + 3);
    if (c + 2 < 272) SC_GLOAD2(c + 2);
    __syncthreads();
  }
  __builtin_amdgcn_s_setprio(0);
#undef SC_GLOAD1
#undef SC_GLOAD2
#undef SC_STAGE1
#undef SC_STAGE2
}

DEV void attn_item(const P& p, int item, char* smem) {
  const int tid = tid_l(), lane = tid & 63, wid = tid >> 6, l15 = lane & 15, quad = lane >> 4;
  bool lat = item < 1536;
  int b, hq, qb;
  if (lat) { b = item / 192; int rem = item % 192; hq = rem / 32; qb = rem % 32; }
  else { int i2 = item - 1536; b = i2 / 12; int rem = i2 % 12; hq = rem / 2; qb = rem % 2; }
  const int kvh = hq / 3;
  const int qrow0 = lat ? MC + b * 4096 + qb * 128 : b * 256 + qb * 128;
  const int nkt = lat ? 68 : 4;
  const float LOG2E = 1.4426950408889634f;

  bf16x8 qf[2][2];
#pragma unroll
  for (int mi = 0; mi < 2; ++mi)
#pragma unroll
    for (int ks = 0; ks < 2; ++ks)
      qf[mi][ks] = *(const bf16x8*)(p.z + (size_t)(qrow0 + wid * 32 + mi * 16 + l15) * INC + 1920 + hq * 64 + ks * 32 + quad * 8);

  f32x4 Ot[2][4];
  float mrow[2], lpart[2];
#pragma unroll
  for (int mi = 0; mi < 2; ++mi) {
#pragma unroll
    for (int nd = 0; nd < 4; ++nd) Ot[mi][nd] = f32x4{0.f, 0.f, 0.f, 0.f};
    mrow[mi] = -1e30f;
    lpart[mi] = 0.f;
  }
  const int lrow = tid >> 3, lch = tid & 7;
  uint4 rk0, rk1, rv0, rv1;
#define ATT_GLOAD(KT)                                                                         \
  {                                                                                           \
    const int kt_ = (KT);                                                                     \
    const u16* kp;                                                                            \
    const u16* vp;                                                                            \
    int vstride;                                                                              \
    if (lat && kt_ < 64) {                                                                    \
      kp = p.z + (size_t)(MC + b * 4096 + kt_ * 64) * INC + 2304 + kvh * 64;                  \
      vp = p.vTl + (size_t)((b * 2 + kvh) * 64) * SEQ + kt_ * 64;                             \
      vstride = SEQ;                                                                          \
    } else {                                                                                  \
      const int kc = lat ? kt_ - 64 : kt_;                                                    \
      kp = p.z + (size_t)(b * 256 + kc * 64) * INC + 2304 + kvh * 64;                         \
      vp = p.vTc + (size_t)((b * 2 + kvh) * 64) * CTXL + kc * 64;                             \
      vstride = CTXL;                                                                         \
    }                                                                                         \
    rk0 = *(const uint4*)(kp + (size_t)(lrow)*INC + lch * 8);                                 \
    rk1 = *(const uint4*)(kp + (size_t)(lrow + 32) * INC + lch * 8);                          \
    rv0 = *(const uint4*)(vp + (size_t)(lrow)*vstride + lch * 8);                             \
    rv1 = *(const uint4*)(vp + (size_t)(lrow + 32) * vstride + lch * 8);                      \
  }
#define ATT_LSTORE(BUF)                                     \
  {                                                         \
    char* Kb_ = smem + (BUF)*16384;                         \
    *(uint4*)(Kb_ + swz(lrow, lch)) = rk0;                  \
    *(uint4*)(Kb_ + swz(lrow + 32, lch)) = rk1;             \
    *(uint4*)(Kb_ + 8192 + swz(lrow, lch)) = rv0;           \
    *(uint4*)(Kb_ + 8192 + swz(lrow + 32, lch)) = rv1;      \
  }
  ATT_GLOAD(0);
  ATT_LSTORE(0);
  __syncthreads();
  for (int kt = 0; kt < nkt; ++kt) {
    const int buf = kt & 1;
    if (kt + 1 < nkt) ATT_GLOAD(kt + 1);
    const char* Kb = smem + buf * 16384;
    const char* Vb = Kb + 8192;
    f32x4 St[2][4];
#pragma unroll
    for (int mi = 0; mi < 2; ++mi)
#pragma unroll
      for (int ni = 0; ni < 4; ++ni) St[mi][ni] = f32x4{0.f, 0.f, 0.f, 0.f};
#pragma unroll
    for (int ks = 0; ks < 2; ++ks) {
      bf16x8 kf[4];
#pragma unroll
      for (int ni = 0; ni < 4; ++ni) kf[ni] = *(const bf16x8*)(Kb + swz(ni * 16 + l15, ks * 4 + quad));
#pragma unroll
      for (int mi = 0; mi < 2; ++mi)
#pragma unroll
        for (int ni = 0; ni < 4; ++ni) St[mi][ni] = mfma16(kf[ni], qf[mi][ks], St[mi][ni]);
    }
    bf16x8 pf[2][2];
#pragma unroll
    for (int mi = 0; mi < 2; ++mi) {
      float mx = St[mi][0][0];
#pragma unroll
      for (int ni = 0; ni < 4; ++ni)
#pragma unroll
        for (int jj = 0; jj < 4; ++jj) mx = fmaxf(mx, St[mi][ni][jj]);
      mx = fmaxf(mx, __shfl_xor(mx, 16));
      mx = fmaxf(mx, __shfl_xor(mx, 32));
      const float mnew = fmaxf(mrow[mi], mx);
      const float alpha = __builtin_amdgcn_exp2f((mrow[mi] - mnew) * LOG2E);
      mrow[mi] = mnew;
      const float mb = mnew * LOG2E;
      float ps = 0.f;
      float pv[4][4];
#pragma unroll
      for (int ni = 0; ni < 4; ++ni)
#pragma unroll
        for (int jj = 0; jj < 4; ++jj) {
          pv[ni][jj] = __builtin_amdgcn_exp2f(St[mi][ni][jj] * LOG2E - mb);
          ps += pv[ni][jj];
        }
      lpart[mi] = lpart[mi] * alpha + ps;
#pragma unroll
      for (int nd = 0; nd < 4; ++nd) {
        Ot[mi][nd][0] *= alpha; Ot[mi][nd][1] *= alpha; Ot[mi][nd][2] *= alpha; Ot[mi][nd][3] *= alpha;
      }
#pragma unroll
      for (int s2 = 0; s2 < 2; ++s2) {
        union { unsigned u[4]; bf16x8 v; } pk;
        pk.u[0] = pk2(pv[2 * s2][0], pv[2 * s2][1]);
        pk.u[1] = pk2(pv[2 * s2][2], pv[2 * s2][3]);
        pk.u[2] = pk2(pv[2 * s2 + 1][0], pv[2 * s2 + 1][1]);
        pk.u[3] = pk2(pv[2 * s2 + 1][2], pv[2 * s2 + 1][3]);
        pf[mi][s2] = pk.v;
      }
    }
#pragma unroll
    for (int s2 = 0; s2 < 2; ++s2) {
      bf16x8 vf[4];
#pragma unroll
      for (int nd = 0; nd < 4; ++nd) {
        const int drow = nd * 16 + l15;
        union { uint2 h[2]; bf16x8 v; } vv;
        vv.h[0] = *(const uint2*)(Vb + swz(drow, 4 * s2 + (quad >> 1)) + (quad & 1) * 8);
        vv.h[1] = *(const uint2*)(Vb + swz(drow, 4 * s2 + 2 + (quad >> 1)) + (quad & 1) * 8);
        vf[nd] = vv.v;
      }
#pragma unroll
      for (int mi = 0; mi < 2; ++mi)
#pragma unroll
        for (int nd = 0; nd < 4; ++nd) Ot[mi][nd] = mfma16(vf[nd], pf[mi][s2], Ot[mi][nd]);
    }
    if (kt + 1 < nkt) ATT_LSTORE(buf ^ 1);
    __syncthreads();
  }
#undef ATT_GLOAD
#undef ATT_LSTORE
#pragma unroll
  for (int mi = 0; mi < 2; ++mi) {
    float lsum = lpart[mi];
    lsum += __shfl_xor(lsum, 16);
    lsum += __shfl_xor(lsum, 32);
    const float inv = 1.f / lsum;
    const int r = qrow0 + wid * 32 + mi * 16 + l15;
#pragma unroll
    for (int nd = 0; nd < 4; ++nd)
      *(uint2*)(p.act + (size_t)r * DM + 640 + hq * 64 + nd * 16 + quad * 4) =
          make_uint2(pk2(Ot[mi][nd][0] * inv, Ot[mi][nd][1] * inv), pk2(Ot[mi][nd][2] * inv, Ot[mi][nd][3] * inv));
  }
}

DEV void sgate_item(const P& p, int l, int ck, int g, char* smem) {
  const int tid = tid_l(), lane = tid & 63, wid = tid >> 6, l15 = lane & 15, quad = lane >> 4;
  const int m0 = ck * 128;
  u16* sVT = (u16*)smem;
  {
    const int q = tid >> 1, half = tid & 1;
    const u16* src = p.z + (size_t)(m0 + q) * INC + 1408 + 256 + g * 64 + half * 32;
    float v[32];
    float ss = 0.f;
#pragma unroll
    for (int cidx = 0; cidx < 4; ++cidx) {
      uint4 u = *(const uint4*)(src + cidx * 8);
      unsigned uu[4] = {u.x, u.y, u.z, u.w};
#pragma unroll
      for (int e = 0; e < 4; ++e) {
        float f0 = geluf_(bf2f((u16)(uu[e] & 0xffff)));
        float f1 = geluf_(bf2f((u16)(uu[e] >> 16)));
        v[cidx * 8 + e * 2] = f0;
        v[cidx * 8 + e * 2 + 1] = f1;
        ss += f0 * f0 + f1 * f1;
      }
    }
    ss += __shfl_xor(ss, 1);
    const float rstd = rsqrtf(ss * (1.f / 64.f) + 1e-6f);
    const float* gn = p.sgn + l * 256 + g * 64 + half * 32;
#pragma unroll
    for (int e = 0; e < 32; ++e) sVT[(half * 32 + e) * 136 + q] = f2bf(v[e] * rstd * gn[e]);
  }
  __syncthreads();
  f32x4 acc[2][4];
#pragma unroll
  for (int mi = 0; mi < 2; ++mi)
#pragma unroll
    for (int ni = 0; ni < 4; ++ni) acc[mi][ni] = f32x4{0.f, 0.f, 0.f, 0.f};
  const u16* Wg = p.sgW + (size_t)(l * 4 + g) * 128 * 128;
#pragma unroll
  for (int ks = 0; ks < 4; ++ks) {
    bf16x8 a[2], bb[4];
#pragma unroll
    for (int mi = 0; mi < 2; ++mi) a[mi] = *(const bf16x8*)(Wg + (size_t)(wid * 32 + mi * 16 + l15) * 128 + ks * 32 + quad * 8);
#pragma unroll
    for (int ni = 0; ni < 4; ++ni) bb[ni] = *(const bf16x8*)(sVT + (ni * 16 + l15) * 136 + ks * 32 + quad * 8);
#pragma unroll
    for (int mi = 0; mi < 2; ++mi)
#pragma unroll
      for (int ni = 0; ni < 4; ++ni) acc[mi][ni] = mfma16(a[mi], bb[ni], acc[mi][ni]);
  }
#pragma unroll
  for (int mi = 0; mi < 2; ++mi)
#pragma unroll
    for (int j = 0; j < 4; ++j) {
      const int pr = wid * 32 + mi * 16 + quad * 4 + j;
      const float bias = p.sg_b[(size_t)(l * 4 + g) * 128 + pr];
#pragma unroll
      for (int ni = 0; ni < 4; ++ni) {
        const int c = ni * 16 + l15;
        float u = geluf_(bf2f(p.z[(size_t)(m0 + pr) * INC + 1408 + g * 64 + c]));
        p.act[(size_t)(m0 + pr) * DM + 384 + g * 64 + c] = f2bf(u * (acc[mi][ni][j] + bias));
      }
    }
  __syncthreads();
}

DEV void mix_phase(const P& p, int l, char* smem, int cidx) {
  __shared__ int s_item;
  const bool last = (l == DEPTH - 1);
  const int n_attn = last ? 1536 : 1632;
  const int ck_lo = last ? 16 : 0;
  const int n_sg = (NMT - ck_lo) * 4;
  const int total = SCAN_ITEMS + n_attn + n_sg;
  const int bid = bid_l();
  bool first = bid < SCAN_ITEMS;
  for (;;) {
    int it;
    if (first) {
      it = bid;
      first = false;
    } else {
      if (tid_l() == 0) s_item = SCAN_ITEMS + atomicAdd(p.cnt + cidx, 1);
      __syncthreads();
      it = s_item;
      __syncthreads();
    }
    if (it >= total) break;
    if (it < SCAN_ITEMS) {
      int nr = SCAN_REP; asm volatile("" : "+s"(nr));
      for (int rr = 0; rr < nr; ++rr) scan_item(p, l, it, smem);
    } else if (it < SCAN_ITEMS + n_attn) {
      int nr = ATT_REP; asm volatile("" : "+s"(nr));
      for (int rr = 0; rr < nr; ++rr) { attn_item(p, it - SCAN_ITEMS, smem); __syncthreads(); }
    } else {
      int i2 = it - SCAN_ITEMS - n_attn;
      int nr = SG_REP; asm volatile("" : "+s"(nr));
      for (int rr = 0; rr < nr; ++rr) sgate_item(p, l, ck_lo + (i2 >> 2), i2 & 3, smem);
    }
  }
}

DEV void apost_phase(const P& p, int l, int mt_lo, char* smem) {
  const int tid = tid_l(), lane = tid & 63, wid = tid >> 6, l15 = lane & 15, quad = lane >> 4;
  for (int i = bid_l() * 256 + tid; i < MT; i += gridDim.x * 256) { p.rss1[i] = 0.f; p.rss2[i] = 0.f; }
  const int nit = (NMT - mt_lo) * 6;
  for (int it = bid_l(); it < nit; it += gridDim.x) {
    const int mt = mt_lo + it / 6;
    const int hh = it % 6;
    const int m0 = mt * 128;
    bf16x8 a[2][4];
#pragma unroll
    for (int mi = 0; mi < 2; ++mi)
#pragma unroll
      for (int ks = 0; ks < 4; ++ks)
        a[mi][ks] = *(const bf16x8*)(p.z + (size_t)(m0 + wid * 32 + mi * 16 + l15) * INC + 1280 + ks * 32 + quad * 8);
    {
      f32x4 acc[2][4];
#pragma unroll
      for (int mi = 0; mi < 2; ++mi)
#pragma unroll
        for (int ni = 0; ni < 4; ++ni) acc[mi][ni] = f32x4{0.f, 0.f, 0.f, 0.f};
#pragma unroll
      for (int ks = 0; ks < 4; ++ks) {
        bf16x8 bb[4];
#pragma unroll
        for (int ni = 0; ni < 4; ++ni)
          bb[ni] = *(const bf16x8*)(p.gUpT + ((size_t)l * 384 + hh * 64 + ni * 16 + l15) * 128 + ks * 32 + quad * 8);
#pragma unroll
        for (int mi = 0; mi < 2; ++mi)
#pragma unroll
          for (int ni = 0; ni < 4; ++ni) acc[mi][ni] = mfma16(bb[ni], a[mi][ks], acc[mi][ni]);
      }
      float4 lg[4], lb[4];
#pragma unroll
      for (int ni = 0; ni < 4; ++ni) {
        lg[ni] = *(const float4*)(p.ln_g + l * 384 + hh * 64 + ni * 16 + quad * 4);
        lb[ni] = *(const float4*)(p.ln_b + l * 384 + hh * 64 + ni * 16 + quad * 4);
      }
#pragma unroll
      for (int mi = 0; mi < 2; ++mi) {
        const int r = m0 + wid * 32 + mi * 16 + l15;
        float4 ys[4];
        uint2 vraw[4];
        float sm = 0.f;
#pragma unroll
        for (int ni = 0; ni < 4; ++ni) {
          const int c = hh * 64 + ni * 16 + quad * 4;
          const float4 y0 = *(const float4*)(p.y + (size_t)r * 384 + c);
          const float4 y1 = *(const float4*)(p.y + ((size_t)MT + r) * 384 + c);
          ys[ni] = make_float4(y0.x + y1.x, y0.y + y1.y, y0.z + y1.z, y0.w + y1.w);
          vraw[ni] = *(const uint2*)(p.z + (size_t)r * INC + 768 + c);
          sm += (ys[ni].x + ys[ni].y) + (ys[ni].z + ys[ni].w);
        }
        const float4 bq0 = *(const float4*)(p.bonus + (size_t)r * 48 + hh * 4);
        const float4 bq1 = *(const float4*)(p.bonus + (size_t)r * 48 + (6 + hh) * 4);
        const float bon = (bq0.x + bq0.y) + (bq0.z + bq0.w) + (bq1.x + bq1.y) + (bq1.z + bq1.w);
        sm += __shfl_xor(sm, 16);
        sm += __shfl_xor(sm, 32);
        const float mean = sm * (1.f / 64.f);
        float vs = 0.f;
#pragma unroll
        for (int ni = 0; ni < 4; ++ni) {
          ys[ni].x -= mean; ys[ni].y -= mean; ys[ni].z -= mean; ys[ni].w -= mean;
          vs += ys[ni].x * ys[ni].x + ys[ni].y * ys[ni].y + ys[ni].z * ys[ni].z + ys[ni].w * ys[ni].w;
        }
        vs += __shfl_xor(vs, 16);
        vs += __shfl_xor(vs, 32);
        const float rstd = rsqrtf(vs * (1.f / 64.f) + 64e-5f);
#pragma unroll
        for (int ni = 0; ni < 4; ++ni) {
          const int c = hh * 64 + ni * 16 + quad * 4;
          const float v0 = __uint_as_float(vraw[ni].x << 16), v1 = __uint_as_float(vraw[ni].x & 0xffff0000u);
          const float v2 = __uint_as_float(vraw[ni].y << 16), v3 = __uint_as_float(vraw[ni].y & 0xffff0000u);
          const float o0 = (ys[ni].x * rstd * lg[ni].x + lb[ni].x + bon * v0) * acc[mi][ni][0];
          const float o1 = (ys[ni].y * rstd * lg[ni].y + lb[ni].y + bon * v1) * acc[mi][ni][1];
          const float o2 = (ys[ni].z * rstd * lg[ni].z + lb[ni].z + bon * v2) * acc[mi][ni][2];
          const float o3 = (ys[ni].w * rstd * lg[ni].w + lb[ni].w + bon * v3) * acc[mi][ni][3];
          *(uint2*)(p.act + (size_t)r * DM + c) = make_uint2(pk2(o0, o1), pk2(o2, o3));
        }
        __builtin_amdgcn_sched_barrier(0);
      }
    }
  }
}

DEV uint2 ld8(const u16* q) { return *(const uint2*)q; }
DEV void up4(const uint2 u, float (&f)[4]) {
  f[0] = __uint_as_float(u.x << 16); f[1] = __uint_as_float(u.x & 0xffff0000u);
  f[2] = __uint_as_float(u.y << 16); f[3] = __uint_as_float(u.y & 0xffff0000u);
}
DEV void prep_phase(const P& p, int l, XcdBarrier& xb) {
  const int tid = tid_l(), lane = tid & 63, l15 = lane & 15;
  const int nb = gridDim.x, bid = bid_l();
  constexpr int NR = 8;
  const int rpb = (((MT + nb - 1) / nb) + NR - 1) & ~(NR - 1);
  const int ra = bid * rpb;
  const int rb = min(ra + rpb, MT);
  const bool active = ra < MT;
  const bool has1 = tid < 96;
  const int col0 = tid * 4, col1 = 1024 + tid * 4;
  uint2 hp0 = make_uint2(0, 0), hn0 = hp0, hp1 = hp0, hn1 = hp0;
  if (active) {
    if (ra > 0) { hp0 = ld8(p.z + (size_t)(ra - 1) * INC + col0); if (has1) hp1 = ld8(p.z + (size_t)(ra - 1) * INC + col1); }
    if (rb < MT) { hn0 = ld8(p.z + (size_t)rb * INC + col0); if (has1) hn1 = ld8(p.z + (size_t)rb * INC + col1); }
  }
  xcd_barrier(xb);
  if (!active) return;
  const float* cw = p.conv + (size_t)l * 3 * 1408;
#pragma unroll 1
  for (int pass = 0; pass < 2; ++pass) {
    if (pass == 1 && !has1) break;
    const int col = pass ? col1 : col0;
    const int typ = col < 1152 ? 0 : (col < 1216 ? 1 : (col < 1280 ? 0 : 2));
    const bool isk = col >= 384 && col < 768;
    float c0[4], c1[4], c2[4], kk4[4];
#pragma unroll
    for (int e = 0; e < 4; ++e) {
      c0[e] = cw[col + e]; c1[e] = cw[1408 + col + e]; c2[e] = cw[2816 + col + e];
      kk4[e] = isk ? p.k_k[l * 384 + (col - 384) + e] : 0.f;
    }
    const int hh = isk ? (col - 384) >> 6 : 0;
    u16* zc = p.z + col;
    uint2 prev = pass ? hp1 : hp0;
    const uint2 halo_n = pass ? hn1 : hn0;
    uint2 cur = ld8(zc + (size_t)ra * INC);
    for (int r = ra; r < rb; r += NR) {
      uint2 w[NR + 2];
      w[0] = prev;
      w[1] = cur;
#pragma unroll
      for (int q = 0; q < NR; ++q) {
        const int rr = r + 1 + q;
        w[q + 2] = rr < rb ? ld8(zc + (size_t)rr * INC) : halo_n;
      }
#pragma unroll
      for (int q = 0; q < NR; ++q) {
        const int rr = r + q;
        const uint2 xp = w[q], xc = w[q + 1], xn = w[q + 2];
        const int tt = rr < MC ? (rr & 255) : ((rr - MC) & 4095);
        const int len = rr < MC ? 256 : 4096;
        const float mp = tt > 0 ? 1.f : 0.f, mn = tt < len - 1 ? 1.f : 0.f;
        float fp[4], fc[4], fn[4], o[4];
        up4(xp, fp); up4(xc, fc); up4(xn, fn);
#pragma unroll
        for (int e = 0; e < 4; ++e) {
          float v = fc[e] * c1[e] + mp * (fp[e] * c0[e]) + mn * (fn[e] * c2[e]);
          if (typ == 1) v = tanh_fast(v);
          else if (typ == 2) v = sigmoidf_(v);
          o[e] = v;
        }
        if (isk) {
          float q0 = o[0] * kk4[0], q1 = o[1] * kk4[1], q2 = o[2] * kk4[2], q3 = o[3] * kk4[3];
          float ss = red16_sum(q0 * q0 + q1 * q1 + q2 * q2 + q3 * q3);
          if (l15 == 0 && rr < rb) p.invn[(size_t)rr * 8 + hh] = 1.f / fmaxf(sqrtf(ss), 1e-12f);
        }
        if (rr < rb) *(uint2*)(zc + (size_t)rr * INC) = make_uint2(pk2(o[0], o[1]), pk2(o[2], o[3]));
      }
      prev = w[NR];
      cur = w[NR + 1];
    }
  }
}

__global__ void __launch_bounds__(256, 2) fwd_megakernel(P p, int ph_lo, int ph_hi) {
  __shared__ __attribute__((aligned(16))) char smem[65536 - 16];
  cg::grid_group grid = cg::this_grid();
  XcdBarrier xb;
  xb.bar = p.xbar; xb.x = 0; xb.nloc = 0u; xb.nx = 0u;
  for (int ph = ph_lo; ph < ph_hi; ++ph) {
    if (ph > ph_lo) {
      if (ph == ph_lo + 1) {
        grid.sync();
        xb = xcd_barrier_post(p.xbar);
      } else {
        xcd_barrier(xb);
      }
    }
    if (ph == 0) { phase0(p, smem); continue; }
    if (ph == 1) { phase0b(p, smem); continue; }
    if (ph == 2 + 6 * DEPTH) { final_norm(p); continue; }
    const int l = (ph - 2) / 6, sub = (ph - 2) % 6;
    const bool last = (l == DEPTH - 1);
    const int mt_lo = last ? 16 : 0;
    GX g0{};
    g0.rss_acc = nullptr; g0.aout = nullptr; g0.gnext = nullptr; g0.lmod = 0; g0.scoff = 0;
    if (sub == 0) {
      gemm_phase<EPI_Z>(p, l, p.act, DM, p.wIn + (size_t)l * 2560 * 1024, 1024, 20, 0, 0, smem, g0, 0);
    } else if (sub == 1) {
      prep_phase(p, l, xb);
      xcd_barrier(xb);
      mix_phase(p, l, smem, l);
    } else if (sub == 2) {
      apost_phase(p, l, mt_lo, smem);
    } else if (sub == 3 || sub == 5) {
      const bool g4 = sub == 5;
      GX gx{};
      gx.rss_acc = g4 ? p.rss1 : p.rss2;
      gx.aout = g4 ? (last ? nullptr : p.act) : p.act2;
      gx.gnext = g4 ? p.n1g + (last ? 0 : (l + 1) * DM) : p.n2g + l * DM;
      gx.lmod = g4 ? (last ? l : l + 1) : l;
      gx.scoff = g4 ? 1024 : 4096;
      gemm_phase<EPI_RES>(p, l, g4 ? p.h : p.act, g4 ? DFF : DM,
                          g4 ? p.w2t + (size_t)l * 1024 * 2816 : p.wOut + (size_t)l * 1024 * 1024, g4 ? 2816 : 1024, 8, mt_lo,
                          g4 ? 5120 : 2048, smem, gx, 0);
    } else {
      gemm_phase<EPI_SWIGLU>(p, l, p.act2, DM, p.w1t + (size_t)l * 5632 * 1024, 1024, 44, mt_lo, 0, smem, g0, 0);
    }
  }
}

extern "C" void kernel_launch(void* const* d_in, const int* in_sizes, int n_in, void* d_out, int out_size, void* d_ws,
                              size_t ws_size, hipStream_t stream) {
  static int grid_blocks = 0;
  if (!grid_blocks) {
    int dev = 0, cus = 0, per_cu = 0;
    hipGetDevice(&dev);
    hipDeviceGetAttribute(&cus, hipDeviceAttributeMultiprocessorCount, dev);
    hipOccupancyMaxActiveBlocksPerMultiprocessor(&per_cu, fwd_megakernel, 256, 0);
    if (per_cu > 2) per_cu = 2;
    if (per_cu < 1) per_cu = 1;
    grid_blocks = cus * per_cu;
  }
  P p{};
  const float* const* in = (const float* const*)d_in;
  p.x = in[0]; p.c = in[1]; p.ctx = in[2]; p.c_ctx = in[3]; p.n1g = in[4]; p.n2g = in[5]; p.ada_w = in[6]; p.ada_b = in[7];
  p.w_in = in[8]; p.conv = in[9]; p.w0 = in[10]; p.w_up = in[11]; p.a0 = in[12]; p.a_up = in[13]; p.g_up = in[14];
  p.k_k = in[15]; p.k_a = in[16]; p.r_k = in[17]; p.ln_g = in[18]; p.ln_b = in[19]; p.sgn = in[20]; p.sg_w = in[21];
  p.sg_b = in[22]; p.q_g = in[23]; p.k_g = in[24]; p.w_out = in[25]; p.w1 = in[26]; p.w2 = in[27]; p.fng = in[28];
  p.out = (float*)d_out;
  char* ws = (char*)d_ws;
  size_t off = 0;
  auto take = [&](size_t bytes) { char* r = ws + off; off += (bytes + 255) & ~(size_t)255; return r; };
  p.wIn = (u16*)take((size_t)4 * 2560 * 1024 * 2);
  p.wOut = (u16*)take((size_t)4 * 1024 * 1024 * 2);
  p.w1t = (u16*)take((size_t)4 * 5632 * 1024 * 2);
  p.w2t = (u16*)take((size_t)4 * 1024 * 2816 * 2);
  p.wUpT = (u16*)take((size_t)8 * 384 * 64 * 2);
  p.aUpT = (u16*)take((size_t)8 * 384 * 64 * 2);
  p.gUpT = (u16*)take((size_t)4 * 384 * 128 * 2);
  p.sgW = (u16*)take((size_t)16 * 128 * 128 * 2);
  p.mods = (float*)take((size_t)4 * 9 * 6144 * 4);
  p.rope = (float*)take(2048 * 4);
  p.cnt = (int*)take(256);
  p.xbar = (unsigned*)take((size_t)XCD_BAR_WORDS * 4);
  p.xc = (float*)take((size_t)MC * DM * 4);
  p.act = (u16*)take((size_t)MT * DM * 2);
  p.z = (u16*)take((size_t)MT * DFF * 2);
  p.h = p.z;
  p.vTl = (u16*)take((size_t)16 * 64 * SEQ * 2);
  p.vTc = (u16*)take((size_t)16 * 64 * CTXL * 2);
  p.y = (float*)take((size_t)2 * MT * 384 * 4);
  p.bonus = (float*)take((size_t)MT * 48 * 4);
  p.invn = (float*)take((size_t)MT * 8 * 4);
  p.rss1 = (float*)take((size_t)MT * 4);
  p.rss2 = (float*)take((size_t)MT * 4);
  p.bz = (float*)take((size_t)4 * 9 * 2560 * 4);
  p.bh = (float*)take((size_t)4 * 9 * 5632 * 4);
  p.act2 = (u16*)p.y;
  if (off > ws_size) { fprintf(stderr, "workspace too small: need %zu have %zu\n", off, ws_size); return; }
  int ph_lo = 0, ph_hi = 3 + 6 * DEPTH;
  void* args[] = {&p, &ph_lo, &ph_hi};
  hipError_t e = hipLaunchCooperativeKernel((void*)fwd_megakernel, dim3(grid_blocks), dim3(256), args, 0, stream);
  if (e != hipSuccess) fprintf(stderr, "cooperative launch failed: %s (grid %d)\n", hipGetErrorString(e), grid_blocks);
}
```

```cpp
#include <hip/hip_runtime.h>
#include <hip/hip_bf16.h>
#include <hip/hip_cooperative_groups.h>
#include <cstdio>
namespace cg = cooperative_groups;

typedef __attribute__((ext_vector_type(8))) short bf16x8;
typedef __attribute__((ext_vector_type(4))) float f32x4;
typedef unsigned short u16;
typedef __attribute__((ext_vector_type(2))) float float2v;

#define DEV __device__ __forceinline__
DEV int tid_l() { int t = threadIdx.x; asm volatile("" : "+v"(t)); return t; }
DEV int bid_l() { int b = blockIdx.x; asm volatile("" : "+s"(b)); return b; }

constexpr int DM = 1024, NBATCH = 8, SEQ = 4096, DEPTH = 4, CTXL = 256;
constexpr int MC = NBATCH * CTXL;
constexpr int ML = NBATCH * SEQ;
constexpr int MT = MC + ML;
constexpr int INC = 2560, DFF = 2816;
constexpr int NMT = MT / 128;
#ifndef PROBE_MASK
#define PROBE_MASK 0
#endif
#define SCAN_REP 1
#define ATT_REP 1
#define SG_REP 1

struct P {
  const float *x, *c, *ctx, *c_ctx, *n1g, *n2g, *ada_w, *ada_b, *w_in, *conv, *w0, *w_up, *a0, *a_up, *g_up,
      *k_k, *k_a, *r_k, *ln_g, *ln_b, *sgn, *sg_w, *sg_b, *q_g, *k_g, *w_out, *w1, *w2, *fng;
  float* out;
  u16 *wIn, *wOut, *w1t, *w2t, *wUpT, *aUpT, *gUpT, *sgW;
  float *mods, *rope;
  int* cnt;
  unsigned* xbar;
  float* xc;
  u16 *act, *z, *h, *vTl, *vTc;
  float *y, *bonus, *invn;
  float *rss1, *rss2, *bz, *bh;
  u16* act2;
};

typedef __attribute__((ext_vector_type(2))) __bf16 bf16x2v;
typedef __attribute__((ext_vector_type(2))) float f32x2v;
DEV unsigned pk2(float a, float b) {
  f32x2v v = {a, b};
  bf16x2v r = __builtin_convertvector(v, bf16x2v);
  return *(unsigned*)&r;
}
DEV u16 f2bf(float f) { return (u16)(pk2(f, 0.f) & 0xffffu); }
DEV float bf2f(u16 h) { return __uint_as_float(((unsigned)h) << 16); }
DEV float sigmoidf_(float x) { return __builtin_amdgcn_rcpf(1.f + __expf(-x)); }
DEV float siluf_(float x) { return x * __builtin_amdgcn_rcpf(1.f + __expf(-x)); }
DEV float geluf_(float x) {
  float u = 0.7978845608028654f * (x + 0.044715f * x * x * x);
  return 0.5f * x * (1.f + tanhf(u));
}
DEV int swz(int r, int ch) { return r * 128 + ((ch ^ ((r >> 1) & 7)) << 4); }

template <int CTRL>
DEV float dppf(float v) {
  return __int_as_float(__builtin_amdgcn_update_dpp(0, __float_as_int(v), CTRL, 0xF, 0xF, false));
}
DEV float red16_sum(float v) {
  v += dppf<0xB1>(v);
  v += dppf<0x4E>(v);
  v += dppf<0x141>(v);
  v += dppf<0x140>(v);
  return v;
}
DEV float red16_max(float v) {
  v = fmaxf(v, dppf<0xB1>(v));
  v = fmaxf(v, dppf<0x4E>(v));
  v = fmaxf(v, dppf<0x141>(v));
  v = fmaxf(v, dppf<0x140>(v));
  return v;
}
DEV float wave_sum(float v) {
#pragma unroll
  for (int o = 32; o >= 1; o >>= 1) v += __shfl_xor(v, o);
  return v;
}
DEV f32x4 mfma16(bf16x8 a, bf16x8 b, f32x4 c) { return __builtin_amdgcn_mfma_f32_16x16x32_bf16(a, b, c, 0, 0, 0); }


#define XB_TMO      128
#define XB_XCNT(j)  (256  + 64 * (j))
#define XB_XSUB(j)  (1280 + 64 * (j))
#define XB_XGEN(j)  (2304 + 64 * (j))
#define XB_TOP      3328
#define XB_TOPGEN   3392
#define XCD_BAR_WORDS 3456
#define XB_SPIN_CAP (1u << 20)
DEV unsigned xb_ld(unsigned* q) { return __hip_atomic_load(q, __ATOMIC_RELAXED, __HIP_MEMORY_SCOPE_AGENT); }
DEV unsigned xb_add(unsigned* q, unsigned v) { return __hip_atomic_fetch_add(q, v, __ATOMIC_RELAXED, __HIP_MEMORY_SCOPE_AGENT); }
DEV unsigned xb_xcc_id() { return (unsigned)__builtin_amdgcn_s_getreg((3 << 11) | 20) & 0xFu; }
#define XB_SPIN(cond, bar) do { unsigned _sp = 0; while (cond) { __builtin_amdgcn_s_sleep(1); \
    if ((++_sp & 255u) == 0u) { if (xb_ld(&(bar)[XB_TMO])) break; if (_sp > XB_SPIN_CAP) { atomicAdd(&(bar)[XB_TMO], 1u); break; } } } } while (0)
struct XcdBarrier { unsigned* bar; unsigned x; unsigned nloc, nx; };
DEV XcdBarrier xcd_barrier_post(unsigned* bar) {
  XcdBarrier b; b.bar = bar; b.x = xb_xcc_id(); b.nloc = 0u; b.nx = 0u;
  if (threadIdx.x == 0) (void)xb_add(&bar[XB_XCNT(b.x)], 1u);
  return b;
}
DEV void xcd_barrier_complete(unsigned* bar, unsigned x, unsigned& nloc, unsigned& nx) {
  const unsigned G = gridDim.x * gridDim.y * gridDim.z;
  unsigned sum, cnt, mine, sp = 0u;
  for (;;) {
    sum = 0u; cnt = 0u; mine = 0u;
#pragma unroll
    for (unsigned j = 0; j < 16; ++j) { const unsigned c = xb_ld(&bar[XB_XCNT(j)]); sum += c; cnt += (c > 0u) ? 1u : 0u; mine = (j == x) ? c : mine; }
    if (sum == G) break;
    __builtin_amdgcn_s_sleep(1);
    if ((++sp & 255u) == 0u) { if (xb_ld(&bar[XB_TMO])) break; if (sp > XB_SPIN_CAP) { atomicAdd(&bar[XB_TMO], 1u); break; } }
  }
  nloc = mine > 0u ? mine : 1u; nx = cnt > 0u ? cnt : 1u;
}
DEV void xcd_barrier(XcdBarrier& b) {
  asm volatile("s_waitcnt vmcnt(0)" ::: "memory");
  __syncthreads();
  if (threadIdx.x == 0) {
    unsigned* bar = b.bar;
    __builtin_amdgcn_s_waitcnt(0);
    if (b.nloc == 0u) xcd_barrier_complete(bar, b.x, b.nloc, b.nx);
    const unsigned nloc = b.nloc, nx = b.nx;
    const unsigned old = xb_add(&bar[XB_XSUB(b.x)], 1u);
    const unsigned gen = old / nloc;
    if (old + 1u == (gen + 1u) * nloc) {
      __builtin_amdgcn_fence(__ATOMIC_RELEASE, "agent");
      asm volatile("s_waitcnt vmcnt(0)" ::: "memory");
      const unsigned og = xb_add(&bar[XB_TOP], 1u);
      const unsigned tg = og / nx;
      if (og + 1u == (tg + 1u) * nx) xb_add(&bar[XB_TOPGEN], 1u);
      else XB_SPIN(xb_ld(&bar[XB_TOPGEN]) == tg, bar);
      __builtin_amdgcn_fence(__ATOMIC_ACQUIRE, "agent");
      xb_add(&bar[XB_XGEN(b.x)], 1u);
      asm volatile("s_waitcnt vmcnt(0)" ::: "memory");
    } else {
      XB_SPIN(xb_ld(&bar[XB_XGEN(b.x)]) == gen, bar);
      __builtin_amdgcn_fence(__ATOMIC_ACQUIRE, "agent");
      asm volatile("s_waitcnt vmcnt(0)" ::: "memory");
    }
  }
  __syncthreads();
}

DEV void tr_tile(const float* __restrict__ src, u16* __restrict__ dst, int K, int N, int kt, int nt, bool il, float* lds) {
  const int tid = tid_l();
  const int k0 = kt * 64, n0 = nt * 64;
  {
    const int c = tid & 63, r0 = tid >> 6;
#pragma unroll
    for (int i = 0; i < 16; ++i) {
      int r = r0 + i * 4;
      lds[r * 65 + c] = src[(size_t)(k0 + r) * N + n0 + c];
    }
  }
  __syncthreads();
  {
    const int ch = tid & 7, nn0 = tid >> 3;
#pragma unroll
    for (int i = 0; i < 2; ++i) {
      const int n = nn0 + i * 32;
      const int gn = n0 + n;
      int np = gn;
      if (il) {
        int j = gn < DFF ? gn : gn - DFF;
        np = (j >> 4) * 32 + (j & 15) + (gn < DFF ? 0 : 16);
      }
      const float* sp = lds + (ch * 8) * 65 + n;
      uint4 o;
      o.x = pk2(sp[0 * 65], sp[1 * 65]);
      o.y = pk2(sp[2 * 65], sp[3 * 65]);
      o.z = pk2(sp[4 * 65], sp[5 * 65]);
      o.w = pk2(sp[6 * 65], sp[7 * 65]);
      *(uint4*)(dst + (size_t)np * K + k0 + ch * 8) = o;
    }
  }
  __syncthreads();
}

DEV void phase0(const P& p, char* smem) {
  float* lds = (float*)smem;
  const int tid = tid_l();
  constexpr int C0 = 2560, C1 = C0 + 1024, C2 = C1 + 5632, C3 = C2 + 2816, C4 = C3 + 48, C5 = C4 + 48, C6 = C5 + 48,
                C7 = C6 + 64, C8 = C7 + 384, C9 = C8 + 1;
  for (int it = bid_l(); it < C9; it += gridDim.x) {
    if (it < C6) {
      const float* src; u16* dst; int K, N, kt, nt; bool il = false;
      if (it < C0) {
        int l = it / 640, r = it % 640;
        src = p.w_in + (size_t)l * 1024 * 2560; dst = p.wIn + (size_t)l * 2560 * 1024; K = 1024; N = 2560; kt = r / 40; nt = r % 40;
      } else if (it < C1) {
        int i2 = it - C0, l = i2 / 256, r = i2 % 256;
        src = p.w_out + (size_t)l * 1024 * 1024; dst = p.wOut + (size_t)l * 1024 * 1024; K = 1024; N = 1024; kt = r / 16; nt = r % 16;
      } else if (it < C2) {
        int i2 = it - C1, l = i2 / 1408, r = i2 % 1408;
        src = p.w1 + (size_t)l * 1024 * 5632; dst = p.w1t + (size_t)l * 5632 * 1024; K = 1024; N = 5632; kt = r / 88; nt = r % 88; il = true;
      } else if (it < C3) {
        int i2 = it - C2, l = i2 / 704, r = i2 % 704;
        src = p.w2 + (size_t)l * 2816 * 1024; dst = p.w2t + (size_t)l * 1024 * 2816; K = 2816; N = 1024; kt = r / 16; nt = r % 16;
      } else if (it < C4) {
        int i2 = it - C3, bb = i2 / 6;
        src = p.w_up + (size_t)bb * 64 * 384; dst = p.wUpT + (size_t)bb * 384 * 64; K = 64; N = 384; kt = 0; nt = i2 % 6;
      } else if (it < C5) {
        int i2 = it - C4, bb = i2 / 6;
        src = p.a_up + (size_t)bb * 64 * 384; dst = p.aUpT + (size_t)bb * 384 * 64; K = 64; N = 384; kt = 0; nt = i2 % 6;
      } else {
        int i2 = it - C5, l = i2 / 12, r = i2 % 12;
        src = p.g_up + (size_t)l * 128 * 384; dst = p.gUpT + (size_t)l * 384 * 128; K = 128; N = 384; kt = r / 6; nt = r % 6;
      }
      tr_tile(src, dst, K, N, kt, nt, il, lds);
    } else if (it < C7) {
      int i2 = it - C6;
      for (int i = 0; i < 16; ++i) {
        int e = i2 * 4096 + i * 256 + tid;
        p.sgW[e] = f2bf(p.sg_w[e]);
      }
    } else if (it < C8) {
      int i2 = it - C7, l = i2 / 96, cb = i2 % 96;
      for (int e = tid; e < 9 * 1024; e += 256) {
        int s = e >> 10, k = e & 1023;
        float v = s < 8 ? p.c[s * 1024 + k] : p.c_ctx[k];
        lds[e] = siluf_(v);
      }
      __syncthreads();
      const int col = tid & 63, kq = tid >> 6;
      const int n = cb * 64 + col;
      float acc[9];
#pragma unroll
      for (int s = 0; s < 9; ++s) acc[s] = 0.f;
      const float* wp = p.ada_w + (size_t)l * 1024 * 6144 + n;
#pragma unroll 4
      for (int k = kq * 256; k < kq * 256 + 256; ++k) {
        float w = wp[(size_t)k * 6144];
#pragma unroll
        for (int s = 0; s < 9; ++s) acc[s] += lds[s * 1024 + k] * w;
      }
      __syncthreads();
      float* red = lds + 9216;
#pragma unroll
      for (int s = 0; s < 9; ++s) red[(kq * 9 + s) * 64 + col] = acc[s];
      __syncthreads();
      for (int e = tid; e < 9 * 64; e += 256) {
        int s = e >> 6, cc = e & 63;
        float v = red[(0 * 9 + s) * 64 + cc] + red[(1 * 9 + s) * 64 + cc] + red[(2 * 9 + s) * 64 + cc] + red[(3 * 9 + s) * 64 + cc];
        int nn = cb * 64 + cc;
        p.mods[((size_t)l * 9 + s) * 6144 + nn] = v + p.ada_b[l * 6144 + nn];
      }
      __syncthreads();
    } else {
      for (int e = tid; e < 1024; e += 256) {
        int pos = e >> 4, i = e & 15;
        float inv = powf(10000.f, -(float)i / 16.f);
        float ang = (float)pos * inv;
        p.rope[e * 2] = cosf(ang);
        p.rope[e * 2 + 1] = sinf(ang);
      }
      if (tid < 64) p.cnt[tid] = 0;
    }
  }
}

DEV void norm_phase(const P& p, int l, const float* __restrict__ g, int shoff, int scoff, int row_lo, bool from_input) {
  const int tid = tid_l();
  const int lane = tid & 63;
  const int gw = bid_l() * 4 + (tid >> 6), nw = gridDim.x * 4;
  const float* lat = from_input ? p.x : p.out;
  const float* cx = from_input ? p.ctx : p.xc;
  for (int r0 = row_lo + gw; r0 < MT; r0 += 4 * nw) {
    float4 v[4][4];
#pragma unroll
    for (int u = 0; u < 4; ++u) {
      const int r = r0 + u * nw;
      if (r < MT) {
        const float* src = r < MC ? cx + (size_t)r * DM : lat + (size_t)(r - MC) * DM;
#pragma unroll
        for (int i = 0; i < 4; ++i) v[u][i] = *(const float4*)(src + i * 256 + lane * 4);
      }
    }
#pragma unroll
    for (int u = 0; u < 4; ++u) {
      const int r = r0 + u * nw;
      if (r < MT) {
        const int s = r < MC ? 8 : (r - MC) >> 12;
        const float* md = p.mods + ((size_t)l * 9 + s) * 6144;
        float ss = 0.f;
#pragma unroll
        for (int i = 0; i < 4; ++i) ss += v[u][i].x * v[u][i].x + v[u][i].y * v[u][i].y + v[u][i].z * v[u][i].z + v[u][i].w * v[u][i].w;
        ss = wave_sum(ss);
        const float rstd = rsqrtf(ss * (1.f / DM) + 1e-6f);
#pragma unroll
        for (int i = 0; i < 4; ++i) {
          const int c = i * 256 + lane * 4;
          float4 gg = *(const float4*)(g + c);
          float4 sh = *(const float4*)(md + shoff + c);
          float4 sc = *(const float4*)(md + scoff + c);
          float o0 = v[u][i].x * rstd * gg.x * (1.f + sc.x) + sh.x;
          float o1 = v[u][i].y * rstd * gg.y * (1.f + sc.y) + sh.y;
          float o2 = v[u][i].z * rstd * gg.z * (1.f + sc.z) + sh.z;
          float o3 = v[u][i].w * rstd * gg.w * (1.f + sc.w) + sh.w;
          uint2 o;
          o.x = pk2(o0, o1);
          o.y = pk2(o2, o3);
          *(uint2*)(p.act + (size_t)r * DM + c) = o;
        }
      }
    }
  }
}

DEV void final_norm(const P& p) {
  const int tid = tid_l();
  const int lane = tid & 63;
  const int gw = bid_l() * 4 + (tid >> 6), nw = gridDim.x * 4;
  for (int r0 = gw; r0 < ML; r0 += 4 * nw) {
    float4 v[4][4];
#pragma unroll
    for (int u = 0; u < 4; ++u) {
      const int r = r0 + u * nw;
      if (r < ML) {
#pragma unroll
        for (int i = 0; i < 4; ++i) v[u][i] = *(const float4*)(p.out + (size_t)r * DM + i * 256 + lane * 4);
      }
    }
#pragma unroll
    for (int u = 0; u < 4; ++u) {
      const int r = r0 + u * nw;
      if (r < ML) {
        const float rstd = rsqrtf(p.rss1[MC + r] * (1.f / DM) + 1e-6f);
#pragma unroll
        for (int i = 0; i < 4; ++i) {
          const int c = i * 256 + lane * 4;
          float4 gg = *(const float4*)(p.fng + c);
          float4 o;
          o.x = v[u][i].x * rstd * gg.x;
          o.y = v[u][i].y * rstd * gg.y;
          o.z = v[u][i].z * rstd * gg.z;
          o.w = v[u][i].w * rstd * gg.w;
          *(float4*)(p.out + (size_t)r * DM + c) = o;
        }
      }
    }
  }
}

DEV void phase0b(const P& p, char* smem) {
  float* lds = (float*)smem;
  const int tid = tid_l(), lane = tid & 63;
  for (int it = bid_l(); it < 512; it += gridDim.x) {
    const bool isz = it < 160;
    const int i2 = isz ? it : it - 160;
    const int l = isz ? i2 / 40 : i2 / 88, cb = isz ? i2 % 40 : i2 % 88;
    const int N = isz ? 2560 : 5632;
    const float* W = isz ? p.w_in + (size_t)l * 1024 * 2560 : p.w1 + (size_t)l * 1024 * 5632;
    for (int e = tid; e < 9 * 1024; e += 256) {
      const int s9 = e >> 10, k = e & 1023;
      lds[e] = p.mods[((size_t)l * 9 + s9) * 6144 + (isz ? 0 : 3072) + k];
    }
    __syncthreads();
    const int col = tid & 63, kq = tid >> 6;
    const int n = cb * 64 + col;
    float acc[9];
#pragma unroll
    for (int s9 = 0; s9 < 9; ++s9) acc[s9] = 0.f;
    const float* wp = W + n;
#pragma unroll 4
    for (int k = kq * 256; k < kq * 256 + 256; ++k) {
      const float w = wp[(size_t)k * N];
#pragma unroll
      for (int s9 = 0; s9 < 9; ++s9) acc[s9] += lds[s9 * 1024 + k] * w;
    }
    __syncthreads();
    float* red = lds + 9216;
#pragma unroll
    for (int s9 = 0; s9 < 9; ++s9) red[(kq * 9 + s9) * 64 + col] = acc[s9];
    __syncthreads();
    for (int e = tid; e < 9 * 64; e += 256) {
      const int s9 = e >> 6, cc = e & 63;
      const float v = red[(0 * 9 + s9) * 64 + cc] + red[(1 * 9 + s9) * 64 + cc] + red[(2 * 9 + s9) * 64 + cc] + red[(3 * 9 + s9) * 64 + cc];
      const int gn = cb * 64 + cc;
      if (isz) p.bz[((size_t)l * 9 + s9) * 2560 + gn] = v;
      else {
        const int j = gn < DFF ? gn : gn - DFF;
        const int np = (j >> 4) * 32 + (j & 15) + (gn < DFF ? 0 : 16);
        p.bh[((size_t)l * 9 + s9) * 5632 + np] = v;
      }
    }
    __syncthreads();
  }
  const int gw = bid_l() * 4 + (tid >> 6), nw = gridDim.x * 4;
  for (int r0 = gw; r0 < MT; r0 += 4 * nw) {
    float4 v[4][4];
#pragma unroll
    for (int u = 0; u < 4; ++u) {
      const int r = r0 + u * nw;
      if (r < MT) {
        const float* src = r < MC ? p.ctx + (size_t)r * DM : p.x + (size_t)(r - MC) * DM;
#pragma unroll
        for (int i = 0; i < 4; ++i) v[u][i] = *(const float4*)(src + i * 256 + lane * 4);
      }
    }
#pragma unroll
    for (int u = 0; u < 4; ++u) {
      const int r = r0 + u * nw;
      if (r < MT) {
        const int s9 = r < MC ? 8 : (r - MC) >> 12;
        const float* md = p.mods + (size_t)s9 * 6144 + 1024;
        float ss = 0.f;
#pragma unroll
        for (int i = 0; i < 4; ++i) ss += v[u][i].x * v[u][i].x + v[u][i].y * v[u][i].y + v[u][i].z * v[u][i].z + v[u][i].w * v[u][i].w;
        ss = wave_sum(ss);
        if (lane == 0) p.rss1[r] = ss;
#pragma unroll
        for (int i = 0; i < 4; ++i) {
          const int c = i * 256 + lane * 4;
          const float4 gg = *(const float4*)(p.n1g + c);
          const float4 sc = *(const float4*)(md + c);
          *(uint2*)(p.act + (size_t)r * DM + c) =
              make_uint2(pk2(v[u][i].x * gg.x * (1.f + sc.x), v[u][i].y * gg.y * (1.f + sc.y)),
                         pk2(v[u][i].z * gg.z * (1.f + sc.z), v[u][i].w * gg.w * (1.f + sc.w)));
        }
      }
    }
  }
}

enum { EPI_Z = 0, EPI_RES = 1, EPI_SWIGLU = 2 };
struct GX { float* rss_acc; u16* aout; const float* gnext; int lmod; int scoff; };

template <int EPI>
DEV void gemm_phase(const P& p, int l, const u16* __restrict__ A, int lda, const u16* __restrict__ Bt, int K, int NT,
                           int mt_lo, int goff, char* smem, GX gx, int dry = 0) {
  const int tid = tid_l(), lane = tid & 63, wid = tid >> 6, wr = wid >> 1, wc = wid & 1, l15 = lane & 15, quad = lane >> 4;
  const int nmt = NMT - mt_lo;
  const int nk = K / 64;
  const int npn = NT >> 2;
  const int npatch = (nmt >> 4) * npn;
  const int tmax = ((npatch + 7) >> 3) * 512;
#define G_MAP(T, OK, M0, N0)                                                                        \
  {                                                                                                 \
    const int xcd_ = (T)&7, sidx_ = (T) >> 3;                                                       \
    const int gp_ = (sidx_ >> 6) * 8 + xcd_;                                                        \
    OK = (T) < tmax && gp_ < npatch;                                                                \
    const int within_ = sidx_ & 63;                                                                 \
    M0 = (mt_lo + (gp_ / npn) * 16 + (within_ & 15)) * 128;                                         \
    N0 = ((gp_ % npn) * 4 + (within_ >> 4)) * 128;                                                  \
  }
  uint4 xa0, xa1, xa2, xa3, xb0, xb1, xb2, xb3, ya0, ya1, ya2, ya3, yb0, yb1, yb2, yb3;
  int t = bid_l();
  bool have;
  int m0, n0;
  G_MAP(t, have, m0, n0);
  const u16* Ag = A + (size_t)(m0 + (tid >> 3)) * lda + (tid & 7) * 8;
  const u16* Bg = Bt + (size_t)(n0 + (tid >> 3)) * K + (tid & 7) * 8;
  bool primed = false;
  while (have) {
    f32x4 acc[4][4];
#pragma unroll
    for (int i = 0; i < 4; ++i)
#pragma unroll
      for (int j = 0; j < 4; ++j) acc[i][j] = f32x4{0.f, 0.f, 0.f, 0.f};
#define G_GL(P, KT)                                                          \
    {                                                                        \
      const int k0_ = (KT)*64;                                               \
      P##a0 = *(const uint4*)(Ag + k0_);                                     \
      P##b0 = *(const uint4*)(Bg + k0_);                                     \
      P##a1 = *(const uint4*)(Ag + (size_t)32 * lda + k0_);                  \
      P##b1 = *(const uint4*)(Bg + (size_t)32 * K + k0_);                    \
      P##a2 = *(const uint4*)(Ag + (size_t)64 * lda + k0_);                  \
      P##b2 = *(const uint4*)(Bg + (size_t)64 * K + k0_);                    \
      P##a3 = *(const uint4*)(Ag + (size_t)96 * lda + k0_);                  \
      P##b3 = *(const uint4*)(Bg + (size_t)96 * K + k0_);                    \
    }
#define G_LS(P, BUF)                                                         \
    {                                                                        \
      char* Aw_ = smem + (BUF)*32768;                                        \
      *(uint4*)(Aw_ + swz((tid >> 3), tid & 7)) = P##a0;                     \
      *(uint4*)(Aw_ + 16384 + swz((tid >> 3), tid & 7)) = P##b0;             \
      *(uint4*)(Aw_ + swz((tid >> 3) + 32, tid & 7)) = P##a1;                \
      *(uint4*)(Aw_ + 16384 + swz((tid >> 3) + 32, tid & 7)) = P##b1;        \
      *(uint4*)(Aw_ + swz((tid >> 3) + 64, tid & 7)) = P##a2;                \
      *(uint4*)(Aw_ + 16384 + swz((tid >> 3) + 64, tid & 7)) = P##b2;        \
      *(uint4*)(Aw_ + swz((tid >> 3) + 96, tid & 7)) = P##a3;                \
      *(uint4*)(Aw_ + 16384 + swz((tid >> 3) + 96, tid & 7)) = P##b3;        \
    }
#define G_COMPUTE(BUF)                                                                                             \
    {                                                                                                              \
      const char* As = smem + (BUF)*32768;                                                                         \
      const char* Bs = As + 16384;                                                                                 \
      _Pragma("unroll") for (int kh = 0; kh < 2; ++kh) {                                                           \
        bf16x8 a[4], b[4];                                                                                         \
        _Pragma("unroll") for (int mi = 0; mi < 4; ++mi)                                                           \
            a[mi] = *(const bf16x8*)(As + swz(wr * 64 + mi * 16 + l15, kh * 4 + quad));                            \
        _Pragma("unroll") for (int ni = 0; ni < 4; ++ni)                                                           \
            b[ni] = *(const bf16x8*)(Bs + swz(wc * 64 + ni * 16 + l15, kh * 4 + quad));                            \
        _Pragma("unroll") for (int mi = 0; mi < 4; ++mi)                                                           \
            _Pragma("unroll") for (int ni = 0; ni < 4; ++ni) acc[mi][ni] = mfma16(b[ni], a[mi], acc[mi][ni]);      \
      }                                                                                                            \
    }
    if (!primed) {
      G_GL(x, 0);
      G_GL(y, 1);
    }
    G_LS(x, 0);
    if (2 < nk) G_GL(x, 2);
    __syncthreads();
    for (int kt = 0; kt < nk; kt += 2) {
      G_COMPUTE(0);
      G_LS(y, 1);
      if (kt + 3 < nk) G_GL(y, kt + 3);
      __syncthreads();
      G_COMPUTE(1);
      if (kt + 2 < nk) G_LS(x, 0);
      if (kt + 4 < nk) G_GL(x, kt + 4);
      __syncthreads();
    }
    const int em0 = m0, en0 = n0;
    t += gridDim.x;
    G_MAP(t, have, m0, n0);
    if (have) {
      Ag = A + (size_t)(m0 + (tid >> 3)) * lda + (tid & 7) * 8;
      Bg = Bt + (size_t)(n0 + (tid >> 3)) * K + (tid & 7) * 8;
      G_GL(x, 0);
      G_GL(y, 1);
      primed = true;
    }
    if (dry) {
      if (acc[0][0][0] == 1.2345e33f) p.bonus[0] = acc[1][1][1] + acc[2][2][2] + acc[3][3][3];
      continue;
    }
    const int cw0 = en0 + wc * 64;
    if constexpr (EPI == EPI_Z || EPI == EPI_SWIGLU) {
      const int sb_ = em0 < MC ? 8 : (em0 - MC) >> 12;
      const float* rssp = EPI == EPI_Z ? p.rss1 : p.rss2;
      const float* bias = EPI == EPI_Z ? p.bz + ((size_t)l * 9 + sb_) * 2560 + cw0 : p.bh + ((size_t)l * 9 + sb_) * 5632 + cw0;
      float rsv[4];
#pragma unroll
      for (int mi = 0; mi < 4; ++mi) rsv[mi] = rsqrtf(rssp[em0 + wr * 64 + mi * 16 + l15] * (1.f / DM) + 1e-6f);
#pragma unroll
      for (int ni = 0; ni < 4; ++ni) {
        const float4 bb = *(const float4*)(bias + ni * 16 + quad * 4);
#pragma unroll
        for (int mi = 0; mi < 4; ++mi) {
          acc[mi][ni][0] = acc[mi][ni][0] * rsv[mi] + bb.x;
          acc[mi][ni][1] = acc[mi][ni][1] * rsv[mi] + bb.y;
          acc[mi][ni][2] = acc[mi][ni][2] * rsv[mi] + bb.z;
          acc[mi][ni][3] = acc[mi][ni][3] * rsv[mi] + bb.w;
        }
      }
    }
    if constexpr (EPI == EPI_Z) {
      if (cw0 < 1920) {
#pragma unroll
        for (int mi = 0; mi < 4; ++mi) {
          const int r = em0 + wr * 64 + mi * 16 + l15;
#pragma unroll
          for (int ni = 0; ni < 4; ++ni)
            *(uint2*)(p.z + (size_t)r * INC + cw0 + ni * 16 + quad * 4) =
                make_uint2(pk2(acc[mi][ni][0], acc[mi][ni][1]), pk2(acc[mi][ni][2], acc[mi][ni][3]));
          __builtin_amdgcn_sched_barrier(0);
        }
      } else {
        const int hh = (cw0 - 1920) >> 6;
        if (hh < 8) {
          const float* gp = (hh < 6 ? p.q_g : p.k_g) + l * 64;
          float4 gv[4];
#pragma unroll
          for (int ni = 0; ni < 4; ++ni) gv[ni] = *(const float4*)(gp + ni * 16 + quad * 4);
          const float qs = hh < 6 ? 0.125f : 1.f;
#pragma unroll
          for (int mi = 0; mi < 4; ++mi) {
            const int r = em0 + wr * 64 + mi * 16 + l15;
            float ss = 0.f;
#pragma unroll
            for (int ni = 0; ni < 4; ++ni)
#pragma unroll
              for (int j = 0; j < 4; ++j) ss += acc[mi][ni][j] * acc[mi][ni][j];
            ss += __shfl_xor(ss, 16);
            ss += __shfl_xor(ss, 32);
            const float rstd = rsqrtf(ss * (1.f / 64.f) + 1e-6f) ;
            float yv[4][4];
#pragma unroll
            for (int ni = 0; ni < 4; ++ni) {
              yv[ni][0] = acc[mi][ni][0] * rstd * gv[ni].x;
              yv[ni][1] = acc[mi][ni][1] * rstd * gv[ni].y;
              yv[ni][2] = acc[mi][ni][2] * rstd * gv[ni].z;
              yv[ni][3] = acc[mi][ni][3] * rstd * gv[ni].w;
            }
            if (r >= MC) {
              const int tt = (r - MC) & 4095;
              const int prow = tt >> 6, pcol = tt & 63;
              const float* rr_ = p.rope + (prow * 16 + quad * 4) * 2;
              const float* rc_ = p.rope + (pcol * 16 + quad * 4) * 2;
              const float4 ra = *(const float4*)rr_, rb = *(const float4*)(rr_ + 4);
              const float4 ca = *(const float4*)rc_, cb = *(const float4*)(rc_ + 4);
              const float cr[4] = {ra.x, ra.z, rb.x, rb.z}, sr[4] = {ra.y, ra.w, rb.y, rb.w};
              const float cc[4] = {ca.x, ca.z, cb.x, cb.z}, sc[4] = {ca.y, ca.w, cb.y, cb.w};
#pragma unroll
              for (int j = 0; j < 4; ++j) {
                const float a0 = yv[0][j] * cr[j] - yv[1][j] * sr[j], a1 = yv[1][j] * cr[j] + yv[0][j] * sr[j];
                const float a2 = yv[2][j] * cc[j] - yv[3][j] * sc[j], a3 = yv[3][j] * cc[j] + yv[2][j] * sc[j];
                yv[0][j] = a0; yv[1][j] = a1; yv[2][j] = a2; yv[3][j] = a3;
              }
            }
#pragma unroll
            for (int ni = 0; ni < 4; ++ni)
              *(uint2*)(p.z + (size_t)r * INC + cw0 + ni * 16 + quad * 4) =
                  make_uint2(pk2(yv[ni][0] * qs, yv[ni][1] * qs), pk2(yv[ni][2] * qs, yv[ni][3] * qs));
            __builtin_amdgcn_sched_barrier(0);
          }
        } else {
          const int kvh = hh - 8;
#pragma unroll
          for (int mi = 0; mi < 4; ++mi) {
            const int r = em0 + wr * 64 + mi * 16 + l15;
            u16* vb;
            int vstride;
            if (r < MC) { vb = p.vTc + ((size_t)(((r >> 8) * 2 + kvh) * 64)) * CTXL + (r & 255); vstride = CTXL; }
            else { const int rr = r - MC; vb = p.vTl + ((size_t)(((rr >> 12) * 2 + kvh) * 64)) * SEQ + (rr & 4095); vstride = SEQ; }
#pragma unroll
            for (int ni = 0; ni < 4; ++ni)
#pragma unroll
              for (int j = 0; j < 4; ++j) vb[(size_t)(ni * 16 + quad * 4 + j) * vstride] = f2bf(acc[mi][ni][j]);
            __builtin_amdgcn_sched_barrier(0);
          }
        }
      }
    } else if constexpr (EPI == EPI_RES) {
      const int s = em0 < MC ? 8 : (em0 - MC) >> 12;
      const float* gate = p.mods + ((size_t)l * 9 + s) * 6144 + goff;
      float4 gv[4], gm[4];
#pragma unroll
      for (int ni = 0; ni < 4; ++ni) {
        gv[ni] = *(const float4*)(gate + cw0 + ni * 16 + quad * 4);
        gm[ni] = make_float4(0.f, 0.f, 0.f, 0.f);
        if (gx.aout) {
          const float4 g4 = *(const float4*)(gx.gnext + cw0 + ni * 16 + quad * 4);
          const float4 s4 = *(const float4*)(p.mods + ((size_t)gx.lmod * 9 + s) * 6144 + gx.scoff + cw0 + ni * 16 + quad * 4);
          gm[ni] = make_float4(g4.x * (1.f + s4.x), g4.y * (1.f + s4.y), g4.z * (1.f + s4.z), g4.w * (1.f + s4.w));
        }
      }
#pragma unroll
      for (int mi = 0; mi < 4; ++mi) {
        const int r = em0 + wr * 64 + mi * 16 + l15;
        const float* src;
        if (l == 0 && goff == 2048) src = r < MC ? p.ctx + (size_t)r * DM : p.x + (size_t)(r - MC) * DM;
        else src = r < MC ? p.xc + (size_t)r * DM : p.out + (size_t)(r - MC) * DM;
        float* dst = r < MC ? p.xc + (size_t)r * DM : p.out + (size_t)(r - MC) * DM;
        float ssq = 0.f;
#pragma unroll
        for (int ni = 0; ni < 4; ++ni) {
          const int c = cw0 + ni * 16 + quad * 4;
          const float4 xv = *(const float4*)(src + c);
          float4 o;
          o.x = xv.x + gv[ni].x * acc[mi][ni][0];
          o.y = xv.y + gv[ni].y * acc[mi][ni][1];
          o.z = xv.z + gv[ni].z * acc[mi][ni][2];
          o.w = xv.w + gv[ni].w * acc[mi][ni][3];
          *(float4*)(dst + c) = o;
          ssq += o.x * o.x + o.y * o.y + o.z * o.z + o.w * o.w;
          if (gx.aout) {
            *(uint2*)(gx.aout + (size_t)r * DM + c) =
                make_uint2(pk2(o.x * gm[ni].x, o.y * gm[ni].y), pk2(o.z * gm[ni].z, o.w * gm[ni].w));
          }
        }
        ssq += __shfl_xor(ssq, 16);
        ssq += __shfl_xor(ssq, 32);
        if (quad == 0) {
          const float old_ = unsafeAtomicAdd(gx.rss_acc + r, ssq);
          asm volatile("" ::"v"(old_));
        }
        __builtin_amdgcn_sched_barrier(0);
      }
    } else {
      const int hc0 = (en0 >> 1) + wc * 32;
#pragma unroll
      for (int mi = 0; mi < 4; ++mi) {
        const int r = em0 + wr * 64 + mi * 16 + l15;
#pragma unroll
        for (int pp = 0; pp < 2; ++pp) {
          float hv[4];
#pragma unroll
          for (int j = 0; j < 4; ++j) hv[j] = siluf_(acc[mi][2 * pp][j]) * acc[mi][2 * pp + 1][j];
          *(uint2*)(p.h + (size_t)r * DFF + hc0 + pp * 16 + quad * 4) = make_uint2(pk2(hv[0], hv[1]), pk2(hv[2], hv[3]));
        }
        __builtin_amdgcn_sched_barrier(0);
      }
    }
  }
}
#undef G_GL
#undef G_LS
#undef G_COMPUTE
#undef G_MAP

template <int LPR>
DEV float red_lpr(float v) {
  v += dppf<0xB1>(v);
  v += dppf<0x4E>(v);
  if (LPR >= 8) v += dppf<0x141>(v);
  if (LPR >= 16) v += dppf<0x140>(v);
  return v;
}

constexpr int SCAN_LPR = 8;
constexpr int SCAN_RPB = 256 / SCAN_LPR;
constexpr int SCAN_NPART = 64 / SCAN_RPB;
constexpr int SCAN_JL = 64 / SCAN_LPR;
constexpr int SCAN_ITEMS = 96 * SCAN_NPART;

DEV float red8_sum(float v) {
  v += dppf<0xB1>(v);
  v += dppf<0x4E>(v);
  v += dppf<0x141>(v);
  return v;
}
DEV float tanh_fast(float x) {
  float e = __expf(2.f * x);
  return 1.f - 2.f * __builtin_amdgcn_rcpf(1.f + e);
}

struct ChunkPos { int len, rowbase, tlo; };
DEV ChunkPos chunk_pos(int c, int d, int b) {
  ChunkPos cp;
  const int s0 = c * 16;
  int pos0;
  if (s0 < 256) { cp.len = 256; pos0 = s0; cp.rowbase = b * 256; }
  else { cp.len = 4096; pos0 = s0 - 256; cp.rowbase = MC + b * 4096; }
  cp.tlo = d ? (cp.len - 16 - pos0) : pos0;
  return cp;
}

constexpr int SC_R = 0, SC_KD = 12288, SC_V = 24576, SC_W = 30720, SC_KA = 38912, SC_NKK = 47104;

DEV void cvt8(const uint4 u, float4& lo, float4& hi) {
  lo.x = __uint_as_float(u.x << 16); lo.y = __uint_as_float(u.x & 0xffff0000u);
  lo.z = __uint_as_float(u.y << 16); lo.w = __uint_as_float(u.y & 0xffff0000u);
  hi.x = __uint_as_float(u.z << 16); hi.y = __uint_as_float(u.z & 0xffff0000u);
  hi.z = __uint_as_float(u.w << 16); hi.w = __uint_as_float(u.w & 0xffff0000u);
}

DEV void scan_item(const P& p, int l, int item, char* smem) {
  const int tid = tid_l(), lane = tid & 63, wid = tid >> 6, l15 = lane & 15, quad = lane >> 4;
  constexpr int LPR = SCAN_LPR, RPB = SCAN_RPB, JL = SCAN_JL, NV = RPB / 8;
  const int scan = item / SCAN_NPART, part = item % SCAN_NPART;
  const int d = scan / 48, b = (scan % 48) / 6, h = scan % 6;
  const int rloc = tid / LPR, jq = tid % LPR;
  const int irow = part * RPB + rloc;
  const int j0 = jq * JL;

  const int c_ts = (tid & 127) >> 3, c_ch = tid & 7;
  const int c_col = (tid < 128 ? 0 : 384) + h * 64 + c_ch * 8;
  const int v_ts = tid / NV, v_ch = tid % NV;
  const int v_col = 768 + h * 64 + part * RPB + v_ch * 8;

  const int n2 = wid * 16 + l15;
  bf16x8 bW[2], bA[2];
  {
    const u16* wb = p.wUpT + ((size_t)(l * 2 + d) * 384 + h * 64 + n2) * 64 + quad * 8;
    const u16* ab = p.aUpT + ((size_t)(l * 2 + d) * 384 + h * 64 + n2) * 64 + quad * 8;
    bW[0] = *(const bf16x8*)(wb);
    bW[1] = *(const bf16x8*)(wb + 32);
    bA[0] = *(const bf16x8*)(ab);
    bA[1] = *(const bf16x8*)(ab + 32);
  }
  const float w0v = p.w0[(size_t)(l * 2 + d) * 384 + h * 64 + n2];
  const float a0v = p.a0[(size_t)(l * 2 + d) * 384 + h * 64 + n2];
  const float kkc = p.k_k[l * 384 + h * 64 + n2], kac = p.k_a[l * 384 + h * 64 + n2], rkc = p.r_k[l * 384 + h * 64 + n2];

  float2v S2[JL / 2];
#pragma unroll
  for (int j = 0; j < JL / 2; ++j) S2[j] = float2v{0.f, 0.f};
  uint4 g_rk, g_v;
  bf16x8 g_wd0, g_wd1, g_ad0, g_ad1;
  float g_inv[4];

#define SC_GLOAD1(CC)                                                                                  \
  {                                                                                                    \
    const ChunkPos cp_ = chunk_pos((CC), d, b);                                                        \
    g_rk = *(const uint4*)(p.z + (size_t)(cp_.rowbase + cp_.tlo + c_ts) * INC + c_col);                \
    if (tid < 16 * NV) g_v = *(const uint4*)(p.z + (size_t)(cp_.rowbase + cp_.tlo + v_ts) * INC + v_col);  \
  }
#define SC_GLOAD2(CC)                                                                                  \
  {                                                                                                    \
    const ChunkPos cp_ = chunk_pos((CC), d, b);                                                        \
    const u16* rp_ = p.z + (size_t)(cp_.rowbase + cp_.tlo + l15) * INC + 1152 + quad * 8;              \
    g_wd0 = *(const bf16x8*)(rp_);                                                                     \
    g_wd1 = *(const bf16x8*)(rp_ + 32);                                                                \
    g_ad0 = *(const bf16x8*)(rp_ + 64);                                                                \
    g_ad1 = *(const bf16x8*)(rp_ + 96);                                                                \
    _Pragma("unroll") for (int j = 0; j < 4; ++j)                                                      \
      g_inv[j] = p.invn[(size_t)(cp_.rowbase + cp_.tlo + quad * 4 + j) * 8 + h];                       \
  }
#define SC_STAGE1(CC)                                                                                  \
  {                                                                                                    \
    const int i3_ = (CC) % 3;                                                                          \
    float4 lo_, hi_;                                                                                   \
    cvt8(g_rk, lo_, hi_);                                                                              \
    float* dst_ = (float*)(smem + (tid < 128 ? SC_R : SC_KD) + i3_ * 4096) + c_ts * 64 + c_ch * 8;     \
    *(float4*)dst_ = lo_;                                                                              \
    *(float4*)(dst_ + 4) = hi_;                                                                        \
    if (tid < 16 * NV) {                                                                               \
      cvt8(g_v, lo_, hi_);                                                                             \
      float* dv_ = (float*)(smem + SC_V + i3_ * 2048) + v_ts * RPB + v_ch * 8;                         \
      *(float4*)dv_ = lo_;                                                                             \
      *(float4*)(dv_ + 4) = hi_;                                                                       \
    }                                                                                                  \
  }
#define SC_STAGE2(CC)                                                                                  \
  {                                                                                                    \
    const int i3_ = (CC) % 3, i2_ = (CC)&1;                                                            \
    const ChunkPos cp_ = chunk_pos((CC), d, b);                                                        \
    f32x4 accW = f32x4{0.f, 0.f, 0.f, 0.f}, accA = f32x4{0.f, 0.f, 0.f, 0.f};                          \
    accW = mfma16(g_wd0, bW[0], accW);                                                                 \
    accW = mfma16(g_wd1, bW[1], accW);                                                                 \
    accA = mfma16(g_ad0, bA[0], accA);                                                                 \
    accA = mfma16(g_ad1, bA[1], accA);                                                                 \
    float bon_[4];                                                                                     \
    _Pragma("unroll") for (int j = 0; j < 4; ++j) {                                                    \
      const int ts = quad * 4 + j;                                                                     \
      float* kdp = (float*)(smem + SC_KD + i3_ * 4096) + ts * 64 + n2;                                 \
      const float kv = *kdp;                                                                           \
      const float rv = *((const float*)(smem + SC_R + i3_ * 4096) + ts * 64 + n2);                     \
      const float sg = sigmoidf_(w0v + accW[j]);                                                       \
      const float wv = __expf(-0.6065306597126334f * sg);                                              \
      const float av = sigmoidf_(a0v + accA[j]);                                                       \
      const float kn = kv * kkc * g_inv[j];                                                            \
      const float kd = kv * (1.f + (av - 1.f) * kac);                                                  \
      *((float*)(smem + SC_W + i2_ * 4096) + ts * 64 + n2) = wv;                                       \
      *((float*)(smem + SC_NKK + i2_ * 4096) + ts * 64 + n2) = -kn;                                    \
      *((float*)(smem + SC_KA + i2_ * 4096) + ts * 64 + n2) = kn * av;                                 \
      *kdp = kd;                                                                                       \
      bon_[j] = rv * kd * rkc;                                                                         \
    }                                                                                                  \
    _Pragma("unroll") for (int j = 0; j < 4; ++j) bon_[j] = red16_sum(bon_[j]);                        \
    if (l15 == 0 && part == 0) {                                                                       \
      _Pragma("unroll") for (int j = 0; j < 4; ++j)                                                    \
        p.bonus[(size_t)(cp_.rowbase + cp_.tlo + quad * 4 + j) * 48 + (d * 6 + h) * 4 + wid] = bon_[j]; \
    }                                                                                                  \
  }

  __builtin_amdgcn_s_setprio(3);
  SC_GLOAD1(0);
  SC_GLOAD2(0);
  SC_STAGE1(0);
  SC_GLOAD1(1);
  __syncthreads();
  SC_STAGE2(0);
  SC_STAGE1(1);
  SC_GLOAD1(2);
  SC_GLOAD2(1);
  __syncthreads();

  for (int c = 0; c < 272; ++c) {
    {
      const int i3 = c % 3, i2 = c & 1;
      const ChunkPos cp = chunk_pos(c, d, b);
      const float* pW = (const float*)(smem + SC_W + i2 * 4096) + j0;
      const float* pN = (const float*)(smem + SC_NKK + i2 * 4096) + j0;
      const float* pA = (const float*)(smem + SC_KA + i2 * 4096) + j0;
      const float* pD = (const float*)(smem + SC_KD + i3 * 4096) + j0;
      const float* pR = (const float*)(smem + SC_R + i3 * 4096) + j0;
      const float* pV = (const float*)(smem + SC_V + i3 * 2048) + rloc;
      float* yp = p.y + ((size_t)d * MT + cp.rowbase + cp.tlo) * 384 + h * 64 + irow;
      float yk0 = 0.f, yk1 = 0.f;
      constexpr int NQ = JL / 4;
      float4 cw[NQ], cn[NQ], ca[NQ], cd[NQ], cr[NQ];
      float cvi;
#define SC_LD(TS, W, N, A, D, R, VI)                                                             \
      _Pragma("unroll") for (int q = 0; q < NQ; ++q) {                                           \
        W[q] = *(const float4*)(pW + (TS)*64 + q * 4); N[q] = *(const float4*)(pN + (TS)*64 + q * 4); \
        A[q] = *(const float4*)(pA + (TS)*64 + q * 4); D[q] = *(const float4*)(pD + (TS)*64 + q * 4); \
        R[q] = *(const float4*)(pR + (TS)*64 + q * 4);                                           \
      }                                                                                          \
      VI = pV[(TS)*RPB];
      {
        const int ts0 = d ? 15 : 0;
        SC_LD(ts0, cw, cn, ca, cd, cr, cvi)
      }
#pragma unroll
      for (int si = 0; si < 16; ++si) {
        float4 xw[NQ], xn[NQ], xa[NQ], xd[NQ], xr[NQ];
        float xvi = 0.f;
        if (si + 1 < 16) {
          const int tsn = d ? 14 - si : si + 1;
          SC_LD(tsn, xw, xn, xa, xd, xr, xvi)
        }
        float2v sa2 = S2[0] * float2v{cn[0].x, cn[0].y};
        sa2 = S2[1] * float2v{cn[0].z, cn[0].w} + sa2;
        if constexpr (NQ == 2) {
          float2v sb2 = S2[2] * float2v{cn[1].x, cn[1].y};
          sb2 = S2[3] * float2v{cn[1].z, cn[1].w} + sb2;
          sa2 = sa2 + sb2;
        }
        const float2v viv = float2v{cvi, cvi};
        float2v u2[JL / 2];
#pragma unroll
        for (int q = 0; q < NQ; ++q) {
          u2[2 * q] = S2[2 * q] * float2v{cw[q].x, cw[q].y} + viv * float2v{cd[q].x, cd[q].y};
          u2[2 * q + 1] = S2[2 * q + 1] * float2v{cw[q].z, cw[q].w} + viv * float2v{cd[q].z, cd[q].w};
        }
        const float sa = LPR == 16 ? red16_sum(sa2.x + sa2.y) : red8_sum(sa2.x + sa2.y);
        const float2v sav = float2v{sa, sa};
#pragma unroll
        for (int q = 0; q < NQ; ++q) {
          S2[2 * q] = sav * float2v{ca[q].x, ca[q].y} + u2[2 * q];
          S2[2 * q + 1] = sav * float2v{ca[q].z, ca[q].w} + u2[2 * q + 1];
        }
        float2v y2 = S2[0] * float2v{cr[0].x, cr[0].y};
        y2 = S2[1] * float2v{cr[0].z, cr[0].w} + y2;
        if constexpr (NQ == 2) {
          float2v yb2 = S2[2] * float2v{cr[1].x, cr[1].y};
          yb2 = S2[3] * float2v{cr[1].z, cr[1].w} + yb2;
          y2 = y2 + yb2;
        }
        const float yv = LPR == 16 ? red16_sum(y2.x + y2.y) : red8_sum(y2.x + y2.y);
        if (si < LPR) yk0 = (jq == si) ? yv : yk0;
        else yk1 = (jq == si - LPR) ? yv : yk1;
        if (si + 1 < 16) {
#pragma unroll
          for (int q = 0; q < NQ; ++q) { cw[q] = xw[q]; cn[q] = xn[q]; ca[q] = xa[q]; cd[q] = xd[q]; cr[q] = xr[q]; }
          cvi = xvi;
        }
      }
#undef SC_LD
      {
        const int tsa = d ? 15 - jq : jq;
        yp[(size_t)tsa * 384] = yk0;
        if constexpr (LPR == 8) {
          const int tsb = d ? 7 - jq : 8 + jq;
          yp[(size_t)tsb * 384] = yk1;
        }
      }
    }
    if (c + 1 < 272) SC_STAGE2(c + 1);
    if (c + 2 < 272) SC_STAGE1(c + 2);
    if (c + 3 < 272) SC_GLOAD1(c + 3);
    if (c + 2 < 272) SC_GLOAD2(c + 2);
    __syncthreads();
  }
  __builtin_amdgcn_s_setprio(0);
#undef SC_GLOAD1
#undef SC_GLOAD2
#undef SC_STAGE1
#undef SC_STAGE2
}

DEV void attn_item(const P& p, int item, char* smem) {
  const int tid = tid_l(), lane = tid & 63, wid = tid >> 6, l15 = lane & 15, quad = lane >> 4;
  bool lat = item < 1536;
  int b, hq, qb;
  if (lat) { b = item / 192; int rem = item % 192; hq = rem / 32; qb = rem % 32; }
  else { int i2 = item - 1536; b = i2 / 12; int rem = i2 % 12; hq = rem / 2; qb = rem % 2; }
  const int kvh = hq / 3;
  const int qrow0 = lat ? MC + b * 4096 + qb * 128 : b * 256 + qb * 128;
  const int nkt = lat ? 68 : 4;
  const float LOG2E = 1.4426950408889634f;

  bf16x8 qf[2][2];
#pragma unroll
  for (int mi = 0; mi < 2; ++mi)
#pragma unroll
    for (int ks = 0; ks < 2; ++ks)
      qf[mi][ks] = *(const bf16x8*)(p.z + (size_t)(qrow0 + wid * 32 + mi * 16 + l15) * INC + 1920 + hq * 64 + ks * 32 + quad * 8);

  f32x4 Ot[2][4];
  float mrow[2], lpart[2];
#pragma unroll
  for (int mi = 0; mi < 2; ++mi) {
#pragma unroll
    for (int nd = 0; nd < 4; ++nd) Ot[mi][nd] = f32x4{0.f, 0.f, 0.f, 0.f};
    mrow[mi] = -1e30f;
    lpart[mi] = 0.f;
  }
  const int lrow = tid >> 3, lch = tid & 7;
  uint4 rk0, rk1, rv0, rv1;
#define ATT_GLOAD(KT)                                                                         \
  {                                                                                           \
    const int kt_ = (KT);                                                                     \
    const u16* kp;                                                                            \
    const u16* vp;                                                                            \
    int vstride;                                                                              \
    if (lat && kt_ < 64) {                                                                    \
      kp = p.z + (size_t)(MC + b * 4096 + kt_ * 64) * INC + 2304 + kvh * 64;                  \
      vp = p.vTl + (size_t)((b * 2 + kvh) * 64) * SEQ + kt_ * 64;                             \
      vstride = SEQ;                                                                          \
    } else {                                                                                  \
      const int kc = lat ? kt_ - 64 : kt_;                                                    \
      kp = p.z + (size_t)(b * 256 + kc * 64) * INC + 2304 + kvh * 64;                         \
      vp = p.vTc + (size_t)((b * 2 + kvh) * 64) * CTXL + kc * 64;                             \
      vstride = CTXL;                                                                         \
    }                                                                                         \
    rk0 = *(const uint4*)(kp + (size_t)(lrow)*INC + lch * 8);                                 \
    rk1 = *(const uint4*)(kp + (size_t)(lrow + 32) * INC + lch * 8);                          \
    rv0 = *(const uint4*)(vp + (size_t)(lrow)*vstride + lch * 8);                             \
    rv1 = *(const uint4*)(vp + (size_t)(lrow + 32) * vstride + lch * 8);                      \
  }
#define ATT_LSTORE(BUF)                                     \
  {                                                         \
    char* Kb_ = smem + (BUF)*16384;                         \
    *(uint4*)(Kb_ + swz(lrow, lch)) = rk0;                  \
    *(uint4*)(Kb_ + swz(lrow + 32, lch)) = rk1;             \
    *(uint4*)(Kb_ + 8192 + swz(lrow, lch)) = rv0;           \
    *(uint4*)(Kb_ + 8192 + swz(lrow + 32, lch)) = rv1;      \
  }
  ATT_GLOAD(0);
  ATT_LSTORE(0);
  __syncthreads();
  for (int kt = 0; kt < nkt; ++kt) {
    const int buf = kt & 1;
    if (kt + 1 < nkt) ATT_GLOAD(kt + 1);
    const char* Kb = smem + buf * 16384;
    const char* Vb = Kb + 8192;
    f32x4 St[2][4];
#pragma unroll
    for (int mi = 0; mi < 2; ++mi)
#pragma unroll
      for (int ni = 0; ni < 4; ++ni) St[mi][ni] = f32x4{0.f, 0.f, 0.f, 0.f};
#pragma unroll
    for (int ks = 0; ks < 2; ++ks) {
      bf16x8 kf[4];
#pragma unroll
      for (int ni = 0; ni < 4; ++ni) kf[ni] = *(const bf16x8*)(Kb + swz(ni * 16 + l15, ks * 4 + quad));
#pragma unroll
      for (int mi = 0; mi < 2; ++mi)
#pragma unroll
        for (int ni = 0; ni < 4; ++ni) St[mi][ni] = mfma16(kf[ni], qf[mi][ks], St[mi][ni]);
    }
    bf16x8 pf[2][2];
#pragma unroll
    for (int mi = 0; mi < 2; ++mi) {
      float mx = St[mi][0][0];
#pragma unroll
      for (int ni = 0; ni < 4; ++ni)
#pragma unroll
        for (int jj = 0; jj < 4; ++jj) mx = fmaxf(mx, St[mi][ni][jj]);
      mx = fmaxf(mx, __shfl_xor(mx, 16));
      mx = fmaxf(mx, __shfl_xor(mx, 32));
      const float mnew = fmaxf(mrow[mi], mx);
      const float alpha = __builtin_amdgcn_exp2f((mrow[mi] - mnew) * LOG2E);
      mrow[mi] = mnew;
      const float mb = mnew * LOG2E;
      float ps = 0.f;
      float pv[4][4];
#pragma unroll
      for (int ni = 0; ni < 4; ++ni)
#pragma unroll
        for (int jj = 0; jj < 4; ++jj) {
          pv[ni][jj] = __builtin_amdgcn_exp2f(St[mi][ni][jj] * LOG2E - mb);
          ps += pv[ni][jj];
        }
      lpart[mi] = lpart[mi] * alpha + ps;
#pragma unroll
      for (int nd = 0; nd < 4; ++nd) {
        Ot[mi][nd][0] *= alpha; Ot[mi][nd][1] *= alpha; Ot[mi][nd][2] *= alpha; Ot[mi][nd][3] *= alpha;
      }
#pragma unroll
      for (int s2 = 0; s2 < 2; ++s2) {
        union { unsigned u[4]; bf16x8 v; } pk;
        pk.u[0] = pk2(pv[2 * s2][0], pv[2 * s2][1]);
        pk.u[1] = pk2(pv[2 * s2][2], pv[2 * s2][3]);
        pk.u[2] = pk2(pv[2 * s2 + 1][0], pv[2 * s2 + 1][1]);
        pk.u[3] = pk2(pv[2 * s2 + 1][2], pv[2 * s2 + 1][3]);
        pf[mi][s2] = pk.v;
      }
    }
#pragma unroll
    for (int s2 = 0; s2 < 2; ++s2) {
      bf16x8 vf[4];
#pragma unroll
      for (int nd = 0; nd < 4; ++nd) {
        const int drow = nd * 16 + l15;
        union { uint2 h[2]; bf16x8 v; } vv;
        vv.h[0] = *(const uint2*)(Vb + swz(drow, 4 * s2 + (quad >> 1)) + (quad & 1) * 8);
        vv.h[1] = *(const uint2*)(Vb + swz(drow, 4 * s2 + 2 + (quad >> 1)) + (quad & 1) * 8);
        vf[nd] = vv.v;
      }
#pragma unroll
      for (int mi = 0; mi < 2; ++mi)
#pragma unroll
        for (int nd = 0; nd < 4; ++nd) Ot[mi][nd] = mfma16(vf[nd], pf[mi][s2], Ot[mi][nd]);
    }
    if (kt + 1 < nkt) ATT_LSTORE(buf ^ 1);
    __syncthreads();
  }
#undef ATT_GLOAD
#undef ATT_LSTORE
#pragma unroll
  for (int mi = 0; mi < 2; ++mi) {
    float lsum = lpart[mi];
    lsum += __shfl_xor(lsum, 16);
    lsum += __shfl_xor(lsum, 32);
    const float inv = 1.f / lsum;
    const int r = qrow0 + wid * 32 + mi * 16 + l15;
#pragma unroll
    for (int nd = 0; nd < 4; ++nd)
      *(uint2*)(p.act + (size_t)r * DM + 640 + hq * 64 + nd * 16 + quad * 4) =
          make_uint2(pk2(Ot[mi][nd][0] * inv, Ot[mi][nd][1] * inv), pk2(Ot[mi][nd][2] * inv, Ot[mi][nd][3] * inv));
  }
}

DEV void sgate_item(const P& p, int l, int ck, int g, char* smem) {
  const int tid = tid_l(), lane = tid & 63, wid = tid >> 6, l15 = lane & 15, quad = lane >> 4;
  const int m0 = ck * 128;
  u16* sVT = (u16*)smem;
  {
    const int q = tid >> 1, half = tid & 1;
    const u16* src = p.z + (size_t)(m0 + q) * INC + 1408 + 256 + g * 64 + half * 32;
    float v[32];
    float ss = 0.f;
#pragma unroll
    for (int cidx = 0; cidx < 4; ++cidx) {
      uint4 u = *(const uint4*)(src + cidx * 8);
      unsigned uu[4] = {u.x, u.y, u.z, u.w};
#pragma unroll
      for (int e = 0; e < 4; ++e) {
        float f0 = geluf_(bf2f((u16)(uu[e] & 0xffff)));
        float f1 = geluf_(bf2f((u16)(uu[e] >> 16)));
        v[cidx * 8 + e * 2] = f0;
        v[cidx * 8 + e * 2 + 1] = f1;
        ss += f0 * f0 + f1 * f1;
      }
    }
    ss += __shfl_xor(ss, 1);
    const float rstd = rsqrtf(ss * (1.f / 64.f) + 1e-6f);
    const float* gn = p.sgn + l * 256 + g * 64 + half * 32;
#pragma unroll
    for (int e = 0; e < 32; ++e) sVT[(half * 32 + e) * 136 + q] = f2bf(v[e] * rstd * gn[e]);
  }
  __syncthreads();
  f32x4 acc[2][4];
#pragma unroll
  for (int mi = 0; mi < 2; ++mi)
#pragma unroll
    for (int ni = 0; ni < 4; ++ni) acc[mi][ni] = f32x4{0.f, 0.f, 0.f, 0.f};
  const u16* Wg = p.sgW + (size_t)(l * 4 + g) * 128 * 128;
#pragma unroll
  for (int ks = 0; ks < 4; ++ks) {
    bf16x8 a[2], bb[4];
#pragma unroll
    for (int mi = 0; mi < 2; ++mi) a[mi] = *(const bf16x8*)(Wg + (size_t)(wid * 32 + mi * 16 + l15) * 128 + ks * 32 + quad * 8);
#pragma unroll
    for (int ni = 0; ni < 4; ++ni) bb[ni] = *(const bf16x8*)(sVT + (ni * 16 + l15) * 136 + ks * 32 + quad * 8);
#pragma unroll
    for (int mi = 0; mi < 2; ++mi)
#pragma unroll
      for (int ni = 0; ni < 4; ++ni) acc[mi][ni] = mfma16(a[mi], bb[ni], acc[mi][ni]);
  }
#pragma unroll
  for (int mi = 0; mi < 2; ++mi)
#pragma unroll
    for (int j = 0; j < 4; ++j) {
      const int pr = wid * 32 + mi * 16 + quad * 4 + j;
      const float bias = p.sg_b[(size_t)(l * 4 + g) * 128 + pr];
#pragma unroll
      for (int ni = 0; ni < 4; ++ni) {
        const int c = ni * 16 + l15;
        float u = geluf_(bf2f(p.z[(size_t)(m0 + pr) * INC + 1408 + g * 64 + c]));
        p.act[(size_t)(m0 + pr) * DM + 384 + g * 64 + c] = f2bf(u * (acc[mi][ni][j] + bias));
      }
    }
  __syncthreads();
}

DEV void mix_phase(const P& p, int l, char* smem, int cidx) {
  __shared__ int s_item;
  const bool last = (l == DEPTH - 1);
  const int n_attn = last ? 1536 : 1632;
  const int ck_lo = last ? 16 : 0;
  const int n_sg = (NMT - ck_lo) * 4;
  const int total = SCAN_ITEMS + n_attn + n_sg;
  const int bid = bid_l();
  bool first = bid < SCAN_ITEMS;
  for (;;) {
    int it;
    if (first) {
      it = bid;
      first = false;
    } else {
      if (tid_l() == 0) s_item = SCAN_ITEMS + atomicAdd(p.cnt + cidx, 1);
      __syncthreads();
      it = s_item;
      __syncthreads();
    }
    if (it >= total) break;
    if (it < SCAN_ITEMS) {
      int nr = SCAN_REP; asm volatile("" : "+s"(nr));
      for (int rr = 0; rr < nr; ++rr) scan_item(p, l, it, smem);
    } else if (it < SCAN_ITEMS + n_attn) {
      int nr = ATT_REP; asm volatile("" : "+s"(nr));
      for (int rr = 0; rr < nr; ++rr) { attn_item(p, it - SCAN_ITEMS, smem); __syncthreads(); }
    } else {
      int i2 = it - SCAN_ITEMS - n_attn;
      int nr = SG_REP; asm volatile("" : "+s"(nr));
      for (int rr = 0; rr < nr; ++rr) sgate_item(p, l, ck_lo + (i2 >> 2), i2 & 3, smem);
    }
  }
}

DEV void apost_phase(const P& p, int l, int mt_lo, char* smem) {
  const int tid = tid_l(), lane = tid & 63, wid = tid >> 6, l15 = lane & 15, quad = lane >> 4;
  for (int i = bid_l() * 256 + tid; i < MT; i += gridDim.x * 256) { p.rss1[i] = 0.f; p.rss2[i] = 0.f; }
  const int nit = (NMT - mt_lo) * 6;
  for (int it = bid_l(); it < nit; it += gridDim.x) {
    const int mt = mt_lo + it / 6;
    const int hh = it % 6;
    const int m0 = mt * 128;
    bf16x8 a[2][4];
#pragma unroll
    for (int mi = 0; mi < 2; ++mi)
#pragma unroll
      for (int ks = 0; ks < 4; ++ks)
        a[mi][ks] = *(const bf16x8*)(p.z + (size_t)(m0 + wid * 32 + mi * 16 + l15) * INC + 1280 + ks * 32 + quad * 8);
    {
      f32x4 acc[2][4];
#pragma unroll
      for (int mi = 0; mi < 2; ++mi)
#pragma unroll
        for (int ni = 0; ni < 4; ++ni) acc[mi][ni] = f32x4{0.f, 0.f, 0.f, 0.f};
#pragma unroll
      for (int ks = 0; ks < 4; ++ks) {
        bf16x8 bb[4];
#pragma unroll
        for (int ni = 0; ni < 4; ++ni)
          bb[ni] = *(const bf16x8*)(p.gUpT + ((size_t)l * 384 + hh * 64 + ni * 16 + l15) * 128 + ks * 32 + quad * 8);
#pragma unroll
        for (int mi = 0; mi < 2; ++mi)
#pragma unroll
          for (int ni = 0; ni < 4; ++ni) acc[mi][ni] = mfma16(bb[ni], a[mi][ks], acc[mi][ni]);
      }
      float4 lg[4], lb[4];
#pragma unroll
      for (int ni = 0; ni < 4; ++ni) {
        lg[ni] = *(const float4*)(p.ln_g + l * 384 + hh * 64 + ni * 16 + quad * 4);
        lb[ni] = *(const float4*)(p.ln_b + l * 384 + hh * 64 + ni * 16 + quad * 4);
      }
#pragma unroll
      for (int mi = 0; mi < 2; ++mi) {
        const int r = m0 + wid * 32 + mi * 16 + l15;
        float4 ys[4];
        uint2 vraw[4];
        float sm = 0.f;
#pragma unroll
        for (int ni = 0; ni < 4; ++ni) {
          const int c = hh * 64 + ni * 16 + quad * 4;
          const float4 y0 = *(const float4*)(p.y + (size_t)r * 384 + c);
          const float4 y1 = *(const float4*)(p.y + ((size_t)MT + r) * 384 + c);
          ys[ni] = make_float4(y0.x + y1.x, y0.y + y1.y, y0.z + y1.z, y0.w + y1.w);
          vraw[ni] = *(const uint2*)(p.z + (size_t)r * INC + 768 + c);
          sm += (ys[ni].x + ys[ni].y) + (ys[ni].z + ys[ni].w);
        }
        const float4 bq0 = *(const float4*)(p.bonus + (size_t)r * 48 + hh * 4);
        const float4 bq1 = *(const float4*)(p.bonus + (size_t)r * 48 + (6 + hh) * 4);
        const float bon = (bq0.x + bq0.y) + (bq0.z + bq0.w) + (bq1.x + bq1.y) + (bq1.z + bq1.w);
        sm += __shfl_xor(sm, 16);
        sm += __shfl_xor(sm, 32);
        const float mean = sm * (1.f / 64.f);
        float vs = 0.f;
#pragma unroll
        for (int ni = 0; ni < 4; ++ni) {
          ys[ni].x -= mean; ys[ni].y -= mean; ys[ni].z -= mean; ys[ni].w -= mean;
          vs += ys[ni].x * ys[ni].x + ys[ni].y * ys[ni].y + ys[ni].z * ys[ni].z + ys[ni].w * ys[ni].w;
        }
        vs += __shfl_xor(vs, 16);
        vs += __shfl_xor(vs, 32);
        const float rstd = rsqrtf(vs * (1.f / 64.f) + 64e-5f);
#pragma unroll
        for (int ni = 0; ni < 4; ++ni) {
          const int c = hh * 64 + ni * 16 + quad * 4;
          const float v0 = __uint_as_float(vraw[ni].x << 16), v1 = __uint_as_float(vraw[ni].x & 0xffff0000u);
          const float v2 = __uint_as_float(vraw[ni].y << 16), v3 = __uint_as_float(vraw[ni].y & 0xffff0000u);
          const float o0 = (ys[ni].x * rstd * lg[ni].x + lb[ni].x + bon * v0) * acc[mi][ni][0];
          const float o1 = (ys[ni].y * rstd * lg[ni].y + lb[ni].y + bon * v1) * acc[mi][ni][1];
          const float o2 = (ys[ni].z * rstd * lg[ni].z + lb[ni].z + bon * v2) * acc[mi][ni][2];
          const float o3 = (ys[ni].w * rstd * lg[ni].w + lb[ni].w + bon * v3) * acc[mi][ni][3];
          *(uint2*)(p.act + (size_t)r * DM + c) = make_uint2(pk2(o0, o1), pk2(o2, o3));
        }
        __builtin_amdgcn_sched_barrier(0);
      }
    }
  }
}

DEV uint2 ld8(const u16* q) { return *(const uint2*)q; }
DEV void up4(const uint2 u, float (&f)[4]) {
  f[0] = __uint_as_float(u.x << 16); f[1] = __uint_as_float(u.x & 0xffff0000u);
  f[2] = __uint_as_float(u.y << 16); f[3] = __uint_as_float(u.y & 0xffff0000u);
}
DEV void prep_phase(const P& p, int l, XcdBarrier& xb) {
  const int tid = tid_l(), lane = tid & 63, l15 = lane & 15;
  const int nb = gridDim.x, bid = bid_l();
  constexpr int NR = 8;
  const int rpb = (((MT + nb - 1) / nb) + NR - 1) & ~(NR - 1);
  const int ra = bid * rpb;
  const int rb = min(ra + rpb, MT);
  const bool active = ra < MT;
  const bool has1 = tid < 96;
  const int col0 = tid * 4, col1 = 1024 + tid * 4;
  uint2 hp0 = make_uint2(0, 0), hn0 = hp0, hp1 = hp0, hn1 = hp0;
  if (active) {
    if (ra > 0) { hp0 = ld8(p.z + (size_t)(ra - 1) * INC + col0); if (has1) hp1 = ld8(p.z + (size_t)(ra - 1) * INC + col1); }
    if (rb < MT) { hn0 = ld8(p.z + (size_t)rb * INC + col0); if (has1) hn1 = ld8(p.z + (size_t)rb * INC + col1); }
  }
  xcd_barrier(xb);
  if (!active) return;
  const float* cw = p.conv + (size_t)l * 3 * 1408;
#pragma unroll 1
  for (int pass = 0; pass < 2; ++pass) {
    if (pass == 1 && !has1) break;
    const int col = pass ? col1 : col0;
    const int typ = col < 1152 ? 0 : (col < 1216 ? 1 : (col < 1280 ? 0 : 2));
    const bool isk = col >= 384 && col < 768;
    float c0[4], c1[4], c2[4], kk4[4];
#pragma unroll
    for (int e = 0; e < 4; ++e) {
      c0[e] = cw[col + e]; c1[e] = cw[1408 + col + e]; c2[e] = cw[2816 + col + e];
      kk4[e] = isk ? p.k_k[l * 384 + (col - 384) + e] : 0.f;
    }
    const int hh = isk ? (col - 384) >> 6 : 0;
    u16* zc = p.z + col;
    uint2 prev = pass ? hp1 : hp0;
    const uint2 halo_n = pass ? hn1 : hn0;
    uint2 cur = ld8(zc + (size_t)ra * INC);
    for (int r = ra; r < rb; r += NR) {
      uint2 w[NR + 2];
      w[0] = prev;
      w[1] = cur;
#pragma unroll
      for (int q = 0; q < NR; ++q) {
        const int rr = r + 1 + q;
        w[q + 2] = rr < rb ? ld8(zc + (size_t)rr * INC) : halo_n;
      }
#pragma unroll
      for (int q = 0; q < NR; ++q) {
        const int rr = r + q;
        const uint2 xp = w[q], xc = w[q + 1], xn = w[q + 2];
        const int tt = rr < MC ? (rr & 255) : ((rr - MC) & 4095);
        const int len = rr < MC ? 256 : 4096;
        const float mp = tt > 0 ? 1.f : 0.f, mn = tt < len - 1 ? 1.f : 0.f;
        float fp[4], fc[4], fn[4], o[4];
        up4(xp, fp); up4(xc, fc); up4(xn, fn);
#pragma unroll
        for (int e = 0; e < 4; ++e) {
          float v = fc[e] * c1[e] + mp * (fp[e] * c0[e]) + mn * (fn[e] * c2[e]);
          if (typ == 1) v = tanh_fast(v);
          else if (typ == 2) v = sigmoidf_(v);
          o[e] = v;
        }
        if (isk) {
          float q0 = o[0] * kk4[0], q1 = o[1] * kk4[1], q2 = o[2] * kk4[2], q3 = o[3] * kk4[3];
          float ss = red16_sum(q0 * q0 + q1 * q1 + q2 * q2 + q3 * q3);
          if (l15 == 0 && rr < rb) p.invn[(size_t)rr * 8 + hh] = 1.f / fmaxf(sqrtf(ss), 1e-12f);
        }
        if (rr < rb) *(uint2*)(zc + (size_t)rr * INC) = make_uint2(pk2(o[0], o[1]), pk2(o[2], o[3]));
      }
      prev = w[NR];
      cur = w[NR + 1];
    }
  }
}

__global__ void __launch_bounds__(256, 2) fwd_megakernel(P p, int ph_lo, int ph_hi) {
  __shared__ __attribute__((aligned(16))) char smem[65536 - 16];
  cg::grid_group grid = cg::this_grid();
  XcdBarrier xb = xcd_barrier_post(p.xbar);
  if (ph_hi < 0) grid.sync();
  for (int ph = ph_lo; ph < ph_hi; ++ph) {
    if (ph > ph_lo) xcd_barrier(xb);
    if (ph == 0) { phase0(p, smem); continue; }
    if (ph == 1) { phase0b(p, smem); continue; }
    if (ph == 2 + 6 * DEPTH) { final_norm(p); continue; }
    const int l = (ph - 2) / 6, sub = (ph - 2) % 6;
    const bool last = (l == DEPTH - 1);
    const int mt_lo = last ? 16 : 0;
    GX g0{};
    g0.rss_acc = nullptr; g0.aout = nullptr; g0.gnext = nullptr; g0.lmod = 0; g0.scoff = 0;
    if (sub == 0) {
      gemm_phase<EPI_Z>(p, l, p.act, DM, p.wIn + (size_t)l * 2560 * 1024, 1024, 20, 0, 0, smem, g0, 0);
    } else if (sub == 1) {
      prep_phase(p, l, xb);
      xcd_barrier(xb);
      mix_phase(p, l, smem, l);
    } else if (sub == 2) {
      apost_phase(p, l, mt_lo, smem);
    } else if (sub == 3 || sub == 5) {
      const bool g4 = sub == 5;
      GX gx{};
      gx.rss_acc = g4 ? p.rss1 : p.rss2;
      gx.aout = g4 ? (last ? nullptr : p.act) : p.act2;
      gx.gnext = g4 ? p.n1g + (last ? 0 : (l + 1) * DM) : p.n2g + l * DM;
      gx.lmod = g4 ? (last ? l : l + 1) : l;
      gx.scoff = g4 ? 1024 : 4096;
      gemm_phase<EPI_RES>(p, l, g4 ? p.h : p.act, g4 ? DFF : DM,
                          g4 ? p.w2t + (size_t)l * 1024 * 2816 : p.wOut + (size_t)l * 1024 * 1024, g4 ? 2816 : 1024, 8, mt_lo,
                          g4 ? 5120 : 2048, smem, gx, 0);
    } else {
      gemm_phase<EPI_SWIGLU>(p, l, p.act2, DM, p.w1t + (size_t)l * 5632 * 1024, 1024, 44, mt_lo, 0, smem, g0, 0);
    }
  }
}

extern "C" void kernel_launch(void* const* d_in, const int* in_sizes, int n_in, void* d_out, int out_size, void* d_ws,
                              size_t ws_size, hipStream_t stream) {
  static int grid_blocks = 0;
  if (!grid_blocks) {
    int dev = 0, cus = 0, per_cu = 0;
    hipGetDevice(&dev);
    hipDeviceGetAttribute(&cus, hipDeviceAttributeMultiprocessorCount, dev);
    hipOccupancyMaxActiveBlocksPerMultiprocessor(&per_cu, fwd_megakernel, 256, 0);
    if (per_cu > 2) per_cu = 2;
    if (per_cu < 1) per_cu = 1;
    grid_blocks = cus * per_cu;
  }
  P p{};
  const float* const* in = (const float* const*)d_in;
  p.x = in[0]; p.c = in[1]; p.ctx = in[2]; p.c_ctx = in[3]; p.n1g = in[4]; p.n2g = in[5]; p.ada_w = in[6]; p.ada_b = in[7];
  p.w_in = in[8]; p.conv = in[9]; p.w0 = in[10]; p.w_up = in[11]; p.a0 = in[12]; p.a_up = in[13]; p.g_up = in[14];
  p.k_k = in[15]; p.k_a = in[16]; p.r_k = in[17]; p.ln_g = in[18]; p.ln_b = in[19]; p.sgn = in[20]; p.sg_w = in[21];
  p.sg_b = in[22]; p.q_g = in[23]; p.k_g = in[24]; p.w_out = in[25]; p.w1 = in[26]; p.w2 = in[27]; p.fng = in[28];
  p.out = (float*)d_out;
  char* ws = (char*)d_ws;
  size_t off = 0;
  auto take = [&](size_t bytes) { char* r = ws + off; off += (bytes + 255) & ~(size_t)255; return r; };
  p.wIn = (u16*)take((size_t)4 * 2560 * 1024 * 2);
  p.wOut = (u16*)take((size_t)4 * 1024 * 1024 * 2);
  p.w1t = (u16*)take((size_t)4 * 5632 * 1024 * 2);
  p.w2t = (u16*)take((size_t)4 * 1024 * 2816 * 2);
  p.wUpT = (u16*)take((size_t)8 * 384 * 64 * 2);
  p.aUpT = (u16*)take((size_t)8 * 384 * 64 * 2);
  p.gUpT = (u16*)take((size_t)4 * 384 * 128 * 2);
  p.sgW = (u16*)take((size_t)16 * 128 * 128 * 2);
  p.mods = (float*)take((size_t)4 * 9 * 6144 * 4);
  p.rope = (float*)take(2048 * 4);
  p.cnt = (int*)take(256);
  p.xbar = (unsigned*)take((size_t)XCD_BAR_WORDS * 4);
  p.xc = (float*)take((size_t)MC * DM * 4);
  p.act = (u16*)take((size_t)MT * DM * 2);
  p.z = (u16*)take((size_t)MT * DFF * 2);
  p.h = p.z;
  p.vTl = (u16*)take((size_t)16 * 64 * SEQ * 2);
  p.vTc = (u16*)take((size_t)16 * 64 * CTXL * 2);
  p.y = (float*)take((size_t)2 * MT * 384 * 4);
  p.bonus = (float*)take((size_t)MT * 48 * 4);
  p.invn = (float*)take((size_t)MT * 8 * 4);
  p.rss1 = (float*)take((size_t)MT * 4);
  p.rss2 = (float*)take((size_t)MT * 4);
  p.bz = (float*)take((size_t)4 * 9 * 2560 * 4);
  p.bh = (float*)take((size_t)4 * 9 * 5632 * 4);
  p.act2 = (u16*)p.y;
  if (off > ws_size) { fprintf(stderr, "workspace too small: need %zu have %zu\n", off, ws_size); return; }
  int ph_lo = 0, ph_hi = 3 + 6 * DEPTH;
  (void)hipMemsetAsync(p.xbar, 0, (size_t)XCD_BAR_WORDS * 4, stream);
  void* args[] = {&p, &ph_lo, &ph_hi};
  hipError_t e = hipLaunchCooperativeKernel((void*)fwd_megakernel, dim3(grid_blocks), dim3(256), args, 0, stream);
  if (e != hipSuccess) fprintf(stderr, "cooperative launch failed: %s (grid %d)\n", hipGetErrorString(e), grid_blocks);
}
```

```cpp
#include <hip/hip_runtime.h>
#include <hip/hip_bf16.h>
#include <hip/hip_cooperative_groups.h>
#include <cstdio>
namespace cg = cooperative_groups;

typedef __attribute__((ext_vector_type(8))) short bf16x8;
typedef __attribute__((ext_vector_type(4))) float f32x4;
typedef unsigned short u16;
typedef __attribute__((ext_vector_type(2))) float float2v;

#define DEV __device__ __forceinline__
DEV int tid_l() { int t = threadIdx.x; asm volatile("" : "+v"(t)); return t; }
DEV int bid_l() { int b = blockIdx.x; asm volatile("" : "+s"(b)); return b; }

constexpr int DM = 1024, NBATCH = 8, SEQ = 4096, DEPTH = 4, CTXL = 256;
constexpr int MC = NBATCH * CTXL;
constexpr int ML = NBATCH * SEQ;
constexpr int MT = MC + ML;
constexpr int INC = 2560, DFF = 2816;
constexpr int NMT = MT / 128;
#ifndef PROBE_MASK
#define PROBE_MASK 0
#endif
#define SCAN_REP 1
#define ATT_REP 1
#define SG_REP 1

struct P {
  const float *x, *c, *ctx, *c_ctx, *n1g, *n2g, *ada_w, *ada_b, *w_in, *conv, *w0, *w_up, *a0, *a_up, *g_up,
      *k_k, *k_a, *r_k, *ln_g, *ln_b, *sgn, *sg_w, *sg_b, *q_g, *k_g, *w_out, *w1, *w2, *fng;
  float* out;
  u16 *wIn, *wOut, *w1t, *w2t, *wUpT, *aUpT, *gUpT, *sgW;
  float *mods, *rope;
  int* cnt;
  unsigned* xbar;
  float* xc;
  u16 *act, *z, *h, *vTl, *vTc;
  float *y, *bonus, *invn;
  float *rss1, *rss2, *bz, *bh;
  u16* act2;
};

typedef __attribute__((ext_vector_type(2))) __bf16 bf16x2v;
typedef __attribute__((ext_vector_type(2))) float f32x2v;
DEV unsigned pk2(float a, float b) {
  f32x2v v = {a, b};
  bf16x2v r = __builtin_convertvector(v, bf16x2v);
  return *(unsigned*)&r;
}
DEV u16 f2bf(float f) { return (u16)(pk2(f, 0.f) & 0xffffu); }
DEV float bf2f(u16 h) { return __uint_as_float(((unsigned)h) << 16); }
DEV float sigmoidf_(float x) { return __builtin_amdgcn_rcpf(1.f + __expf(-x)); }
DEV float siluf_(float x) { return x * __builtin_amdgcn_rcpf(1.f + __expf(-x)); }
DEV float geluf_(float x) {
  float u = 0.7978845608028654f * (x + 0.044715f * x * x * x);
  return 0.5f * x * (1.f + tanhf(u));
}
DEV int swz(int r, int ch) { return r * 128 + ((ch ^ ((r >> 1) & 7)) << 4); }

template <int CTRL>
DEV float dppf(float v) {
  return __int_as_float(__builtin_amdgcn_update_dpp(0, __float_as_int(v), CTRL, 0xF, 0xF, false));
}
DEV float red16_sum(float v) {
  v += dppf<0xB1>(v);
  v += dppf<0x4E>(v);
  v += dppf<0x141>(v);
  v += dppf<0x140>(v);
  return v;
}
DEV float red16_max(float v) {
  v = fmaxf(v, dppf<0xB1>(v));
  v = fmaxf(v, dppf<0x4E>(v));
  v = fmaxf(v, dppf<0x141>(v));
  v = fmaxf(v, dppf<0x140>(v));
  return v;
}
DEV float wave_sum(float v) {
#pragma unroll
  for (int o = 32; o >= 1; o >>= 1) v += __shfl_xor(v, o);
  return v;
}
DEV f32x4 mfma16(bf16x8 a, bf16x8 b, f32x4 c) { return __builtin_amdgcn_mfma_f32_16x16x32_bf16(a, b, c, 0, 0, 0); }


#define XB_TMO      128
#define XB_XCNT(j)  (256  + 64 * (j))
#define XB_XSUB(j)  (1280 + 64 * (j))
#define XB_XGEN(j)  (2304 + 64 * (j))
#define XB_TOP      3328
#define XB_TOPGEN   3392
#define XCD_BAR_WORDS 3456
#define XB_SPIN_CAP (1u << 20)
DEV unsigned xb_ld(unsigned* q) { return __hip_atomic_load(q, __ATOMIC_RELAXED, __HIP_MEMORY_SCOPE_AGENT); }
DEV unsigned xb_add(unsigned* q, unsigned v) { return __hip_atomic_fetch_add(q, v, __ATOMIC_RELAXED, __HIP_MEMORY_SCOPE_AGENT); }
DEV unsigned xb_xcc_id() { return (unsigned)__builtin_amdgcn_s_getreg((3 << 11) | 20) & 0xFu; }
#define XB_SPIN(cond, bar) do { unsigned _sp = 0; while (cond) { __builtin_amdgcn_s_sleep(1); \
    if ((++_sp & 255u) == 0u) { if (xb_ld(&(bar)[XB_TMO])) break; if (_sp > XB_SPIN_CAP) { atomicAdd(&(bar)[XB_TMO], 1u); break; } } } } while (0)
struct XcdBarrier { unsigned* bar; unsigned x; unsigned nloc, nx; };
DEV XcdBarrier xcd_barrier_post(unsigned* bar) {
  XcdBarrier b; b.bar = bar; b.x = xb_xcc_id(); b.nloc = 0u; b.nx = 0u;
  if (threadIdx.x == 0) (void)xb_add(&bar[XB_XCNT(b.x)], 1u);
  return b;
}
DEV void xcd_barrier_complete(unsigned* bar, unsigned x, unsigned& nloc, unsigned& nx) {
  const unsigned G = gridDim.x * gridDim.y * gridDim.z;
  unsigned sum, cnt, mine, sp = 0u;
  for (;;) {
    sum = 0u; cnt = 0u; mine = 0u;
#pragma unroll
    for (unsigned j = 0; j < 16; ++j) { const unsigned c = xb_ld(&bar[XB_XCNT(j)]); sum += c; cnt += (c > 0u) ? 1u : 0u; mine = (j == x) ? c : mine; }
    if (sum == G) break;
    __builtin_amdgcn_s_sleep(1);
    if ((++sp & 255u) == 0u) { if (xb_ld(&bar[XB_TMO])) break; if (sp > XB_SPIN_CAP) { atomicAdd(&bar[XB_TMO], 1u); break; } }
  }
  nloc = mine > 0u ? mine : 1u; nx = cnt > 0u ? cnt : 1u;
}
DEV void xcd_barrier(XcdBarrier& b) {
  asm volatile("s_waitcnt vmcnt(0)" ::: "memory");
  __syncthreads();
  if (threadIdx.x == 0) {
    unsigned* bar = b.bar;
    __builtin_amdgcn_s_waitcnt(0);
    if (b.nloc == 0u) xcd_barrier_complete(bar, b.x, b.nloc, b.nx);
    const unsigned nloc = b.nloc, nx = b.nx;
    const unsigned old = xb_add(&bar[XB_XSUB(b.x)], 1u);
    const unsigned gen = old / nloc;
    if (old + 1u == (gen + 1u) * nloc) {
      __builtin_amdgcn_fence(__ATOMIC_RELEASE, "agent");
      asm volatile("s_waitcnt vmcnt(0)" ::: "memory");
      const unsigned og = xb_add(&bar[XB_TOP], 1u);
      const unsigned tg = og / nx;
      if (og + 1u == (tg + 1u) * nx) xb_add(&bar[XB_TOPGEN], 1u);
      else XB_SPIN(xb_ld(&bar[XB_TOPGEN]) == tg, bar);
      __builtin_amdgcn_fence(__ATOMIC_ACQUIRE, "agent");
      xb_add(&bar[XB_XGEN(b.x)], 1u);
      asm volatile("s_waitcnt vmcnt(0)" ::: "memory");
    } else {
      XB_SPIN(xb_ld(&bar[XB_XGEN(b.x)]) == gen, bar);
      __builtin_amdgcn_fence(__ATOMIC_ACQUIRE, "agent");
      asm volatile("s_waitcnt vmcnt(0)" ::: "memory");
    }
  }
  __syncthreads();
}

DEV void tr_tile(const float* __restrict__ src, u16* __restrict__ dst, int K, int N, int kt, int nt, bool il, float* lds) {
  const int tid = tid_l();
  const int k0 = kt * 64, n0 = nt * 64;
  {
    const int c = tid & 63, r0 = tid >> 6;
#pragma unroll
    for (int i = 0; i < 16; ++i) {
      int r = r0 + i * 4;
      lds[r * 65 + c] = src[(size_t)(k0 + r) * N + n0 + c];
    }
  }
  __syncthreads();
  {
    const int ch = tid & 7, nn0 = tid >> 3;
#pragma unroll
    for (int i = 0; i < 2; ++i) {
      const int n = nn0 + i * 32;
      const int gn = n0 + n;
      int np = gn;
      if (il) {
        int j = gn < DFF ? gn : gn - DFF;
        np = (j >> 4) * 32 + (j & 15) + (gn < DFF ? 0 : 16);
      }
      const float* sp = lds + (ch * 8) * 65 + n;
      uint4 o;
      o.x = pk2(sp[0 * 65], sp[1 * 65]);
      o.y = pk2(sp[2 * 65], sp[3 * 65]);
      o.z = pk2(sp[4 * 65], sp[5 * 65]);
      o.w = pk2(sp[6 * 65], sp[7 * 65]);
      *(uint4*)(dst + (size_t)np * K + k0 + ch * 8) = o;
    }
  }
  __syncthreads();
}

DEV void phase0(const P& p, char* smem) {
  float* lds = (float*)smem;
  const int tid = tid_l();
  constexpr int C0 = 2560, C1 = C0 + 1024, C2 = C1 + 5632, C3 = C2 + 2816, C4 = C3 + 48, C5 = C4 + 48, C6 = C5 + 48,
                C7 = C6 + 64, C8 = C7 + 384, C9 = C8 + 1;
  for (int it = bid_l(); it < C9; it += gridDim.x) {
    if (it < C6) {
      const float* src; u16* dst; int K, N, kt, nt; bool il = false;
      if (it < C0) {
        int l = it / 640, r = it % 640;
        src = p.w_in + (size_t)l * 1024 * 2560; dst = p.wIn + (size_t)l * 2560 * 1024; K = 1024; N = 2560; kt = r / 40; nt = r % 40;
      } else if (it < C1) {
        int i2 = it - C0, l = i2 / 256, r = i2 % 256;
        src = p.w_out + (size_t)l * 1024 * 1024; dst = p.wOut + (size_t)l * 1024 * 1024; K = 1024; N = 1024; kt = r / 16; nt = r % 16;
      } else if (it < C2) {
        int i2 = it - C1, l = i2 / 1408, r = i2 % 1408;
        src = p.w1 + (size_t)l * 1024 * 5632; dst = p.w1t + (size_t)l * 5632 * 1024; K = 1024; N = 5632; kt = r / 88; nt = r % 88; il = true;
      } else if (it < C3) {
        int i2 = it - C2, l = i2 / 704, r = i2 % 704;
        src = p.w2 + (size_t)l * 2816 * 1024; dst = p.w2t + (size_t)l * 1024 * 2816; K = 2816; N = 1024; kt = r / 16; nt = r % 16;
      } else if (it < C4) {
        int i2 = it - C3, bb = i2 / 6;
        src = p.w_up + (size_t)bb * 64 * 384; dst = p.wUpT + (size_t)bb * 384 * 64; K = 64; N = 384; kt = 0; nt = i2 % 6;
      } else if (it < C5) {
        int i2 = it - C4, bb = i2 / 6;
        src = p.a_up + (size_t)bb * 64 * 384; dst = p.aUpT + (size_t)bb * 384 * 64; K = 64; N = 384; kt = 0; nt = i2 % 6;
      } else {
        int i2 = it - C5, l = i2 / 12, r = i2 % 12;
        src = p.g_up + (size_t)l * 128 * 384; dst = p.gUpT + (size_t)l * 384 * 128; K = 128; N = 384; kt = r / 6; nt = r % 6;
      }
      tr_tile(src, dst, K, N, kt, nt, il, lds);
    } else if (it < C7) {
      int i2 = it - C6;
      for (int i = 0; i < 16; ++i) {
        int e = i2 * 4096 + i * 256 + tid;
        p.sgW[e] = f2bf(p.sg_w[e]);
      }
    } else if (it < C8) {
      int i2 = it - C7, l = i2 / 96, cb = i2 % 96;
      for (int e = tid; e < 9 * 1024; e += 256) {
        int s = e >> 10, k = e & 1023;
        float v = s < 8 ? p.c[s * 1024 + k] : p.c_ctx[k];
        lds[e] = siluf_(v);
      }
      __syncthreads();
      const int col = tid & 63, kq = tid >> 6;
      const int n = cb * 64 + col;
      float acc[9];
#pragma unroll
      for (int s = 0; s < 9; ++s) acc[s] = 0.f;
      const float* wp = p.ada_w + (size_t)l * 1024 * 6144 + n;
#pragma unroll 4
      for (int k = kq * 256; k < kq * 256 + 256; ++k) {
        float w = wp[(size_t)k * 6144];
#pragma unroll
        for (int s = 0; s < 9; ++s) acc[s] += lds[s * 1024 + k] * w;
      }
      __syncthreads();
      float* red = lds + 9216;
#pragma unroll
      for (int s = 0; s < 9; ++s) red[(kq * 9 + s) * 64 + col] = acc[s];
      __syncthreads();
      for (int e = tid; e < 9 * 64; e += 256) {
        int s = e >> 6, cc = e & 63;
        float v = red[(0 * 9 + s) * 64 + cc] + red[(1 * 9 + s) * 64 + cc] + red[(2 * 9 + s) * 64 + cc] + red[(3 * 9 + s) * 64 + cc];
        int nn = cb * 64 + cc;
        p.mods[((size_t)l * 9 + s) * 6144 + nn] = v + p.ada_b[l * 6144 + nn];
      }
      __syncthreads();
    } else {
      for (int e = tid; e < 1024; e += 256) {
        int pos = e >> 4, i = e & 15;
        float inv = powf(10000.f, -(float)i / 16.f);
        float ang = (float)pos * inv;
        p.rope[e * 2] = cosf(ang);
        p.rope[e * 2 + 1] = sinf(ang);
      }
      if (tid < 64) p.cnt[tid] = 0;
    }
  }
}

DEV void norm_phase(const P& p, int l, const float* __restrict__ g, int shoff, int scoff, int row_lo, bool from_input) {
  const int tid = tid_l();
  const int lane = tid & 63;
  const int gw = bid_l() * 4 + (tid >> 6), nw = gridDim.x * 4;
  const float* lat = from_input ? p.x : p.out;
  const float* cx = from_input ? p.ctx : p.xc;
  for (int r0 = row_lo + gw; r0 < MT; r0 += 4 * nw) {
    float4 v[4][4];
#pragma unroll
    for (int u = 0; u < 4; ++u) {
      const int r = r0 + u * nw;
      if (r < MT) {
        const float* src = r < MC ? cx + (size_t)r * DM : lat + (size_t)(r - MC) * DM;
#pragma unroll
        for (int i = 0; i < 4; ++i) v[u][i] = *(const float4*)(src + i * 256 + lane * 4);
      }
    }
#pragma unroll
    for (int u = 0; u < 4; ++u) {
      const int r = r0 + u * nw;
      if (r < MT) {
        const int s = r < MC ? 8 : (r - MC) >> 12;
        const float* md = p.mods + ((size_t)l * 9 + s) * 6144;
        float ss = 0.f;
#pragma unroll
        for (int i = 0; i < 4; ++i) ss += v[u][i].x * v[u][i].x + v[u][i].y * v[u][i].y + v[u][i].z * v[u][i].z + v[u][i].w * v[u][i].w;
        ss = wave_sum(ss);
        const float rstd = rsqrtf(ss * (1.f / DM) + 1e-6f);
#pragma unroll
        for (int i = 0; i < 4; ++i) {
          const int c = i * 256 + lane * 4;
          float4 gg = *(const float4*)(g + c);
          float4 sh = *(const float4*)(md + shoff + c);
          float4 sc = *(const float4*)(md + scoff + c);
          float o0 = v[u][i].x * rstd * gg.x * (1.f + sc.x) + sh.x;
          float o1 = v[u][i].y * rstd * gg.y * (1.f + sc.y) + sh.y;
          float o2 = v[u][i].z * rstd * gg.z * (1.f + sc.z) + sh.z;
          float o3 = v[u][i].w * rstd * gg.w * (1.f + sc.w) + sh.w;
          uint2 o;
          o.x = pk2(o0, o1);
          o.y = pk2(o2, o3);
          *(uint2*)(p.act + (size_t)r * DM + c) = o;
        }
      }
    }
  }
}

DEV void final_norm(const P& p) {
  const int tid = tid_l();
  const int lane = tid & 63;
  const int gw = bid_l() * 4 + (tid >> 6), nw = gridDim.x * 4;
  for (int r0 = gw; r0 < ML; r0 += 4 * nw) {
    float4 v[4][4];
#pragma unroll
    for (int u = 0; u < 4; ++u) {
      const int r = r0 + u * nw;
      if (r < ML) {
#pragma unroll
        for (int i = 0; i < 4; ++i) v[u][i] = *(const float4*)(p.out + (size_t)r * DM + i * 256 + lane * 4);
      }
    }
#pragma unroll
    for (int u = 0; u < 4; ++u) {
      const int r = r0 + u * nw;
      if (r < ML) {
        const float rstd = rsqrtf(p.rss1[MC + r] * (1.f / DM) + 1e-6f);
#pragma unroll
        for (int i = 0; i < 4; ++i) {
          const int c = i * 256 + lane * 4;
          float4 gg = *(const float4*)(p.fng + c);
          float4 o;
          o.x = v[u][i].x * rstd * gg.x;
          o.y = v[u][i].y * rstd * gg.y;
          o.z = v[u][i].z * rstd * gg.z;
          o.w = v[u][i].w * rstd * gg.w;
          *(float4*)(p.out + (size_t)r * DM + c) = o;
        }
      }
    }
  }
}

DEV void phase0b(const P& p, char* smem) {
  float* lds = (float*)smem;
  const int tid = tid_l(), lane = tid & 63;
  for (int it = bid_l(); it < 512; it += gridDim.x) {
    const bool isz = it < 160;
    const int i2 = isz ? it : it - 160;
    const int l = isz ? i2 / 40 : i2 / 88, cb = isz ? i2 % 40 : i2 % 88;
    const int N = isz ? 2560 : 5632;
    const float* W = isz ? p.w_in + (size_t)l * 1024 * 2560 : p.w1 + (size_t)l * 1024 * 5632;
    for (int e = tid; e < 9 * 1024; e += 256) {
      const int s9 = e >> 10, k = e & 1023;
      lds[e] = p.mods[((size_t)l * 9 + s9) * 6144 + (isz ? 0 : 3072) + k];
    }
    __syncthreads();
    const int col = tid & 63, kq = tid >> 6;
    const int n = cb * 64 + col;
    float acc[9];
#pragma unroll
    for (int s9 = 0; s9 < 9; ++s9) acc[s9] = 0.f;
    const float* wp = W + n;
#pragma unroll 4
    for (int k = kq * 256; k < kq * 256 + 256; ++k) {
      const float w = wp[(size_t)k * N];
#pragma unroll
      for (int s9 = 0; s9 < 9; ++s9) acc[s9] += lds[s9 * 1024 + k] * w;
    }
    __syncthreads();
    float* red = lds + 9216;
#pragma unroll
    for (int s9 = 0; s9 < 9; ++s9) red[(kq * 9 + s9) * 64 + col] = acc[s9];
    __syncthreads();
    for (int e = tid; e < 9 * 64; e += 256) {
      const int s9 = e >> 6, cc = e & 63;
      const float v = red[(0 * 9 + s9) * 64 + cc] + red[(1 * 9 + s9) * 64 + cc] + red[(2 * 9 + s9) * 64 + cc] + red[(3 * 9 + s9) * 64 + cc];
      const int gn = cb * 64 + cc;
      if (isz) p.bz[((size_t)l * 9 + s9) * 2560 + gn] = v;
      else {
        const int j = gn < DFF ? gn : gn - DFF;
        const int np = (j >> 4) * 32 + (j & 15) + (gn < DFF ? 0 : 16);
        p.bh[((size_t)l * 9 + s9) * 5632 + np] = v;
      }
    }
    __syncthreads();
  }
  const int gw = bid_l() * 4 + (tid >> 6), nw = gridDim.x * 4;
  for (int r0 = gw; r0 < MT; r0 += 4 * nw) {
    float4 v[4][4];
#pragma unroll
    for (int u = 0; u < 4; ++u) {
      const int r = r0 + u * nw;
      if (r < MT) {
        const float* src = r < MC ? p.ctx + (size_t)r * DM : p.x + (size_t)(r - MC) * DM;
#pragma unroll
        for (int i = 0; i < 4; ++i) v[u][i] = *(const float4*)(src + i * 256 + lane * 4);
      }
    }
#pragma unroll
    for (int u = 0; u < 4; ++u) {
      const int r = r0 + u * nw;
      if (r < MT) {
        const int s9 = r < MC ? 8 : (r - MC) >> 12;
        const float* md = p.mods + (size_t)s9 * 6144 + 1024;
        float ss = 0.f;
#pragma unroll
        for (int i = 0; i < 4; ++i) ss += v[u][i].x * v[u][i].x + v[u][i].y * v[u][i].y + v[u][i].z * v[u][i].z + v[u][i].w * v[u][i].w;
        ss = wave_sum(ss);
        if (lane == 0) p.rss1[r] = ss;
#pragma unroll
        for (int i = 0; i < 4; ++i) {
          const int c = i * 256 + lane * 4;
          const float4 gg = *(const float4*)(p.n1g + c);
          const float4 sc = *(const float4*)(md + c);
          *(uint2*)(p.act + (size_t)r * DM + c) =
              make_uint2(pk2(v[u][i].x * gg.x * (1.f + sc.x), v[u][i].y * gg.y * (1.f + sc.y)),
                         pk2(v[u][i].z * gg.z * (1.f + sc.z), v[u][i].w * gg.w * (1.f + sc.w)));
        }
      }
    }
  }
}

enum { EPI_Z = 0, EPI_RES = 1, EPI_SWIGLU = 2 };
struct GX { float* rss_acc; u16* aout; const float* gnext; int lmod; int scoff; };

template <int EPI>
DEV void gemm_phase(const P& p, int l, const u16* __restrict__ A, int lda, const u16* __restrict__ Bt, int K, int NT,
                           int mt_lo, int goff, char* smem, GX gx, int dry = 0) {
  const int tid = tid_l(), lane = tid & 63, wid = tid >> 6, wr = wid >> 1, wc = wid & 1, l15 = lane & 15, quad = lane >> 4;
  const int nmt = NMT - mt_lo;
  const int nk = K / 64;
  const int npn = NT >> 2;
  const int npatch = (nmt >> 4) * npn;
  const int tmax = ((npatch + 7) >> 3) * 512;
#define G_MAP(T, OK, M0, N0)                                                                        \
  {                                                                                                 \
    const int xcd_ = (T)&7, sidx_ = (T) >> 3;                                                       \
    const int gp_ = (sidx_ >> 6) * 8 + xcd_;                                                        \
    OK = (T) < tmax && gp_ < npatch;                                                                \
    const int within_ = sidx_ & 63;                                                                 \
    M0 = (mt_lo + (gp_ / npn) * 16 + (within_ & 15)) * 128;                                         \
    N0 = ((gp_ % npn) * 4 + (within_ >> 4)) * 128;                                                  \
  }
  uint4 xa0, xa1, xa2, xa3, xb0, xb1, xb2, xb3, ya0, ya1, ya2, ya3, yb0, yb1, yb2, yb3;
  int t = bid_l();
  bool have;
  int m0, n0;
  G_MAP(t, have, m0, n0);
  const u16* Ag = A + (size_t)(m0 + (tid >> 3)) * lda + (tid & 7) * 8;
  const u16* Bg = Bt + (size_t)(n0 + (tid >> 3)) * K + (tid & 7) * 8;
  bool primed = false;
  while (have) {
    f32x4 acc[4][4];
#pragma unroll
    for (int i = 0; i < 4; ++i)
#pragma unroll
      for (int j = 0; j < 4; ++j) acc[i][j] = f32x4{0.f, 0.f, 0.f, 0.f};
#define G_GL(P, KT)                                                          \
    {                                                                        \
      const int k0_ = (KT)*64;                                               \
      P##a0 = *(const uint4*)(Ag + k0_);                                     \
      P##b0 = *(const uint4*)(Bg + k0_);                                     \
      P##a1 = *(const uint4*)(Ag + (size_t)32 * lda + k0_);                  \
      P##b1 = *(const uint4*)(Bg + (size_t)32 * K + k0_);                    \
      P##a2 = *(const uint4*)(Ag + (size_t)64 * lda + k0_);                  \
      P##b2 = *(const uint4*)(Bg + (size_t)64 * K + k0_);                    \
      P##a3 = *(const uint4*)(Ag + (size_t)96 * lda + k0_);                  \
      P##b3 = *(const uint4*)(Bg + (size_t)96 * K + k0_);                    \
    }
#define G_LS(P, BUF)                                                         \
    {                                                                        \
      char* Aw_ = smem + (BUF)*32768;                                        \
      *(uint4*)(Aw_ + swz((tid >> 3), tid & 7)) = P##a0;                     \
      *(uint4*)(Aw_ + 16384 + swz((tid >> 3), tid & 7)) = P##b0;             \
      *(uint4*)(Aw_ + swz((tid >> 3) + 32, tid & 7)) = P##a1;                \
      *(uint4*)(Aw_ + 16384 + swz((tid >> 3) + 32, tid & 7)) = P##b1;        \
      *(uint4*)(Aw_ + swz((tid >> 3) + 64, tid & 7)) = P##a2;                \
      *(uint4*)(Aw_ + 16384 + swz((tid >> 3) + 64, tid & 7)) = P##b2;        \
      *(uint4*)(Aw_ + swz((tid >> 3) + 96, tid & 7)) = P##a3;                \
      *(uint4*)(Aw_ + 16384 + swz((tid >> 3) + 96, tid & 7)) = P##b3;        \
    }
#define G_COMPUTE(BUF)                                                                                             \
    {                                                                                                              \
      const char* As = smem + (BUF)*32768;                                                                         \
      const char* Bs = As + 16384;                                                                                 \
      _Pragma("unroll") for (int kh = 0; kh < 2; ++kh) {                                                           \
        bf16x8 a[4], b[4];                                                                                         \
        _Pragma("unroll") for (int mi = 0; mi < 4; ++mi)                                                           \
            a[mi] = *(const bf16x8*)(As + swz(wr * 64 + mi * 16 + l15, kh * 4 + quad));                            \
        _Pragma("unroll") for (int ni = 0; ni < 4; ++ni)                                                           \
            b[ni] = *(const bf16x8*)(Bs + swz(wc * 64 + ni * 16 + l15, kh * 4 + quad));                            \
        _Pragma("unroll") for (int mi = 0; mi < 4; ++mi)                                                           \
            _Pragma("unroll") for (int ni = 0; ni < 4; ++ni) acc[mi][ni] = mfma16(b[ni], a[mi], acc[mi][ni]);      \
      }                                                                                                            \
    }
    if (!primed) {
      G_GL(x, 0);
      G_GL(y, 1);
    }
    G_LS(x, 0);
    if (2 < nk) G_GL(x, 2);
    __syncthreads();
    for (int kt = 0; kt < nk; kt += 2) {
      G_COMPUTE(0);
      G_LS(y, 1);
      if (kt + 3 < nk) G_GL(y, kt + 3);
      __syncthreads();
      G_COMPUTE(1);
      if (kt + 2 < nk) G_LS(x, 0);
      if (kt + 4 < nk) G_GL(x, kt + 4);
      __syncthreads();
    }
    const int em0 = m0, en0 = n0;
    t += gridDim.x;
    G_MAP(t, have, m0, n0);
    if (have) {
      Ag = A + (size_t)(m0 + (tid >> 3)) * lda + (tid & 7) * 8;
      Bg = Bt + (size_t)(n0 + (tid >> 3)) * K + (tid & 7) * 8;
      G_GL(x, 0);
      G_GL(y, 1);
      primed = true;
    }
    if (dry) {
      if (acc[0][0][0] == 1.2345e33f) p.bonus[0] = acc[1][1][1] + acc[2][2][2] + acc[3][3][3];
      continue;
    }
    const int cw0 = en0 + wc * 64;
    if constexpr (EPI == EPI_Z || EPI == EPI_SWIGLU) {
      const int sb_ = em0 < MC ? 8 : (em0 - MC) >> 12;
      const float* rssp = EPI == EPI_Z ? p.rss1 : p.rss2;
      const float* bias = EPI == EPI_Z ? p.bz + ((size_t)l * 9 + sb_) * 2560 + cw0 : p.bh + ((size_t)l * 9 + sb_) * 5632 + cw0;
      float rsv[4];
#pragma unroll
      for (int mi = 0; mi < 4; ++mi) rsv[mi] = rsqrtf(rssp[em0 + wr * 64 + mi * 16 + l15] * (1.f / DM) + 1e-6f);
#pragma unroll
      for (int ni = 0; ni < 4; ++ni) {
        const float4 bb = *(const float4*)(bias + ni * 16 + quad * 4);
#pragma unroll
        for (int mi = 0; mi < 4; ++mi) {
          acc[mi][ni][0] = acc[mi][ni][0] * rsv[mi] + bb.x;
          acc[mi][ni][1] = acc[mi][ni][1] * rsv[mi] + bb.y;
          acc[mi][ni][2] = acc[mi][ni][2] * rsv[mi] + bb.z;
          acc[mi][ni][3] = acc[mi][ni][3] * rsv[mi] + bb.w;
        }
      }
    }
    if constexpr (EPI == EPI_Z) {
      if (cw0 < 1920) {
#pragma unroll
        for (int mi = 0; mi < 4; ++mi) {
          const int r = em0 + wr * 64 + mi * 16 + l15;
#pragma unroll
          for (int ni = 0; ni < 4; ++ni)
            *(uint2*)(p.z + (size_t)r * INC + cw0 + ni * 16 + quad * 4) =
                make_uint2(pk2(acc[mi][ni][0], acc[mi][ni][1]), pk2(acc[mi][ni][2], acc[mi][ni][3]));
          __builtin_amdgcn_sched_barrier(0);
        }
      } else {
        const int hh = (cw0 - 1920) >> 6;
        if (hh < 8) {
          const float* gp = (hh < 6 ? p.q_g : p.k_g) + l * 64;
          float4 gv[4];
#pragma unroll
          for (int ni = 0; ni < 4; ++ni) gv[ni] = *(const float4*)(gp + ni * 16 + quad * 4);
          const float qs = hh < 6 ? 0.125f : 1.f;
#pragma unroll
          for (int mi = 0; mi < 4; ++mi) {
            const int r = em0 + wr * 64 + mi * 16 + l15;
            float ss = 0.f;
#pragma unroll
            for (int ni = 0; ni < 4; ++ni)
#pragma unroll
              for (int j = 0; j < 4; ++j) ss += acc[mi][ni][j] * acc[mi][ni][j];
            ss += __shfl_xor(ss, 16);
            ss += __shfl_xor(ss, 32);
            const float rstd = rsqrtf(ss * (1.f / 64.f) + 1e-6f) ;
            float yv[4][4];
#pragma unroll
            for (int ni = 0; ni < 4; ++ni) {
              yv[ni][0] = acc[mi][ni][0] * rstd * gv[ni].x;
              yv[ni][1] = acc[mi][ni][1] * rstd * gv[ni].y;
              yv[ni][2] = acc[mi][ni][2] * rstd * gv[ni].z;
              yv[ni][3] = acc[mi][ni][3] * rstd * gv[ni].w;
            }
            if (r >= MC) {
              const int tt = (r - MC) & 4095;
              const int prow = tt >> 6, pcol = tt & 63;
              const float* rr_ = p.rope + (prow * 16 + quad * 4) * 2;
              const float* rc_ = p.rope + (pcol * 16 + quad * 4) * 2;
              const float4 ra = *(const float4*)rr_, rb = *(const float4*)(rr_ + 4);
              const float4 ca = *(const float4*)rc_, cb = *(const float4*)(rc_ + 4);
              const float cr[4] = {ra.x, ra.z, rb.x, rb.z}, sr[4] = {ra.y, ra.w, rb.y, rb.w};
              const float cc[4] = {ca.x, ca.z, cb.x, cb.z}, sc[4] = {ca.y, ca.w, cb.y, cb.w};
#pragma unroll
              for (int j = 0; j < 4; ++j) {
                const float a0 = yv[0][j] * cr[j] - yv[1][j] * sr[j], a1 = yv[1][j] * cr[j] + yv[0][j] * sr[j];
                const float a2 = yv[2][j] * cc[j] - yv[3][j] * sc[j], a3 = yv[3][j] * cc[j] + yv[2][j] * sc[j];
                yv[0][j] = a0; yv[1][j] = a1; yv[2][j] = a2; yv[3][j] = a3;
              }
            }
#pragma unroll
            for (int ni = 0; ni < 4; ++ni)
              *(uint2*)(p.z + (size_t)r * INC + cw0 + ni * 16 + quad * 4) =
                  make_uint2(pk2(yv[ni][0] * qs, yv[ni][1] * qs), pk2(yv[ni][2] * qs, yv[ni][3] * qs));
            __builtin_amdgcn_sched_barrier(0);
          }
        } else {
          const int kvh = hh - 8;
#pragma unroll
          for (int mi = 0; mi < 4; ++mi) {
            const int r = em0 + wr * 64 + mi * 16 + l15;
            u16* vb;
            int vstride;
            if (r < MC) { vb = p.vTc + ((size_t)(((r >> 8) * 2 + kvh) * 64)) * CTXL + (r & 255); vstride = CTXL; }
            else { const int rr = r - MC; vb = p.vTl + ((size_t)(((rr >> 12) * 2 + kvh) * 64)) * SEQ + (rr & 4095); vstride = SEQ; }
#pragma unroll
            for (int ni = 0; ni < 4; ++ni)
#pragma unroll
              for (int j = 0; j < 4; ++j) vb[(size_t)(ni * 16 + quad * 4 + j) * vstride] = f2bf(acc[mi][ni][j]);
            __builtin_amdgcn_sched_barrier(0);
          }
        }
      }
    } else if constexpr (EPI == EPI_RES) {
      const int s = em0 < MC ? 8 : (em0 - MC) >> 12;
      const float* gate = p.mods + ((size_t)l * 9 + s) * 6144 + goff;
      float4 gv[4], gm[4];
#pragma unroll
      for (int ni = 0; ni < 4; ++ni) {
        gv[ni] = *(const float4*)(gate + cw0 + ni * 16 + quad * 4);
        gm[ni] = make_float4(0.f, 0.f, 0.f, 0.f);
        if (gx.aout) {
          const float4 g4 = *(const float4*)(gx.gnext + cw0 + ni * 16 + quad * 4);
          const float4 s4 = *(const float4*)(p.mods + ((size_t)gx.lmod * 9 + s) * 6144 + gx.scoff + cw0 + ni * 16 + quad * 4);
          gm[ni] = make_float4(g4.x * (1.f + s4.x), g4.y * (1.f + s4.y), g4.z * (1.f + s4.z), g4.w * (1.f + s4.w));
        }
      }
#pragma unroll
      for (int mi = 0; mi < 4; ++mi) {
        const int r = em0 + wr * 64 + mi * 16 + l15;
        const float* src;
        if (l == 0 && goff == 2048) src = r < MC ? p.ctx + (size_t)r * DM : p.x + (size_t)(r - MC) * DM;
        else src = r < MC ? p.xc + (size_t)r * DM : p.out + (size_t)(r - MC) * DM;
        float* dst = r < MC ? p.xc + (size_t)r * DM : p.out + (size_t)(r - MC) * DM;
        float ssq = 0.f;
#pragma unroll
        for (int ni = 0; ni < 4; ++ni) {
          const int c = cw0 + ni * 16 + quad * 4;
          const float4 xv = *(const float4*)(src + c);
          float4 o;
          o.x = xv.x + gv[ni].x * acc[mi][ni][0];
          o.y = xv.y + gv[ni].y * acc[mi][ni][1];
          o.z = xv.z + gv[ni].z * acc[mi][ni][2];
          o.w = xv.w + gv[ni].w * acc[mi][ni][3];
          *(float4*)(dst + c) = o;
          ssq += o.x * o.x + o.y * o.y + o.z * o.z + o.w * o.w;
          if (gx.aout) {
            *(uint2*)(gx.aout + (size_t)r * DM + c) =
                make_uint2(pk2(o.x * gm[ni].x, o.y * gm[ni].y), pk2(o.z * gm[ni].z, o.w * gm[ni].w));
          }
        }
        ssq += __shfl_xor(ssq, 16);
        ssq += __shfl_xor(ssq, 32);
        if (quad == 0) {
          const float old_ = unsafeAtomicAdd(gx.rss_acc + r, ssq);
          asm volatile("" ::"v"(old_));
        }
        __builtin_amdgcn_sched_barrier(0);
      }
    } else {
      const int hc0 = (en0 >> 1) + wc * 32;
#pragma unroll
      for (int mi = 0; mi < 4; ++mi) {
        const int r = em0 + wr * 64 + mi * 16 + l15;
#pragma unroll
        for (int pp = 0; pp < 2; ++pp) {
          float hv[4];
#pragma unroll
          for (int j = 0; j < 4; ++j) hv[j] = siluf_(acc[mi][2 * pp][j]) * acc[mi][2 * pp + 1][j];
          *(uint2*)(p.h + (size_t)r * DFF + hc0 + pp * 16 + quad * 4) = make_uint2(pk2(hv[0], hv[1]), pk2(hv[2], hv[3]));
        }
        __builtin_amdgcn_sched_barrier(0);
      }
    }
  }
}
#undef G_GL
#undef G_LS
#undef G_COMPUTE
#undef G_MAP

template <int LPR>
DEV float red_lpr(float v) {
  v += dppf<0xB1>(v);
  v += dppf<0x4E>(v);
  if (LPR >= 8) v += dppf<0x141>(v);
  if (LPR >= 16) v += dppf<0x140>(v);
  return v;
}

constexpr int SCAN_LPR = 8;
constexpr int SCAN_RPB = 256 / SCAN_LPR;
constexpr int SCAN_NPART = 64 / SCAN_RPB;
constexpr int SCAN_JL = 64 / SCAN_LPR;
constexpr int SCAN_ITEMS = 96 * SCAN_NPART;

DEV float red8_sum(float v) {
  v += dppf<0xB1>(v);
  v += dppf<0x4E>(v);
  v += dppf<0x141>(v);
  return v;
}
DEV float tanh_fast(float x) {
  float e = __expf(2.f * x);
  return 1.f - 2.f * __builtin_amdgcn_rcpf(1.f + e);
}

struct ChunkPos { int len, rowbase, tlo; };
DEV ChunkPos chunk_pos(int c, int d, int b) {
  ChunkPos cp;
  const int s0 = c * 16;
  int pos0;
  if (s0 < 256) { cp.len = 256; pos0 = s0; cp.rowbase = b * 256; }
  else { cp.len = 4096; pos0 = s0 - 256; cp.rowbase = MC + b * 4096; }
  cp.tlo = d ? (cp.len - 16 - pos0) : pos0;
  return cp;
}

constexpr int SC_R = 0, SC_KD = 12288, SC_V = 24576, SC_W = 30720, SC_KA = 38912, SC_NKK = 47104;

DEV void cvt8(const uint4 u, float4& lo, float4& hi) {
  lo.x = __uint_as_float(u.x << 16); lo.y = __uint_as_float(u.x & 0xffff0000u);
  lo.z = __uint_as_float(u.y << 16); lo.w = __uint_as_float(u.y & 0xffff0000u);
  hi.x = __uint_as_float(u.z << 16); hi.y = __uint_as_float(u.z & 0xffff0000u);
  hi.z = __uint_as_float(u.w << 16); hi.w = __uint_as_float(u.w & 0xffff0000u);
}

DEV void scan_item(const P& p, int l, int item, char* smem) {
  const int tid = tid_l(), lane = tid & 63, wid = tid >> 6, l15 = lane & 15, quad = lane >> 4;
  constexpr int LPR = SCAN_LPR, RPB = SCAN_RPB, JL = SCAN_JL, NV = RPB / 8;
  const int scan = item / SCAN_NPART, part = item % SCAN_NPART;
  const int d = scan / 48, b = (scan % 48) / 6, h = scan % 6;
  const int rloc = tid / LPR, jq = tid % LPR;
  const int irow = part * RPB + rloc;
  const int j0 = jq * JL;

  const int c_ts = (tid & 127) >> 3, c_ch = tid & 7;
  const int c_col = (tid < 128 ? 0 : 384) + h * 64 + c_ch * 8;
  const int v_ts = tid / NV, v_ch = tid % NV;
  const int v_col = 768 + h * 64 + part * RPB + v_ch * 8;

  const int n2 = wid * 16 + l15;
  bf16x8 bW[2], bA[2];
  {
    const u16* wb = p.wUpT + ((size_t)(l * 2 + d) * 384 + h * 64 + n2) * 64 + quad * 8;
    const u16* ab = p.aUpT + ((size_t)(l * 2 + d) * 384 + h * 64 + n2) * 64 + quad * 8;
    bW[0] = *(const bf16x8*)(wb);
    bW[1] = *(const bf16x8*)(wb + 32);
    bA[0] = *(const bf16x8*)(ab);
    bA[1] = *(const bf16x8*)(ab + 32);
  }
  const float w0v = p.w0[(size_t)(l * 2 + d) * 384 + h * 64 + n2];
  const float a0v = p.a0[(size_t)(l * 2 + d) * 384 + h * 64 + n2];
  const float kkc = p.k_k[l * 384 + h * 64 + n2], kac = p.k_a[l * 384 + h * 64 + n2], rkc = p.r_k[l * 384 + h * 64 + n2];

  float2v S2[JL / 2];
#pragma unroll
  for (int j = 0; j < JL / 2; ++j) S2[j] = float2v{0.f, 0.f};
  uint4 g_rk, g_v;
  bf16x8 g_wd0, g_wd1, g_ad0, g_ad1;
  float g_inv[4];

#define SC_GLOAD1(CC)                                                                                  \
  {                                                                                                    \
    const ChunkPos cp_ = chunk_pos((CC), d, b);                                                        \
    g_rk = *(const uint4*)(p.z + (size_t)(cp_.rowbase + cp_.tlo + c_ts) * INC + c_col);                \
    if (tid < 16 * NV) g_v = *(const uint4*)(p.z + (size_t)(cp_.rowbase + cp_.tlo + v_ts) * INC + v_col);  \
  }
#define SC_GLOAD2(CC)                                                                                  \
  {                                                                                                    \
    const ChunkPos cp_ = chunk_pos((CC), d, b);                                                        \
    const u16* rp_ = p.z + (size_t)(cp_.rowbase + cp_.tlo + l15) * INC + 1152 + quad * 8;              \
    g_wd0 = *(const bf16x8*)(rp_);                                                                     \
    g_wd1 = *(const bf16x8*)(rp_ + 32);                                                                \
    g_ad0 = *(const bf16x8*)(rp_ + 64);                                                                \
    g_ad1 = *(const bf16x8*)(rp_ + 96);                                                                \
    _Pragma("unroll") for (int j = 0; j < 4; ++j)                                                      \
      g_inv[j] = p.invn[(size_t)(cp_.rowbase + cp_.tlo + quad * 4 + j) * 8 + h];                       \
  }
#define SC_STAGE1(CC)                                                                                  \
  {                                                                                                    \
    const int i3_ = (CC) % 3;                                                                          \
    float4 lo_, hi_;                                                                                   \
    cvt8(g_rk, lo_, hi_);                                                                              \
    float* dst_ = (float*)(smem + (tid < 128 ? SC_R : SC_KD) + i3_ * 4096) + c_ts * 64 + c_ch * 8;     \
    *(float4*)dst_ = lo_;                                                                              \
    *(float4*)(dst_ + 4) = hi_;                                                                        \
    if (tid < 16 * NV) {                                                                               \
      cvt8(g_v, lo_, hi_);                                                                             \
      float* dv_ = (float*)(smem + SC_V + i3_ * 2048) + v_ts * RPB + v_ch * 8;                         \
      *(float4*)dv_ = lo_;                                                                             \
      *(float4*)(dv_ + 4) = hi_;                                                                       \
    }                                                                                                  \
  }
#define SC_STAGE2(CC)                                                                                  \
  {                                                                                                    \
    const int i3_ = (CC) % 3, i2_ = (CC)&1;                                                            \
    f32x4 accW = f32x4{0.f, 0.f, 0.f, 0.f}, accA = f32x4{0.f, 0.f, 0.f, 0.f};                          \
    accW = mfma16(g_wd0, bW[0], accW);                                                                 \
    accW = mfma16(g_wd1, bW[1], accW);                                                                 \
    accA = mfma16(g_ad0, bA[0], accA);                                                                 \
    accA = mfma16(g_ad1, bA[1], accA);                                                                 \
    _Pragma("unroll") for (int j = 0; j < 4; ++j) {                                                    \
      const int ts = quad * 4 + j;                                                                     \
      float* kdp = (float*)(smem + SC_KD + i3_ * 4096) + ts * 64 + n2;                                 \
      const float kv = *kdp;                                                                           \
      const float sg = sigmoidf_(w0v + accW[j]);                                                       \
      const float wv = __expf(-0.6065306597126334f * sg);                                              \
      const float av = sigmoidf_(a0v + accA[j]);                                                       \
      const float kn = kv * kkc * g_inv[j];                                                            \
      const float kd = kv * (1.f + (av - 1.f) * kac);                                                  \
      *((float*)(smem + SC_W + i2_ * 4096) + ts * 64 + n2) = wv;                                       \
      *((float*)(smem + SC_NKK + i2_ * 4096) + ts * 64 + n2) = -kn;                                    \
      *((float*)(smem + SC_KA + i2_ * 4096) + ts * 64 + n2) = kn * av;                                 \
      *kdp = kd;                                                                                       \
    }                                                                                                  \
  }

  __builtin_amdgcn_s_setprio(3);
  SC_GLOAD1(0);
  SC_GLOAD2(0);
  SC_STAGE1(0);
  SC_GLOAD1(1);
  __syncthreads();
  SC_STAGE2(0);
  SC_STAGE1(1);
  SC_GLOAD1(2);
  SC_GLOAD2(1);
  __syncthreads();

  for (int c = 0; c < 272; ++c) {
    {
      const int i3 = c % 3, i2 = c & 1;
      const ChunkPos cp = chunk_pos(c, d, b);
      const float* pW = (const float*)(smem + SC_W + i2 * 4096) + j0;
      const float* pN = (const float*)(smem + SC_NKK + i2 * 4096) + j0;
      const float* pA = (const float*)(smem + SC_KA + i2 * 4096) + j0;
      const float* pD = (const float*)(smem + SC_KD + i3 * 4096) + j0;
      const float* pR = (const float*)(smem + SC_R + i3 * 4096) + j0;
      const float* pV = (const float*)(smem + SC_V + i3 * 2048) + rloc;
      float* yp = p.y + ((size_t)d * MT + cp.rowbase + cp.tlo) * 384 + h * 64 + irow;
      float yk0 = 0.f, yk1 = 0.f;
      constexpr int NQ = JL / 4;
      float4 cw[NQ], cn[NQ], ca[NQ], cd[NQ], cr[NQ];
      float cvi;
#define SC_LD(TS, W, N, A, D, R, VI)                                                             \
      _Pragma("unroll") for (int q = 0; q < NQ; ++q) {                                           \
        W[q] = *(const float4*)(pW + (TS)*64 + q * 4); N[q] = *(const float4*)(pN + (TS)*64 + q * 4); \
        A[q] = *(const float4*)(pA + (TS)*64 + q * 4); D[q] = *(const float4*)(pD + (TS)*64 + q * 4); \
        R[q] = *(const float4*)(pR + (TS)*64 + q * 4);                                           \
      }                                                                                          \
      VI = pV[(TS)*RPB];
      {
        const int ts0 = d ? 15 : 0;
        SC_LD(ts0, cw, cn, ca, cd, cr, cvi)
      }
#pragma unroll
      for (int si = 0; si < 16; ++si) {
        float4 xw[NQ], xn[NQ], xa[NQ], xd[NQ], xr[NQ];
        float xvi = 0.f;
        if (si + 1 < 16) {
          const int tsn = d ? 14 - si : si + 1;
          SC_LD(tsn, xw, xn, xa, xd, xr, xvi)
        }
        float2v sa2 = S2[0] * float2v{cn[0].x, cn[0].y};
        sa2 = S2[1] * float2v{cn[0].z, cn[0].w} + sa2;
        if constexpr (NQ == 2) {
          float2v sb2 = S2[2] * float2v{cn[1].x, cn[1].y};
          sb2 = S2[3] * float2v{cn[1].z, cn[1].w} + sb2;
          sa2 = sa2 + sb2;
        }
        const float2v viv = float2v{cvi, cvi};
        float2v u2[JL / 2];
#pragma unroll
        for (int q = 0; q < NQ; ++q) {
          u2[2 * q] = S2[2 * q] * float2v{cw[q].x, cw[q].y} + viv * float2v{cd[q].x, cd[q].y};
          u2[2 * q + 1] = S2[2 * q + 1] * float2v{cw[q].z, cw[q].w} + viv * float2v{cd[q].z, cd[q].w};
        }
        const float sa = LPR == 16 ? red16_sum(sa2.x + sa2.y) : red8_sum(sa2.x + sa2.y);
        const float2v sav = float2v{sa, sa};
#pragma unroll
        for (int q = 0; q < NQ; ++q) {
          S2[2 * q] = sav * float2v{ca[q].x, ca[q].y} + u2[2 * q];
          S2[2 * q + 1] = sav * float2v{ca[q].z, ca[q].w} + u2[2 * q + 1];
        }
        float2v y2 = S2[0] * float2v{cr[0].x, cr[0].y};
        y2 = S2[1] * float2v{cr[0].z, cr[0].w} + y2;
        if constexpr (NQ == 2) {
          float2v yb2 = S2[2] * float2v{cr[1].x, cr[1].y};
          yb2 = S2[3] * float2v{cr[1].z, cr[1].w} + yb2;
          y2 = y2 + yb2;
        }
        const float yv = LPR == 16 ? red16_sum(y2.x + y2.y) : red8_sum(y2.x + y2.y);
        if (si < LPR) yk0 = (jq == si) ? yv : yk0;
        else yk1 = (jq == si - LPR) ? yv : yk1;
        if (si + 1 < 16) {
#pragma unroll
          for (int q = 0; q < NQ; ++q) { cw[q] = xw[q]; cn[q] = xn[q]; ca[q] = xa[q]; cd[q] = xd[q]; cr[q] = xr[q]; }
          cvi = xvi;
        }
      }
#undef SC_LD
      {
        const int tsa = d ? 15 - jq : jq;
        yp[(size_t)tsa * 384] = yk0;
        if constexpr (LPR == 8) {
          const int tsb = d ? 7 - jq : 8 + jq;
          yp[(size_t)tsb * 384] = yk1;
        }
      }
    }
    if (c + 1 < 272) SC_STAGE2(c + 1);
    if (c + 2 < 272) SC_STAGE1(c + 2);
    if (c + 3 < 272) SC_GLOAD1(c + 3);
    if (c + 2 < 272) SC_GLOAD2(c + 2);
    __syncthreads();
  }
  __builtin_amdgcn_s_setprio(0);
#undef SC_GLOAD1
#undef SC_GLOAD2
#undef SC_STAGE1
#undef SC_STAGE2
}

DEV void attn_item(const P& p, int item, char* smem) {
  const int tid = tid_l(), lane = tid & 63, wid = tid >> 6, l15 = lane & 15, quad = lane >> 4;
  bool lat = item < 1536;
  int b, hq, qb;
  if (lat) { b = item / 192; int rem = item % 192; hq = rem / 32; qb = rem % 32; }
  else { int i2 = item - 1536; b = i2 / 12; int rem = i2 % 12; hq = rem / 2; qb = rem % 2; }
  const int kvh = hq / 3;
  const int qrow0 = lat ? MC + b * 4096 + qb * 128 : b * 256 + qb * 128;
  const int nkt = lat ? 68 : 4;
  const float LOG2E = 1.4426950408889634f;

  bf16x8 qf[2][2];
#pragma unroll
  for (int mi = 0; mi < 2; ++mi)
#pragma unroll
    for (int ks = 0; ks < 2; ++ks)
      qf[mi][ks] = *(const bf16x8*)(p.z + (size_t)(qrow0 + wid * 32 + mi * 16 + l15) * INC + 1920 + hq * 64 + ks * 32 + quad * 8);

  f32x4 Ot[2][4];
  float mrow[2], lpart[2];
#pragma unroll
  for (int mi = 0; mi < 2; ++mi) {
#pragma unroll
    for (int nd = 0; nd < 4; ++nd) Ot[mi][nd] = f32x4{0.f, 0.f, 0.f, 0.f};
    mrow[mi] = -1e30f;
    lpart[mi] = 0.f;
  }
  const int lrow = tid >> 3, lch = tid & 7;
  uint4 rk0, rk1, rv0, rv1;
#define ATT_GLOAD(KT)                                                                         \
  {                                                                                           \
    const int kt_ = (KT);                                                                     \
    const u16* kp;                                                                            \
    const u16* vp;                                                                            \
    int vstride;                                                                              \
    if (lat && kt_ < 64) {                                                                    \
      kp = p.z + (size_t)(MC + b * 4096 + kt_ * 64) * INC + 2304 + kvh * 64;                  \
      vp = p.vTl + (size_t)((b * 2 + kvh) * 64) * SEQ + kt_ * 64;                             \
      vstride = SEQ;                                                                          \
    } else {                                                                                  \
      const int kc = lat ? kt_ - 64 : kt_;                                                    \
      kp = p.z + (size_t)(b * 256 + kc * 64) * INC + 2304 + kvh * 64;                         \
      vp = p.vTc + (size_t)((b * 2 + kvh) * 64) * CTXL + kc * 64;                             \
      vstride = CTXL;                                                                         \
    }                                                                                         \
    rk0 = *(const uint4*)(kp + (size_t)(lrow)*INC + lch * 8);                                 \
    rk1 = *(const uint4*)(kp + (size_t)(lrow + 32) * INC + lch * 8);                          \
    rv0 = *(const uint4*)(vp + (size_t)(lrow)*vstride + lch * 8);                             \
    rv1 = *(const uint4*)(vp + (size_t)(lrow + 32) * vstride + lch * 8);                      \
  }
#define ATT_LSTORE(BUF)                                     \
  {                                                         \
    char* Kb_ = smem + (BUF)*16384;                         \
    *(uint4*)(Kb_ + swz(lrow, lch)) = rk0;                  \
    *(uint4*)(Kb_ + swz(lrow + 32, lch)) = rk1;             \
    *(uint4*)(Kb_ + 8192 + swz(lrow, lch)) = rv0;           \
    *(uint4*)(Kb_ + 8192 + swz(lrow + 32, lch)) = rv1;      \
  }
  ATT_GLOAD(0);
  ATT_LSTORE(0);
  __syncthreads();
  for (int kt = 0; kt < nkt; ++kt) {
    const int buf = kt & 1;
    if (kt + 1 < nkt) ATT_GLOAD(kt + 1);
    const char* Kb = smem + buf * 16384;
    const char* Vb = Kb + 8192;
    f32x4 St[2][4];
#pragma unroll
    for (int mi = 0; mi < 2; ++mi)
#pragma unroll
      for (int ni = 0; ni < 4; ++ni) St[mi][ni] = f32x4{0.f, 0.f, 0.f, 0.f};
#pragma unroll
    for (int ks = 0; ks < 2; ++ks) {
      bf16x8 kf[4];
#pragma unroll
      for (int ni = 0; ni < 4; ++ni) kf[ni] = *(const bf16x8*)(Kb + swz(ni * 16 + l15, ks * 4 + quad));
#pragma unroll
      for (int mi = 0; mi < 2; ++mi)
#pragma unroll
        for (int ni = 0; ni < 4; ++ni) St[mi][ni] = mfma16(kf[ni], qf[mi][ks], St[mi][ni]);
    }
    bf16x8 pf[2][2];
#pragma unroll
    for (int mi = 0; mi < 2; ++mi) {
      float mx = St[mi][0][0];
#pragma unroll
      for (int ni = 0; ni < 4; ++ni)
#pragma unroll
        for (int jj = 0; jj < 4; ++jj) mx = fmaxf(mx, St[mi][ni][jj]);
      mx = fmaxf(mx, __shfl_xor(mx, 16));
      mx = fmaxf(mx, __shfl_xor(mx, 32));
      const float mnew = fmaxf(mrow[mi], mx);
      const float alpha = __builtin_amdgcn_exp2f((mrow[mi] - mnew) * LOG2E);
      mrow[mi] = mnew;
      const float mb = mnew * LOG2E;
      float ps = 0.f;
      float pv[4][4];
#pragma unroll
      for (int ni = 0; ni < 4; ++ni)
#pragma unroll
        for (int jj = 0; jj < 4; ++jj) {
          pv[ni][jj] = __builtin_amdgcn_exp2f(St[mi][ni][jj] * LOG2E - mb);
          ps += pv[ni][jj];
        }
      lpart[mi] = lpart[mi] * alpha + ps;
#pragma unroll
      for (int nd = 0; nd < 4; ++nd) {
        Ot[mi][nd][0] *= alpha; Ot[mi][nd][1] *= alpha; Ot[mi][nd][2] *= alpha; Ot[mi][nd][3] *= alpha;
      }
#pragma unroll
      for (int s2 = 0; s2 < 2; ++s2) {
        union { unsigned u[4]; bf16x8 v; } pk;
        pk.u[0] = pk2(pv[2 * s2][0], pv[2 * s2][1]);
        pk.u[1] = pk2(pv[2 * s2][2], pv[2 * s2][3]);
        pk.u[2] = pk2(pv[2 * s2 + 1][0], pv[2 * s2 + 1][1]);
        pk.u[3] = pk2(pv[2 * s2 + 1][2], pv[2 * s2 + 1][3]);
        pf[mi][s2] = pk.v;
      }
    }
#pragma unroll
    for (int s2 = 0; s2 < 2; ++s2) {
      bf16x8 vf[4];
#pragma unroll
      for (int nd = 0; nd < 4; ++nd) {
        const int drow = nd * 16 + l15;
        union { uint2 h[2]; bf16x8 v; } vv;
        vv.h[0] = *(const uint2*)(Vb + swz(drow, 4 * s2 + (quad >> 1)) + (quad & 1) * 8);
        vv.h[1] = *(const uint2*)(Vb + swz(drow, 4 * s2 + 2 + (quad >> 1)) + (quad & 1) * 8);
        vf[nd] = vv.v;
      }
#pragma unroll
      for (int mi = 0; mi < 2; ++mi)
#pragma unroll
        for (int nd = 0; nd < 4; ++nd) Ot[mi][nd] = mfma16(vf[nd], pf[mi][s2], Ot[mi][nd]);
    }
    if (kt + 1 < nkt) ATT_LSTORE(buf ^ 1);
    __syncthreads();
  }
#undef ATT_GLOAD
#undef ATT_LSTORE
#pragma unroll
  for (int mi = 0; mi < 2; ++mi) {
    float lsum = lpart[mi];
    lsum += __shfl_xor(lsum, 16);
    lsum += __shfl_xor(lsum, 32);
    const float inv = 1.f / lsum;
    const int r = qrow0 + wid * 32 + mi * 16 + l15;
#pragma unroll
    for (int nd = 0; nd < 4; ++nd)
      *(uint2*)(p.act + (size_t)r * DM + 640 + hq * 64 + nd * 16 + quad * 4) =
          make_uint2(pk2(Ot[mi][nd][0] * inv, Ot[mi][nd][1] * inv), pk2(Ot[mi][nd][2] * inv, Ot[mi][nd][3] * inv));
  }
}

DEV void sgate_item(const P& p, int l, int ck, int g, char* smem) {
  const int tid = tid_l(), lane = tid & 63, wid = tid >> 6, l15 = lane & 15, quad = lane >> 4;
  const int m0 = ck * 128;
  u16* sVT = (u16*)smem;
  {
    const int q = tid >> 1, half = tid & 1;
    const u16* src = p.z + (size_t)(m0 + q) * INC + 1408 + 256 + g * 64 + half * 32;
    float v[32];
    float ss = 0.f;
#pragma unroll
    for (int cidx = 0; cidx < 4; ++cidx) {
      uint4 u = *(const uint4*)(src + cidx * 8);
      unsigned uu[4] = {u.x, u.y, u.z, u.w};
#pragma unroll
      for (int e = 0; e < 4; ++e) {
        float f0 = geluf_(bf2f((u16)(uu[e] & 0xffff)));
        float f1 = geluf_(bf2f((u16)(uu[e] >> 16)));
        v[cidx * 8 + e * 2] = f0;
        v[cidx * 8 + e * 2 + 1] = f1;
        ss += f0 * f0 + f1 * f1;
      }
    }
    ss += __shfl_xor(ss, 1);
    const float rstd = rsqrtf(ss * (1.f / 64.f) + 1e-6f);
    const float* gn = p.sgn + l * 256 + g * 64 + half * 32;
#pragma unroll
    for (int e = 0; e < 32; ++e) sVT[(half * 32 + e) * 136 + q] = f2bf(v[e] * rstd * gn[e]);
  }
  __syncthreads();
  f32x4 acc[2][4];
#pragma unroll
  for (int mi = 0; mi < 2; ++mi)
#pragma unroll
    for (int ni = 0; ni < 4; ++ni) acc[mi][ni] = f32x4{0.f, 0.f, 0.f, 0.f};
  const u16* Wg = p.sgW + (size_t)(l * 4 + g) * 128 * 128;
#pragma unroll
  for (int ks = 0; ks < 4; ++ks) {
    bf16x8 a[2], bb[4];
#pragma unroll
    for (int mi = 0; mi < 2; ++mi) a[mi] = *(const bf16x8*)(Wg + (size_t)(wid * 32 + mi * 16 + l15) * 128 + ks * 32 + quad * 8);
#pragma unroll
    for (int ni = 0; ni < 4; ++ni) bb[ni] = *(const bf16x8*)(sVT + (ni * 16 + l15) * 136 + ks * 32 + quad * 8);
#pragma unroll
    for (int mi = 0; mi < 2; ++mi)
#pragma unroll
      for (int ni = 0; ni < 4; ++ni) acc[mi][ni] = mfma16(a[mi], bb[ni], acc[mi][ni]);
  }
#pragma unroll
  for (int mi = 0; mi < 2; ++mi)
#pragma unroll
    for (int j = 0; j < 4; ++j) {
      const int pr = wid * 32 + mi * 16 + quad * 4 + j;
      const float bias = p.sg_b[(size_t)(l * 4 + g) * 128 + pr];
#pragma unroll
      for (int ni = 0; ni < 4; ++ni) {
        const int c = ni * 16 + l15;
        float u = geluf_(bf2f(p.z[(size_t)(m0 + pr) * INC + 1408 + g * 64 + c]));
        p.act[(size_t)(m0 + pr) * DM + 384 + g * 64 + c] = f2bf(u * (acc[mi][ni][j] + bias));
      }
    }
  __syncthreads();
}

DEV void mix_phase(const P& p, int l, char* smem, int cidx) {
  __shared__ int s_item;
  const bool last = (l == DEPTH - 1);
  const int n_attn = last ? 1536 : 1632;
  const int ck_lo = last ? 16 : 0;
  const int n_sg = (NMT - ck_lo) * 4;
  const int total = SCAN_ITEMS + n_attn + n_sg;
  const int bid = bid_l();
  bool first = bid < SCAN_ITEMS;
  for (;;) {
    int it;
    if (first) {
      it = bid;
      first = false;
    } else {
      if (tid_l() == 0) s_item = SCAN_ITEMS + atomicAdd(p.cnt + cidx, 1);
      __syncthreads();
      it = s_item;
      __syncthreads();
    }
    if (it >= total) break;
    if (it < SCAN_ITEMS) {
      int nr = SCAN_REP; asm volatile("" : "+s"(nr));
      for (int rr = 0; rr < nr; ++rr) scan_item(p, l, it, smem);
    } else if (it < SCAN_ITEMS + n_attn) {
      int nr = ATT_REP; asm volatile("" : "+s"(nr));
      for (int rr = 0; rr < nr; ++rr) { attn_item(p, it - SCAN_ITEMS, smem); __syncthreads(); }
    } else {
      int i2 = it - SCAN_ITEMS - n_attn;
      int nr = SG_REP; asm volatile("" : "+s"(nr));
      for (int rr = 0; rr < nr; ++rr) sgate_item(p, l, ck_lo + (i2 >> 2), i2 & 3, smem);
    }
  }
}

DEV void apost_phase(const P& p, int l, int mt_lo, char* smem) {
  const int tid = tid_l(), lane = tid & 63, wid = tid >> 6, l15 = lane & 15, quad = lane >> 4;
  for (int i = bid_l() * 256 + tid; i < MT; i += gridDim.x * 256) { p.rss1[i] = 0.f; p.rss2[i] = 0.f; }
  const int nit = (NMT - mt_lo) * 6;
  for (int it = bid_l(); it < nit; it += gridDim.x) {
    const int mt = mt_lo + it / 6;
    const int hh = it % 6;
    const int m0 = mt * 128;
    bf16x8 a[2][4];
#pragma unroll
    for (int mi = 0; mi < 2; ++mi)
#pragma unroll
      for (int ks = 0; ks < 4; ++ks)
        a[mi][ks] = *(const bf16x8*)(p.z + (size_t)(m0 + wid * 32 + mi * 16 + l15) * INC + 1280 + ks * 32 + quad * 8);
    {
      f32x4 acc[2][4];
#pragma unroll
      for (int mi = 0; mi < 2; ++mi)
#pragma unroll
        for (int ni = 0; ni < 4; ++ni) acc[mi][ni] = f32x4{0.f, 0.f, 0.f, 0.f};
#pragma unroll
      for (int ks = 0; ks < 4; ++ks) {
        bf16x8 bb[4];
#pragma unroll
        for (int ni = 0; ni < 4; ++ni)
          bb[ni] = *(const bf16x8*)(p.gUpT + ((size_t)l * 384 + hh * 64 + ni * 16 + l15) * 128 + ks * 32 + quad * 8);
#pragma unroll
        for (int mi = 0; mi < 2; ++mi)
#pragma unroll
          for (int ni = 0; ni < 4; ++ni) acc[mi][ni] = mfma16(bb[ni], a[mi][ks], acc[mi][ni]);
      }
      float bonv[2] = {0.f, 0.f};
      {
        float bon0 = 0.f, bon1 = 0.f;
        uint2 kraw[2][4], rraw[2][4];
#pragma unroll
        for (int mi = 0; mi < 2; ++mi)
#pragma unroll
          for (int ni = 0; ni < 4; ++ni) {
            const size_t ro = (size_t)(m0 + wid * 32 + mi * 16 + l15) * INC + hh * 64 + ni * 16 + quad * 4;
            rraw[mi][ni] = *(const uint2*)(p.z + ro);
            kraw[mi][ni] = *(const uint2*)(p.z + ro + 384);
          }
#pragma unroll
        for (int dd = 0; dd < 2; ++dd) {
          f32x4 aacc[2][4];
#pragma unroll
          for (int mi = 0; mi < 2; ++mi)
#pragma unroll
            for (int ni = 0; ni < 4; ++ni) aacc[mi][ni] = f32x4{0.f, 0.f, 0.f, 0.f};
#pragma unroll
          for (int ks = 0; ks < 2; ++ks) {
            bf16x8 af[2], bb2[4];
#pragma unroll
            for (int mi = 0; mi < 2; ++mi)
              af[mi] = *(const bf16x8*)(p.z + (size_t)(m0 + wid * 32 + mi * 16 + l15) * INC + 1216 + ks * 32 + quad * 8);
#pragma unroll
            for (int ni = 0; ni < 4; ++ni)
              bb2[ni] = *(const bf16x8*)(p.aUpT + ((size_t)(l * 2 + dd) * 384 + hh * 64 + ni * 16 + l15) * 64 + ks * 32 + quad * 8);
#pragma unroll
            for (int mi = 0; mi < 2; ++mi)
#pragma unroll
              for (int ni = 0; ni < 4; ++ni) aacc[mi][ni] = mfma16(bb2[ni], af[mi], aacc[mi][ni]);
          }
#pragma unroll
          for (int ni = 0; ni < 4; ++ni) {
            const int c = hh * 64 + ni * 16 + quad * 4;
            const float4 a04 = *(const float4*)(p.a0 + (size_t)(l * 2 + dd) * 384 + c);
            const float4 ka4 = *(const float4*)(p.k_a + l * 384 + c);
            const float4 rk4 = *(const float4*)(p.r_k + l * 384 + c);
#define BON_TERM(K_, R_, A0_, KA_, RK_, ACC_)                                              \
            {                                                                                 \
              const float av_ = sigmoidf_((A0_) + (ACC_));                                    \
              bsum += (R_) * ((K_) * (1.f + (av_ - 1.f) * (KA_))) * (RK_);                    \
            }
#pragma unroll
            for (int mi = 0; mi < 2; ++mi) {
              const uint2 kr = kraw[mi][ni], rr2 = rraw[mi][ni];
              float bsum = 0.f;
              BON_TERM(__uint_as_float(kr.x << 16), __uint_as_float(rr2.x << 16), a04.x, ka4.x, rk4.x, aacc[mi][ni][0])
              BON_TERM(__uint_as_float(kr.x & 0xffff0000u), __uint_as_float(rr2.x & 0xffff0000u), a04.y, ka4.y, rk4.y, aacc[mi][ni][1])
              BON_TERM(__uint_as_float(kr.y << 16), __uint_as_float(rr2.y << 16), a04.z, ka4.z, rk4.z, aacc[mi][ni][2])
              BON_TERM(__uint_as_float(kr.y & 0xffff0000u), __uint_as_float(rr2.y & 0xffff0000u), a04.w, ka4.w, rk4.w, aacc[mi][ni][3])
              if (mi == 0) bon0 += bsum; else bon1 += bsum;
            }
#undef BON_TERM
          }
        }
        bonv[0] = bon0; bonv[1] = bon1;
#pragma unroll
        for (int mi = 0; mi < 2; ++mi) {
          bonv[mi] += __shfl_xor(bonv[mi], 16);
          bonv[mi] += __shfl_xor(bonv[mi], 32);
        }
      }
      float4 lg[4], lb[4];
#pragma unroll
      for (int ni = 0; ni < 4; ++ni) {
        lg[ni] = *(const float4*)(p.ln_g + l * 384 + hh * 64 + ni * 16 + quad * 4);
        lb[ni] = *(const float4*)(p.ln_b + l * 384 + hh * 64 + ni * 16 + quad * 4);
      }
#pragma unroll
      for (int mi = 0; mi < 2; ++mi) {
        const int r = m0 + wid * 32 + mi * 16 + l15;
        float4 ys[4];
        uint2 vraw[4];
        float sm = 0.f;
#pragma unroll
        for (int ni = 0; ni < 4; ++ni) {
          const int c = hh * 64 + ni * 16 + quad * 4;
          const float4 y0 = *(const float4*)(p.y + (size_t)r * 384 + c);
          const float4 y1 = *(const float4*)(p.y + ((size_t)MT + r) * 384 + c);
          ys[ni] = make_float4(y0.x + y1.x, y0.y + y1.y, y0.z + y1.z, y0.w + y1.w);
          vraw[ni] = *(const uint2*)(p.z + (size_t)r * INC + 768 + c);
          sm += (ys[ni].x + ys[ni].y) + (ys[ni].z + ys[ni].w);
        }
        const float bon = bonv[mi];
        sm += __shfl_xor(sm, 16);
        sm += __shfl_xor(sm, 32);
        const float mean = sm * (1.f / 64.f);
        float vs = 0.f;
#pragma unroll
        for (int ni = 0; ni < 4; ++ni) {
          ys[ni].x -= mean; ys[ni].y -= mean; ys[ni].z -= mean; ys[ni].w -= mean;
          vs += ys[ni].x * ys[ni].x + ys[ni].y * ys[ni].y + ys[ni].z * ys[ni].z + ys[ni].w * ys[ni].w;
        }
        vs += __shfl_xor(vs, 16);
        vs += __shfl_xor(vs, 32);
        const float rstd = rsqrtf(vs * (1.f / 64.f) + 64e-5f);
#pragma unroll
        for (int ni = 0; ni < 4; ++ni) {
          const int c = hh * 64 + ni * 16 + quad * 4;
          const float v0 = __uint_as_float(vraw[ni].x << 16), v1 = __uint_as_float(vraw[ni].x & 0xffff0000u);
          const float v2 = __uint_as_float(vraw[ni].y << 16), v3 = __uint_as_float(vraw[ni].y & 0xffff0000u);
          const float o0 = (ys[ni].x * rstd * lg[ni].x + lb[ni].x + bon * v0) * acc[mi][ni][0];
          const float o1 = (ys[ni].y * rstd * lg[ni].y + lb[ni].y + bon * v1) * acc[mi][ni][1];
          const float o2 = (ys[ni].z * rstd * lg[ni].z + lb[ni].z + bon * v2) * acc[mi][ni][2];
          const float o3 = (ys[ni].w * rstd * lg[ni].w + lb[ni].w + bon * v3) * acc[mi][ni][3];
          *(uint2*)(p.act + (size_t)r * DM + c) = make_uint2(pk2(o0, o1), pk2(o2, o3));
        }
        __builtin_amdgcn_sched_barrier(0);
      }
    }
  }
}

DEV uint2 ld8(const u16* q) { return *(const uint2*)q; }
DEV void up4(const uint2 u, float (&f)[4]) {
  f[0] = __uint_as_float(u.x << 16); f[1] = __uint_as_float(u.x & 0xffff0000u);
  f[2] = __uint_as_float(u.y << 16); f[3] = __uint_as_float(u.y & 0xffff0000u);
}
DEV void prep_phase(const P& p, int l, XcdBarrier& xb) {
  const int tid = tid_l(), lane = tid & 63, l15 = lane & 15;
  const int nb = gridDim.x, bid = bid_l();
  constexpr int NR = 8;
  const int rpb = (((MT + nb - 1) / nb) + NR - 1) & ~(NR - 1);
  const int ra = bid * rpb;
  const int rb = min(ra + rpb, MT);
  const bool active = ra < MT;
  const bool has1 = tid < 96;
  const int col0 = tid * 4, col1 = 1024 + tid * 4;
  uint2 hp0 = make_uint2(0, 0), hn0 = hp0, hp1 = hp0, hn1 = hp0;
  if (active) {
    if (ra > 0) { hp0 = ld8(p.z + (size_t)(ra - 1) * INC + col0); if (has1) hp1 = ld8(p.z + (size_t)(ra - 1) * INC + col1); }
    if (rb < MT) { hn0 = ld8(p.z + (size_t)rb * INC + col0); if (has1) hn1 = ld8(p.z + (size_t)rb * INC + col1); }
  }
  xcd_barrier(xb);
  if (!active) return;
  const float* cw = p.conv + (size_t)l * 3 * 1408;
#pragma unroll 1
  for (int pass = 0; pass < 2; ++pass) {
    if (pass == 1 && !has1) break;
    const int col = pass ? col1 : col0;
    const int typ = col < 1152 ? 0 : (col < 1216 ? 1 : (col < 1280 ? 0 : 2));
    const bool isk = col >= 384 && col < 768;
    float c0[4], c1[4], c2[4], kk4[4];
#pragma unroll
    for (int e = 0; e < 4; ++e) {
      c0[e] = cw[col + e]; c1[e] = cw[1408 + col + e]; c2[e] = cw[2816 + col + e];
      kk4[e] = isk ? p.k_k[l * 384 + (col - 384) + e] : 0.f;
    }
    const int hh = isk ? (col - 384) >> 6 : 0;
    u16* zc = p.z + col;
    uint2 prev = pass ? hp1 : hp0;
    const uint2 halo_n = pass ? hn1 : hn0;
    uint2 cur = ld8(zc + (size_t)ra * INC);
    for (int r = ra; r < rb; r += NR) {
      uint2 w[NR + 2];
      w[0] = prev;
      w[1] = cur;
#pragma unroll
      for (int q = 0; q < NR; ++q) {
        const int rr = r + 1 + q;
        w[q + 2] = rr < rb ? ld8(zc + (size_t)rr * INC) : halo_n;
      }
#pragma unroll
      for (int q = 0; q < NR; ++q) {
        const int rr = r + q;
        const uint2 xp = w[q], xc = w[q + 1], xn = w[q + 2];
        const int tt = rr < MC ? (rr & 255) : ((rr - MC) & 4095);
        const int len = rr < MC ? 256 : 4096;
        const float mp = tt > 0 ? 1.f : 0.f, mn = tt < len - 1 ? 1.f : 0.f;
        float fp[4], fc[4], fn[4], o[4];
        up4(xp, fp); up4(xc, fc); up4(xn, fn);
#pragma unroll
        for (int e = 0; e < 4; ++e) {
          float v = fc[e] * c1[e] + mp * (fp[e] * c0[e]) + mn * (fn[e] * c2[e]);
          if (typ == 1) v = tanh_fast(v);
          else if (typ == 2) v = sigmoidf_(v);
          o[e] = v;
        }
        if (isk) {
          float q0 = o[0] * kk4[0], q1 = o[1] * kk4[1], q2 = o[2] * kk4[2], q3 = o[3] * kk4[3];
          float ss = red16_sum(q0 * q0 + q1 * q1 + q2 * q2 + q3 * q3);
          if (l15 == 0 && rr < rb) p.invn[(size_t)rr * 8 + hh] = 1.f / fmaxf(sqrtf(ss), 1e-12f);
        }
        if (rr < rb) *(uint2*)(zc + (size_t)rr * INC) = make_uint2(pk2(o[0], o[1]), pk2(o[2], o[3]));
      }
      prev = w[NR];
      cur = w[NR + 1];
    }
  }
}

__global__ void __launch_bounds__(256, 2) fwd_megakernel(P p, int ph_lo, int ph_hi) {
  __shared__ __attribute__((aligned(16))) char smem[65536 - 16];
  cg::grid_group grid = cg::this_grid();
  XcdBarrier xb = xcd_barrier_post(p.xbar);
  if (ph_hi < 0) grid.sync();
  for (int ph = ph_lo; ph < ph_hi; ++ph) {
    if (ph > ph_lo) xcd_barrier(xb);
    if (ph == 0) { phase0(p, smem); continue; }
    if (ph == 1) { phase0b(p, smem); continue; }
    if (ph == 2 + 6 * DEPTH) { final_norm(p); continue; }
    const int l = (ph - 2) / 6, sub = (ph - 2) % 6;
    const bool last = (l == DEPTH - 1);
    const int mt_lo = last ? 16 : 0;
    GX g0{};
    g0.rss_acc = nullptr; g0.aout = nullptr; g0.gnext = nullptr; g0.lmod = 0; g0.scoff = 0;
    if (sub == 0) {
      gemm_phase<EPI_Z>(p, l, p.act, DM, p.wIn + (size_t)l * 2560 * 1024, 1024, 20, 0, 0, smem, g0, 0);
    } else if (sub == 1) {
      prep_phase(p, l, xb);
      xcd_barrier(xb);
      mix_phase(p, l, smem, l);
    } else if (sub == 2) {
      apost_phase(p, l, mt_lo, smem);
    } else if (sub == 3 || sub == 5) {
      const bool g4 = sub == 5;
      GX gx{};
      gx.rss_acc = g4 ? p.rss1 : p.rss2;
      gx.aout = g4 ? (last ? nullptr : p.act) : p.act2;
      gx.gnext = g4 ? p.n1g + (last ? 0 : (l + 1) * DM) : p.n2g + l * DM;
      gx.lmod = g4 ? (last ? l : l + 1) : l;
      gx.scoff = g4 ? 1024 : 4096;
      gemm_phase<EPI_RES>(p, l, g4 ? p.h : p.act, g4 ? DFF : DM,
                          g4 ? p.w2t + (size_t)l * 1024 * 2816 : p.wOut + (size_t)l * 1024 * 1024, g4 ? 2816 : 1024, 8, mt_lo,
                          g4 ? 5120 : 2048, smem, gx, 0);
    } else {
      gemm_phase<EPI_SWIGLU>(p, l, p.act2, DM, p.w1t + (size_t)l * 5632 * 1024, 1024, 44, mt_lo, 0, smem, g0, 0);
    }
  }
}

extern "C" void kernel_launch(void* const* d_in, const int* in_sizes, int n_in, void* d_out, int out_size, void* d_ws,
                              size_t ws_size, hipStream_t stream) {
  static int grid_blocks = 0;
  if (!grid_blocks) {
    int dev = 0, cus = 0, per_cu = 0;
    hipGetDevice(&dev);
    hipDeviceGetAttribute(&cus, hipDeviceAttributeMultiprocessorCount, dev);
    hipOccupancyMaxActiveBlocksPerMultiprocessor(&per_cu, fwd_megakernel, 256, 0);
    if (per_cu > 2) per_cu = 2;
    if (per_cu < 1) per_cu = 1;
    grid_blocks = cus * per_cu;
  }
  P p{};
  const float* const* in = (const float* const*)d_in;
  p.x = in[0]; p.c = in[1]; p.ctx = in[2]; p.c_ctx = in[3]; p.n1g = in[4]; p.n2g = in[5]; p.ada_w = in[6]; p.ada_b = in[7];
  p.w_in = in[8]; p.conv = in[9]; p.w0 = in[10]; p.w_up = in[11]; p.a0 = in[12]; p.a_up = in[13]; p.g_up = in[14];
  p.k_k = in[15]; p.k_a = in[16]; p.r_k = in[17]; p.ln_g = in[18]; p.ln_b = in[19]; p.sgn = in[20]; p.sg_w = in[21];
  p.sg_b = in[22]; p.q_g = in[23]; p.k_g = in[24]; p.w_out = in[25]; p.w1 = in[26]; p.w2 = in[27]; p.fng = in[28];
  p.out = (float*)d_out;
  char* ws = (char*)d_ws;
  size_t off = 0;
  auto take = [&](size_t bytes) { char* r = ws + off; off += (bytes + 255) & ~(size_t)255; return r; };
  p.wIn = (u16*)take((size_t)4 * 2560 * 1024 * 2);
  p.wOut = (u16*)take((size_t)4 * 1024 * 1024 * 2);
  p.w1t = (u16*)take((size_t)4 * 5632 * 1024 * 2);
  p.w2t = (u16*)take((size_t)4 * 1024 * 2816 * 2);
  p.wUpT = (u16*)take((size_t)8 * 384 * 64 * 2);
  p.aUpT = (u16*)take((size_t)8 * 384 * 64 * 2);
  p.gUpT = (u16*)take((size_t)4 * 384 * 128 * 2);
  p.sgW = (u16*)take((size_t)16 * 128 * 128 * 2);
  p.mods = (float*)take((size_t)4 * 9 * 6144 * 4);
  p.rope = (float*)take(2048 * 4);
  p.cnt = (int*)take(256);
  p.xbar = (unsigned*)take((size_t)XCD_BAR_WORDS * 4);
  p.xc = (float*)take((size_t)MC * DM * 4);
  p.act = (u16*)take((size_t)MT * DM * 2);
  p.z = (u16*)take((size_t)MT * DFF * 2);
  p.h = p.z;
  p.vTl = (u16*)take((size_t)16 * 64 * SEQ * 2);
  p.vTc = (u16*)take((size_t)16 * 64 * CTXL * 2);
  p.y = (float*)take((size_t)2 * MT * 384 * 4);
  p.bonus = (float*)take((size_t)MT * 48 * 4);
  p.invn = (float*)take((size_t)MT * 8 * 4);
  p.rss1 = (float*)take((size_t)MT * 4);
  p.rss2 = (float*)take((size_t)MT * 4);
  p.bz = (float*)take((size_t)4 * 9 * 2560 * 4);
  p.bh = (float*)take((size_t)4 * 9 * 5632 * 4);
  p.act2 = (u16*)p.y;
  if (off > ws_size) { fprintf(stderr, "workspace too small: need %zu have %zu\n", off, ws_size); return; }
  int ph_lo = 0, ph_hi = 3 + 6 * DEPTH;
  (void)hipMemsetAsync(p.xbar, 0, (size_t)XCD_BAR_WORDS * 4, stream);
  void* args[] = {&p, &ph_lo, &ph_hi};
  hipError_t e = hipLaunchCooperativeKernel((void*)fwd_megakernel, dim3(grid_blocks), dim3(256), args, 0, stream);
  if (e != hipSuccess) fprintf(stderr, "cooperative launch failed: %s (grid %d)\n", hipGetErrorString(e), grid_blocks);
}
```
